# Optimizing an MI355X kernel written in HIP

```python
import math
import jax, jax.numpy as jnp
from jax import lax
import numpy as np

D_MODEL = 1024
BATCH = 8
SEQ = 4096
DEPTH = 4

GRID_W = 64
CTX_LEN = 256
D_FF = 4 * D_MODEL
CONV_K = 4
CONV_LEFT = 2
GDN_HEADS = 4
GDN_DK = 128
GDN_DV = 128
GDN_W = GDN_HEADS * GDN_DK
GDN_CHUNK = 64
LRU_W = D_MODEL - GDN_HEADS * GDN_DV
LRU_BLOCKS = 8
LRU_BW = LRU_W // LRU_BLOCKS
LRU_C = 8.0
EV_IN = 4 * GDN_W + 4 * GDN_HEADS + 2 * LRU_W
DIFF_HEADS = 8
DIFF_D = D_MODEL // DIFF_HEADS // 2
DIFF_DV = 2 * DIFF_D
Q_BLOCK = 128
ROPE_THETA = 10000.0
N_EVEN = (DEPTH + 1) // 2
N_ODD = DEPTH // 2
DEEPNORM_ALPHA = (2 * DEPTH) ** 0.25
DEEPNORM_BETA = (8 * DEPTH) ** -0.25
NORM_EPS = 1e-6

kernel_name = 'hybrid_gdn_rglru_diffattn_prefix_trunk'

F32 = jnp.float32


def _layernorm(x, g, b):
    xf = x.astype(F32)
    mu = jnp.mean(xf, -1, keepdims=True)
    var = jnp.mean(jnp.square(xf - mu), -1, keepdims=True)
    return ((xf - mu) * lax.rsqrt(var + NORM_EPS) * g + b).astype(x.dtype)


def _rmsnorm(x, g):
    xf = x.astype(F32)
    return xf * lax.rsqrt(jnp.mean(xf * xf, -1, keepdims=True) + NORM_EPS) * g.astype(F32)


def _l2norm(x):
    return x * lax.rsqrt(jnp.sum(x * x, -1, keepdims=True) + NORM_EPS)


def _modulate(h, shift, scale):
    return h * (1 + scale) + shift


def _dwconv(x, w):
    k = w.shape[0]
    return lax.conv_general_dilated(x, w[:, None, :], window_strides=(1,),
                                    padding=[(CONV_LEFT, k - 1 - CONV_LEFT)],
                                    dimension_numbers=('NWC', 'WIO', 'NWC'),
                                    feature_group_count=x.shape[-1])


def _axial_rope_tables(row, col):
    half = DIFF_D // 2
    inv = ROPE_THETA ** (-(jnp.arange(0, half, 2, dtype=F32) / half))
    ang_r = row.astype(F32)[:, None] * inv
    ang_c = col.astype(F32)[:, None] * inv
    ang = jnp.concatenate([ang_r, ang_r, ang_c, ang_c], axis=-1)
    return jnp.cos(ang), jnp.sin(ang)


def _rope(t, cos, sin):
    t1, t2, t3, t4 = jnp.split(t.astype(F32), 4, axis=-1)
    rot = jnp.concatenate([-t2, t1, -t4, t3], axis=-1)
    return (t.astype(F32) * cos + rot * sin).astype(t.dtype)


def _gdn_chunk(q, k, v, beta, g, s0):
    bsz, nh, L, _ = q.shape
    n = L // GDN_CHUNK
    chunks = lambda t: t.reshape(bsz, nh, n, GDN_CHUNK, *t.shape[3:])
    q, k, v, beta, g = chunks(q), chunks(k), chunks(v), chunks(beta), chunks(g)
    gam = jnp.cumsum(g, axis=-1)
    idx = jnp.arange(GDN_CHUNK)
    incl = idx[:, None] >= idx[None, :]
    strict = idx[:, None] > idx[None, :]
    decay = jnp.exp(jnp.where(incl, gam[..., :, None] - gam[..., None, :], -jnp.inf))
    kb = k * beta[..., None]
    a_strict = jnp.where(strict, jnp.einsum('bhnid,bhnjd->bhnij', kb, k) * decay, 0.0)
    eye = jnp.eye(GDN_CHUNK, dtype=F32)
    t_mat = lax.linalg.triangular_solve(eye + a_strict, jnp.broadcast_to(eye, a_strict.shape),
                                        left_side=True, lower=True, unit_diagonal=True)
    u = t_mat @ (v * beta[..., None])
    w = t_mat @ (kb * jnp.exp(gam)[..., None])
    qk = jnp.einsum('bhnid,bhnjd->bhnij', q, k) * decay
    q_dec = q * jnp.exp(gam)[..., None]
    k_dec = k * jnp.exp(gam[..., -1:] - gam)[..., None]
    c_dec = jnp.exp(gam[..., -1])

    def step(s, xs):
        u_c, w_c, qk_c, qd_c, kd_c, cd_c = xs
        v_new = u_c - w_c @ s
        o = qd_c @ s + qk_c @ v_new
        s = s * cd_c[..., None, None] + jnp.einsum('bhcd,bhce->bhde', kd_c, v_new)
        return s, o

    xs = tuple(jnp.moveaxis(t, 2, 0) for t in (u, w, qk, q_dec, k_dec, c_dec))
    s_fin, o = lax.scan(step, s0, xs)
    o = jnp.moveaxis(o, 0, 2).reshape(bsz, nh, L, -1)
    return o, s_fin


def _gdn_prep(qkv, a, b, conv_w, a_log, dt_bias):
    bsz, L, _ = qkv.shape
    qkv = jax.nn.silu(_dwconv(qkv, conv_w)).astype(F32)
    q, k, v = jnp.split(qkv, 3, axis=-1)
    heads = lambda t: t.reshape(bsz, L, GDN_HEADS, -1).transpose(0, 2, 1, 3)
    q = _l2norm(heads(q)) * GDN_DK ** -0.5
    k = _l2norm(heads(k))
    v = heads(v)
    a = a.astype(F32).reshape(bsz, L, 2, GDN_HEADS)
    g = -jnp.exp(a_log.astype(F32)) * jax.nn.softplus(a + dt_bias.astype(F32))
    beta = jax.nn.sigmoid(b.astype(F32).reshape(bsz, L, 2, GDN_HEADS))
    return q, k, v, g.transpose(2, 0, 3, 1), beta.transpose(2, 0, 3, 1)


def _gdn_bidir(ctx_in, lat_in):
    qc, kc, vc, gc, bc = ctx_in
    ql, kl, vl, gl, bl = lat_in
    s0 = jnp.zeros((qc.shape[0], GDN_HEADS, GDN_DK, GDN_DV), F32)
    flip = lambda t: jnp.flip(t, axis=2)
    oc_f, s_f = _gdn_chunk(qc, kc, vc, bc[0], gc[0], s0)
    ol_f, _ = _gdn_chunk(ql, kl, vl, bl[0], gl[0], s_f)
    oc_b, s_b = _gdn_chunk(flip(qc), flip(kc), flip(vc), flip(bc[1]), flip(gc[1]), s0)
    ol_b, _ = _gdn_chunk(flip(ql), flip(kl), flip(vl), flip(bl[1]), flip(gl[1]), s_b)
    return oc_f + flip(oc_b), ol_f + flip(ol_b)


def _gdn_out(o, z, norm_g):
    bsz, _, L, _ = o.shape
    o = _rmsnorm(o.transpose(0, 2, 1, 3), norm_g)
    zz = jax.nn.silu(z.astype(F32)).reshape(bsz, L, GDN_HEADS, GDN_DV)
    return (o * zz).reshape(bsz, L, GDN_W)


def _lru_coeffs(xr, gate_w, gate_b, lam):
    bsz, L, _ = xr.shape
    xb = xr.reshape(bsz, L, LRU_BLOCKS, LRU_BW)
    gates = jnp.einsum('blnc,gncd->gblnd', xb, gate_w.astype(F32)).reshape(2, bsz, L, LRU_W)
    gates = gates + gate_b.astype(F32)[:, None, None, :]
    r = jax.nn.sigmoid(gates[0])
    i = jax.nn.sigmoid(gates[1])
    log_a = -LRU_C * r * jax.nn.softplus(-lam.astype(F32))
    a = jnp.exp(log_a)
    u = jnp.sqrt(-jnp.expm1(2.0 * log_a)) * (i * xr)
    return a, u


def _lin_scan(a, u, h0):
    u = u.at[:, 0].add(a[:, 0] * h0)
    comb = lambda l, r: (l[0] * r[0], r[0] * l[1] + r[1])
    _, h = lax.associative_scan(comb, (a, u), axis=1)
    return h


def _lru_bidir(xr_c, xr_l, gate_w, gate_b, lam):
    h0 = jnp.zeros((xr_c.shape[0], LRU_W), F32)
    flip = lambda t: jnp.flip(t, axis=1)
    a, u = _lru_coeffs(xr_c, gate_w[0], gate_b[0], lam[0])
    hc_f = _lin_scan(a, u, h0)
    a, u = _lru_coeffs(xr_l, gate_w[0], gate_b[0], lam[0])
    hl_f = _lin_scan(a, u, hc_f[:, -1])
    a, u = _lru_coeffs(flip(xr_c), gate_w[1], gate_b[1], lam[1])
    hc_b = _lin_scan(a, u, h0)
    a, u = _lru_coeffs(flip(xr_l), gate_w[1], gate_b[1], lam[1])
    hl_b = _lin_scan(a, u, hc_b[:, -1])
    return hc_f + flip(hc_b), hl_f + flip(hl_b)


def _even_mixer(u_ctx, u_lat, w_in, w_out, qkv_conv, a_log, dt_bias, gdn_norm,
                lru_conv_w, lru_conv_b, lru_gate_w, lru_gate_b, lru_lambda, need_ctx):
    cuts = [3 * GDN_W, 4 * GDN_W, 4 * GDN_W + 2 * GDN_HEADS, 4 * GDN_W + 4 * GDN_HEADS,
            4 * GDN_W + 4 * GDN_HEADS + LRU_W]

    def local(u):
        qkv, z, a, b, xr, gate = jnp.split(u @ w_in, cuts, axis=-1)
        gdn = _gdn_prep(qkv, a, b, qkv_conv, a_log, dt_bias)
        xr = (_dwconv(xr, lru_conv_w) + lru_conv_b).astype(F32)
        return gdn, z, xr, gate

    gdn_c, z_c, xr_c, gate_c = local(u_ctx)
    gdn_l, z_l, xr_l, gate_l = local(u_lat)
    o_c, o_l = _gdn_bidir(gdn_c, gdn_l)
    h_c, h_l = _lru_bidir(xr_c, xr_l, lru_gate_w, lru_gate_b, lru_lambda)

    def merge(o, z, h, gate, dtype):
        y = jnp.concatenate([_gdn_out(o, z, gdn_norm), h * jax.nn.gelu(gate.astype(F32))], axis=-1)
        return (y.astype(w_out.dtype) @ w_out).astype(dtype)

    y_lat = merge(o_l, z_l, h_l, gate_l, u_lat.dtype)
    y_ctx = merge(o_c, z_c, h_c, gate_c, u_ctx.dtype) if need_ctx else None
    return y_ctx, y_lat


def _diff_attend(q, k, v, lam):
    s = jnp.einsum('bqhmd,bkhmd->bhmqk', q, k).astype(F32) * DIFF_D ** -0.5
    p = jax.nn.softmax(s, axis=-1)
    p = p[:, :, 0] - lam * p[:, :, 1]
    return jnp.einsum('bhqk,bkhv->bqhv', p.astype(v.dtype), v)


def _diff_mixer(u_ctx, u_lat, w_qkv, w_out, lam_vec, subln, cos, sin, layer_idx, need_ctx):
    lam_init = 0.8 - 0.6 * math.exp(-0.3 * layer_idx)
    lv = lam_vec.astype(F32)
    lam = jnp.exp(jnp.sum(lv[0] * lv[1])) - jnp.exp(jnp.sum(lv[2] * lv[3])) + lam_init

    def heads(u):
        bsz, L, _ = u.shape
        q, k, v = jnp.split(u @ w_qkv, 3, axis=-1)
        return (q.reshape(bsz, L, DIFF_HEADS, 2, DIFF_D), k.reshape(bsz, L, DIFF_HEADS, 2, DIFF_D),
                v.reshape(bsz, L, DIFF_HEADS, DIFF_DV))

    qc, kc, vc = heads(u_ctx)
    ql, kl, vl = heads(u_lat)
    cb, sb = cos[None, :, None, None, :], sin[None, :, None, None, :]
    ql, kl = _rope(ql, cb, sb), _rope(kl, cb, sb)
    k_all = jnp.concatenate([kc, kl], axis=1)
    v_all = jnp.concatenate([vc, vl], axis=1)
    bsz, L = ql.shape[:2]
    nb = L // Q_BLOCK
    qb = jnp.moveaxis(ql.reshape(bsz, nb, Q_BLOCK, DIFF_HEADS, 2, DIFF_D), 1, 0)
    o_l = lax.map(lambda qblk: _diff_attend(qblk, k_all, v_all, lam), qb)
    o_l = jnp.moveaxis(o_l, 0, 1).reshape(bsz, L, DIFF_HEADS, DIFF_DV)

    def out(o, dtype):
        y = _rmsnorm(o, subln) * (1.0 - lam_init)
        y = y.reshape(o.shape[0], o.shape[1], D_MODEL).astype(w_out.dtype)
        return (y @ w_out).astype(dtype)

    y_lat = out(o_l, u_lat.dtype)
    y_ctx = out(_diff_attend(qc, kc, vc, lam), u_ctx.dtype) if need_ctx else None
    return y_ctx, y_lat


def _mlp(u, w1, w2):
    return jnp.square(jax.nn.relu(u @ w1)) @ w2


def setup_inputs(seed: int = 0) -> dict:
    key = jax.random.key(seed)
    ks = jax.random.split(key, 24)
    nrm = lambda k, shape, s: jax.random.normal(k, shape, F32) * s
    x = nrm(ks[0], (BATCH, SEQ, D_MODEL), 1.0)
    c = nrm(ks[1], (BATCH, D_MODEL), 1.0)
    ctx = nrm(ks[2], (BATCH, CTX_LEN, D_MODEL), 1.0)
    c_ctx = nrm(ks[3], (D_MODEL,), 1.0)
    ada_w = nrm(ks[4], (DEPTH, D_MODEL, 6 * D_MODEL), 0.5 * D_MODEL ** -0.5)
    ada_b = nrm(ks[5], (DEPTH, 6 * D_MODEL), 0.02)
    ln_g = 1.0 + nrm(ks[6], (DEPTH, 2, D_MODEL), 0.02)
    ln_b = nrm(ks[7], (DEPTH, 2, D_MODEL), 0.02)
    mlp_w1 = nrm(ks[8], (DEPTH, D_MODEL, D_FF), D_MODEL ** -0.5)
    mlp_w2 = nrm(ks[9], (DEPTH, D_FF, D_MODEL), DEEPNORM_BETA * D_FF ** -0.5)
    mix_w_out = nrm(ks[10], (DEPTH, D_MODEL, D_MODEL), DEEPNORM_BETA * D_MODEL ** -0.5)
    ev_w_in = nrm(ks[11], (N_EVEN, D_MODEL, EV_IN), D_MODEL ** -0.5)
    ev_qkv_conv = nrm(ks[12], (N_EVEN, CONV_K, 3 * GDN_W), CONV_K ** -0.5)
    ev_a_log = jnp.log(jax.random.uniform(ks[13], (N_EVEN, 2, GDN_HEADS), F32, 1.0, 16.0))
    dt = jnp.exp(jax.random.uniform(ks[14], (N_EVEN, 2, GDN_HEADS), F32, math.log(1e-3), math.log(1e-1)))
    ev_dt_bias = dt + jnp.log(-jnp.expm1(-dt))
    ev_gdn_norm = 1.0 + nrm(ks[15], (N_EVEN, GDN_DV), 0.02)
    ev_lru_conv_w = nrm(ks[16], (N_EVEN, CONV_K, LRU_W), CONV_K ** -0.5)
    ev_lru_conv_b = nrm(ks[17], (N_EVEN, LRU_W), 0.02)
    ev_lru_gate_w = nrm(ks[18], (N_EVEN, 2, 2, LRU_BLOCKS, LRU_BW, LRU_BW), LRU_BW ** -0.5)
    ev_lru_gate_b = nrm(ks[19], (N_EVEN, 2, 2, LRU_W), 0.02)
    a_c = jax.random.uniform(ks[20], (N_EVEN, 2, LRU_W), F32, 0.9, 0.999)
    sig = a_c ** (1.0 / LRU_C)
    ev_lru_lambda = jnp.log(sig) - jnp.log1p(-sig)
    od_w_qkv = nrm(ks[21], (N_ODD, D_MODEL, 3 * D_MODEL), D_MODEL ** -0.5)
    od_lambda = nrm(ks[22], (N_ODD, 4, DIFF_D), 0.1)
    od_subln = 1.0 + nrm(ks[23], (N_ODD, DIFF_DV), 0.02)
    return {'x': x, 'c': c, 'ctx': ctx, 'c_ctx': c_ctx, 'ada_w': ada_w, 'ada_b': ada_b,
            'ln_g': ln_g, 'ln_b': ln_b, 'mlp_w1': mlp_w1, 'mlp_w2': mlp_w2, 'mix_w_out': mix_w_out,
            'ev_w_in': ev_w_in, 'ev_qkv_conv': ev_qkv_conv, 'ev_a_log': ev_a_log, 'ev_dt_bias': ev_dt_bias,
            'ev_gdn_norm': ev_gdn_norm, 'ev_lru_conv_w': ev_lru_conv_w, 'ev_lru_conv_b': ev_lru_conv_b,
            'ev_lru_gate_w': ev_lru_gate_w, 'ev_lru_gate_b': ev_lru_gate_b, 'ev_lru_lambda': ev_lru_lambda,
            'od_w_qkv': od_w_qkv, 'od_lambda': od_lambda, 'od_subln': od_subln}


def reference(x, c, ctx, c_ctx, ada_w, ada_b, ln_g, ln_b, mlp_w1, mlp_w2, mix_w_out,
              ev_w_in, ev_qkv_conv, ev_a_log, ev_dt_bias, ev_gdn_norm, ev_lru_conv_w, ev_lru_conv_b,
              ev_lru_gate_w, ev_lru_gate_b, ev_lru_lambda, od_w_qkv, od_lambda, od_subln):
    n_lat = x.shape[1]
    rows = n_lat // GRID_W
    row = jnp.repeat(jnp.arange(rows), GRID_W)
    col = jnp.tile(jnp.arange(GRID_W), rows)
    cos, sin = _axial_rope_tables(row, col)
    silu_c = jax.nn.silu(c)
    silu_cc = jax.nn.silu(c_ctx)
    h_lat, h_ctx = x, ctx
    for i in range(DEPTH):
        last = i == DEPTH - 1
        m_l = [m[:, None, :] for m in jnp.split(silu_c @ ada_w[i] + ada_b[i], 6, axis=-1)]
        m_c = jnp.split(silu_cc @ ada_w[i] + ada_b[i], 6, axis=-1)
        u_l = _modulate(h_lat, m_l[0], m_l[1])
        u_c = _modulate(h_ctx, m_c[0], m_c[1])
        j = i // 2
        if i % 2 == 0:
            y_c, y_l = _even_mixer(u_c, u_l, ev_w_in[j], mix_w_out[i], ev_qkv_conv[j], ev_a_log[j],
                                   ev_dt_bias[j], ev_gdn_norm[j], ev_lru_conv_w[j], ev_lru_conv_b[j],
                                   ev_lru_gate_w[j], ev_lru_gate_b[j], ev_lru_lambda[j], not last)
        else:
            y_c, y_l = _diff_mixer(u_c, u_l, od_w_qkv[j], mix_w_out[i], od_lambda[j], od_subln[j],
                                   cos, sin, i, not last)
        h_lat = _layernorm(DEEPNORM_ALPHA * h_lat + m_l[2] * y_l, ln_g[i, 0], ln_b[i, 0])
        f_l = _mlp(_modulate(h_lat, m_l[3], m_l[4]), mlp_w1[i], mlp_w2[i])
        h_lat = _layernorm(DEEPNORM_ALPHA * h_lat + m_l[5] * f_l, ln_g[i, 1], ln_b[i, 1])
        if not last:
            h_ctx = _layernorm(DEEPNORM_ALPHA * h_ctx + m_c[2] * y_c, ln_g[i, 0], ln_b[i, 0])
            f_c = _mlp(_modulate(h_ctx, m_c[3], m_c[4]), mlp_w1[i], mlp_w2[i])
            h_ctx = _layernorm(DEEPNORM_ALPHA * h_ctx + m_c[5] * f_c, ln_g[i, 1], ln_b[i, 1])
    return h_lat
```

```cpp
#include <hip/hip_runtime.h>
#include <hip/hip_cooperative_groups.h>
#include <cstdio>
#include <cstdint>
namespace cg = cooperative_groups;

#define LAS __attribute__((address_space(3)))
typedef unsigned short bf16_t;
typedef short bf16x8 __attribute__((ext_vector_type(8)));
typedef float f32x4 __attribute__((ext_vector_type(4)));
typedef float f32x2 __attribute__((ext_vector_type(2)));
typedef float f32x16 __attribute__((ext_vector_type(16)));
typedef unsigned u32x4 __attribute__((ext_vector_type(4)));
typedef unsigned u32x2 __attribute__((ext_vector_type(2)));
typedef __bf16 bf16x2_t __attribute__((ext_vector_type(2)));

constexpr int D = 1024, NB = 8, SEQ = 4096, CTXL = 256, FF = 4096;
constexpr int ML = NB * SEQ, MC = NB * CTXL, MT = ML + MC;
constexpr int EVN = 3088, EVNP = 3328, ODN = 3072;
constexpr float ALPHA = 1.6817928305074292f;
constexpr float EPS = 1e-6f;
constexpr int NKV = CTXL + SEQ;
constexpr float QSCALE = 0.125f * 1.4426950408889634f;

constexpr size_t MiB = 1u << 20;
constexpr size_t WS_MISC = 0;
constexpr size_t WS_BAR = 65536;
constexpr size_t WS_MOD = 1 * MiB;
constexpr size_t WS_WA = 2 * MiB;
constexpr size_t WS_WO = 9 * MiB;
constexpr size_t WS_W1 = 11 * MiB;
constexpr size_t WS_W2 = 19 * MiB;
constexpr size_t WS_HC = 27 * MiB;
constexpr size_t WS_U = 35 * MiB;
constexpr size_t WS_P = 103 * MiB;
constexpr size_t WS_X = 324 * MiB;
constexpr size_t WS_V = WS_X;
constexpr size_t WS_OF = WS_X + 34 * MiB;
constexpr size_t WS_OB = WS_X + 68 * MiB;
constexpr size_t WS_G = WS_X + 102 * MiB;
constexpr size_t WS_BT = WS_X + 104 * MiB;
constexpr size_t WS_TOTA = WS_X + 106 * MiB;
constexpr size_t WS_TOTH = WS_X + 109 * MiB;
constexpr size_t WS_CARRY = WS_X + 112 * MiB;
constexpr size_t WS_HLAST = 375 * MiB;
constexpr size_t WS_PART = 376 * MiB;
constexpr size_t WS_TB = WS_X + 116 * MiB;
constexpr size_t WS_QKB = WS_X + 150 * MiB;
constexpr size_t WS_GAM = WS_X + 184 * MiB;
constexpr size_t WS_END = WS_X + 186 * MiB;

constexpr int LDS_BYTES = 147456;

__device__ __forceinline__ float bf2f(unsigned v) { return __uint_as_float(v << 16); }
__device__ __forceinline__ unsigned pk2(float lo, float hi) { f32x2 v = {lo, hi}; bf16x2_t b = __builtin_convertvector(v, bf16x2_t); return __builtin_bit_cast(unsigned, b); }
__device__ __forceinline__ unsigned f2bf(float f) { return pk2(f, 0.f) & 0xffffu; }
__device__ __forceinline__ void unpack8(const u32x4 r, float* o) {
    o[0] = __uint_as_float(r.x << 16); o[1] = __uint_as_float(r.x & 0xffff0000u);
    o[2] = __uint_as_float(r.y << 16); o[3] = __uint_as_float(r.y & 0xffff0000u);
    o[4] = __uint_as_float(r.z << 16); o[5] = __uint_as_float(r.z & 0xffff0000u);
    o[6] = __uint_as_float(r.w << 16); o[7] = __uint_as_float(r.w & 0xffff0000u);
}
__device__ __forceinline__ u32x4 pack8(const float* v) { u32x4 o; o.x = pk2(v[0], v[1]); o.y = pk2(v[2], v[3]); o.z = pk2(v[4], v[5]); o.w = pk2(v[6], v[7]); return o; }
__device__ __forceinline__ float sigmoidf_(float x) { return 1.f / (1.f + expf(-x)); }
__device__ __forceinline__ float siluf_(float x) { return x / (1.f + expf(-x)); }
__device__ __forceinline__ float fsigmoid(float x) { return __builtin_amdgcn_rcpf(1.0f + __builtin_amdgcn_exp2f(-1.4426950408889634f * x)); }
__device__ __forceinline__ float fsilu(float x) { return x * fsigmoid(x); }
__device__ __forceinline__ float softplusf_(float x) { return fmaxf(x, 0.f) + log1pf(expf(-fabsf(x))); }
__device__ __forceinline__ float gelu_tanh(float x) { const float u = 0.7978845608028654f * (x + 0.044715f * x * x * x); return 0.5f * x * (1.f + tanhf(u)); }
__device__ __forceinline__ float dppf(float v, const int ctrl_sel) {
    int r;
    if (ctrl_sel == 0) r = __builtin_amdgcn_update_dpp(0, __float_as_int(v), 0xB1, 0xF, 0xF, true);
    else if (ctrl_sel == 1) r = __builtin_amdgcn_update_dpp(0, __float_as_int(v), 0x4E, 0xF, 0xF, true);
    else if (ctrl_sel == 2) r = __builtin_amdgcn_update_dpp(0, __float_as_int(v), 0x141, 0xF, 0xF, true);
    else r = __builtin_amdgcn_update_dpp(0, __float_as_int(v), 0x140, 0xF, 0xF, true);
    return __int_as_float(r);
}
__device__ __forceinline__ float rowsum16(float v) { v += dppf(v, 0); v += dppf(v, 1); v += dppf(v, 2); v += dppf(v, 3); return v; }
__device__ __forceinline__ float wave_sum(float v) {
#pragma unroll
    for (int o = 1; o < 64; o <<= 1) v += __shfl_xor(v, o);
    return v;
}
__device__ __forceinline__ float xhalf_max(float v) { auto rr = __builtin_amdgcn_permlane32_swap(__float_as_uint(v), __float_as_uint(v), false, false); return fmaxf(__uint_as_float(rr[0]), __uint_as_float(rr[1])); }
__device__ __forceinline__ float xhalf_sum(float v) { auto rr = __builtin_amdgcn_permlane32_swap(__float_as_uint(v), __float_as_uint(v), false, false); return __uint_as_float(rr[0]) + __uint_as_float(rr[1]); }
#define LDS_WAIT() asm volatile("s_waitcnt lgkmcnt(0)" ::: "memory")

namespace pg8 {
constexpr int BM = 256, BK = 64, HALF = 128, HTB = HALF * BK * 2, STAGE_BYTES = 8 * HTB, NXCD = 8, WGM = 8;
__host__ __device__ __forceinline__ int lds_byte(int r, int c) { const int st = (r >> 4) * 2 + (c >> 5), rr = r & 15, cc = c & 31, ob = rr * 64 + cc * 2; return st * 1024 + (ob ^ (((ob >> 9) & 1) << 5)); }
__host__ __device__ __forceinline__ void stage_rc(int b, int& R, int& C) { const int st = b / 1024, sb = b % 1024, swz = sb ^ (((sb >> 9) & 1) << 5); R = (st >> 1) * 16 + swz / 64; C = (st & 1) * 32 + (swz % 64) / 2; }
__host__ __device__ __forceinline__ int perm32(int rho) { const int n = rho >> 4, i = rho & 15; return 8 * (i >> 2) + 4 * n + (i & 3); }
struct Unit { int pm, pn, ks; };
struct Gemm { const bf16_t* A; const bf16_t* Bt; int M, N, K, lda, ldb, nks; };
struct StaticOrder {
    int nM, nN, nwg, G, c;
    int nks;
    __device__ void init(int M, int N, int G_, int c_, int nks_) { nM = M / BM; nN = N / BM; nwg = nM * nN; G = G_; c = c_; nks = nks_; }
    __device__ bool next(int i, Unit& u) const {
        const long L = (long)i * G + c; if (L >= (long)nwg * nks) return false;
        u.ks = (int)(L % nks); int wgid = (int)(L / nks); { const int q = nwg / NXCD, r = nwg % NXCD, xcd = wgid % NXCD, off = wgid / NXCD; wgid = (xcd < r ? xcd * (q + 1) : r * (q + 1) + (xcd - r) * q) + off; }
        const int nig = WGM * nN, gid = wgid / nig, fm = gid * WGM, gsz = (nM - fm) < WGM ? (nM - fm) : WGM;
        u.pm = fm + ((wgid % nig) % gsz); u.pn = (wgid % nig) / gsz; return true;
    }
};
struct EpiBf16 {
    static constexpr bool PERM = true;
    bf16_t* O; int ldc; int act; const float* gate; int bb_force; size_t ks_stride;
    __device__ __forceinline__ void operator()(const f32x4 (&acc)[2][2][4][2], const Unit& u, int wr, int wc, int fr, int fq) const {
        const int rt = u.pm * BM; const int bb = bb_force >= 0 ? bb_force : (rt >= ML ? 8 : (rt >> 12));
        const int row0 = rt + wr * 64 + fr; const int col0 = u.pn * BM + wc * 32 + 8 * fq;
        f32x4 gv[2][2];
#pragma unroll
        for (int bj = 0; bj < 2; ++bj)
#pragma unroll
            for (int n = 0; n < 2; ++n) gv[bj][n] = gate ? *(const f32x4*)(gate + bb * 6144 + col0 + bj * HALF + 4 * n) : (f32x4){1.f, 1.f, 1.f, 1.f};
#pragma unroll
        for (int ai = 0; ai < 2; ++ai)
#pragma unroll
            for (int m = 0; m < 4; ++m) { bf16_t* rowp = O + (size_t)u.ks * ks_stride + (size_t)(row0 + ai * HALF + m * 16) * ldc + col0;
#pragma unroll
                for (int bj = 0; bj < 2; ++bj) { f32x4 v0 = acc[ai][bj][m][0], v1 = acc[ai][bj][m][1];
                    if (act == 2) {
#pragma unroll
                        for (int e = 0; e < 4; ++e) { float a0 = fmaxf(v0[e], 0.f), a1 = fmaxf(v1[e], 0.f); v0[e] = a0 * a0; v1[e] = a1 * a1; } }
                    v0 = v0 * gv[bj][0]; v1 = v1 * gv[bj][1];
                    u32x4 w; w.x = pk2(v0[0], v0[1]); w.y = pk2(v0[2], v0[3]); w.z = pk2(v1[0], v1[1]); w.w = pk2(v1[2], v1[3]);
                    *(u32x4*)(rowp + bj * HALF) = w; } }
    }
};

template <class Epi>
__device__ __forceinline__ void gemm_phase(LAS unsigned char* lds, const Gemm g, const StaticOrder& S, const Epi& E, const int tid) {
    const int wid = __builtin_amdgcn_readfirstlane(tid >> 6), lane = tid & 63, wr = wid >> 2, wc = wid & 3, fr = lane & 15, fq = lane >> 4;
    const int K = g.K, nt = K / BK;
    unsigned voffA[2], voffB[2];
#pragma unroll
    for (int i = 0; i < 2; ++i) { int R, C; stage_rc(tid * 16 + i * 8192, R, C); const int Rb = Epi::PERM ? ((R & ~31) + perm32(R & 31)) : R;
        voffA[i] = (unsigned)(R * g.lda + C) * 2u; voffB[i] = (unsigned)(Rb * g.ldb + C) * 2u; }
    const size_t kstep = (size_t)(BK * 2);
    const size_t hA = (size_t)HALF * g.lda * 2, hB = (size_t)HALF * g.ldb * 2, kso = (size_t)K * 2;
    const size_t tA = 2 * hA, tB = 2 * hB;
    const unsigned ldsw = (unsigned)wid * 1024u;
    const int aoff = lds_byte(wr * 64 + fr, fq * 8), boff = lds_byte(wc * 32 + fr, fq * 8);
#define PG8_SA(b, h) (((b) * 2 + (h)) * HTB)
#define PG8_SB(b, h) ((4 + (b) * 2 + (h)) * HTB)
#define PG8_STAGE(bufoff, gbase, voff) do { _Pragma("unroll") for (int _i = 0; _i < 2; ++_i) \
        __builtin_amdgcn_global_load_lds((const unsigned*)((const char*)(gbase) + (voff)[_i]), (LAS unsigned*)(lds + (bufoff) + ldsw + _i * 8192), 16, 0, 0); } while (0)
#define PG8_LDA(dst, b, h) do { _Pragma("unroll") for (int m = 0; m < 4; ++m) _Pragma("unroll") for (int k = 0; k < 2; ++k) dst[m][k] = *(const LAS bf16x8*)(lds + PG8_SA(b, h) + aoff + m * 2048 + k * 1024); } while (0)
#define PG8_LDB(dst, b, h) do { _Pragma("unroll") for (int n = 0; n < 2; ++n) _Pragma("unroll") for (int k = 0; k < 2; ++k) dst[n][k] = *(const LAS bf16x8*)(lds + PG8_SB(b, h) + boff + n * 2048 + k * 1024); } while (0)
#define PG8_MMA(ai, bj, At, Bt) do { __builtin_amdgcn_s_setprio(1); _Pragma("unroll") for (int m = 0; m < 4; ++m) _Pragma("unroll") for (int n = 0; n < 2; ++n) _Pragma("unroll") for (int k = 0; k < 2; ++k) \
        acc[ai][bj][m][n] = __builtin_amdgcn_mfma_f32_16x16x32_bf16(Bt[n][k], At[m][k], acc[ai][bj][m][n], 0, 0, 0); __builtin_amdgcn_s_setprio(0); } while (0)
#define PG8_WAIT_V(n) asm volatile("s_waitcnt vmcnt(" #n ")" ::: "memory")
#define PG8_WAIT_L(n) asm volatile("s_waitcnt lgkmcnt(" #n ")" ::: "memory")
#define PG8_BAR __builtin_amdgcn_s_barrier()
#define PG8_SCHED __builtin_amdgcn_sched_barrier(0)
    Unit cur, nxt; int ui = 0;
    if (!S.next(0, cur)) return;
    f32x4 acc[2][2][4][2];
#pragma unroll
    for (int a = 0; a < 2; ++a)
#pragma unroll
        for (int b = 0; b < 2; ++b)
#pragma unroll
            for (int m = 0; m < 4; ++m)
#pragma unroll
                for (int n = 0; n < 2; ++n) acc[a][b][m][n] = (f32x4){0.f, 0.f, 0.f, 0.f};
    bf16x8 At[4][2], B0[2][2], B1[2][2];
    const char* cA = (const char*)g.A + (size_t)cur.pm * tA + cur.ks * kso; const char* cB = (const char*)g.Bt + (size_t)cur.pn * tB + cur.ks * kso;
    PG8_STAGE(PG8_SB(0, 0), cB, voffB); PG8_STAGE(PG8_SB(0, 1), cB + hB, voffB); PG8_STAGE(PG8_SA(0, 0), cA, voffA); PG8_STAGE(PG8_SA(0, 1), cA + hA, voffA);
    if (wr == 1) PG8_BAR;
    PG8_WAIT_V(2); PG8_BAR;
    PG8_STAGE(PG8_SB(1, 0), cB + kstep, voffB); PG8_STAGE(PG8_SA(1, 0), cA + kstep, voffA); PG8_STAGE(PG8_SB(1, 1), cB + hB + kstep, voffB);
    PG8_WAIT_V(6); PG8_BAR;
    for (;;) {
        const bool has_next = S.next(ui + 1, nxt);
        const char* nA = has_next ? (const char*)g.A + (size_t)nxt.pm * tA + nxt.ks * kso : cA; const char* nB = has_next ? (const char*)g.Bt + (size_t)nxt.pn * tB + nxt.ks * kso : cB;
        for (int t = 0; t < nt; t += 2) {
            const bool last = (t == nt - 2);
            const char* a1 = cA + (size_t)(t + 1) * kstep;
            const char* a2 = last ? nA : cA + (size_t)(t + 2) * kstep; const char* b2 = last ? nB : cB + (size_t)(t + 2) * kstep;
            const char* a3 = a2 + kstep; const char* b3 = b2 + kstep;
            PG8_LDB(B0, 0, 0); PG8_LDB(B1, 0, 1); PG8_SCHED; PG8_LDA(At, 0, 0); PG8_STAGE(PG8_SA(1, 1), a1 + hA, voffA);
            PG8_WAIT_V(8); PG8_WAIT_L(0); PG8_BAR; PG8_MMA(0, 0, At, B0); PG8_MMA(0, 1, At, B1); PG8_BAR; PG8_SCHED;
            PG8_LDA(At, 0, 1); PG8_STAGE(PG8_SB(0, 0), b2, voffB); PG8_STAGE(PG8_SB(0, 1), b2 + hB, voffB); PG8_STAGE(PG8_SA(0, 0), a2, voffA);
            PG8_WAIT_V(8); PG8_WAIT_L(0); PG8_BAR; PG8_MMA(1, 0, At, B0); PG8_MMA(1, 1, At, B1); PG8_BAR; PG8_SCHED;
            PG8_LDB(B0, 1, 0); PG8_LDB(B1, 1, 1); PG8_SCHED; PG8_LDA(At, 1, 0); PG8_STAGE(PG8_SA(0, 1), a2 + hA, voffA);
            PG8_WAIT_V(8); PG8_WAIT_L(0); PG8_BAR; PG8_MMA(0, 0, At, B0); PG8_MMA(0, 1, At, B1); PG8_BAR; PG8_SCHED;
            PG8_LDA(At, 1, 1); PG8_STAGE(PG8_SB(1, 0), b3, voffB); PG8_STAGE(PG8_SB(1, 1), b3 + hB, voffB); PG8_STAGE(PG8_SA(1, 0), a3, voffA);
            PG8_WAIT_V(8); PG8_WAIT_L(0); PG8_BAR; PG8_MMA(1, 0, At, B0); PG8_MMA(1, 1, At, B1); PG8_BAR; PG8_SCHED;
        }
        if (wr == 0) PG8_BAR;
        E(acc, cur, wr, wc, fr, fq);
        if (!has_next) break;
#pragma unroll
        for (int a = 0; a < 2; ++a)
#pragma unroll
            for (int b = 0; b < 2; ++b)
#pragma unroll
                for (int m = 0; m < 4; ++m)
#pragma unroll
                    for (int n = 0; n < 2; ++n) acc[a][b][m][n] = (f32x4){0.f, 0.f, 0.f, 0.f};
        cur = nxt; cA = nA; cB = nB; ++ui;
        if (wr == 1) PG8_BAR;
    }
    PG8_WAIT_V(0);
    PG8_BAR;
#undef PG8_SA
#undef PG8_SB
#undef PG8_STAGE
#undef PG8_LDA
#undef PG8_LDB
#undef PG8_MMA
#undef PG8_WAIT_V
#undef PG8_WAIT_L
#undef PG8_BAR
#undef PG8_SCHED
}
}

struct Args { const float* in[24]; float* out; unsigned char* ws; int ph_lo, ph_hi; };
typedef const __attribute__((address_space(4))) Args* KA;
enum { I_X = 0, I_C, I_CTX, I_CCTX, I_ADAW, I_ADAB, I_LNG, I_LNB, I_W1, I_W2, I_WOUT, I_EVWIN, I_EVQKVCONV, I_EVALOG, I_EVDTB, I_EVGDNNORM,
       I_LRUCW, I_LRUCB, I_LRUGW, I_LRUGB, I_LRULAM, I_ODWQKV, I_ODLAM, I_ODSUBLN };
enum { K_PROA = 0, K_PROB, K_PROJ, K_E2, K_E3, K_E4, K_O2, K_O3, K_WOUT, K_LN1, K_MLP1, K_MLP2, K_LN2, K_E2B };
constexpr int N_PHASES = 2 + 10 + 8 + 10 + 8;

__device__ __forceinline__ void transpose_item(const float* W, int K, int N, int Npad, bf16_t* WT, LAS float* scr, int item, int lane) {
    const int nblk = Npad / 32, kb = item / nblk, nb = item % nblk, k0 = 64 * kb, n0 = 32 * nb;
    const int n = n0 + (lane & 31);
    { float wv[32];
#pragma unroll
      for (int i = 0; i < 32; ++i) { const int kk = 2 * i + (lane >> 5); wv[i] = (n < N) ? W[(size_t)(k0 + kk) * N + n] : 0.f; }
#pragma unroll
      for (int i = 0; i < 32; ++i) { const int kk = 2 * i + (lane >> 5); scr[kk * 33 + (lane & 31)] = wv[i]; } }
    LDS_WAIT();
    const int c = lane & 7;
#pragma unroll
    for (int j = 0; j < 4; ++j) { const int nn = (lane >> 3) + 8 * j; const LAS float* s = scr + (8 * c) * 33 + nn;
        u32x4 o; o.x = pk2(s[0 * 33], s[1 * 33]); o.y = pk2(s[2 * 33], s[3 * 33]); o.z = pk2(s[4 * 33], s[5 * 33]); o.w = pk2(s[6 * 33], s[7 * 33]);
        *(u32x4*)(WT + (size_t)(n0 + nn) * K + k0 + 8 * c) = o; }
    LDS_WAIT();
}
__device__ __forceinline__ void conv_weights(KA a, int L, LAS unsigned char* lds, int gw, int NGW, int wave, int lane) {
    LAS float* scr = (LAS float*)(lds + wave * 16384);
    const bool even = (L & 1) == 0; const int j2 = L >> 1;
    const float* Wa = even ? a->in[I_EVWIN] + (size_t)j2 * D * EVN : a->in[I_ODWQKV] + (size_t)j2 * D * ODN;
    const int Na = even ? EVN : ODN, Nap = even ? EVNP : ODN;
    const int IA = (D / 64) * (Nap / 32), IO = (D / 64) * (D / 32), I1 = (D / 64) * (FF / 32), I2 = (FF / 64) * (D / 32);
    bf16_t* WA = (bf16_t*)(a->ws + WS_WA); bf16_t* WO = (bf16_t*)(a->ws + WS_WO); bf16_t* W1 = (bf16_t*)(a->ws + WS_W1); bf16_t* W2 = (bf16_t*)(a->ws + WS_W2);
    for (int it = gw; it < IA + IO + I1 + I2; it += NGW) {
        int r = it;
        if (r < IA) { transpose_item(Wa, D, Na, Nap, WA, scr, r, lane); continue; } r -= IA;
        if (r < IO) { transpose_item(a->in[I_WOUT] + (size_t)L * D * D, D, D, D, WO, scr, r, lane); continue; } r -= IO;
        if (r < I1) { transpose_item(a->in[I_W1] + (size_t)L * D * FF, D, FF, FF, W1, scr, r, lane); continue; } r -= I1;
        transpose_item(a->in[I_W2] + (size_t)L * FF * D, FF, D, D, W2, scr, r, lane);
    }
}

__device__ __forceinline__ void modulate_row_store(const f32x4 (&v)[4], const float* mod_bb, int sidx, bf16_t* urow, int lane) {
#pragma unroll
    for (int j = 0; j < 4; ++j) { const int c = 4 * (lane + 64 * j);
        const f32x4 sh = *(const f32x4*)(mod_bb + sidx * D + c), sc = *(const f32x4*)(mod_bb + (sidx + 1) * D + c);
        const f32x4 u = v[j] * (sc + 1.0f) + sh; u32x2 w; w.x = pk2(u[0], u[1]); w.y = pk2(u[2], u[3]); *(u32x2*)(urow + c) = w; }
}
__device__ __forceinline__ void prologue_b(KA a, int gw, int NGW, int lane) {
    const float* MOD = (const float*)(a->ws + WS_MOD); bf16_t* U = (bf16_t*)(a->ws + WS_U);
    for (int row = gw; row < MT; row += NGW) {
        const bool isctx = row >= ML; const int bb = isctx ? 8 : (row >> 12);
        const float* hp = isctx ? a->in[I_CTX] + (size_t)(row - ML) * D : a->in[I_X] + (size_t)row * D;
        f32x4 v[4];
#pragma unroll
        for (int j = 0; j < 4; ++j) v[j] = *(const f32x4*)(hp + 4 * (lane + 64 * j));
        modulate_row_store(v, MOD + (size_t)(0 * 9 + bb) * 6144, 0, U + (size_t)row * D, lane);
    }
}
__device__ __forceinline__ void ln_row_finish(f32x4 (&v)[4], float s, const float* lg, const float* lb, bf16_t* hp16, float* hp32, bool do_u, const float* mod_bb, int sidx, bf16_t* urow, int lane) {
    const float mean = wave_sum(s) * (1.f / D); float s2 = 0.f;
#pragma unroll
    for (int j = 0; j < 4; ++j) { v[j] = v[j] - mean; s2 += (v[j][0] * v[j][0] + v[j][1] * v[j][1]) + (v[j][2] * v[j][2] + v[j][3] * v[j][3]); }
    const float rstd = 1.0f / sqrtf(wave_sum(s2) * (1.f / D) + EPS);
#pragma unroll
    for (int j = 0; j < 4; ++j) { const int c = 4 * (lane + 64 * j); const f32x4 gg = *(const f32x4*)(lg + c), bbv = *(const f32x4*)(lb + c);
        v[j] = v[j] * rstd * gg + bbv;
        if (hp32) __builtin_nontemporal_store(v[j], (f32x4*)(hp32 + c));
        else { typedef _Float16 h4_t __attribute__((ext_vector_type(4))); const u32x2 w = __builtin_bit_cast(u32x2, __builtin_convertvector(v[j], h4_t)); __builtin_nontemporal_store(w, (u32x2*)(hp16 + c)); } }
    if (do_u) modulate_row_store(v, mod_bb, sidx, urow, lane);
}
typedef _Float16 h16x4 __attribute__((ext_vector_type(4)));
__device__ __forceinline__ f32x4 hf4(const u32x2 w) { return __builtin_convertvector(__builtin_bit_cast(h16x4, w), f32x4); }
__device__ __forceinline__ u32x2 f4h(const f32x4 v) { return __builtin_bit_cast(u32x2, __builtin_convertvector(v, h16x4)); }
__device__ __forceinline__ f32x4 bf4(const u32x2 w) { return (f32x4){__uint_as_float(w.x << 16), __uint_as_float(w.x & 0xffff0000u), __uint_as_float(w.y << 16), __uint_as_float(w.y & 0xffff0000u)}; }
__device__ __forceinline__ void ln_pass(KA a, int L, int which, int nrows, bool do_u, int Lm, int sidx, const bf16_t* T, int npart, int gw, int NGW, int lane) {
    const float* MOD = (const float*)(a->ws + WS_MOD); bf16_t* U = (bf16_t*)(a->ws + WS_U); bf16_t* HC = (bf16_t*)(a->ws + WS_HC);
    const float* lg = a->in[I_LNG] + (size_t)(L * 2 + which) * D; const float* lb = a->in[I_LNB] + (size_t)(L * 2 + which) * D;
    const bool first = (L == 0 && which == 0), fin = (L == 3 && which == 1);
    bf16_t* HL = (bf16_t*)((unsigned char*)a->out + (size_t)64 * MiB); bf16_t* HX = (bf16_t*)(a->ws + WS_HLAST);
    const bf16_t* hin16 = fin ? HX : HL;
    bf16_t* hout16 = (L == 3 && which == 0) ? HX : HL;
    const int nmain = npart > 0 ? ML : nrows;
    if (first) {
        f32x4 hv[4]; u32x2 tw[4];
#define LN_FETCH(HV, TW, row_) do { const int r_ = (row_); const float* hin_ = a->in[I_X] + (size_t)r_ * D; const bf16_t* tp_ = T + (size_t)r_ * D; \
        _Pragma("unroll") for (int j = 0; j < 4; ++j) { const int c = 4 * (lane + 64 * j); HV[j] = __builtin_nontemporal_load((const f32x4*)(hin_ + c)); TW[j] = __builtin_nontemporal_load((const u32x2*)(tp_ + c)); } } while (0)
        if (gw < nmain) LN_FETCH(hv, tw, gw);
#pragma unroll 2
        for (int row = gw; row < nmain; row += NGW) {
            f32x4 hn[4]; u32x2 tn[4]; const int nrow = row + NGW < nmain ? row + NGW : row;
            LN_FETCH(hn, tn, nrow);
            f32x4 v[4]; float s = 0.f;
#pragma unroll
            for (int j = 0; j < 4; ++j) { v[j] = hv[j] * ALPHA + bf4(tw[j]); s += (v[j][0] + v[j][1]) + (v[j][2] + v[j][3]); }
            ln_row_finish(v, s, lg, lb, hout16 + (size_t)row * D, nullptr, do_u, MOD + (size_t)(Lm * 9 + (row >> 12)) * 6144, sidx, U + (size_t)row * D, lane);
#pragma unroll
            for (int j = 0; j < 4; ++j) { hv[j] = hn[j]; tw[j] = tn[j]; }
        }
#undef LN_FETCH
    } else {
        u32x2 hv[4], tw[4];
#define LN_FETCH(HV, TW, row_) do { const int r_ = (row_); const bf16_t* hin_ = hin16 + (size_t)r_ * D; const bf16_t* tp_ = T + (size_t)r_ * D; \
        _Pragma("unroll") for (int j = 0; j < 4; ++j) { const int c = 4 * (lane + 64 * j); HV[j] = __builtin_nontemporal_load((const u32x2*)(hin_ + c)); TW[j] = __builtin_nontemporal_load((const u32x2*)(tp_ + c)); } } while (0)
        if (gw < nmain) LN_FETCH(hv, tw, gw);
#pragma unroll 2
        for (int row = gw; row < nmain; row += NGW) {
            u32x2 hn[4], tn[4]; const int nrow = row + NGW < nmain ? row + NGW : row;
            LN_FETCH(hn, tn, nrow);
            f32x4 v[4]; float s = 0.f;
#pragma unroll
            for (int j = 0; j < 4; ++j) { v[j] = hf4(hv[j]) * ALPHA + bf4(tw[j]); s += (v[j][0] + v[j][1]) + (v[j][2] + v[j][3]); }
            ln_row_finish(v, s, lg, lb, hout16 + (size_t)row * D, fin ? a->out + (size_t)row * D : nullptr, do_u, MOD + (size_t)(Lm * 9 + (row >> 12)) * 6144, sidx, U + (size_t)row * D, lane);
#pragma unroll
            for (int j = 0; j < 4; ++j) { hv[j] = hn[j]; tw[j] = tn[j]; }
        }
#undef LN_FETCH
    }
    if (npart > 0) {
        const bf16_t* PART = (const bf16_t*)(a->ws + WS_PART);
        for (int row = ML + gw; row < nrows; row += NGW) {
            const size_t rc = (size_t)(row - ML); bf16_t* hp = HC + rc * D;
            f32x4 v[4]; float s = 0.f;
#pragma unroll
            for (int j = 0; j < 4; ++j) { const int c = 4 * (lane + 64 * j); f32x4 tv = {0.f, 0.f, 0.f, 0.f};
                for (int ks = 0; ks < npart; ++ks) tv += bf4(*(const u32x2*)(PART + (size_t)ks * MC * D + rc * D + c));
                const f32x4 hh = first ? *(const f32x4*)(a->in[I_CTX] + rc * D + c) : hf4(*(const u32x2*)(hp + c));
                v[j] = hh * ALPHA + tv; s += (v[j][0] + v[j][1]) + (v[j][2] + v[j][3]); }
            ln_row_finish(v, s, lg, lb, hp, nullptr, do_u, MOD + (size_t)(Lm * 9 + 8) * 6144, sidx, U + (size_t)row * D, lane);
        }
    }
}

__device__ __forceinline__ void prologue_a(KA a, LAS unsigned char* lds, int bid, int G, int tid, int wave, int lane) {
    float* MOD = (float*)(a->ws + WS_MOD); float* MISC = (float*)(a->ws + WS_MISC);
    LAS float* sv = (LAS float*)lds;
    LAS float* red = (LAS float*)(lds + 9 * 1024 * 4);
    for (int i = tid; i < 9 * 1024; i += 512) { const int bb = i >> 10, k = i & 1023; const float v = bb < 8 ? a->in[I_C][bb * 1024 + k] : a->in[I_CCTX][k]; sv[i] = siluf_(v); }
    __syncthreads();
    for (int unit = bid; unit < 192; unit += G) {
        const int L = unit / 48, cb = unit % 48, col = tid & 127, kq = tid >> 7;
        const float* w = a->in[I_ADAW] + (size_t)L * D * 6144 + cb * 128 + col;
        float acc[9];
#pragma unroll
        for (int bb = 0; bb < 9; ++bb) acc[bb] = 0.f;
        for (int k0 = kq * 256; k0 < kq * 256 + 256; k0 += 16) { float wv[16];
#pragma unroll
            for (int i = 0; i < 16; ++i) wv[i] = w[(size_t)(k0 + i) * 6144];
#pragma unroll
            for (int i = 0; i < 16; ++i)
#pragma unroll
                for (int bb = 0; bb < 9; ++bb) acc[bb] += sv[bb * 1024 + k0 + i] * wv[i]; }
#pragma unroll
        for (int bb = 0; bb < 9; ++bb) red[(kq * 9 + bb) * 128 + col] = acc[bb];
        __syncthreads();
        for (int i = tid; i < 9 * 128; i += 512) { const int bb = i >> 7, cc = i & 127;
            float s = (red[(0 * 9 + bb) * 128 + cc] + red[(1 * 9 + bb) * 128 + cc]) + (red[(2 * 9 + bb) * 128 + cc] + red[(3 * 9 + bb) * 128 + cc]);
            s += a->in[I_ADAB][L * 6144 + cb * 128 + cc]; MOD[(size_t)(L * 9 + bb) * 6144 + cb * 128 + cc] = s; }
        __syncthreads();
    }
    if (bid == G - 1) {
        if (tid < 16) {
            double th = 1.0; for (int j = 0; j < tid; ++j) th *= 0.56234132519034908;
            const double t2 = th * th; double sn = th, term = th, cs = 1.0, tc = 1.0;
            for (int k = 1; k < 12; ++k) { tc *= -t2 / ((2.0 * k - 1.0) * (2.0 * k)); cs += tc; term *= -t2 / ((2.0 * k) * (2.0 * k + 1.0)); sn += term; }
            double c = 1.0, s = 0.0;
            for (int p = 0; p < 64; ++p) { MISC[64 + p * 16 + tid] = (float)c; MISC[1088 + p * 16 + tid] = (float)s; const double c2 = c * cs - s * sn, s2 = s * cs + c * sn; c = c2; s = s2; }
        }
        if (tid >= 64 && tid < 66) { const int j = tid - 64; const float* lv = a->in[I_ODLAM] + j * 256; float d0 = 0.f, d1 = 0.f;
            for (int i = 0; i < 64; ++i) { d0 += lv[i] * lv[64 + i]; d1 += lv[128 + i] * lv[192 + i]; }
            const float li = 0.8f - 0.6f * expf(-0.3f * (float)(2 * j + 1)); MISC[j] = expf(d0) - expf(d1) + li; MISC[2 + j] = li; }
    }
    __syncthreads();
    conv_weights(a, 0, lds, bid * 8 + wave, G * 8, wave, lane);
}

__device__ __forceinline__ void attn_prep(KA a, LAS unsigned char* lds, int bid, int G, int tid) {
    bf16_t* P = (bf16_t*)(a->ws + WS_P); bf16_t* VT = (bf16_t*)(a->ws + WS_V); const float* MISC = (const float*)(a->ws + WS_MISC);
    const float* tabc = MISC + 64; const float* tabs = MISC + 1088;
    constexpr int VP = 2064;
    for (int u = bid; u < 2 * NB * 68; u += G) {
        const bool vpart = u >= NB * 68; const int uu = vpart ? u - NB * 68 : u;
        const int b = uu / 68, tl = uu % 68; const bool isctx = tl < 4; const int t0 = isctx ? tl * 64 : (tl - 4) * 64;
        const int rowbase = isctx ? ML + b * CTXL + t0 : b * SEQ + t0; const int kv0 = isctx ? t0 : CTXL + t0;
        if (!vpart) {
#pragma unroll 1
            for (int half = 0; half < 2; ++half) {
                u32x4 r1[4], r2[4], r3[4], r4[4];
#pragma unroll
                for (int k = 0; k < 4; ++k) { const int it = tid + 512 * (4 * half + k); const int r = it >> 6, rem = it & 63, vec = rem >> 1, part = rem & 1;
                    const bf16_t* p = P + (size_t)(rowbase + r) * ODN + vec * 64 + part * 8;
                    r1[k] = *(const u32x4*)(p); r2[k] = *(const u32x4*)(p + 16); r3[k] = *(const u32x4*)(p + 32); r4[k] = *(const u32x4*)(p + 48); }
#pragma unroll
                for (int k = 0; k < 4; ++k) { const int it = tid + 512 * (4 * half + k); const int r = it >> 6, rem = it & 63, vec = rem >> 1, part = rem & 1; const bool isq = vec < 16;
                    if (isctx && !isq) continue;
                    bf16_t* p = P + (size_t)(rowbase + r) * ODN + vec * 64 + part * 8;
                    float t1[8], t2[8], t3[8], t4[8];
                    unpack8(r1[k], t1); unpack8(r2[k], t2); unpack8(r3[k], t3); unpack8(r4[k], t4);
                    const float sc = isq ? QSCALE : 1.0f;
                    if (!isctx) {
                        const int pos = t0 + r, rp = pos >> 6, cp = pos & 63;
#pragma unroll
                        for (int j = 0; j < 8; ++j) { const int jj = part * 8 + j;
                            const float cr = tabc[rp * 16 + jj], sr = tabs[rp * 16 + jj], cc = tabc[cp * 16 + jj], ss = tabs[cp * 16 + jj];
                            const float o1 = t1[j] * cr - t2[j] * sr, o2 = t2[j] * cr + t1[j] * sr, o3 = t3[j] * cc - t4[j] * ss, o4 = t4[j] * cc + t3[j] * ss;
                            t1[j] = o1 * sc; t2[j] = o2 * sc; t3[j] = o3 * sc; t4[j] = o4 * sc; }
                    } else {
#pragma unroll
                        for (int j = 0; j < 8; ++j) { t1[j] *= sc; t2[j] *= sc; t3[j] *= sc; t4[j] *= sc; }
                    }
                    *(u32x4*)(p) = pack8(t1); *(u32x4*)(p + 16) = pack8(t2); *(u32x4*)(p + 32) = pack8(t3); *(u32x4*)(p + 48) = pack8(t4);
                }
            }
        } else {
            { u32x4 rv[16];
#pragma unroll
              for (int k = 0; k < 16; ++k) { const int id = tid + 512 * k; rv[k] = *(const u32x4*)(P + (size_t)(rowbase + (id >> 7)) * ODN + 2048 + (id & 127) * 8); }
#pragma unroll
              for (int k = 0; k < 16; ++k) { const int id = tid + 512 * k; *(LAS u32x4*)(lds + (id >> 7) * VP + (id & 127) * 16) = rv[k]; } }
            __syncthreads();
#pragma unroll 4
            for (int k = 0; k < 16; ++k) { const int oc = tid + 512 * k; const int col = oc & 1023, c = oc >> 10;
                unsigned w[4];
#pragma unroll
                for (int j = 0; j < 4; ++j) { const unsigned lo = *(const LAS bf16_t*)(lds + (8 * c + 2 * j) * VP + col * 2), hi = *(const LAS bf16_t*)(lds + (8 * c + 2 * j + 1) * VP + col * 2); w[j] = lo | (hi << 16); }
                u32x4 o; o.x = w[0]; o.y = w[1]; o.z = w[2]; o.w = w[3];
                *(u32x4*)(VT + ((size_t)(b * 8 * 128 + col)) * NKV + kv0 + 8 * c) = o; }
            __syncthreads();
        }
    }
}

constexpr int AT_KB = 64 * 272, AT_VB = 128 * 144, AT_BUF = AT_KB + AT_VB, AT_OX = 0;
static_assert(3 * AT_BUF <= LDS_BYTES - 16 && 128 * 132 * 4 <= 3 * AT_BUF, "attention lds");
__device__ __forceinline__ void at_qk(const LAS unsigned char* Kb, const bf16x8 (&qf)[4], f32x16& s0, f32x16& s1, int m, int krow, int hi) {
#pragma unroll
    for (int r = 0; r < 16; ++r) { s0[r] = 0.f; s1[r] = 0.f; }
#pragma unroll
    for (int ks = 0; ks < 4; ++ks) {
        const bf16x8 a0 = *(const LAS bf16x8*)(Kb + krow * 272 + (m * 64 + ks * 16 + hi * 8) * 2);
        const bf16x8 a1 = *(const LAS bf16x8*)(Kb + (krow + 32) * 272 + (m * 64 + ks * 16 + hi * 8) * 2);
        s0 = __builtin_amdgcn_mfma_f32_32x32x16_bf16(a0, qf[ks], s0, 0, 0, 0);
        s1 = __builtin_amdgcn_mfma_f32_32x32x16_bf16(a1, qf[ks], s1, 0, 0, 0);
    }
}
template <bool HAS_NEXT>
__device__ __forceinline__ void at_step(const LAS unsigned char* Kn, const LAS unsigned char* Vc, const bf16x8 (&qf)[4], f32x16 (&o)[4], f32x16& s0, f32x16& s1, float& mrun, float& lsum, int m, int krow, int r32, int hi) {
    f32x16 n0, n1;
#pragma unroll
    for (int r = 0; r < 16; ++r) { n0[r] = 0.f; n1[r] = 0.f; }
    float ps = 0.f;
#pragma unroll
    for (int ks = 0; ks < 4; ++ks) {
        if (HAS_NEXT) {
            const bf16x8 a0 = *(const LAS bf16x8*)(Kn + krow * 272 + (m * 64 + ks * 16 + hi * 8) * 2);
            const bf16x8 a1 = *(const LAS bf16x8*)(Kn + (krow + 32) * 272 + (m * 64 + ks * 16 + hi * 8) * 2);
            n0 = __builtin_amdgcn_mfma_f32_32x32x16_bf16(a0, qf[ks], n0, 0, 0, 0);
            n1 = __builtin_amdgcn_mfma_f32_32x32x16_bf16(a1, qf[ks], n1, 0, 0, 0);
        }
#pragma unroll
        for (int r = 4 * ks; r < 4 * ks + 4; ++r) { s0[r] = __builtin_amdgcn_exp2f(s0[r] - mrun); s1[r] = __builtin_amdgcn_exp2f(s1[r] - mrun); ps += s0[r] + s1[r]; }
    }
    lsum += ps;
    bf16x8 pb[4];
    { u32x4 w;
      w.x = pk2(s0[0], s0[1]); w.y = pk2(s0[2], s0[3]); w.z = pk2(s0[4], s0[5]); w.w = pk2(s0[6], s0[7]); pb[0] = __builtin_bit_cast(bf16x8, w);
      w.x = pk2(s0[8], s0[9]); w.y = pk2(s0[10], s0[11]); w.z = pk2(s0[12], s0[13]); w.w = pk2(s0[14], s0[15]); pb[1] = __builtin_bit_cast(bf16x8, w);
      w.x = pk2(s1[0], s1[1]); w.y = pk2(s1[2], s1[3]); w.z = pk2(s1[4], s1[5]); w.w = pk2(s1[6], s1[7]); pb[2] = __builtin_bit_cast(bf16x8, w);
      w.x = pk2(s1[8], s1[9]); w.y = pk2(s1[10], s1[11]); w.z = pk2(s1[12], s1[13]); w.w = pk2(s1[14], s1[15]); pb[3] = __builtin_bit_cast(bf16x8, w); }
    float mx = -3.0e38f;
#pragma unroll
    for (int db = 0; db < 4; ++db) {
#pragma unroll
        for (int i = 0; i < 4; ++i) {
            const bf16x8 av = *(const LAS bf16x8*)(Vc + (32 * db + r32) * 144 + (16 * i + 8 * hi) * 2);
            o[db] = __builtin_amdgcn_mfma_f32_32x32x16_bf16(av, pb[i], o[db], 0, 0, 0);
        }
        if (HAS_NEXT) {
#pragma unroll
            for (int r = 4 * db; r < 4 * db + 4; ++r) mx = fmaxf(mx, fmaxf(n0[r], n1[r]));
        }
    }
    if (HAS_NEXT) {
        mx = xhalf_max(mx);
        const float mnew = fmaxf(mrun, mx);
        if (__any(mnew > mrun)) {
            const float al = __builtin_amdgcn_exp2f(mrun - mnew); lsum *= al;
#pragma unroll
            for (int db = 0; db < 4; ++db)
#pragma unroll
                for (int r = 0; r < 16; ++r) o[db][r] *= al;
            mrun = mnew;
        }
        s0 = n0; s1 = n1;
    }
}
__device__ __forceinline__ void attn_phase(KA a, int L, LAS unsigned char* lds, int bid, int G, int tid, int wave, int lane, bool do_store) {
    bf16_t* P = (bf16_t*)(a->ws + WS_P); const bf16_t* VT = (const bf16_t*)(a->ws + WS_V); const float* MISC = (const float*)(a->ws + WS_MISC);
    const int j2 = L >> 1; const float lam = MISC[j2], lam_init = MISC[2 + j2];
    const float* subln = a->in[I_ODSUBLN] + j2 * 128;
    const int nunits = 2048 + (L == 1 ? 128 : 0);
    const int m = wave & 1, qs = wave >> 1, r32 = lane & 31, hi = lane >> 5;
    const int krow = (r32 & 0x13) | ((r32 & 4) << 1) | ((r32 & 8) >> 1);
    for (int u = bid; u < nunits; u += G) {
        int bh, qb; const bool isctx = u >= 2048;
        if (!isctx) { bh = (u >> 8) * 8 + (u & 7); qb = (u >> 3) & 31; } else { const int u2 = u - 2048; bh = u2 >> 1; qb = u2 & 1; }
        const int b = bh >> 3, h = bh & 7;
        const int qrow = (isctx ? ML + b * CTXL : b * SEQ) + qb * 128 + qs * 32 + r32;
        const int ntiles = isctx ? 4 : 68;
        bf16x8 qf[4];
#pragma unroll
        for (int ks = 0; ks < 4; ++ks) qf[ks] = *(const bf16x8*)(P + (size_t)qrow * ODN + h * 128 + m * 64 + ks * 16 + hi * 8);
        const int kr0 = tid >> 4, kc = tid & 15;
        const int vd0 = tid >> 3, vc = tid & 7;
        const bf16_t* vsrc0 = VT + ((size_t)(bh * 128 + vd0)) * NKV + 8 * vc; const bf16_t* vsrc1 = vsrc0 + (size_t)64 * NKV;
        u32x4 rk0, rk1, rv0, rv1;
#define AT_LOAD(t) do { const int kv_ = 64 * (t) + kr0; const int g0_ = kv_ < CTXL ? ML + b * CTXL + kv_ : b * SEQ + kv_ - CTXL; const int kv1_ = kv_ + 32; const int g1_ = kv1_ < CTXL ? ML + b * CTXL + kv1_ : b * SEQ + kv1_ - CTXL; \
        rk0 = *(const u32x4*)(P + (size_t)g0_ * ODN + 1024 + h * 128 + kc * 8); rk1 = *(const u32x4*)(P + (size_t)g1_ * ODN + 1024 + h * 128 + kc * 8); \
        rv0 = *(const u32x4*)(vsrc0 + 64 * (t)); rv1 = *(const u32x4*)(vsrc1 + 64 * (t)); } while (0)
#define AT_STORE(boff) do { LAS unsigned char* kb_ = lds + (boff); LAS unsigned char* vb_ = kb_ + AT_KB; \
        *(LAS u32x4*)(kb_ + kr0 * 272 + kc * 16) = rk0; *(LAS u32x4*)(kb_ + (kr0 + 32) * 272 + kc * 16) = rk1; \
        *(LAS u32x4*)(vb_ + vd0 * 144 + vc * 16) = rv0; *(LAS u32x4*)(vb_ + (vd0 + 64) * 144 + vc * 16) = rv1; } while (0)
        { AT_LOAD(0); const u32x4 k0_ = rk0, k1_ = rk1, v0_ = rv0, v1_ = rv1;
          AT_LOAD(1);
          { LAS unsigned char* kb_ = lds; LAS unsigned char* vb_ = kb_ + AT_KB;
            *(LAS u32x4*)(kb_ + kr0 * 272 + kc * 16) = k0_; *(LAS u32x4*)(kb_ + (kr0 + 32) * 272 + kc * 16) = k1_;
            *(LAS u32x4*)(vb_ + vd0 * 144 + vc * 16) = v0_; *(LAS u32x4*)(vb_ + (vd0 + 64) * 144 + vc * 16) = v1_; }
          AT_STORE(AT_BUF); }
        __syncthreads();
        f32x16 o[4];
#pragma unroll
        for (int db = 0; db < 4; ++db)
#pragma unroll
            for (int r = 0; r < 16; ++r) o[db][r] = 0.f;
        f32x16 s0, s1;
        at_qk(lds, qf, s0, s1, m, krow, hi);
        float mrun, lsum = 0.f;
        { float mx = fmaxf(s0[0], s1[0]);
#pragma unroll
          for (int r = 1; r < 16; ++r) mx = fmaxf(mx, fmaxf(s0[r], s1[r]));
          mrun = xhalf_max(mx); }
        int bc = 0, bn = AT_BUF, bs = 2 * AT_BUF;
        for (int t = 0; t + 1 < ntiles; ++t) {
            const bool stage = t + 2 < ntiles;
            if (stage) AT_LOAD(t + 2);
            at_step<true>(lds + bn, lds + bc + AT_KB, qf, o, s0, s1, mrun, lsum, m, krow, r32, hi);
            if (stage) AT_STORE(bs);
            __syncthreads();
            const int tmp = bc; bc = bn; bn = bs; bs = tmp;
        }
        at_step<false>(lds, lds + bc + AT_KB, qf, o, s0, s1, mrun, lsum, m, krow, r32, hi);
        __syncthreads();
#undef AT_LOAD
#undef AT_STORE
        lsum = xhalf_sum(lsum);
        const float inv = 1.0f / lsum;
        LAS float* ox = (LAS float*)(lds + AT_OX) + (qs * 32 + r32) * 132;
        if (m == 1) {
#pragma unroll
            for (int db = 0; db < 4; ++db)
#pragma unroll
                for (int r4 = 0; r4 < 4; ++r4) { f32x4 v = {o[db][4 * r4] * inv, o[db][4 * r4 + 1] * inv, o[db][4 * r4 + 2] * inv, o[db][4 * r4 + 3] * inv};
                    *(LAS f32x4*)(ox + 32 * db + 8 * r4 + 4 * hi) = v; }
        }
        __syncthreads();
        if (m == 0) {
            float ssq = 0.f;
#pragma unroll
            for (int db = 0; db < 4; ++db)
#pragma unroll
                for (int r4 = 0; r4 < 4; ++r4) { const f32x4 v1 = *(const LAS f32x4*)(ox + 32 * db + 8 * r4 + 4 * hi);
#pragma unroll
                    for (int e = 0; e < 4; ++e) { const float v = o[db][4 * r4 + e] * inv - lam * v1[e]; o[db][4 * r4 + e] = v; ssq += v * v; } }
            ssq = xhalf_sum(ssq);
            const float sc = (1.0f / sqrtf(ssq * (1.f / 128.f) + EPS)) * (1.0f - lam_init);
            bf16_t* op = P + (size_t)qrow * ODN + h * 128;
#pragma unroll
            for (int db = 0; db < 4; ++db)
#pragma unroll
                for (int r4 = 0; r4 < 4; ++r4) { const int dv = 32 * db + 8 * r4 + 4 * hi; const f32x4 g4 = *(const f32x4*)(subln + dv);
                    u32x2 w; w.x = pk2(o[db][4 * r4] * sc * g4[0], o[db][4 * r4 + 1] * sc * g4[1]); w.y = pk2(o[db][4 * r4 + 2] * sc * g4[2], o[db][4 * r4 + 3] * sc * g4[3]);
                    if (do_store) *(u32x2*)(op + dv) = w; }
        }
        __syncthreads();
    }
}

__device__ __forceinline__ void gdn_prep(KA a, int L, LAS unsigned char* lds, int gw, int NGW, int tid, int lane) {
    const int j2 = L >> 1;
    const bf16_t* P = (const bf16_t*)(a->ws + WS_P);
    bf16_t* QN = (bf16_t*)(a->ws + WS_U); bf16_t* KN = QN + (size_t)MT * 512; bf16_t* V = (bf16_t*)(a->ws + WS_V);
    float* Gb = (float*)(a->ws + WS_G); float* Bt = (float*)(a->ws + WS_BT);
    const float* cw = a->in[I_EVQKVCONV] + (size_t)j2 * 4 * 1536;
    LAS float* cwl = (LAS float*)lds;
    for (int i = tid; i < 4 * 1536 / 4; i += 512) *(LAS f32x4*)(cwl + 4 * i) = *(const f32x4*)(cw + 4 * i);
    __syncthreads();
    float alog = 0.f, dtb = 0.f;
    if (lane < 8) { alog = -expf(a->in[I_EVALOG][j2 * 8 + lane]); dtb = a->in[I_EVDTB][j2 * 8 + lane]; }
    for (int blk = gw; blk < MT / 17; blk += NGW) {
        const int r0 = 17 * blk;
        u32x4 R[20][3]; unsigned ab[17];
#define GP_LOAD(k_) do { const int row_ = r0 - 2 + (k_); const bool ok_ = row_ >= 0 && row_ < MT; \
        _Pragma("unroll") for (int p = 0; p < 3; ++p) R[k_][p] = ok_ ? *(const u32x4*)(P + (size_t)row_ * EVNP + p * 512 + 8 * lane) : (u32x4){0u, 0u, 0u, 0u}; } while (0)
#pragma unroll
        for (int k = 0; k < 6; ++k) GP_LOAD(k);
#pragma unroll
        for (int i = 0; i < 17; ++i) ab[i] = lane < 16 ? (unsigned)P[(size_t)(r0 + i) * EVNP + 2048 + lane] : 0u;
#pragma unroll
        for (int i = 0; i < 17; ++i) {
            if (i + 6 < 20) GP_LOAD(i + 6);
            const int row = r0 + i;
            const bool isctx = row >= ML; const int t = isctx ? ((row - ML) & (CTXL - 1)) : (row & (SEQ - 1)); const int len = isctx ? CTXL : SEQ;
            float val[3][8];
#pragma unroll
            for (int p = 0; p < 3; ++p) {
                float acc[8];
#pragma unroll
                for (int e = 0; e < 8; ++e) acc[e] = 0.f;
#pragma unroll
                for (int j = 0; j < 4; ++j) { const int tt = t + j - 2;
                    if (tt >= 0 && tt < len) { float x[8]; unpack8(R[i + j][p], x);
                        const f32x4 w0 = *(const LAS f32x4*)(cwl + j * 1536 + p * 512 + 8 * lane), w1 = *(const LAS f32x4*)(cwl + j * 1536 + p * 512 + 8 * lane + 4);
#pragma unroll
                        for (int e = 0; e < 8; ++e) acc[e] += (e < 4 ? w0[e & 3] : w1[e & 3]) * x[e]; } }
#pragma unroll
                for (int e = 0; e < 8; ++e) val[p][e] = fsilu(acc[e]);
            }
            float sq = 0.f, sk = 0.f;
#pragma unroll
            for (int e = 0; e < 8; ++e) { sq += val[0][e] * val[0][e]; sk += val[1][e] * val[1][e]; }
            sq = rowsum16(sq); sk = rowsum16(sk);
            const float rq = (1.0f / sqrtf(sq + EPS)) * 0.08838834764831845f, rk = 1.0f / sqrtf(sk + EPS);
#pragma unroll
            for (int e = 0; e < 8; ++e) { val[0][e] *= rq; val[1][e] *= rk; }
            *(u32x4*)(QN + (size_t)row * 512 + 8 * lane) = pack8(val[0]);
            *(u32x4*)(KN + (size_t)row * 512 + 8 * lane) = pack8(val[1]);
            *(u32x4*)(V + (size_t)row * 512 + 8 * lane) = pack8(val[2]);
            if (lane < 8) Gb[(size_t)row * 8 + lane] = alog * softplusf_(bf2f(ab[i]) + dtb);
            else if (lane < 16) Bt[(size_t)row * 8 + lane - 8] = sigmoidf_(bf2f(ab[i]));
        }
#undef GP_LOAD
    }
    __syncthreads();
}

constexpr int LR_XIN = 0, LR_XC = 17152, LR_XCB = LR_XC + 16384, LR_AU = LR_XCB + 9216, LR_WT = LR_AU + 65536, LR_END = LR_WT + 36864;
static_assert(LR_END <= LDS_BYTES, "lru lds");
template <int PASS>
__device__ __forceinline__ void lru_units(KA a, int L, LAS unsigned char* lds, int bid, int G, int tid) {
    const int j2 = L >> 1;
    const bf16_t* P = (const bf16_t*)(a->ws + WS_P); bf16_t* U = (bf16_t*)(a->ws + WS_U);
    float* TOTA = (float*)(a->ws + WS_TOTA); float* TOTH = (float*)(a->ws + WS_TOTH); const float* CARRY = (const float*)(a->ws + WS_CARRY);
    const float* cw = a->in[I_LRUCW] + (size_t)j2 * 4 * 512; const float* cb = a->in[I_LRUCB] + (size_t)j2 * 512;
    const float* gw_ = a->in[I_LRUGW] + (size_t)j2 * 2 * 2 * 8 * 64 * 64; const float* gb_ = a->in[I_LRUGB] + (size_t)j2 * 2 * 2 * 512; const float* lam_ = a->in[I_LRULAM] + (size_t)j2 * 2 * 512;
    LAS float* xin = (LAS float*)(lds + LR_XIN);
    LAS float* xc = (LAS float*)(lds + LR_XC);
    LAS bf16_t* xcb = (LAS bf16_t*)(lds + LR_XCB);
    LAS float* au = (LAS float*)(lds + LR_AU);
    LAS bf16_t* wt = (LAS bf16_t*)(lds + LR_WT);
    LAS float* sg = (LAS float*)(lds + LR_XIN);
    const int lane = tid & 63, w = tid >> 6, mt = w & 3, nh = w >> 2, fr = lane & 15, fq = lane >> 4;
    int cur_nblk = -1;
    const int cc = tid & 63;
    float cbv = 0.f, cwv[4] = {0.f, 0.f, 0.f, 0.f};
    float gbr[2][2], gbi[2][2], gsp[2][2];
#pragma unroll
    for (int q = 0; q < 2; ++q)
#pragma unroll
        for (int r = 0; r < 2; ++r) { gbr[q][r] = 0.f; gbi[q][r] = 0.f; gsp[q][r] = 0.f; }
    const int rrA = tid >> 3, c8 = (tid & 7) * 8, rrB = 64 + (tid >> 3);
    u32x4 xa = {0u, 0u, 0u, 0u}, xb = {0u, 0u, 0u, 0u}, gt4 = {0u, 0u, 0u, 0u};
#define LR_FETCH(XA, XB, GT, u_) do { const int nb_ = (u_) & 7, cs_ = (u_) >> 3, b_ = cs_ / 68, sl_ = cs_ % 68; const bool ic_ = sl_ < 4; const int t0_ = ic_ ? sl_ * 64 : (sl_ - 4) * 64; \
        const int len_ = ic_ ? CTXL : SEQ; const int rb_ = ic_ ? ML + b_ * CTXL : b_ * SEQ; const int ta_ = t0_ + rrA - 2, tb_ = t0_ + rrB - 2; \
        XA = (u32x4){0u, 0u, 0u, 0u}; XB = (u32x4){0u, 0u, 0u, 0u}; \
        if (ta_ >= 0 && ta_ < len_) XA = *(const u32x4*)(P + (size_t)(rb_ + ta_) * EVNP + 2064 + nb_ * 64 + c8); \
        if (tid < 24 && tb_ < len_) XB = *(const u32x4*)(P + (size_t)(rb_ + tb_) * EVNP + 2064 + nb_ * 64 + c8); \
        if (PASS == 2) GT = *(const u32x4*)(P + (size_t)(rb_ + t0_ + rrA) * EVNP + 2576 + nb_ * 64 + c8); } while (0)
    if (bid < NB * 68 * 8) LR_FETCH(xa, xb, gt4, bid);
    for (int u = bid; u < NB * 68 * 8; u += G) {
        const int nblk = u & 7, cs = u >> 3, b = cs / 68, slot = cs % 68; const bool isctx = slot < 4; const int t0 = isctx ? slot * 64 : (slot - 4) * 64;
        const int rowbase = isctx ? ML + b * CTXL : b * SEQ;
        u32x4 nxa, nxb, ngt = {0u, 0u, 0u, 0u};
        { const int un = u + G < NB * 68 * 8 ? u + G : u; LR_FETCH(nxa, nxb, ngt, un); }
        if (nblk != cur_nblk) {
            for (int i0 = tid; i0 < 4 * 4096; i0 += 512 * 8) { float wv[8];
#pragma unroll
                for (int k = 0; k < 8; ++k) { const int i = i0 + 512 * k; wv[k] = gw_[((size_t)((i >> 12) * 8 + nblk)) * 4096 + (i & 4095)]; }
#pragma unroll
                for (int k = 0; k < 8; ++k) { const int i = i0 + 512 * k; const int dg = i >> 12, c = (i >> 6) & 63, d = i & 63; wt[(dg * 64 + d) * 72 + c] = (bf16_t)f2bf(wv[k]); } }
            cbv = cb[nblk * 64 + cc];
#pragma unroll
            for (int dir = 0; dir < 2; ++dir)
#pragma unroll
                for (int nt = 0; nt < 2; ++nt) { const int ch = nblk * 64 + 32 * nh + 16 * nt + fr;
                    gbr[dir][nt] = gb_[(dir * 2 + 0) * 512 + ch]; gbi[dir][nt] = gb_[(dir * 2 + 1) * 512 + ch]; gsp[dir][nt] = softplusf_(-lam_[dir * 512 + ch]); }
#pragma unroll
            for (int j = 0; j < 4; ++j) cwv[j] = cw[j * 512 + nblk * 64 + cc];
            cur_nblk = nblk;
        }
        { float f[8]; unpack8(xa, f); *(LAS f32x4*)(xin + rrA * 64 + c8) = (f32x4){f[0], f[1], f[2], f[3]}; *(LAS f32x4*)(xin + rrA * 64 + c8 + 4) = (f32x4){f[4], f[5], f[6], f[7]};
          if (tid < 24) { unpack8(xb, f); *(LAS f32x4*)(xin + rrB * 64 + c8) = (f32x4){f[0], f[1], f[2], f[3]}; *(LAS f32x4*)(xin + rrB * 64 + c8 + 4) = (f32x4){f[4], f[5], f[6], f[7]}; } }
        __syncthreads();
#pragma unroll
        for (int k = 0; k < 8; ++k) { const int t = (tid >> 6) + 8 * k;
            float v = cbv;
#pragma unroll
            for (int j = 0; j < 4; ++j) v += cwv[j] * xin[(t + j) * 64 + cc];
            xc[t * 64 + cc] = v; xcb[t * 72 + cc] = (bf16_t)f2bf(v); }
        __syncthreads();
        {
            f32x4 acc[4][2];
#pragma unroll
            for (int dg = 0; dg < 4; ++dg)
#pragma unroll
                for (int nt = 0; nt < 2; ++nt) acc[dg][nt] = (f32x4){0.f, 0.f, 0.f, 0.f};
            bf16x8 af[2];
#pragma unroll
            for (int ks = 0; ks < 2; ++ks) af[ks] = *(const LAS bf16x8*)(xcb + (16 * mt + fr) * 72 + 32 * ks + 8 * fq);
#pragma unroll
            for (int dg = 0; dg < 4; ++dg)
#pragma unroll
                for (int nt = 0; nt < 2; ++nt)
#pragma unroll
                    for (int ks = 0; ks < 2; ++ks) { const bf16x8 bfm = *(const LAS bf16x8*)(wt + (dg * 64 + 32 * nh + 16 * nt + fr) * 72 + 32 * ks + 8 * fq);
                        acc[dg][nt] = __builtin_amdgcn_mfma_f32_16x16x32_bf16(af[ks], bfm, acc[dg][nt], 0, 0, 0); }
#pragma unroll
            for (int dir = 0; dir < 2; ++dir)
#pragma unroll
                for (int nt = 0; nt < 2; ++nt) { const int d = 32 * nh + 16 * nt + fr, ch = nblk * 64 + d;
                    const float br = gbr[dir][nt], bi = gbi[dir][nt], sp = gsp[dir][nt];
#pragma unroll
                    for (int r = 0; r < 4; ++r) { const int t = 16 * mt + 4 * fq + r;
                        const float rr = fsigmoid(acc[dir * 2 + 0][nt][r] + br), ii = fsigmoid(acc[dir * 2 + 1][nt][r] + bi);
                        const float la = -8.0f * 1.4426950408889634f * rr * sp; const float av = __builtin_amdgcn_exp2f(la);
                        const float uv = __builtin_amdgcn_sqrtf(fmaxf(1.0f - av * av, 0.f)) * (ii * xc[t * 64 + d]);
                        au[((dir * 2 + 0) * 64 + t) * 64 + d] = av; au[((dir * 2 + 1) * 64 + t) * 64 + d] = uv; } }
        }
        __syncthreads();
        {
            const int seg = tid >> 7, dir = (tid >> 6) & 1, c = tid & 63, ch = nblk * 64 + c;
            const LAS float* ap = au + ((dir * 2 + 0) * 64) * 64 + c; LAS float* up = au + ((dir * 2 + 1) * 64) * 64 + c;
            float A = 1.f, H = 0.f;
#pragma unroll 4
            for (int s = seg * 16; s < seg * 16 + 16; ++s) { const int t = dir ? 63 - s : s; const float av = ap[t * 64], uv = up[t * 64]; H = av * H + uv; A *= av; }
            sg[((0 * 4 + seg) * 2 + dir) * 64 + c] = A; sg[((1 * 4 + seg) * 2 + dir) * 64 + c] = H;
            __syncthreads();
            const size_t idx = ((size_t)((b * 2 + dir) * 68 + slot)) * 512 + ch;
            if (PASS == 1) {
                if (seg == 0) { float At = 1.f, Ht = 0.f;
#pragma unroll
                    for (int q = 0; q < 4; ++q) { const float Aq = sg[((0 * 4 + q) * 2 + dir) * 64 + c], Hq = sg[((1 * 4 + q) * 2 + dir) * 64 + c]; Ht = Aq * Ht + Hq; At *= Aq; }
                    TOTA[idx] = At; TOTH[idx] = Ht; }
            } else {
                float Hin = CARRY[idx];
                for (int q = 0; q < seg; ++q) { const float Aq = sg[((0 * 4 + q) * 2 + dir) * 64 + c], Hq = sg[((1 * 4 + q) * 2 + dir) * 64 + c]; Hin = Aq * Hin + Hq; }
#pragma unroll 4
                for (int s = seg * 16; s < seg * 16 + 16; ++s) { const int t = dir ? 63 - s : s; const float av = ap[t * 64], uv = up[t * 64]; Hin = av * Hin + uv; up[t * 64] = Hin; }
            }
        }
        __syncthreads();
        if (PASS == 2) {
            { const int t = rrA; float gt[8], y[8]; unpack8(gt4, gt);
              const LAS float* hf = au + ((0 * 2 + 1) * 64 + t) * 64 + c8; const LAS float* hb = au + ((1 * 2 + 1) * 64 + t) * 64 + c8;
              const f32x4 f0 = *(const LAS f32x4*)(hf), f1 = *(const LAS f32x4*)(hf + 4), b0 = *(const LAS f32x4*)(hb), b1 = *(const LAS f32x4*)(hb + 4);
#pragma unroll
              for (int e = 0; e < 8; ++e) { const float hs = (e < 4 ? f0[e & 3] + b0[e & 3] : f1[e & 3] + b1[e & 3]); const float g = gt[e];
                  y[e] = hs * g * fsigmoid(1.5957691216057308f * (g + 0.044715f * g * g * g)); }
              *(u32x4*)(U + (size_t)(rowbase + t0 + t) * D + 512 + nblk * 64 + c8) = pack8(y); }
            __syncthreads();
        }
        xa = nxa; xb = nxb; gt4 = ngt;
    }
#undef LR_FETCH
}

constexpr int GS_NS = 32, GS_K = 0, GS_Q = 16384, GS_V = 32768, GS_EG = 36864, GS_BTO = 36992, GS_BUF = 37120;
__device__ __forceinline__ void gdn_scan(KA a, LAS unsigned char* lds, int bid, int G, int tid, int wave, int lane) {
    const bf16_t* QN = (const bf16_t*)(a->ws + WS_U); const bf16_t* KN = QN + (size_t)MT * 512; const bf16_t* V = (const bf16_t*)(a->ws + WS_V);
    const float* Gb = (const float*)(a->ws + WS_G); const float* Bt = (const float*)(a->ws + WS_BT);
    for (int u = bid; u < 256; u += G) {
        const int chain = u >> 2, qd = u & 3, b = chain >> 3, h = (chain >> 1) & 3, dir = chain & 1;
        bf16_t* OD = (bf16_t*)(a->ws + (dir ? WS_OB : WS_OF));
        const int kg = lane & 7, cl = (wave & 3) * 8 + (lane >> 3), col = h * 128 + qd * 32 + cl;
        f32x2 S[8];
#pragma unroll
        for (int i = 0; i < 8; ++i) S[i] = (f32x2){0.f, 0.f};
#define GS_ROW(s) ((s) < CTXL ? (ML + b * CTXL + (dir ? CTXL - 1 - (s) : (s))) : (b * SEQ + (dir ? SEQ - 1 - ((s) - CTXL) : ((s) - CTXL))))
        const int lsl = tid >> 4, lc = tid & 15;
        u32x4 rk, rq, rv; float rg = 0.f;
#define GS_LOAD(blk) do { const int s_ = (blk) * GS_NS + lsl; const size_t row_ = (size_t)GS_ROW(s_); \
        rk = *(const u32x4*)(KN + row_ * 512 + h * 128 + lc * 8); rq = *(const u32x4*)(QN + row_ * 512 + h * 128 + lc * 8); \
        if (tid < 128) { const int s2_ = (blk) * GS_NS + (tid >> 2); const size_t r2_ = (size_t)GS_ROW(s2_); rv = *(const u32x4*)(V + r2_ * 512 + h * 128 + qd * 32 + (tid & 3) * 8); } \
        else if (tid < 160) { const int s2_ = (blk) * GS_NS + (tid - 128); rg = expf(Gb[(size_t)GS_ROW(s2_) * 8 + dir * 4 + h]); } \
        else if (tid < 192) { const int s2_ = (blk) * GS_NS + (tid - 160); rg = Bt[(size_t)GS_ROW(s2_) * 8 + dir * 4 + h]; } } while (0)
#define GS_ST8(dst, r) do { float f_[8]; unpack8(r, f_); *(LAS f32x4*)(dst) = (f32x4){f_[0], f_[1], f_[2], f_[3]}; *(LAS f32x4*)((dst) + 16) = (f32x4){f_[4], f_[5], f_[6], f_[7]}; } while (0)
#define GS_STORE(buf) do { LAS unsigned char* p_ = lds + (buf) * GS_BUF; \
        GS_ST8(p_ + GS_K + lsl * 512 + lc * 32, rk); GS_ST8(p_ + GS_Q + lsl * 512 + lc * 32, rq); \
        if (tid < 128) GS_ST8(p_ + GS_V + (tid >> 2) * 128 + (tid & 3) * 32, rv); \
        else if (tid < 160) *(LAS float*)(p_ + GS_EG + (tid - 128) * 4) = rg; \
        else if (tid < 192) *(LAS float*)(p_ + GS_BTO + (tid - 160) * 4) = rg; } while (0)
        GS_LOAD(0); GS_STORE(0);
        __syncthreads();
        constexpr int NBLK = NKV / GS_NS;
        for (int blk = 0; blk < NBLK; ++blk) {
            const bool more = blk + 1 < NBLK;
            if (more) GS_LOAD(blk + 1);
            const LAS unsigned char* p = lds + (blk & 1) * GS_BUF;
            if (wave < 4) {
              f32x4 k4[4], q4[4]; float vv, eg, bt;
#define GS_FETCH(K4, Q4, VV, EG, BT, sl_) do { _Pragma("unroll") for (int i = 0; i < 4; ++i) { K4[i] = *(const LAS f32x4*)(p + GS_K + (sl_) * 512 + kg * 64 + i * 16); Q4[i] = *(const LAS f32x4*)(p + GS_Q + (sl_) * 512 + kg * 64 + i * 16); } \
                VV = *(const LAS float*)(p + GS_V + (sl_) * 128 + cl * 4); EG = *(const LAS float*)(p + GS_EG + (sl_) * 4); BT = *(const LAS float*)(p + GS_BTO + (sl_) * 4); } while (0)
              GS_FETCH(k4, q4, vv, eg, bt, 0);
              bf16_t* odp = OD + (size_t)GS_ROW(blk * GS_NS) * 512 + col; const int ostep = dir ? -512 : 512;
#pragma unroll 2
              for (int sl = 0; sl < GS_NS; ++sl) {
                f32x4 nk4[4], nq4[4]; float nvv, neg, nbt;
                const int sn = sl + 1 < GS_NS ? sl + 1 : sl;
                GS_FETCH(nk4, nq4, nvv, neg, nbt, sn);
                f32x2 pa = {0.f, 0.f}, pb = {0.f, 0.f};
#pragma unroll
                for (int i = 0; i < 4; ++i) { pa += (f32x2){k4[i][0], k4[i][1]} * S[2 * i]; pb += (f32x2){k4[i][2], k4[i][3]} * S[2 * i + 1]; }
                const f32x2 pab = pa + pb; float pp = pab[0] + pab[1];
                pp += dppf(pp, 0); pp += dppf(pp, 1); pp += dppf(pp, 2);
                const float dl = bt * (vv - eg * pp);
                f32x2 oa = {0.f, 0.f}, ob = {0.f, 0.f};
#pragma unroll
                for (int i = 0; i < 4; ++i) {
                    S[2 * i] = S[2 * i] * eg + (f32x2){k4[i][0], k4[i][1]} * dl; S[2 * i + 1] = S[2 * i + 1] * eg + (f32x2){k4[i][2], k4[i][3]} * dl;
                    oa += (f32x2){q4[i][0], q4[i][1]} * S[2 * i]; ob += (f32x2){q4[i][2], q4[i][3]} * S[2 * i + 1]; }
                const f32x2 oab = oa + ob; float oo = oab[0] + oab[1];
                oo += dppf(oo, 0); oo += dppf(oo, 1); oo += dppf(oo, 2);
                if (kg == 0) odp[(ptrdiff_t)sl * ostep] = (bf16_t)f2bf(oo);
#pragma unroll
                for (int i = 0; i < 4; ++i) { k4[i] = nk4[i]; q4[i] = nq4[i]; }
                vv = nvv; eg = neg; bt = nbt;
              }
#undef GS_FETCH
            }
            if (more) GS_STORE((blk + 1) & 1);
            __syncthreads();
        }
#undef GS_ROW
#undef GS_LOAD
#undef GS_STORE
#undef GS_ST8
    }
    { const int gid = bid * 512 + tid;
      if (gid < NB * 2 * 512) { const int ch = gid & 511, dir = (gid >> 9) & 1, b = gid >> 10;
        const float* TOTA = (const float*)(a->ws + WS_TOTA); const float* TOTH = (const float*)(a->ws + WS_TOTH); float* CARRY = (float*)(a->ws + WS_CARRY);
        float carry = 0.f;
        for (int s = 0; s < 68; ++s) { const int slot = dir ? (s < 4 ? 3 - s : 67 - (s - 4)) : s; const size_t idx = ((size_t)((b * 2 + dir) * 68 + slot)) * 512 + ch;
            CARRY[idx] = carry; carry = TOTA[idx] * carry + TOTH[idx]; } } }
}


__device__ __forceinline__ int gs_row(int b, int dir, int s) { return s < CTXL ? (ML + b * CTXL + (dir ? CTXL - 1 - s : s)) : (b * SEQ + (dir ? SEQ - 1 - (s - CTXL) : (s - CTXL))); }
__device__ __forceinline__ float fexp(float x) { return __builtin_amdgcn_exp2f(1.4426950408889634f * x); }
constexpr int CP_WAVE = 64 * 68 * 4 + 512;
__device__ __forceinline__ void gdn_chunk_prep(KA a, LAS unsigned char* lds, int gw, int NGW, int wave, int lane) {
    const bf16_t* QN = (const bf16_t*)(a->ws + WS_U); const bf16_t* KN = QN + (size_t)MT * 512;
    const float* Gb = (const float*)(a->ws + WS_G); const float* Bt = (const float*)(a->ws + WS_BT);
    bf16_t* Tb = (bf16_t*)(a->ws + WS_TB); bf16_t* QKb = (bf16_t*)(a->ws + WS_QKB); float* GAM = (float*)(a->ws + WS_GAM);
    LAS float* Am = (LAS float*)(lds + wave * CP_WAVE); LAS float* gl = Am + 64 * 68; LAS float* bl = gl + 64;
    const int r32 = lane & 31, hi = lane >> 5;
    bf16x8 kf[2][8]; float gi_raw = 0.f, bt_raw = 0.f;
#define CP_FETCH(cu_) do { const int ch_ = (cu_) / 68, n_ = (cu_) % 68, b_ = ch_ >> 3, h_ = (ch_ >> 1) & 3, d_ = ch_ & 1; const int r0_ = gs_row(b_, d_, 64 * n_), rs_ = d_ ? -1 : 1; \
        _Pragma("unroll") for (int blk = 0; blk < 2; ++blk) _Pragma("unroll") for (int ks = 0; ks < 8; ++ks) \
            kf[blk][ks] = *(const bf16x8*)(KN + (size_t)(r0_ + rs_ * (32 * blk + r32)) * 512 + h_ * 128 + 16 * ks + 8 * hi); \
        const size_t rl_ = (size_t)(r0_ + rs_ * lane); gi_raw = Gb[rl_ * 8 + d_ * 4 + h_]; bt_raw = Bt[rl_ * 8 + d_ * 4 + h_]; } while (0)
    if (gw < 64 * 68) CP_FETCH(gw);
    for (int cu = gw; cu < 64 * 68; cu += NGW) {
        const int chain = cu / 68, n = cu % 68, b = chain >> 3, h = (chain >> 1) & 3, dir = chain & 1;
        const int row0 = gs_row(b, dir, 64 * n), rs = dir ? -1 : 1;
        { float gi = gi_raw;
#pragma unroll
          for (int o = 1; o < 64; o <<= 1) { const float t = __shfl_up(gi, o); if (lane >= o) gi += t; }
          gl[lane] = gi; bl[lane] = bt_raw; GAM[(size_t)cu * 64 + lane] = gi; }
        LDS_WAIT();
        const float gj0 = gl[r32], gj1 = gl[32 + r32];
#pragma unroll
        for (int tl = 0; tl < 3; ++tl) { const int mb = tl == 0 ? 0 : 1, nb = tl == 2 ? 1 : 0;
            f32x16 acc;
#pragma unroll
            for (int r = 0; r < 16; ++r) acc[r] = 0.f;
#pragma unroll
            for (int ks = 0; ks < 8; ++ks) acc = __builtin_amdgcn_mfma_f32_32x32x16_bf16(kf[mb][ks], kf[nb][ks], acc, 0, 0, 0);
            const int j = 32 * nb + r32; const float gj = nb ? gj1 : gj0;
#pragma unroll
            for (int q = 0; q < 4; ++q) { const int i0 = 32 * mb + 8 * q + 4 * hi; const f32x4 gmi = *(const LAS f32x4*)(gl + i0), bti = *(const LAS f32x4*)(bl + i0);
#pragma unroll
                for (int e = 0; e < 4; ++e) { const int i = i0 + e; Am[i * 68 + j] = (i > j) ? bti[e] * acc[4 * q + e] * fexp(gmi[e] - gj) : 0.f; } }
        }
        asm volatile("" ::: "memory");
        {
            bf16_t* qko = QKb + (size_t)cu * 4096;
#pragma unroll
            for (int mb = 0; mb < 2; ++mb) {
                bf16x8 qf[8];
#pragma unroll
                for (int ks = 0; ks < 8; ++ks) qf[ks] = *(const bf16x8*)(QN + (size_t)(row0 + rs * (32 * mb + r32)) * 512 + h * 128 + 16 * ks + 8 * hi);
#pragma unroll
                for (int nb = 0; nb <= mb; ++nb) {
                    f32x16 acc;
#pragma unroll
                    for (int r = 0; r < 16; ++r) acc[r] = 0.f;
#pragma unroll
                    for (int ks = 0; ks < 8; ++ks) acc = __builtin_amdgcn_mfma_f32_32x32x16_bf16(qf[ks], kf[nb][ks], acc, 0, 0, 0);
                    const int j = 32 * nb + r32; const float gj = nb ? gj1 : gj0;
#pragma unroll
                    for (int q = 0; q < 4; ++q) { const int i0 = 32 * mb + 8 * q + 4 * hi; const f32x4 gmi = *(const LAS f32x4*)(gl + i0);
#pragma unroll
                        for (int e = 0; e < 4; ++e) { const int i = i0 + e; qko[i * 64 + j] = (bf16_t)f2bf((i >= j) ? acc[4 * q + e] * fexp(gmi[e] - gj) : 0.f); } }
                }
                asm volatile("" ::: "memory");
            }
#pragma unroll
            for (int q = 0; q < 4; ++q)
#pragma unroll
                for (int e = 0; e < 4; ++e) qko[(8 * q + 4 * hi + e) * 64 + 32 + r32] = (bf16_t)0;
        }
        asm volatile("" ::: "memory");
        LDS_WAIT();
        { const int cn = cu + NGW < 64 * 68 ? cu + NGW : cu; CP_FETCH(cn); }
        {
            float Tc[64]; int ln = lane;
#pragma unroll
            for (int i = 0; i < 64; ++i) {
                if ((i & 3) == 0) asm volatile("" : "+v"(ln));
                float acc = (i == ln) ? 1.f : 0.f, acc1 = 0.f;
#pragma unroll
                for (int jj = 0; jj < (i + 3) / 4; ++jj) { const f32x4 a4 = *(const LAS f32x4*)(Am + i * 68 + 4 * jj);
#pragma unroll
                    for (int e = 0; e < 4; ++e) if (4 * jj + e < i) { if (e & 1) acc1 -= a4[e] * Tc[4 * jj + e]; else acc -= a4[e] * Tc[4 * jj + e]; } }
                Tc[i] = acc + acc1;
                if ((i & 1) == 1) asm volatile("" ::: "memory");
            }
            bf16_t* to = Tb + (size_t)cu * 4096 + lane;
#pragma unroll
            for (int i = 0; i < 64; ++i) to[i * 64] = (bf16_t)f2bf(Tc[i]);
        }
        LDS_WAIT();
    }
#undef CP_FETCH
}

constexpr int CS_KN = 0, CS_QN = 17408, CS_KT = 34816, CS_T = 53248, CS_QK = 62464, CS_VT = 71680, CS_GB = 76288, CS_ST = 77312, CS_RT = 86016, CS_VNT = 90624, CS_VDT = 95232, CS_END = 99840;
__device__ __forceinline__ void cs_compute(LAS unsigned char* lds, int wave, int r32, int hi, f32x16& acc, f32x16& Sreg, bf16_t* op, int row0, int rs) {
    const LAS float* gamL = (const LAS float*)(lds + CS_GB); const LAS float* betL = gamL + 64;
    const int mb = wave & 1;
    if (wave < 4) {
        const LAS unsigned char* X = lds + ((wave >> 1) ? CS_QN : CS_KN) + (32 * mb + r32) * 272 + 16 * hi; const LAS unsigned char* Sb = lds + CS_ST + r32 * 272 + 16 * hi;
#pragma unroll
        for (int r = 0; r < 16; ++r) acc[r] = 0.f;
#pragma unroll
        for (int ks = 0; ks < 8; ++ks) acc = __builtin_amdgcn_mfma_f32_32x32x16_bf16(*(const LAS bf16x8*)(X + 32 * ks), *(const LAS bf16x8*)(Sb + 32 * ks), acc, 0, 0, 0);
    }
    if (wave < 2) {
#pragma unroll
        for (int q = 0; q < 4; ++q) { const int t0 = 32 * mb + 8 * q + 4 * hi; const f32x4 gm = *(const LAS f32x4*)(gamL + t0), bt = *(const LAS f32x4*)(betL + t0);
            const u32x2 vv = *(const LAS u32x2*)(lds + CS_VT + r32 * 144 + t0 * 2);
            const float v0 = __uint_as_float(vv.x << 16), v1 = __uint_as_float(vv.x & 0xffff0000u), v2 = __uint_as_float(vv.y << 16), v3 = __uint_as_float(vv.y & 0xffff0000u);
            u32x2 w; w.x = pk2(bt[0] * (v0 - fexp(gm[0]) * acc[4 * q]), bt[1] * (v1 - fexp(gm[1]) * acc[4 * q + 1]));
            w.y = pk2(bt[2] * (v2 - fexp(gm[2]) * acc[4 * q + 2]), bt[3] * (v3 - fexp(gm[3]) * acc[4 * q + 3]));
            *(LAS u32x2*)(lds + CS_RT + r32 * 144 + t0 * 2) = w; }
    }
    __syncthreads();
    if (wave < 2) {
        f32x16 vn;
#pragma unroll
        for (int r = 0; r < 16; ++r) vn[r] = 0.f;
        const LAS unsigned char* Ta = lds + CS_T + (32 * mb + r32) * 144 + 16 * hi; const LAS unsigned char* Rb = lds + CS_RT + r32 * 144 + 16 * hi;
#pragma unroll
        for (int ks = 0; ks < 4; ++ks) vn = __builtin_amdgcn_mfma_f32_32x32x16_bf16(*(const LAS bf16x8*)(Ta + 32 * ks), *(const LAS bf16x8*)(Rb + 32 * ks), vn, 0, 0, 0);
        const float glast = gamL[63];
#pragma unroll
        for (int q = 0; q < 4; ++q) { const int t0 = 32 * mb + 8 * q + 4 * hi; const f32x4 gm = *(const LAS f32x4*)(gamL + t0);
            u32x2 w; w.x = pk2(vn[4 * q], vn[4 * q + 1]); w.y = pk2(vn[4 * q + 2], vn[4 * q + 3]);
            *(LAS u32x2*)(lds + CS_VNT + r32 * 144 + t0 * 2) = w;
            w.x = pk2(vn[4 * q] * fexp(glast - gm[0]), vn[4 * q + 1] * fexp(glast - gm[1])); w.y = pk2(vn[4 * q + 2] * fexp(glast - gm[2]), vn[4 * q + 3] * fexp(glast - gm[3]));
            *(LAS u32x2*)(lds + CS_VDT + r32 * 144 + t0 * 2) = w; }
    }
    __syncthreads();
    if (wave == 2 || wave == 3) {
#pragma unroll
        for (int q = 0; q < 4; ++q) { const int t0 = 32 * mb + 8 * q + 4 * hi; const f32x4 gm = *(const LAS f32x4*)(gamL + t0);
#pragma unroll
            for (int e = 0; e < 4; ++e) acc[4 * q + e] *= fexp(gm[e]); }
        const LAS unsigned char* Qa = lds + CS_QK + (32 * mb + r32) * 144 + 16 * hi; const LAS unsigned char* Vb = lds + CS_VNT + r32 * 144 + 16 * hi;
#pragma unroll
        for (int ks = 0; ks < 4; ++ks) acc = __builtin_amdgcn_mfma_f32_32x32x16_bf16(*(const LAS bf16x8*)(Qa + 32 * ks), *(const LAS bf16x8*)(Vb + 32 * ks), acc, 0, 0, 0);
#pragma unroll
        for (int r = 0; r < 16; ++r) { const int tok = 32 * mb + (r & 3) + 8 * (r >> 2) + 4 * hi; op[(ptrdiff_t)(row0 + rs * tok) * 512] = (bf16_t)f2bf(acc[r]); }
    } else if (wave >= 4) {
        const int mk = wave - 4; const float cd = fexp(gamL[63]);
#pragma unroll
        for (int r = 0; r < 16; ++r) Sreg[r] *= cd;
        const LAS unsigned char* Ka = lds + CS_KT + (32 * mk + r32) * 144 + 16 * hi; const LAS unsigned char* Db = lds + CS_VDT + r32 * 144 + 16 * hi;
#pragma unroll
        for (int ks = 0; ks < 4; ++ks) Sreg = __builtin_amdgcn_mfma_f32_32x32x16_bf16(*(const LAS bf16x8*)(Ka + 32 * ks), *(const LAS bf16x8*)(Db + 32 * ks), Sreg, 0, 0, 0);
#pragma unroll
        for (int q = 0; q < 4; ++q) { u32x2 w; w.x = pk2(Sreg[4 * q], Sreg[4 * q + 1]); w.y = pk2(Sreg[4 * q + 2], Sreg[4 * q + 3]);
            *(LAS u32x2*)(lds + CS_ST + r32 * 272 + (32 * mk + 8 * q + 4 * hi) * 2) = w; }
    }
    __syncthreads();
}
__device__ __forceinline__ void gdn_chunk_scan(KA a, LAS unsigned char* lds, int bid, int G, int tid, int wave, int lane) {
    const bf16_t* QN = (const bf16_t*)(a->ws + WS_U); const bf16_t* KN = QN + (size_t)MT * 512; const bf16_t* V = (const bf16_t*)(a->ws + WS_V);
    const float* Bt = (const float*)(a->ws + WS_BT);
    const bf16_t* Tb = (const bf16_t*)(a->ws + WS_TB); const bf16_t* QKb = (const bf16_t*)(a->ws + WS_QKB); const float* GAM = (const float*)(a->ws + WS_GAM);
    const int r32 = lane & 31, hi = lane >> 5;
    for (int u = bid; u < 256; u += G) {
        const int chain = u >> 2, qd = u & 3, b = chain >> 3, h = (chain >> 1) & 3, dir = chain & 1, rs = dir ? -1 : 1;
        bf16_t* op = (bf16_t*)(a->ws + (dir ? WS_OB : WS_OF)) + h * 128 + qd * 32 + r32;
        u32x4 rkA[2], rqA[2], rTA, rQKA, rVA; float rgbA = 0.f;
        u32x4 rkB[2], rqB[2], rTB, rQKB, rVB; float rgbB = 0.f;
#define CS_LOAD(S_, n_) do { const int row0_ = gs_row(b, dir, 64 * (n_)); const size_t cu_ = (size_t)(chain * 68 + (n_)); const size_t rowl_ = (size_t)(row0_ + rs * lane); \
        _Pragma("unroll") for (int i_ = 0; i_ < 2; ++i_) { const int c16_ = wave + 8 * i_; \
            rk##S_[i_] = *(const u32x4*)(KN + rowl_ * 512 + h * 128 + c16_ * 8); rq##S_[i_] = *(const u32x4*)(QN + rowl_ * 512 + h * 128 + c16_ * 8); } \
        rT##S_ = *(const u32x4*)(Tb + cu_ * 4096 + tid * 8); rQK##S_ = *(const u32x4*)(QKb + cu_ * 4096 + tid * 8); \
        if (wave < 4) rV##S_ = *(const u32x4*)(V + rowl_ * 512 + h * 128 + qd * 32 + wave * 8); \
        if (tid < 64) rgb##S_ = GAM[cu_ * 64 + tid]; else if (tid < 128) rgb##S_ = Bt[(size_t)(row0_ + rs * (tid - 64)) * 8 + dir * 4 + h]; } while (0)
#define CS_T16(base, v, col0, tok) do { const unsigned w_[4] = {(v).x, (v).y, (v).z, (v).w}; _Pragma("unroll") for (int e_ = 0; e_ < 8; ++e_) \
        *(LAS bf16_t*)(lds + (base) + ((col0) + e_) * 144 + (tok) * 2) = (bf16_t)((e_ & 1) ? (w_[e_ >> 1] >> 16) : (w_[e_ >> 1] & 0xffffu)); } while (0)
#define CS_STORE(S_) do { \
        _Pragma("unroll") for (int i_ = 0; i_ < 2; ++i_) { const int c16_ = wave + 8 * i_; \
            *(LAS u32x4*)(lds + CS_KN + lane * 272 + c16_ * 16) = rk##S_[i_]; *(LAS u32x4*)(lds + CS_QN + lane * 272 + c16_ * 16) = rq##S_[i_]; CS_T16(CS_KT, rk##S_[i_], c16_ * 8, lane); } \
        *(LAS u32x4*)(lds + CS_T + (tid >> 3) * 144 + (tid & 7) * 16) = rT##S_; *(LAS u32x4*)(lds + CS_QK + (tid >> 3) * 144 + (tid & 7) * 16) = rQK##S_; \
        if (wave < 4) CS_T16(CS_VT, rV##S_, wave * 8, lane); \
        if (tid < 128) *(LAS float*)(lds + CS_GB + tid * 4) = rgb##S_; } while (0)
        CS_LOAD(A, 0);
        for (int i = tid; i < 32 * 272 / 4; i += 512) *(LAS unsigned*)(lds + CS_ST + i * 4) = 0u;
        CS_STORE(A);
        __syncthreads();
        CS_LOAD(A, 1);
        f32x16 Sreg, acc;
#pragma unroll
        for (int r = 0; r < 16; ++r) { Sreg[r] = 0.f; acc[r] = 0.f; }
        for (int n = 0; n < 68; n += 2) {
            if (n + 2 < 68) CS_LOAD(B, n + 2);
            cs_compute(lds, wave, r32, hi, acc, Sreg, op, gs_row(b, dir, 64 * n), rs);
            CS_STORE(A);
            __syncthreads();
            if (n + 3 < 68) CS_LOAD(A, n + 3);
            cs_compute(lds, wave, r32, hi, acc, Sreg, op, gs_row(b, dir, 64 * (n + 1)), rs);
            if (n + 2 < 68) CS_STORE(B);
            __syncthreads();
        }
#undef CS_LOAD
#undef CS_T16
#undef CS_STORE
    }
    if (wave == 0 && lane < 32) {
      const float* TOTA = (const float*)(a->ws + WS_TOTA); const float* TOTH = (const float*)(a->ws + WS_TOTH); float* CARRY = (float*)(a->ws + WS_CARRY);
      for (int gid = bid * 32 + lane; gid < NB * 2 * 512; gid += G * 32) { const int ch = gid & 511, dir = (gid >> 9) & 1, b = gid >> 10;
        float carry = 0.f;
        for (int s0 = 0; s0 < 68; s0 += 17) {
            float ta[17], th[17];
#pragma unroll
            for (int k = 0; k < 17; ++k) { const int s = s0 + k; const int slot = dir ? (s < 4 ? 3 - s : 67 - (s - 4)) : s; const size_t idx = ((size_t)((b * 2 + dir) * 68 + slot)) * 512 + ch; ta[k] = TOTA[idx]; th[k] = TOTH[idx]; }
#pragma unroll
            for (int k = 0; k < 17; ++k) { const int s = s0 + k; const int slot = dir ? (s < 4 ? 3 - s : 67 - (s - 4)) : s; const size_t idx = ((size_t)((b * 2 + dir) * 68 + slot)) * 512 + ch; CARRY[idx] = carry; carry = ta[k] * carry + th[k]; }
        } } }
}

__device__ __forceinline__ void gdn_merge(KA a, int L, int gw, int NGW, int lane) {
    const int j2 = L >> 1;
    const bf16_t* P = (const bf16_t*)(a->ws + WS_P); bf16_t* U = (bf16_t*)(a->ws + WS_U);
    const bf16_t* OF = (const bf16_t*)(a->ws + WS_OF); const bf16_t* OB = (const bf16_t*)(a->ws + WS_OB);
    const float* gn = a->in[I_EVGDNNORM] + j2 * 128 + ((8 * lane) & 127);
    float g8[8];
#pragma unroll
    for (int e = 0; e < 8; ++e) g8[e] = gn[e];
    for (int row = gw; row < MT; row += NGW) {
        float of[8], ob[8], z[8], y[8];
        unpack8(*(const u32x4*)(OF + (size_t)row * 512 + 8 * lane), of); unpack8(*(const u32x4*)(OB + (size_t)row * 512 + 8 * lane), ob);
        unpack8(*(const u32x4*)(P + (size_t)row * EVNP + 1536 + 8 * lane), z);
        float ssq = 0.f;
#pragma unroll
        for (int e = 0; e < 8; ++e) { of[e] += ob[e]; ssq += of[e] * of[e]; }
        ssq = rowsum16(ssq);
        const float rms = 1.0f / sqrtf(ssq * (1.f / 128.f) + EPS);
#pragma unroll
        for (int e = 0; e < 8; ++e) y[e] = of[e] * rms * g8[e] * fsilu(z[e]);
        *(u32x4*)(U + (size_t)row * D + 8 * lane) = pack8(y);
    }
}


#define XB_TMO      128
#define XB_XCNT(j)  (256  + 64 * (j))
#define XB_XSUB(j)  (1280 + 64 * (j))
#define XB_XGEN(j)  (2304 + 64 * (j))
#define XB_TOP      3328
#define XB_TOPGEN   3392
#define XCD_BAR_WORDS 3456
#define XB_SPIN_CAP (1u << 20)
__device__ __forceinline__ unsigned xb_ld(unsigned* p)              { return __hip_atomic_load(p, __ATOMIC_RELAXED, __HIP_MEMORY_SCOPE_AGENT); }
__device__ __forceinline__ unsigned xb_add(unsigned* p, unsigned v) { return __hip_atomic_fetch_add(p, v, __ATOMIC_RELAXED, __HIP_MEMORY_SCOPE_AGENT); }
__device__ __forceinline__ unsigned xb_xcc_id() { return (unsigned)__builtin_amdgcn_s_getreg((3 << 11) | 20) & 0xFu; }
#define XB_SPIN(cond, bar) do { unsigned _sp = 0; while (cond) { __builtin_amdgcn_s_sleep(1); \
    if ((++_sp & 255u) == 0u) { if (xb_ld(&(bar)[XB_TMO])) break; if (_sp > XB_SPIN_CAP) { atomicAdd(&(bar)[XB_TMO], 1u); break; } } } } while (0)
struct XcdBarrier { unsigned* bar; unsigned x; volatile LAS unsigned* st; };
__device__ __forceinline__ XcdBarrier xcd_barrier_post(unsigned* bar, volatile LAS unsigned* st) {
    XcdBarrier b; b.bar = bar; b.x = xb_xcc_id(); b.st = st;
    if (threadIdx.x == 0) (void)xb_add(&bar[XB_XCNT(b.x)], 1u);
    return b;
}
__device__ __forceinline__ void xcd_barrier_complete(unsigned* bar, unsigned x, unsigned& nloc, unsigned& nx) {
    const unsigned G = gridDim.x * gridDim.y * gridDim.z;
    unsigned sum, cnt, mine, sp = 0u;
    for (;;) {
        sum = 0u; cnt = 0u; mine = 0u;
#pragma unroll
        for (unsigned j = 0; j < 16; ++j) { const unsigned c = xb_ld(&bar[XB_XCNT(j)]); sum += c; cnt += (c > 0u) ? 1u : 0u; mine = (j == x) ? c : mine; }
        if (sum == G) break;
        __builtin_amdgcn_s_sleep(1);
        if ((++sp & 255u) == 0u) { if (xb_ld(&bar[XB_TMO])) break; if (sp > XB_SPIN_CAP) { atomicAdd(&bar[XB_TMO], 1u); break; } }
    }
    nloc = mine > 0u ? mine : 1u; nx = cnt > 0u ? cnt : 1u;
}
__device__ __forceinline__ void xcd_barrier(const XcdBarrier& b) {
    asm volatile("s_waitcnt vmcnt(0)" ::: "memory");
    __syncthreads();
    if (threadIdx.x == 0) {
        unsigned* bar = b.bar;
        __builtin_amdgcn_s_waitcnt(0);
        unsigned nloc = b.st[0], nx = b.st[1];
        if (nloc == 0u) { xcd_barrier_complete(bar, b.x, nloc, nx); b.st[0] = nloc; b.st[1] = nx; }
        const unsigned old = xb_add(&bar[XB_XSUB(b.x)], 1u);
        const unsigned gen = old / nloc;
        if (old + 1u == (gen + 1u) * nloc) {
            __builtin_amdgcn_fence(__ATOMIC_RELEASE, "agent");
            asm volatile("s_waitcnt vmcnt(0)" ::: "memory");
            const unsigned og = xb_add(&bar[XB_TOP], 1u);
            const unsigned tg = og / nx;
            if (og + 1u == (tg + 1u) * nx) xb_add(&bar[XB_TOPGEN], 1u);
            else XB_SPIN(xb_ld(&bar[XB_TOPGEN]) == tg, bar);
            __builtin_amdgcn_fence(__ATOMIC_ACQUIRE, "agent");
            xb_add(&bar[XB_XGEN(b.x)], 1u);
            asm volatile("s_waitcnt vmcnt(0)" ::: "memory");
        } else {
            XB_SPIN(xb_ld(&bar[XB_XGEN(b.x)]) == gen, bar);
            __builtin_amdgcn_fence(__ATOMIC_ACQUIRE, "agent");
            asm volatile("s_waitcnt vmcnt(0)" ::: "memory");
        }
    }
    __syncthreads();
}

__device__ __forceinline__ void decode_phase(int ph, int& L, int& kind) {
    if (ph == 0) { L = 0; kind = K_PROA; return; }
    if (ph == 1) { L = 0; kind = K_PROB; return; }
    int p = ph - 2;
    if (p < 10) { L = 0; } else if (p < 18) { L = 1; p -= 10; } else if (p < 28) { L = 2; p -= 18; } else { L = 3; p -= 28; }
    if ((L & 1) == 0) { kind = p == 0 ? K_PROJ : p == 1 ? K_E2 : p == 2 ? K_E2B : p == 3 ? K_E3 : p == 4 ? K_E4 : p == 5 ? K_WOUT : p == 6 ? K_LN1 : p == 7 ? K_MLP1 : p == 8 ? K_MLP2 : K_LN2; }
    else { kind = p == 0 ? K_PROJ : p == 1 ? K_O2 : p == 2 ? K_O3 : p == 3 ? K_WOUT : p == 4 ? K_LN1 : p == 5 ? K_MLP1 : p == 6 ? K_MLP2 : K_LN2; }
}

#ifndef MK_DUP_GEMM
#define MK_DUP_GEMM 0
#endif
#ifndef MK_DUP_KIND
#define MK_DUP_KIND -1
#endif
#ifndef MK_SKIP1
#define MK_SKIP1 1
#endif
#ifndef MK_K2
#define MK_K2 1024
#endif
#ifndef MK_PHM
#define MK_PHM 0xffffu
#endif
#define EN(k) ((MK_PHM >> (k)) & 1u)
__global__ void __launch_bounds__(512, 2) fwd_kernel(Args args) {
    extern __shared__ __attribute__((aligned(16))) unsigned char lds_raw[];
    LAS unsigned char* lds = (LAS unsigned char*)lds_raw;
    cg::grid_group grid = cg::this_grid();
    const int G = gridDim.x;
    volatile LAS unsigned* bst = (volatile LAS unsigned*)(lds + LDS_BYTES - 16);
    if (threadIdx.x < 2) bst[threadIdx.x] = 0u;
    __syncthreads();
    const XcdBarrier xbar = xcd_barrier_post((unsigned*)(args.ws + WS_BAR), bst);
    const int ph_lo = args.ph_lo, ph_hi = args.ph_hi;
    bool second = false;
    for (int ph = ph_lo; ph < ph_hi; ) {
        KA a = (KA)__builtin_amdgcn_kernarg_segment_ptr(); asm volatile("" : "+s"(a));
        int tid = threadIdx.x; asm volatile("" : "+v"(tid));
        int bid = blockIdx.x; asm volatile("" : "+s"(bid));
        const int lane = tid & 63, wave = __builtin_amdgcn_readfirstlane(tid >> 6), gw = bid * 8 + wave, NGW = G * 8;
        bf16_t* U = (bf16_t*)(a->ws + WS_U); bf16_t* P = (bf16_t*)(a->ws + WS_P); float* HC = (float*)(a->ws + WS_HC);
        const float* MOD = (const float*)(a->ws + WS_MOD);
        int L, kind; decode_phase(ph, L, kind);
        const bool even = (L & 1) == 0; const bool last = L == 3;
        const int Mrows = last ? ML : MT;
        const bool isgemm = kind == K_PROJ || kind == K_MLP1 || kind == K_WOUT || kind == K_MLP2;
        const bool dup = (MK_DUP_GEMM && isgemm) || kind == MK_DUP_KIND;
        if (EN(K_PROA) && kind == K_PROA) prologue_a(a, lds, bid, G, tid, wave, lane);
        else if (EN(K_PROB) && kind == K_PROB) prologue_b(a, gw, NGW, lane);
        else if (EN(K_PROJ) && (kind == K_PROJ || kind == K_MLP1 || kind == K_WOUT || kind == K_MLP2)) {
            const float* modL = MOD + (size_t)L * 9 * 6144;
            const bool split = (kind == K_WOUT || kind == K_MLP2) && !last;
            const int ncall = split ? 2 : 1;
            for (int call = 0; call < ncall; ++call) {
                pg8::Gemm g; pg8::EpiBf16 E;
                if (kind == K_PROJ) { g = pg8::Gemm{U, (const bf16_t*)(a->ws + WS_WA), MT, even ? EVNP : ODN, D, D, D, 1}; E = pg8::EpiBf16{P, even ? EVNP : ODN, 0, nullptr, -1, 0}; }
                else if (kind == K_MLP1) { g = pg8::Gemm{U, (const bf16_t*)(a->ws + WS_W1), Mrows, FF, D, D, D, 1}; E = pg8::EpiBf16{P, FF, 2, nullptr, -1, 0}; }
                else if (kind == K_WOUT) { const bf16_t* A = even ? U : P; const int lda = even ? D : ODN;
                    if (call == 0) { g = pg8::Gemm{A, (const bf16_t*)(a->ws + WS_WO), ML, D, D, lda, D, 1}; E = pg8::EpiBf16{even ? P : U, D, 0, modL + 2 * D, -1, 0}; }
                    else { g = pg8::Gemm{A + (size_t)ML * lda, (const bf16_t*)(a->ws + WS_WO), MC, D, D / 4, lda, D, 4}; E = pg8::EpiBf16{(bf16_t*)(a->ws + WS_PART), D, 0, modL + 2 * D, 8, (size_t)MC * D}; } }
                else { if (call == 0) { g = pg8::Gemm{P, (const bf16_t*)(a->ws + WS_W2), ML, D, FF, FF, FF, 1}; E = pg8::EpiBf16{U, D, 0, modL + 5 * D, -1, 0}; }
                    else { g = pg8::Gemm{P + (size_t)ML * FF, (const bf16_t*)(a->ws + WS_W2), MC, D, FF / 8, FF, FF, 8}; E = pg8::EpiBf16{(bf16_t*)(a->ws + WS_PART), D, 0, modL + 5 * D, 8, (size_t)MC * D}; } }
                pg8::StaticOrder S; S.init(g.M, g.N, G, bid, g.nks);
                pg8::gemm_phase<pg8::EpiBf16>(lds, g, S, E, tid);
            }
        }
        else if (EN(K_LN1) && kind == K_LN1) ln_pass(a, L, 0, Mrows, true, L, 3, even ? P : U, last ? 0 : 4, gw, NGW, lane);
        else if (EN(K_LN2) && kind == K_LN2) {
            ln_pass(a, L, 1, Mrows, !last, L + 1, 0, U, last ? 0 : 8, gw, NGW, lane);
            if (!last) conv_weights(a, L + 1, lds, gw, NGW, wave, lane);
        }
        else if (EN(K_E2) && kind == K_E2) { gdn_prep(a, L, lds, gw, NGW, tid, lane); lru_units<1>(a, L, lds, bid, G, tid); }
        else if (EN(K_E2B) && kind == K_E2B) gdn_chunk_prep(a, lds, gw, NGW, wave, lane);
        else if (EN(K_E3) && kind == K_E3) gdn_chunk_scan(a, lds, bid, G, tid, wave, lane);
        else if (EN(K_E4) && kind == K_E4) { gdn_merge(a, L, gw, NGW, lane); lru_units<2>(a, L, lds, bid, G, tid); }
        else if (EN(K_O2) && kind == K_O2) attn_prep(a, lds, bid, G, tid);
        else if (EN(K_O3) && kind == K_O3) attn_phase(a, L, lds, bid, G, tid, wave, lane, !dup || second);
        if (dup && !second) { second = true; grid.sync(); continue; }
        second = false; ++ph;
        if (ph < ph_hi) { if (ph == ph_lo + 1) grid.sync(); else xcd_barrier(xbar); }
    }
}

#ifndef MK_PH_HI
#define MK_PH_HI N_PHASES
#endif
#ifndef MK_PER_PHASE
#define MK_PER_PHASE 0
#endif
extern "C" void kernel_launch(void* const* d_in, const int* in_sizes, int n_in, void* d_out, int out_size, void* d_ws, size_t ws_size, hipStream_t stream) {
    static int grid = 0;
    if (grid == 0) {
        if (n_in != 24 || ws_size < WS_END) { fprintf(stderr, "kernel_launch: unexpected n_in %d / ws_size %zu\n", n_in, ws_size); grid = -1; return; }
        int dev = 0, cus = 0, per_cu = 0;
        (void)hipGetDevice(&dev); (void)hipDeviceGetAttribute(&cus, hipDeviceAttributeMultiprocessorCount, dev);
        if (hipFuncSetAttribute((const void*)fwd_kernel, hipFuncAttributeMaxDynamicSharedMemorySize, LDS_BYTES) != hipSuccess) { fprintf(stderr, "kernel_launch: hipFuncSetAttribute failed\n"); grid = -1; return; }
        (void)hipOccupancyMaxActiveBlocksPerMultiprocessor(&per_cu, (const void*)fwd_kernel, 512, LDS_BYTES);
        (void)hipGetLastError();
        if (per_cu < 1) per_cu = 1;
        grid = cus;
        fprintf(stderr, "kernel_launch: cus %d per_cu %d grid %d\n", cus, per_cu, grid);
    }
    if (grid < 0) return;
    Args a{};
    for (int i = 0; i < 24; ++i) a.in[i] = (const float*)d_in[i];
    a.out = (float*)d_out; a.ws = (unsigned char*)d_ws;
#if MK_PER_PHASE
    for (int ph = 0; ph < N_PHASES; ++ph) { a.ph_lo = ph; a.ph_hi = ph + 1; hipLaunchKernelGGL(fwd_kernel, dim3(grid), dim3(512), LDS_BYTES, stream, a); }
#else
    a.ph_lo = 0; a.ph_hi = MK_PH_HI;
    (void)hipMemsetAsync((unsigned char*)d_ws + WS_BAR, 0, 16384, stream);
    void* args[] = {&a};
    hipError_t e = hipLaunchCooperativeKernel((const void*)fwd_kernel, dim3(grid), dim3(512), args, LDS_BYTES, stream);
    if (e != hipSuccess) fprintf(stderr, "kernel_launch: cooperative launch failed: %s (grid %d)\n", hipGetErrorString(e), grid);
#endif
}
```

```cpp
#include <hip/hip_runtime.h>
#include <hip/hip_cooperative_groups.h>
#include <cstdio>
#include <cstdint>
namespace cg = cooperative_groups;

#define LAS __attribute__((address_space(3)))
typedef unsigned short bf16_t;
typedef short bf16x8 __attribute__((ext_vector_type(8)));
typedef float f32x4 __attribute__((ext_vector_type(4)));
typedef float f32x2 __attribute__((ext_vector_type(2)));
typedef float f32x16 __attribute__((ext_vector_type(16)));
typedef unsigned u32x4 __attribute__((ext_vector_type(4)));
typedef unsigned u32x2 __attribute__((ext_vector_type(2)));
typedef __bf16 bf16x2_t __attribute__((ext_vector_type(2)));

constexpr int D = 1024, NB = 8, SEQ = 4096, CTXL = 256, FF = 4096;
constexpr int ML = NB * SEQ, MC = NB * CTXL, MT = ML + MC;
constexpr int EVN = 3088, EVNP = 3328, ODN = 3072;
constexpr float ALPHA = 1.6817928305074292f;
constexpr float EPS = 1e-6f;
constexpr int NKV = CTXL + SEQ;
constexpr float QSCALE = 0.125f * 1.4426950408889634f;

constexpr size_t MiB = 1u << 20;
constexpr size_t WS_MISC = 0;
constexpr size_t WS_BAR = 65536;
constexpr size_t WS_MOD = 1 * MiB;
constexpr size_t WS_WA = 2 * MiB;
constexpr size_t WS_WO = 9 * MiB;
constexpr size_t WS_W1 = 11 * MiB;
constexpr size_t WS_W2 = 19 * MiB;
constexpr size_t WS_HC = 27 * MiB;
constexpr size_t WS_U = 35 * MiB;
constexpr size_t WS_P = 103 * MiB;
constexpr size_t WS_X = 324 * MiB;
constexpr size_t WS_V = WS_X;
constexpr size_t WS_OF = WS_X + 34 * MiB;
constexpr size_t WS_OB = WS_X + 68 * MiB;
constexpr size_t WS_G = WS_X + 102 * MiB;
constexpr size_t WS_BT = WS_X + 104 * MiB;
constexpr size_t WS_TOTA = WS_X + 106 * MiB;
constexpr size_t WS_TOTH = WS_X + 109 * MiB;
constexpr size_t WS_CARRY = WS_X + 112 * MiB;
constexpr size_t WS_HLAST = 375 * MiB;
constexpr size_t WS_PART = 376 * MiB;
constexpr size_t WS_TB = WS_X + 116 * MiB;
constexpr size_t WS_QKB = WS_X + 150 * MiB;
constexpr size_t WS_GAM = WS_X + 184 * MiB;
constexpr size_t WS_END = WS_X + 186 * MiB;

constexpr int LDS_BYTES = 147456;

__device__ __forceinline__ float bf2f(unsigned v) { return __uint_as_float(v << 16); }
__device__ __forceinline__ unsigned pk2(float lo, float hi) { f32x2 v = {lo, hi}; bf16x2_t b = __builtin_convertvector(v, bf16x2_t); return __builtin_bit_cast(unsigned, b); }
__device__ __forceinline__ unsigned f2bf(float f) { return pk2(f, 0.f) & 0xffffu; }
__device__ __forceinline__ void unpack8(const u32x4 r, float* o) {
    o[0] = __uint_as_float(r.x << 16); o[1] = __uint_as_float(r.x & 0xffff0000u);
    o[2] = __uint_as_float(r.y << 16); o[3] = __uint_as_float(r.y & 0xffff0000u);
    o[4] = __uint_as_float(r.z << 16); o[5] = __uint_as_float(r.z & 0xffff0000u);
    o[6] = __uint_as_float(r.w << 16); o[7] = __uint_as_float(r.w & 0xffff0000u);
}
__device__ __forceinline__ u32x4 pack8(const float* v) { u32x4 o; o.x = pk2(v[0], v[1]); o.y = pk2(v[2], v[3]); o.z = pk2(v[4], v[5]); o.w = pk2(v[6], v[7]); return o; }
__device__ __forceinline__ float sigmoidf_(float x) { return 1.f / (1.f + expf(-x)); }
__device__ __forceinline__ float siluf_(float x) { return x / (1.f + expf(-x)); }
__device__ __forceinline__ float fsigmoid(float x) { return __builtin_amdgcn_rcpf(1.0f + __builtin_amdgcn_exp2f(-1.4426950408889634f * x)); }
__device__ __forceinline__ float fsilu(float x) { return x * fsigmoid(x); }
__device__ __forceinline__ float softplusf_(float x) { return fmaxf(x, 0.f) + log1pf(expf(-fabsf(x))); }
__device__ __forceinline__ float gelu_tanh(float x) { const float u = 0.7978845608028654f * (x + 0.044715f * x * x * x); return 0.5f * x * (1.f + tanhf(u)); }
__device__ __forceinline__ float dppf(float v, const int ctrl_sel) {
    int r;
    if (ctrl_sel == 0) r = __builtin_amdgcn_update_dpp(0, __float_as_int(v), 0xB1, 0xF, 0xF, true);
    else if (ctrl_sel == 1) r = __builtin_amdgcn_update_dpp(0, __float_as_int(v), 0x4E, 0xF, 0xF, true);
    else if (ctrl_sel == 2) r = __builtin_amdgcn_update_dpp(0, __float_as_int(v), 0x141, 0xF, 0xF, true);
    else r = __builtin_amdgcn_update_dpp(0, __float_as_int(v), 0x140, 0xF, 0xF, true);
    return __int_as_float(r);
}
__device__ __forceinline__ float rowsum16(float v) { v += dppf(v, 0); v += dppf(v, 1); v += dppf(v, 2); v += dppf(v, 3); return v; }
__device__ __forceinline__ float wave_sum(float v) {
#pragma unroll
    for (int o = 1; o < 64; o <<= 1) v += __shfl_xor(v, o);
    return v;
}
__device__ __forceinline__ float xhalf_max(float v) { auto rr = __builtin_amdgcn_permlane32_swap(__float_as_uint(v), __float_as_uint(v), false, false); return fmaxf(__uint_as_float(rr[0]), __uint_as_float(rr[1])); }
__device__ __forceinline__ float xhalf_sum(float v) { auto rr = __builtin_amdgcn_permlane32_swap(__float_as_uint(v), __float_as_uint(v), false, false); return __uint_as_float(rr[0]) + __uint_as_float(rr[1]); }
#define LDS_WAIT() asm volatile("s_waitcnt lgkmcnt(0)" ::: "memory")

namespace pg8 {
constexpr int BM = 256, BK = 64, HALF = 128, HTB = HALF * BK * 2, STAGE_BYTES = 8 * HTB, NXCD = 8, WGM = 8;
__host__ __device__ __forceinline__ int lds_byte(int r, int c) { const int st = (r >> 4) * 2 + (c >> 5), rr = r & 15, cc = c & 31, ob = rr * 64 + cc * 2; return st * 1024 + (ob ^ (((ob >> 9) & 1) << 5)); }
__host__ __device__ __forceinline__ void stage_rc(int b, int& R, int& C) { const int st = b / 1024, sb = b % 1024, swz = sb ^ (((sb >> 9) & 1) << 5); R = (st >> 1) * 16 + swz / 64; C = (st & 1) * 32 + (swz % 64) / 2; }
__host__ __device__ __forceinline__ int perm32(int rho) { const int n = rho >> 4, i = rho & 15; return 8 * (i >> 2) + 4 * n + (i & 3); }
struct Unit { int pm, pn, ks; };
struct Gemm { const bf16_t* A; const bf16_t* Bt; int M, N, K, lda, ldb, nks; };
struct StaticOrder {
    int nM, nN, nwg, G, c;
    int nks;
    __device__ void init(int M, int N, int G_, int c_, int nks_) { nM = M / BM; nN = N / BM; nwg = nM * nN; G = G_; c = c_; nks = nks_; }
    __device__ bool next(int i, Unit& u) const {
        const long L = (long)i * G + c; if (L >= (long)nwg * nks) return false;
        u.ks = (int)(L % nks); int wgid = (int)(L / nks); { const int q = nwg / NXCD, r = nwg % NXCD, xcd = wgid % NXCD, off = wgid / NXCD; wgid = (xcd < r ? xcd * (q + 1) : r * (q + 1) + (xcd - r) * q) + off; }
        const int nig = WGM * nN, gid = wgid / nig, fm = gid * WGM, gsz = (nM - fm) < WGM ? (nM - fm) : WGM;
        u.pm = fm + ((wgid % nig) % gsz); u.pn = (wgid % nig) / gsz; return true;
    }
};
struct EpiBf16 {
    static constexpr bool PERM = true;
    bf16_t* O; int ldc; int act; const float* gate; int bb_force; size_t ks_stride;
    __device__ __forceinline__ void operator()(const f32x4 (&acc)[2][2][4][2], const Unit& u, int wr, int wc, int fr, int fq) const {
        const int rt = u.pm * BM; const int bb = bb_force >= 0 ? bb_force : (rt >= ML ? 8 : (rt >> 12));
        const int row0 = rt + wr * 64 + fr; const int col0 = u.pn * BM + wc * 32 + 8 * fq;
        f32x4 gv[2][2];
#pragma unroll
        for (int bj = 0; bj < 2; ++bj)
#pragma unroll
            for (int n = 0; n < 2; ++n) gv[bj][n] = gate ? *(const f32x4*)(gate + bb * 6144 + col0 + bj * HALF + 4 * n) : (f32x4){1.f, 1.f, 1.f, 1.f};
#pragma unroll
        for (int ai = 0; ai < 2; ++ai)
#pragma unroll
            for (int m = 0; m < 4; ++m) { bf16_t* rowp = O + (size_t)u.ks * ks_stride + (size_t)(row0 + ai * HALF + m * 16) * ldc + col0;
#pragma unroll
                for (int bj = 0; bj < 2; ++bj) { f32x4 v0 = acc[ai][bj][m][0], v1 = acc[ai][bj][m][1];
                    if (act == 2) {
#pragma unroll
                        for (int e = 0; e < 4; ++e) { float a0 = fmaxf(v0[e], 0.f), a1 = fmaxf(v1[e], 0.f); v0[e] = a0 * a0; v1[e] = a1 * a1; } }
                    v0 = v0 * gv[bj][0]; v1 = v1 * gv[bj][1];
                    u32x4 w; w.x = pk2(v0[0], v0[1]); w.y = pk2(v0[2], v0[3]); w.z = pk2(v1[0], v1[1]); w.w = pk2(v1[2], v1[3]);
                    *(u32x4*)(rowp + bj * HALF) = w; } }
    }
};

template <class Epi>
__device__ __forceinline__ void gemm_phase(LAS unsigned char* lds, const Gemm g, const StaticOrder& S, const Epi& E, const int tid) {
    const int wid = __builtin_amdgcn_readfirstlane(tid >> 6), lane = tid & 63, wr = wid >> 2, wc = wid & 3, fr = lane & 15, fq = lane >> 4;
    const int K = g.K, nt = K / BK;
    unsigned voffA[2], voffB[2];
#pragma unroll
    for (int i = 0; i < 2; ++i) { int R, C; stage_rc(tid * 16 + i * 8192, R, C); const int Rb = Epi::PERM ? ((R & ~31) + perm32(R & 31)) : R;
        voffA[i] = (unsigned)(R * g.lda + C) * 2u; voffB[i] = (unsigned)(Rb * g.ldb + C) * 2u; }
    const size_t kstep = (size_t)(BK * 2);
    const size_t hA = (size_t)HALF * g.lda * 2, hB = (size_t)HALF * g.ldb * 2, kso = (size_t)K * 2;
    const size_t tA = 2 * hA, tB = 2 * hB;
    const unsigned ldsw = (unsigned)wid * 1024u;
    const int aoff = lds_byte(wr * 64 + fr, fq * 8), boff = lds_byte(wc * 32 + fr, fq * 8);
#define PG8_SA(b, h) (((b) * 2 + (h)) * HTB)
#define PG8_SB(b, h) ((4 + (b) * 2 + (h)) * HTB)
#define PG8_STAGE(bufoff, gbase, voff) do { _Pragma("unroll") for (int _i = 0; _i < 2; ++_i) \
        __builtin_amdgcn_global_load_lds((const unsigned*)((const char*)(gbase) + (voff)[_i]), (LAS unsigned*)(lds + (bufoff) + ldsw + _i * 8192), 16, 0, 0); } while (0)
#define PG8_LDA(dst, b, h) do { _Pragma("unroll") for (int m = 0; m < 4; ++m) _Pragma("unroll") for (int k = 0; k < 2; ++k) dst[m][k] = *(const LAS bf16x8*)(lds + PG8_SA(b, h) + aoff + m * 2048 + k * 1024); } while (0)
#define PG8_LDB(dst, b, h) do { _Pragma("unroll") for (int n = 0; n < 2; ++n) _Pragma("unroll") for (int k = 0; k < 2; ++k) dst[n][k] = *(const LAS bf16x8*)(lds + PG8_SB(b, h) + boff + n * 2048 + k * 1024); } while (0)
#define PG8_MMA(ai, bj, At, Bt) do { __builtin_amdgcn_s_setprio(1); _Pragma("unroll") for (int m = 0; m < 4; ++m) _Pragma("unroll") for (int n = 0; n < 2; ++n) _Pragma("unroll") for (int k = 0; k < 2; ++k) \
        acc[ai][bj][m][n] = __builtin_amdgcn_mfma_f32_16x16x32_bf16(Bt[n][k], At[m][k], acc[ai][bj][m][n], 0, 0, 0); __builtin_amdgcn_s_setprio(0); } while (0)
#define PG8_WAIT_V(n) asm volatile("s_waitcnt vmcnt(" #n ")" ::: "memory")
#define PG8_WAIT_L(n) asm volatile("s_waitcnt lgkmcnt(" #n ")" ::: "memory")
#define PG8_BAR __builtin_amdgcn_s_barrier()
#define PG8_SCHED __builtin_amdgcn_sched_barrier(0)
    Unit cur, nxt; int ui = 0;
    if (!S.next(0, cur)) return;
    f32x4 acc[2][2][4][2];
#pragma unroll
    for (int a = 0; a < 2; ++a)
#pragma unroll
        for (int b = 0; b < 2; ++b)
#pragma unroll
            for (int m = 0; m < 4; ++m)
#pragma unroll
                for (int n = 0; n < 2; ++n) acc[a][b][m][n] = (f32x4){0.f, 0.f, 0.f, 0.f};
    bf16x8 At[4][2], B0[2][2], B1[2][2];
    const char* cA = (const char*)g.A + (size_t)cur.pm * tA + cur.ks * kso; const char* cB = (const char*)g.Bt + (size_t)cur.pn * tB + cur.ks * kso;
    PG8_STAGE(PG8_SB(0, 0), cB, voffB); PG8_STAGE(PG8_SB(0, 1), cB + hB, voffB); PG8_STAGE(PG8_SA(0, 0), cA, voffA); PG8_STAGE(PG8_SA(0, 1), cA + hA, voffA);
    if (wr == 1) PG8_BAR;
    PG8_WAIT_V(2); PG8_BAR;
    PG8_STAGE(PG8_SB(1, 0), cB + kstep, voffB); PG8_STAGE(PG8_SA(1, 0), cA + kstep, voffA); PG8_STAGE(PG8_SB(1, 1), cB + hB + kstep, voffB);
    PG8_WAIT_V(6); PG8_BAR;
    for (;;) {
        const bool has_next = S.next(ui + 1, nxt);
        const char* nA = has_next ? (const char*)g.A + (size_t)nxt.pm * tA + nxt.ks * kso : cA; const char* nB = has_next ? (const char*)g.Bt + (size_t)nxt.pn * tB + nxt.ks * kso : cB;
        for (int t = 0; t < nt; t += 2) {
            const bool last = (t == nt - 2);
            const char* a1 = cA + (size_t)(t + 1) * kstep;
            const char* a2 = last ? nA : cA + (size_t)(t + 2) * kstep; const char* b2 = last ? nB : cB + (size_t)(t + 2) * kstep;
            const char* a3 = a2 + kstep; const char* b3 = b2 + kstep;
            PG8_LDB(B0, 0, 0); PG8_LDB(B1, 0, 1); PG8_SCHED; PG8_LDA(At, 0, 0); PG8_STAGE(PG8_SA(1, 1), a1 + hA, voffA);
            PG8_WAIT_V(8); PG8_WAIT_L(0); PG8_BAR; PG8_MMA(0, 0, At, B0); PG8_MMA(0, 1, At, B1); PG8_BAR; PG8_SCHED;
            PG8_LDA(At, 0, 1); PG8_STAGE(PG8_SB(0, 0), b2, voffB); PG8_STAGE(PG8_SB(0, 1), b2 + hB, voffB); PG8_STAGE(PG8_SA(0, 0), a2, voffA);
            PG8_WAIT_V(8); PG8_WAIT_L(0); PG8_BAR; PG8_MMA(1, 0, At, B0); PG8_MMA(1, 1, At, B1); PG8_BAR; PG8_SCHED;
            PG8_LDB(B0, 1, 0); PG8_LDB(B1, 1, 1); PG8_SCHED; PG8_LDA(At, 1, 0); PG8_STAGE(PG8_SA(0, 1), a2 + hA, voffA);
            PG8_WAIT_V(8); PG8_WAIT_L(0); PG8_BAR; PG8_MMA(0, 0, At, B0); PG8_MMA(0, 1, At, B1); PG8_BAR; PG8_SCHED;
            PG8_LDA(At, 1, 1); PG8_STAGE(PG8_SB(1, 0), b3, voffB); PG8_STAGE(PG8_SB(1, 1), b3 + hB, voffB); PG8_STAGE(PG8_SA(1, 0), a3, voffA);
            PG8_WAIT_V(8); PG8_WAIT_L(0); PG8_BAR; PG8_MMA(1, 0, At, B0); PG8_MMA(1, 1, At, B1); PG8_BAR; PG8_SCHED;
        }
        if (wr == 0) PG8_BAR;
        E(acc, cur, wr, wc, fr, fq);
        if (!has_next) break;
#pragma unroll
        for (int a = 0; a < 2; ++a)
#pragma unroll
            for (int b = 0; b < 2; ++b)
#pragma unroll
                for (int m = 0; m < 4; ++m)
#pragma unroll
                    for (int n = 0; n < 2; ++n) acc[a][b][m][n] = (f32x4){0.f, 0.f, 0.f, 0.f};
        cur = nxt; cA = nA; cB = nB; ++ui;
        if (wr == 1) PG8_BAR;
    }
    PG8_WAIT_V(0);
    PG8_BAR;
#undef PG8_SA
#undef PG8_SB
#undef PG8_STAGE
#undef PG8_LDA
#undef PG8_LDB
#undef PG8_MMA
#undef PG8_WAIT_V
#undef PG8_WAIT_L
#undef PG8_BAR
#undef PG8_SCHED
}
}

struct Args { const float* in[24]; float* out; unsigned char* ws; int ph_lo, ph_hi; };
typedef const __attribute__((address_space(4))) Args* KA;
enum { I_X = 0, I_C, I_CTX, I_CCTX, I_ADAW, I_ADAB, I_LNG, I_LNB, I_W1, I_W2, I_WOUT, I_EVWIN, I_EVQKVCONV, I_EVALOG, I_EVDTB, I_EVGDNNORM,
       I_LRUCW, I_LRUCB, I_LRUGW, I_LRUGB, I_LRULAM, I_ODWQKV, I_ODLAM, I_ODSUBLN };
enum { K_PROA = 0, K_PROB, K_PROJ, K_E2, K_E3, K_E4, K_O2, K_O3, K_WOUT, K_LN1, K_MLP1, K_MLP2, K_LN2, K_E2B };
constexpr int N_PHASES = 2 + 10 + 8 + 10 + 8;

__device__ __forceinline__ void transpose_item(const float* W, int K, int N, int Npad, bf16_t* WT, LAS float* scr, int item, int lane) {
    const int nblk = Npad / 32, kb = item / nblk, nb = item % nblk, k0 = 64 * kb, n0 = 32 * nb;
    const int n = n0 + (lane & 31);
    { float wv[32];
#pragma unroll
      for (int i = 0; i < 32; ++i) { const int kk = 2 * i + (lane >> 5); wv[i] = (n < N) ? W[(size_t)(k0 + kk) * N + n] : 0.f; }
#pragma unroll
      for (int i = 0; i < 32; ++i) { const int kk = 2 * i + (lane >> 5); scr[kk * 33 + (lane & 31)] = wv[i]; } }
    LDS_WAIT();
    const int c = lane & 7;
#pragma unroll
    for (int j = 0; j < 4; ++j) { const int nn = (lane >> 3) + 8 * j; const LAS float* s = scr + (8 * c) * 33 + nn;
        u32x4 o; o.x = pk2(s[0 * 33], s[1 * 33]); o.y = pk2(s[2 * 33], s[3 * 33]); o.z = pk2(s[4 * 33], s[5 * 33]); o.w = pk2(s[6 * 33], s[7 * 33]);
        *(u32x4*)(WT + (size_t)(n0 + nn) * K + k0 + 8 * c) = o; }
    LDS_WAIT();
}
__device__ __forceinline__ void conv_weights(KA a, int L, LAS unsigned char* lds, int gw, int NGW, int wave, int lane) {
    LAS float* scr = (LAS float*)(lds + wave * 16384);
    const bool even = (L & 1) == 0; const int j2 = L >> 1;
    const float* Wa = even ? a->in[I_EVWIN] + (size_t)j2 * D * EVN : a->in[I_ODWQKV] + (size_t)j2 * D * ODN;
    const int Na = even ? EVN : ODN, Nap = even ? EVNP : ODN;
    const int IA = (D / 64) * (Nap / 32), IO = (D / 64) * (D / 32), I1 = (D / 64) * (FF / 32), I2 = (FF / 64) * (D / 32);
    bf16_t* WA = (bf16_t*)(a->ws + WS_WA); bf16_t* WO = (bf16_t*)(a->ws + WS_WO); bf16_t* W1 = (bf16_t*)(a->ws + WS_W1); bf16_t* W2 = (bf16_t*)(a->ws + WS_W2);
    for (int it = gw; it < IA + IO + I1 + I2; it += NGW) {
        int r = it;
        if (r < IA) { transpose_item(Wa, D, Na, Nap, WA, scr, r, lane); continue; } r -= IA;
        if (r < IO) { transpose_item(a->in[I_WOUT] + (size_t)L * D * D, D, D, D, WO, scr, r, lane); continue; } r -= IO;
        if (r < I1) { transpose_item(a->in[I_W1] + (size_t)L * D * FF, D, FF, FF, W1, scr, r, lane); continue; } r -= I1;
        transpose_item(a->in[I_W2] + (size_t)L * FF * D, FF, D, D, W2, scr, r, lane);
    }
}

__device__ __forceinline__ void modulate_row_store(const f32x4 (&v)[4], const float* mod_bb, int sidx, bf16_t* urow, int lane) {
#pragma unroll
    for (int j = 0; j < 4; ++j) { const int c = 4 * (lane + 64 * j);
        const f32x4 sh = *(const f32x4*)(mod_bb + sidx * D + c), sc = *(const f32x4*)(mod_bb + (sidx + 1) * D + c);
        const f32x4 u = v[j] * (sc + 1.0f) + sh; u32x2 w; w.x = pk2(u[0], u[1]); w.y = pk2(u[2], u[3]); *(u32x2*)(urow + c) = w; }
}
__device__ __forceinline__ void prologue_b(KA a, int gw, int NGW, int lane) {
    const float* MOD = (const float*)(a->ws + WS_MOD); bf16_t* U = (bf16_t*)(a->ws + WS_U);
    for (int row = gw; row < MT; row += NGW) {
        const bool isctx = row >= ML; const int bb = isctx ? 8 : (row >> 12);
        const float* hp = isctx ? a->in[I_CTX] + (size_t)(row - ML) * D : a->in[I_X] + (size_t)row * D;
        f32x4 v[4];
#pragma unroll
        for (int j = 0; j < 4; ++j) v[j] = *(const f32x4*)(hp + 4 * (lane + 64 * j));
        modulate_row_store(v, MOD + (size_t)(0 * 9 + bb) * 6144, 0, U + (size_t)row * D, lane);
    }
}
__device__ __forceinline__ void ln_row_finish(f32x4 (&v)[4], float s, const float* lg, const float* lb, bf16_t* hp16, float* hp32, bool do_u, const float* mod_bb, int sidx, bf16_t* urow, int lane) {
    const float mean = wave_sum(s) * (1.f / D); float s2 = 0.f;
#pragma unroll
    for (int j = 0; j < 4; ++j) { v[j] = v[j] - mean; s2 += (v[j][0] * v[j][0] + v[j][1] * v[j][1]) + (v[j][2] * v[j][2] + v[j][3] * v[j][3]); }
    const float rstd = 1.0f / sqrtf(wave_sum(s2) * (1.f / D) + EPS);
#pragma unroll
    for (int j = 0; j < 4; ++j) { const int c = 4 * (lane + 64 * j); const f32x4 gg = *(const f32x4*)(lg + c), bbv = *(const f32x4*)(lb + c);
        v[j] = v[j] * rstd * gg + bbv;
        if (hp32) __builtin_nontemporal_store(v[j], (f32x4*)(hp32 + c));
        else { typedef _Float16 h4_t __attribute__((ext_vector_type(4))); const u32x2 w = __builtin_bit_cast(u32x2, __builtin_convertvector(v[j], h4_t)); __builtin_nontemporal_store(w, (u32x2*)(hp16 + c)); } }
    if (do_u) modulate_row_store(v, mod_bb, sidx, urow, lane);
}
typedef _Float16 h16x4 __attribute__((ext_vector_type(4)));
__device__ __forceinline__ f32x4 hf4(const u32x2 w) { return __builtin_convertvector(__builtin_bit_cast(h16x4, w), f32x4); }
__device__ __forceinline__ u32x2 f4h(const f32x4 v) { return __builtin_bit_cast(u32x2, __builtin_convertvector(v, h16x4)); }
__device__ __forceinline__ f32x4 bf4(const u32x2 w) { return (f32x4){__uint_as_float(w.x << 16), __uint_as_float(w.x & 0xffff0000u), __uint_as_float(w.y << 16), __uint_as_float(w.y & 0xffff0000u)}; }
__device__ __forceinline__ void ln_pass(KA a, int L, int which, int nrows, bool do_u, int Lm, int sidx, const bf16_t* T, int npart, int gw, int NGW, int lane) {
    const float* MOD = (const float*)(a->ws + WS_MOD); bf16_t* U = (bf16_t*)(a->ws + WS_U); bf16_t* HC = (bf16_t*)(a->ws + WS_HC);
    const float* lg = a->in[I_LNG] + (size_t)(L * 2 + which) * D; const float* lb = a->in[I_LNB] + (size_t)(L * 2 + which) * D;
    const bool first = (L == 0 && which == 0), fin = (L == 3 && which == 1);
    bf16_t* HL = (bf16_t*)((unsigned char*)a->out + (size_t)64 * MiB); bf16_t* HX = (bf16_t*)(a->ws + WS_HLAST);
    const bf16_t* hin16 = fin ? HX : HL;
    bf16_t* hout16 = (L == 3 && which == 0) ? HX : HL;
    const int nmain = npart > 0 ? ML : nrows;
    if (first) {
        f32x4 hv[4]; u32x2 tw[4];
#define LN_FETCH(HV, TW, row_) do { const int r_ = (row_); const float* hin_ = a->in[I_X] + (size_t)r_ * D; const bf16_t* tp_ = T + (size_t)r_ * D; \
        _Pragma("unroll") for (int j = 0; j < 4; ++j) { const int c = 4 * (lane + 64 * j); HV[j] = __builtin_nontemporal_load((const f32x4*)(hin_ + c)); TW[j] = __builtin_nontemporal_load((const u32x2*)(tp_ + c)); } } while (0)
        if (gw < nmain) LN_FETCH(hv, tw, gw);
#pragma unroll 2
        for (int row = gw; row < nmain; row += NGW) {
            f32x4 hn[4]; u32x2 tn[4]; const int nrow = row + NGW < nmain ? row + NGW : row;
            LN_FETCH(hn, tn, nrow);
            f32x4 v[4]; float s = 0.f;
#pragma unroll
            for (int j = 0; j < 4; ++j) { v[j] = hv[j] * ALPHA + bf4(tw[j]); s += (v[j][0] + v[j][1]) + (v[j][2] + v[j][3]); }
            ln_row_finish(v, s, lg, lb, hout16 + (size_t)row * D, nullptr, do_u, MOD + (size_t)(Lm * 9 + (row >> 12)) * 6144, sidx, U + (size_t)row * D, lane);
#pragma unroll
            for (int j = 0; j < 4; ++j) { hv[j] = hn[j]; tw[j] = tn[j]; }
        }
#undef LN_FETCH
    } else {
        u32x2 hv[4], tw[4];
#define LN_FETCH(HV, TW, row_) do { const int r_ = (row_); const bf16_t* hin_ = hin16 + (size_t)r_ * D; const bf16_t* tp_ = T + (size_t)r_ * D; \
        _Pragma("unroll") for (int j = 0; j < 4; ++j) { const int c = 4 * (lane + 64 * j); HV[j] = __builtin_nontemporal_load((const u32x2*)(hin_ + c)); TW[j] = __builtin_nontemporal_load((const u32x2*)(tp_ + c)); } } while (0)
        if (gw < nmain) LN_FETCH(hv, tw, gw);
#pragma unroll 2
        for (int row = gw; row < nmain; row += NGW) {
            u32x2 hn[4], tn[4]; const int nrow = row + NGW < nmain ? row + NGW : row;
            LN_FETCH(hn, tn, nrow);
            f32x4 v[4]; float s = 0.f;
#pragma unroll
            for (int j = 0; j < 4; ++j) { v[j] = hf4(hv[j]) * ALPHA + bf4(tw[j]); s += (v[j][0] + v[j][1]) + (v[j][2] + v[j][3]); }
            ln_row_finish(v, s, lg, lb, hout16 + (size_t)row * D, fin ? a->out + (size_t)row * D : nullptr, do_u, MOD + (size_t)(Lm * 9 + (row >> 12)) * 6144, sidx, U + (size_t)row * D, lane);
#pragma unroll
            for (int j = 0; j < 4; ++j) { hv[j] = hn[j]; tw[j] = tn[j]; }
        }
#undef LN_FETCH
    }
    if (npart > 0) {
        const bf16_t* PART = (const bf16_t*)(a->ws + WS_PART);
        for (int row = ML + gw; row < nrows; row += NGW) {
            const size_t rc = (size_t)(row - ML); bf16_t* hp = HC + rc * D;
            f32x4 v[4]; float s = 0.f;
#pragma unroll
            for (int j = 0; j < 4; ++j) { const int c = 4 * (lane + 64 * j); f32x4 tv = {0.f, 0.f, 0.f, 0.f};
                for (int ks = 0; ks < npart; ++ks) tv += bf4(*(const u32x2*)(PART + (size_t)ks * MC * D + rc * D + c));
                const f32x4 hh = first ? *(const f32x4*)(a->in[I_CTX] + rc * D + c) : hf4(*(const u32x2*)(hp + c));
                v[j] = hh * ALPHA + tv; s += (v[j][0] + v[j][1]) + (v[j][2] + v[j][3]); }
            ln_row_finish(v, s, lg, lb, hp, nullptr, do_u, MOD + (size_t)(Lm * 9 + 8) * 6144, sidx, U + (size_t)row * D, lane);
        }
    }
}

__device__ __forceinline__ void prologue_a(KA a, LAS unsigned char* lds, int bid, int G, int tid, int wave, int lane) {
    float* MOD = (float*)(a->ws + WS_MOD); float* MISC = (float*)(a->ws + WS_MISC);
    LAS float* sv = (LAS float*)lds;
    LAS float* red = (LAS float*)(lds + 9 * 1024 * 4);
    for (int i = tid; i < 9 * 1024; i += 512) { const int bb = i >> 10, k = i & 1023; const float v = bb < 8 ? a->in[I_C][bb * 1024 + k] : a->in[I_CCTX][k]; sv[i] = siluf_(v); }
    __syncthreads();
    for (int unit = bid; unit < 192; unit += G) {
        const int L = unit / 48, cb = unit % 48, col = tid & 127, kq = tid >> 7;
        const float* w = a->in[I_ADAW] + (size_t)L * D * 6144 + cb * 128 + col;
        float acc[9];
#pragma unroll
        for (int bb = 0; bb < 9; ++bb) acc[bb] = 0.f;
        for (int k0 = kq * 256; k0 < kq * 256 + 256; k0 += 16) { float wv[16];
#pragma unroll
            for (int i = 0; i < 16; ++i) wv[i] = w[(size_t)(k0 + i) * 6144];
#pragma unroll
            for (int i = 0; i < 16; ++i)
#pragma unroll
                for (int bb = 0; bb < 9; ++bb) acc[bb] += sv[bb * 1024 + k0 + i] * wv[i]; }
#pragma unroll
        for (int bb = 0; bb < 9; ++bb) red[(kq * 9 + bb) * 128 + col] = acc[bb];
        __syncthreads();
        for (int i = tid; i < 9 * 128; i += 512) { const int bb = i >> 7, cc = i & 127;
            float s = (red[(0 * 9 + bb) * 128 + cc] + red[(1 * 9 + bb) * 128 + cc]) + (red[(2 * 9 + bb) * 128 + cc] + red[(3 * 9 + bb) * 128 + cc]);
            s += a->in[I_ADAB][L * 6144 + cb * 128 + cc]; MOD[(size_t)(L * 9 + bb) * 6144 + cb * 128 + cc] = s; }
        __syncthreads();
    }
    if (bid == G - 1) {
        if (tid < 16) {
            double th = 1.0; for (int j = 0; j < tid; ++j) th *= 0.56234132519034908;
            const double t2 = th * th; double sn = th, term = th, cs = 1.0, tc = 1.0;
            for (int k = 1; k < 12; ++k) { tc *= -t2 / ((2.0 * k - 1.0) * (2.0 * k)); cs += tc; term *= -t2 / ((2.0 * k) * (2.0 * k + 1.0)); sn += term; }
            double c = 1.0, s = 0.0;
            for (int p = 0; p < 64; ++p) { MISC[64 + p * 16 + tid] = (float)c; MISC[1088 + p * 16 + tid] = (float)s; const double c2 = c * cs - s * sn, s2 = s * cs + c * sn; c = c2; s = s2; }
        }
        if (tid >= 64 && tid < 66) { const int j = tid - 64; const float* lv = a->in[I_ODLAM] + j * 256; float d0 = 0.f, d1 = 0.f;
            for (int i = 0; i < 64; ++i) { d0 += lv[i] * lv[64 + i]; d1 += lv[128 + i] * lv[192 + i]; }
            const float li = 0.8f - 0.6f * expf(-0.3f * (float)(2 * j + 1)); MISC[j] = expf(d0) - expf(d1) + li; MISC[2 + j] = li; }
    }
    __syncthreads();
    conv_weights(a, 0, lds, bid * 8 + wave, G * 8, wave, lane);
}

__device__ __forceinline__ void attn_prep(KA a, LAS unsigned char* lds, int bid, int G, int tid) {
    bf16_t* P = (bf16_t*)(a->ws + WS_P); bf16_t* VT = (bf16_t*)(a->ws + WS_V); const float* MISC = (const float*)(a->ws + WS_MISC);
    const float* tabc = MISC + 64; const float* tabs = MISC + 1088;
    constexpr int VP = 2064;
    for (int u = bid; u < 2 * NB * 68; u += G) {
        const bool vpart = u >= NB * 68; const int uu = vpart ? u - NB * 68 : u;
        const int b = uu / 68, tl = uu % 68; const bool isctx = tl < 4; const int t0 = isctx ? tl * 64 : (tl - 4) * 64;
        const int rowbase = isctx ? ML + b * CTXL + t0 : b * SEQ + t0; const int kv0 = isctx ? t0 : CTXL + t0;
        if (!vpart) {
#pragma unroll 1
            for (int half = 0; half < 2; ++half) {
                u32x4 r1[4], r2[4], r3[4], r4[4];
#pragma unroll
                for (int k = 0; k < 4; ++k) { const int it = tid + 512 * (4 * half + k); const int r = it >> 6, rem = it & 63, vec = rem >> 1, part = rem & 1;
                    const bf16_t* p = P + (size_t)(rowbase + r) * ODN + vec * 64 + part * 8;
                    r1[k] = *(const u32x4*)(p); r2[k] = *(const u32x4*)(p + 16); r3[k] = *(const u32x4*)(p + 32); r4[k] = *(const u32x4*)(p + 48); }
#pragma unroll
                for (int k = 0; k < 4; ++k) { const int it = tid + 512 * (4 * half + k); const int r = it >> 6, rem = it & 63, vec = rem >> 1, part = rem & 1; const bool isq = vec < 16;
                    if (isctx && !isq) continue;
                    bf16_t* p = P + (size_t)(rowbase + r) * ODN + vec * 64 + part * 8;
                    float t1[8], t2[8], t3[8], t4[8];
                    unpack8(r1[k], t1); unpack8(r2[k], t2); unpack8(r3[k], t3); unpack8(r4[k], t4);
                    const float sc = isq ? QSCALE : 1.0f;
                    if (!isctx) {
                        const int pos = t0 + r, rp = pos >> 6, cp = pos & 63;
#pragma unroll
                        for (int j = 0; j < 8; ++j) { const int jj = part * 8 + j;
                            const float cr = tabc[rp * 16 + jj], sr = tabs[rp * 16 + jj], cc = tabc[cp * 16 + jj], ss = tabs[cp * 16 + jj];
                            const float o1 = t1[j] * cr - t2[j] * sr, o2 = t2[j] * cr + t1[j] * sr, o3 = t3[j] * cc - t4[j] * ss, o4 = t4[j] * cc + t3[j] * ss;
                            t1[j] = o1 * sc; t2[j] = o2 * sc; t3[j] = o3 * sc; t4[j] = o4 * sc; }
                    } else {
#pragma unroll
                        for (int j = 0; j < 8; ++j) { t1[j] *= sc; t2[j] *= sc; t3[j] *= sc; t4[j] *= sc; }
                    }
                    *(u32x4*)(p) = pack8(t1); *(u32x4*)(p + 16) = pack8(t2); *(u32x4*)(p + 32) = pack8(t3); *(u32x4*)(p + 48) = pack8(t4);
                }
            }
        } else {
            { u32x4 rv[16];
#pragma unroll
              for (int k = 0; k < 16; ++k) { const int id = tid + 512 * k; rv[k] = *(const u32x4*)(P + (size_t)(rowbase + (id >> 7)) * ODN + 2048 + (id & 127) * 8); }
#pragma unroll
              for (int k = 0; k < 16; ++k) { const int id = tid + 512 * k; *(LAS u32x4*)(lds + (id >> 7) * VP + (id & 127) * 16) = rv[k]; } }
            __syncthreads();
#pragma unroll 4
            for (int k = 0; k < 16; ++k) { const int oc = tid + 512 * k; const int col = oc & 1023, c = oc >> 10;
                unsigned w[4];
#pragma unroll
                for (int j = 0; j < 4; ++j) { const unsigned lo = *(const LAS bf16_t*)(lds + (8 * c + 2 * j) * VP + col * 2), hi = *(const LAS bf16_t*)(lds + (8 * c + 2 * j + 1) * VP + col * 2); w[j] = lo | (hi << 16); }
                u32x4 o; o.x = w[0]; o.y = w[1]; o.z = w[2]; o.w = w[3];
                *(u32x4*)(VT + ((size_t)(b * 8 * 128 + col)) * NKV + kv0 + 8 * c) = o; }
            __syncthreads();
        }
    }
}

constexpr int AT_KB = 64 * 272, AT_VB = 128 * 144, AT_BUF = AT_KB + AT_VB, AT_OX = 0;
static_assert(3 * AT_BUF <= LDS_BYTES - 16 && 128 * 132 * 4 <= 3 * AT_BUF, "attention lds");
__device__ __forceinline__ void at_qk(const LAS unsigned char* Kb, const bf16x8 (&qf)[4], f32x16& s0, f32x16& s1, int m, int krow, int hi) {
#pragma unroll
    for (int r = 0; r < 16; ++r) { s0[r] = 0.f; s1[r] = 0.f; }
#pragma unroll
    for (int ks = 0; ks < 4; ++ks) {
        const bf16x8 a0 = *(const LAS bf16x8*)(Kb + krow * 272 + (m * 64 + ks * 16 + hi * 8) * 2);
        const bf16x8 a1 = *(const LAS bf16x8*)(Kb + (krow + 32) * 272 + (m * 64 + ks * 16 + hi * 8) * 2);
        s0 = __builtin_amdgcn_mfma_f32_32x32x16_bf16(a0, qf[ks], s0, 0, 0, 0);
        s1 = __builtin_amdgcn_mfma_f32_32x32x16_bf16(a1, qf[ks], s1, 0, 0, 0);
    }
}
template <bool HAS_NEXT>
__device__ __forceinline__ void at_step(const LAS unsigned char* Kn, const LAS unsigned char* Vc, const bf16x8 (&qf)[4], f32x16 (&o)[4], f32x16& s0, f32x16& s1, float& mrun, float& lsum, int m, int krow, int r32, int hi) {
    f32x16 n0, n1;
#pragma unroll
    for (int r = 0; r < 16; ++r) { n0[r] = 0.f; n1[r] = 0.f; }
    float ps = 0.f;
#pragma unroll
    for (int ks = 0; ks < 4; ++ks) {
        if (HAS_NEXT) {
            const bf16x8 a0 = *(const LAS bf16x8*)(Kn + krow * 272 + (m * 64 + ks * 16 + hi * 8) * 2);
            const bf16x8 a1 = *(const LAS bf16x8*)(Kn + (krow + 32) * 272 + (m * 64 + ks * 16 + hi * 8) * 2);
            n0 = __builtin_amdgcn_mfma_f32_32x32x16_bf16(a0, qf[ks], n0, 0, 0, 0);
            n1 = __builtin_amdgcn_mfma_f32_32x32x16_bf16(a1, qf[ks], n1, 0, 0, 0);
        }
#pragma unroll
        for (int r = 4 * ks; r < 4 * ks + 4; ++r) { s0[r] = __builtin_amdgcn_exp2f(s0[r] - mrun); s1[r] = __builtin_amdgcn_exp2f(s1[r] - mrun); ps += s0[r] + s1[r]; }
    }
    lsum += ps;
    bf16x8 pb[4];
    { u32x4 w;
      w.x = pk2(s0[0], s0[1]); w.y = pk2(s0[2], s0[3]); w.z = pk2(s0[4], s0[5]); w.w = pk2(s0[6], s0[7]); pb[0] = __builtin_bit_cast(bf16x8, w);
      w.x = pk2(s0[8], s0[9]); w.y = pk2(s0[10], s0[11]); w.z = pk2(s0[12], s0[13]); w.w = pk2(s0[14], s0[15]); pb[1] = __builtin_bit_cast(bf16x8, w);
      w.x = pk2(s1[0], s1[1]); w.y = pk2(s1[2], s1[3]); w.z = pk2(s1[4], s1[5]); w.w = pk2(s1[6], s1[7]); pb[2] = __builtin_bit_cast(bf16x8, w);
      w.x = pk2(s1[8], s1[9]); w.y = pk2(s1[10], s1[11]); w.z = pk2(s1[12], s1[13]); w.w = pk2(s1[14], s1[15]); pb[3] = __builtin_bit_cast(bf16x8, w); }
    float mx = -3.0e38f;
#pragma unroll
    for (int db = 0; db < 4; ++db) {
#pragma unroll
        for (int i = 0; i < 4; ++i) {
            const bf16x8 av = *(const LAS bf16x8*)(Vc + (32 * db + r32) * 144 + (16 * i + 8 * hi) * 2);
            o[db] = __builtin_amdgcn_mfma_f32_32x32x16_bf16(av, pb[i], o[db], 0, 0, 0);
        }
        if (HAS_NEXT) {
#pragma unroll
            for (int r = 4 * db; r < 4 * db + 4; ++r) mx = fmaxf(mx, fmaxf(n0[r], n1[r]));
        }
    }
    if (HAS_NEXT) {
        mx = xhalf_max(mx);
        const float mnew = fmaxf(mrun, mx);
        if (__any(mnew > mrun)) {
            const float al = __builtin_amdgcn_exp2f(mrun - mnew); lsum *= al;
#pragma unroll
            for (int db = 0; db < 4; ++db)
#pragma unroll
                for (int r = 0; r < 16; ++r) o[db][r] *= al;
            mrun = mnew;
        }
        s0 = n0; s1 = n1;
    }
}
__device__ __forceinline__ void attn_phase(KA a, int L, LAS unsigned char* lds, int bid, int G, int tid, int wave, int lane, bool do_store) {
    bf16_t* P = (bf16_t*)(a->ws + WS_P); const bf16_t* VT = (const bf16_t*)(a->ws + WS_V); const float* MISC = (const float*)(a->ws + WS_MISC);
    const int j2 = L >> 1; const float lam = MISC[j2], lam_init = MISC[2 + j2];
    const float* subln = a->in[I_ODSUBLN] + j2 * 128;
    const int nunits = 2048 + (L == 1 ? 128 : 0);
    const int m = wave & 1, qs = wave >> 1, r32 = lane & 31, hi = lane >> 5;
    const int krow = (r32 & 0x13) | ((r32 & 4) << 1) | ((r32 & 8) >> 1);
    for (int u = bid; u < nunits; u += G) {
        int bh, qb; const bool isctx = u >= 2048;
        if (!isctx) { bh = (u >> 8) * 8 + (u & 7); qb = (u >> 3) & 31; } else { const int u2 = u - 2048; bh = u2 >> 1; qb = u2 & 1; }
        const int b = bh >> 3, h = bh & 7;
        const int qrow = (isctx ? ML + b * CTXL : b * SEQ) + qb * 128 + qs * 32 + r32;
        const int ntiles = isctx ? 4 : 68;
        bf16x8 qf[4];
#pragma unroll
        for (int ks = 0; ks < 4; ++ks) qf[ks] = *(const bf16x8*)(P + (size_t)qrow * ODN + h * 128 + m * 64 + ks * 16 + hi * 8);
        const int kr0 = tid >> 4, kc = tid & 15;
        const int vd0 = tid >> 3, vc = tid & 7;
        const bf16_t* vsrc0 = VT + ((size_t)(bh * 128 + vd0)) * NKV + 8 * vc; const bf16_t* vsrc1 = vsrc0 + (size_t)64 * NKV;
        u32x4 rk0, rk1, rv0, rv1;
#define AT_LOAD(t) do { const int kv_ = 64 * (t) + kr0; const int g0_ = kv_ < CTXL ? ML + b * CTXL + kv_ : b * SEQ + kv_ - CTXL; const int kv1_ = kv_ + 32; const int g1_ = kv1_ < CTXL ? ML + b * CTXL + kv1_ : b * SEQ + kv1_ - CTXL; \
        rk0 = *(const u32x4*)(P + (size_t)g0_ * ODN + 1024 + h * 128 + kc * 8); rk1 = *(const u32x4*)(P + (size_t)g1_ * ODN + 1024 + h * 128 + kc * 8); \
        rv0 = *(const u32x4*)(vsrc0 + 64 * (t)); rv1 = *(const u32x4*)(vsrc1 + 64 * (t)); } while (0)
#define AT_STORE(boff) do { LAS unsigned char* kb_ = lds + (boff); LAS unsigned char* vb_ = kb_ + AT_KB; \
        *(LAS u32x4*)(kb_ + kr0 * 272 + kc * 16) = rk0; *(LAS u32x4*)(kb_ + (kr0 + 32) * 272 + kc * 16) = rk1; \
        *(LAS u32x4*)(vb_ + vd0 * 144 + vc * 16) = rv0; *(LAS u32x4*)(vb_ + (vd0 + 64) * 144 + vc * 16) = rv1; } while (0)
        { AT_LOAD(0); const u32x4 k0_ = rk0, k1_ = rk1, v0_ = rv0, v1_ = rv1;
          AT_LOAD(1);
          { LAS unsigned char* kb_ = lds; LAS unsigned char* vb_ = kb_ + AT_KB;
            *(LAS u32x4*)(kb_ + kr0 * 272 + kc * 16) = k0_; *(LAS u32x4*)(kb_ + (kr0 + 32) * 272 + kc * 16) = k1_;
            *(LAS u32x4*)(vb_ + vd0 * 144 + vc * 16) = v0_; *(LAS u32x4*)(vb_ + (vd0 + 64) * 144 + vc * 16) = v1_; }
          AT_STORE(AT_BUF); }
        __syncthreads();
        f32x16 o[4];
#pragma unroll
        for (int db = 0; db < 4; ++db)
#pragma unroll
            for (int r = 0; r < 16; ++r) o[db][r] = 0.f;
        f32x16 s0, s1;
        at_qk(lds, qf, s0, s1, m, krow, hi);
        float mrun, lsum = 0.f;
        { float mx = fmaxf(s0[0], s1[0]);
#pragma unroll
          for (int r = 1; r < 16; ++r) mx = fmaxf(mx, fmaxf(s0[r], s1[r]));
          mrun = xhalf_max(mx); }
        int bc = 0, bn = AT_BUF, bs = 2 * AT_BUF;
        for (int t = 0; t + 1 < ntiles; ++t) {
            const bool stage = t + 2 < ntiles;
            if (stage) AT_LOAD(t + 2);
            at_step<true>(lds + bn, lds + bc + AT_KB, qf, o, s0, s1, mrun, lsum, m, krow, r32, hi);
            if (stage) AT_STORE(bs);
            __syncthreads();
            const int tmp = bc; bc = bn; bn = bs; bs = tmp;
        }
        at_step<false>(lds, lds + bc + AT_KB, qf, o, s0, s1, mrun, lsum, m, krow, r32, hi);
        __syncthreads();
#undef AT_LOAD
#undef AT_STORE
        lsum = xhalf_sum(lsum);
        const float inv = 1.0f / lsum;
        LAS float* ox = (LAS float*)(lds + AT_OX) + (qs * 32 + r32) * 132;
        if (m == 1) {
#pragma unroll
            for (int db = 0; db < 4; ++db)
#pragma unroll
                for (int r4 = 0; r4 < 4; ++r4) { f32x4 v = {o[db][4 * r4] * inv, o[db][4 * r4 + 1] * inv, o[db][4 * r4 + 2] * inv, o[db][4 * r4 + 3] * inv};
                    *(LAS f32x4*)(ox + 32 * db + 8 * r4 + 4 * hi) = v; }
        }
        __syncthreads();
        if (m == 0) {
            float ssq = 0.f;
#pragma unroll
            for (int db = 0; db < 4; ++db)
#pragma unroll
                for (int r4 = 0; r4 < 4; ++r4) { const f32x4 v1 = *(const LAS f32x4*)(ox + 32 * db + 8 * r4 + 4 * hi);
#pragma unroll
                    for (int e = 0; e < 4; ++e) { const float v = o[db][4 * r4 + e] * inv - lam * v1[e]; o[db][4 * r4 + e] = v; ssq += v * v; } }
            ssq = xhalf_sum(ssq);
            const float sc = (1.0f / sqrtf(ssq * (1.f / 128.f) + EPS)) * (1.0f - lam_init);
            bf16_t* op = P + (size_t)qrow * ODN + h * 128;
#pragma unroll
            for (int db = 0; db < 4; ++db)
#pragma unroll
                for (int r4 = 0; r4 < 4; ++r4) { const int dv = 32 * db + 8 * r4 + 4 * hi; const f32x4 g4 = *(const f32x4*)(subln + dv);
                    u32x2 w; w.x = pk2(o[db][4 * r4] * sc * g4[0], o[db][4 * r4 + 1] * sc * g4[1]); w.y = pk2(o[db][4 * r4 + 2] * sc * g4[2], o[db][4 * r4 + 3] * sc * g4[3]);
                    if (do_store) *(u32x2*)(op + dv) = w; }
        }
        __syncthreads();
    }
}

__device__ __forceinline__ void gdn_prep(KA a, int L, LAS unsigned char* lds, int gw, int NGW, int tid, int lane) {
    const int j2 = L >> 1;
    const bf16_t* P = (const bf16_t*)(a->ws + WS_P);
    bf16_t* QN = (bf16_t*)(a->ws + WS_U); bf16_t* KN = QN + (size_t)MT * 512; bf16_t* V = (bf16_t*)(a->ws + WS_V);
    float* Gb = (float*)(a->ws + WS_G); float* Bt = (float*)(a->ws + WS_BT);
    const float* cw = a->in[I_EVQKVCONV] + (size_t)j2 * 4 * 1536;
    LAS float* cwl = (LAS float*)lds;
    for (int i = tid; i < 4 * 1536 / 4; i += 512) *(LAS f32x4*)(cwl + 4 * i) = *(const f32x4*)(cw + 4 * i);
    __syncthreads();
    float alog = 0.f, dtb = 0.f;
    if (lane < 8) { alog = -expf(a->in[I_EVALOG][j2 * 8 + lane]); dtb = a->in[I_EVDTB][j2 * 8 + lane]; }
    for (int blk = gw; blk < MT / 17; blk += NGW) {
        const int r0 = 17 * blk;
        u32x4 R[20][3]; unsigned ab[17];
#define GP_LOAD(k_) do { const int row_ = r0 - 2 + (k_); const bool ok_ = row_ >= 0 && row_ < MT; \
        _Pragma("unroll") for (int p = 0; p < 3; ++p) R[k_][p] = ok_ ? *(const u32x4*)(P + (size_t)row_ * EVNP + p * 512 + 8 * lane) : (u32x4){0u, 0u, 0u, 0u}; } while (0)
#pragma unroll
        for (int k = 0; k < 6; ++k) GP_LOAD(k);
#pragma unroll
        for (int i = 0; i < 17; ++i) ab[i] = lane < 16 ? (unsigned)P[(size_t)(r0 + i) * EVNP + 2048 + lane] : 0u;
#pragma unroll
        for (int i = 0; i < 17; ++i) {
            if (i + 6 < 20) GP_LOAD(i + 6);
            const int row = r0 + i;
            const bool isctx = row >= ML; const int t = isctx ? ((row - ML) & (CTXL - 1)) : (row & (SEQ - 1)); const int len = isctx ? CTXL : SEQ;
            float val[3][8];
#pragma unroll
            for (int p = 0; p < 3; ++p) {
                float acc[8];
#pragma unroll
                for (int e = 0; e < 8; ++e) acc[e] = 0.f;
#pragma unroll
                for (int j = 0; j < 4; ++j) { const int tt = t + j - 2;
                    if (tt >= 0 && tt < len) { float x[8]; unpack8(R[i + j][p], x);
                        const f32x4 w0 = *(const LAS f32x4*)(cwl + j * 1536 + p * 512 + 8 * lane), w1 = *(const LAS f32x4*)(cwl + j * 1536 + p * 512 + 8 * lane + 4);
#pragma unroll
                        for (int e = 0; e < 8; ++e) acc[e] += (e < 4 ? w0[e & 3] : w1[e & 3]) * x[e]; } }
#pragma unroll
                for (int e = 0; e < 8; ++e) val[p][e] = fsilu(acc[e]);
            }
            float sq = 0.f, sk = 0.f;
#pragma unroll
            for (int e = 0; e < 8; ++e) { sq += val[0][e] * val[0][e]; sk += val[1][e] * val[1][e]; }
            sq = rowsum16(sq); sk = rowsum16(sk);
            const float rq = (1.0f / sqrtf(sq + EPS)) * 0.08838834764831845f, rk = 1.0f / sqrtf(sk + EPS);
#pragma unroll
            for (int e = 0; e < 8; ++e) { val[0][e] *= rq; val[1][e] *= rk; }
            *(u32x4*)(QN + (size_t)row * 512 + 8 * lane) = pack8(val[0]);
            *(u32x4*)(KN + (size_t)row * 512 + 8 * lane) = pack8(val[1]);
            *(u32x4*)(V + (size_t)row * 512 + 8 * lane) = pack8(val[2]);
            if (lane < 8) Gb[(size_t)row * 8 + lane] = alog * softplusf_(bf2f(ab[i]) + dtb);
            else if (lane < 16) Bt[(size_t)row * 8 + lane - 8] = sigmoidf_(bf2f(ab[i]));
        }
#undef GP_LOAD
    }
    __syncthreads();
}

constexpr int LR_XIN = 0, LR_XC = 17152, LR_XCB = LR_XC + 16384, LR_AU = LR_XCB + 9216, LR_WT = LR_AU + 65536, LR_END = LR_WT + 36864;
static_assert(LR_END <= LDS_BYTES, "lru lds");
template <int PASS>
__device__ __forceinline__ void lru_units(KA a, int L, LAS unsigned char* lds, int bid, int G, int tid) {
    const int j2 = L >> 1;
    const bf16_t* P = (const bf16_t*)(a->ws + WS_P); bf16_t* U = (bf16_t*)(a->ws + WS_U);
    float* TOTA = (float*)(a->ws + WS_TOTA); float* TOTH = (float*)(a->ws + WS_TOTH); const float* CARRY = (const float*)(a->ws + WS_CARRY);
    const float* cw = a->in[I_LRUCW] + (size_t)j2 * 4 * 512; const float* cb = a->in[I_LRUCB] + (size_t)j2 * 512;
    const float* gw_ = a->in[I_LRUGW] + (size_t)j2 * 2 * 2 * 8 * 64 * 64; const float* gb_ = a->in[I_LRUGB] + (size_t)j2 * 2 * 2 * 512; const float* lam_ = a->in[I_LRULAM] + (size_t)j2 * 2 * 512;
    LAS float* xin = (LAS float*)(lds + LR_XIN);
    LAS float* xc = (LAS float*)(lds + LR_XC);
    LAS bf16_t* xcb = (LAS bf16_t*)(lds + LR_XCB);
    LAS float* au = (LAS float*)(lds + LR_AU);
    LAS bf16_t* wt = (LAS bf16_t*)(lds + LR_WT);
    LAS float* sg = (LAS float*)(lds + LR_XIN);
    const int lane = tid & 63, w = tid >> 6, mt = w & 3, nh = w >> 2, fr = lane & 15, fq = lane >> 4;
    int cur_nblk = -1;
    const int cc = tid & 63;
    float cbv = 0.f, cwv[4] = {0.f, 0.f, 0.f, 0.f};
    float gbr[2][2], gbi[2][2], gsp[2][2];
#pragma unroll
    for (int q = 0; q < 2; ++q)
#pragma unroll
        for (int r = 0; r < 2; ++r) { gbr[q][r] = 0.f; gbi[q][r] = 0.f; gsp[q][r] = 0.f; }
    const int rrA = tid >> 3, c8 = (tid & 7) * 8, rrB = 64 + (tid >> 3);
    u32x4 xa = {0u, 0u, 0u, 0u}, xb = {0u, 0u, 0u, 0u}, gt4 = {0u, 0u, 0u, 0u};
#define LR_FETCH(XA, XB, GT, u_) do { const int nb_ = (u_) & 7, cs_ = (u_) >> 3, b_ = cs_ / 68, sl_ = cs_ % 68; const bool ic_ = sl_ < 4; const int t0_ = ic_ ? sl_ * 64 : (sl_ - 4) * 64; \
        const int len_ = ic_ ? CTXL : SEQ; const int rb_ = ic_ ? ML + b_ * CTXL : b_ * SEQ; const int ta_ = t0_ + rrA - 2, tb_ = t0_ + rrB - 2; \
        XA = (u32x4){0u, 0u, 0u, 0u}; XB = (u32x4){0u, 0u, 0u, 0u}; \
        if (ta_ >= 0 && ta_ < len_) XA = *(const u32x4*)(P + (size_t)(rb_ + ta_) * EVNP + 2064 + nb_ * 64 + c8); \
        if (tid < 24 && tb_ < len_) XB = *(const u32x4*)(P + (size_t)(rb_ + tb_) * EVNP + 2064 + nb_ * 64 + c8); \
        if (PASS == 2) GT = *(const u32x4*)(P + (size_t)(rb_ + t0_ + rrA) * EVNP + 2576 + nb_ * 64 + c8); } while (0)
    if (bid < NB * 68 * 8) LR_FETCH(xa, xb, gt4, bid);
    for (int u = bid; u < NB * 68 * 8; u += G) {
        const int nblk = u & 7, cs = u >> 3, b = cs / 68, slot = cs % 68; const bool isctx = slot < 4; const int t0 = isctx ? slot * 64 : (slot - 4) * 64;
        const int rowbase = isctx ? ML + b * CTXL : b * SEQ;
        u32x4 nxa, nxb, ngt = {0u, 0u, 0u, 0u};
        { const int un = u + G < NB * 68 * 8 ? u + G : u; LR_FETCH(nxa, nxb, ngt, un); }
        if (nblk != cur_nblk) {
            for (int i0 = tid; i0 < 4 * 4096; i0 += 512 * 8) { float wv[8];
#pragma unroll
                for (int k = 0; k < 8; ++k) { const int i = i0 + 512 * k; wv[k] = gw_[((size_t)((i >> 12) * 8 + nblk)) * 4096 + (i & 4095)]; }
#pragma unroll
                for (int k = 0; k < 8; ++k) { const int i = i0 + 512 * k; const int dg = i >> 12, c = (i >> 6) & 63, d = i & 63; wt[(dg * 64 + d) * 72 + c] = (bf16_t)f2bf(wv[k]); } }
            cbv = cb[nblk * 64 + cc];
#pragma unroll
            for (int dir = 0; dir < 2; ++dir)
#pragma unroll
                for (int nt = 0; nt < 2; ++nt) { const int ch = nblk * 64 + 32 * nh + 16 * nt + fr;
                    gbr[dir][nt] = gb_[(dir * 2 + 0) * 512 + ch]; gbi[dir][nt] = gb_[(dir * 2 + 1) * 512 + ch]; gsp[dir][nt] = softplusf_(-lam_[dir * 512 + ch]); }
#pragma unroll
            for (int j = 0; j < 4; ++j) cwv[j] = cw[j * 512 + nblk * 64 + cc];
            cur_nblk = nblk;
        }
        { float f[8]; unpack8(xa, f); *(LAS f32x4*)(xin + rrA * 64 + c8) = (f32x4){f[0], f[1], f[2], f[3]}; *(LAS f32x4*)(xin + rrA * 64 + c8 + 4) = (f32x4){f[4], f[5], f[6], f[7]};
          if (tid < 24) { unpack8(xb, f); *(LAS f32x4*)(xin + rrB * 64 + c8) = (f32x4){f[0], f[1], f[2], f[3]}; *(LAS f32x4*)(xin + rrB * 64 + c8 + 4) = (f32x4){f[4], f[5], f[6], f[7]}; } }
        __syncthreads();
#pragma unroll
        for (int k = 0; k < 8; ++k) { const int t = (tid >> 6) + 8 * k;
            float v = cbv;
#pragma unroll
            for (int j = 0; j < 4; ++j) v += cwv[j] * xin[(t + j) * 64 + cc];
            xc[t * 64 + cc] = v; xcb[t * 72 + cc] = (bf16_t)f2bf(v); }
        __syncthreads();
        {
            f32x4 acc[4][2];
#pragma unroll
            for (int dg = 0; dg < 4; ++dg)
#pragma unroll
                for (int nt = 0; nt < 2; ++nt) acc[dg][nt] = (f32x4){0.f, 0.f, 0.f, 0.f};
            bf16x8 af[2];
#pragma unroll
            for (int ks = 0; ks < 2; ++ks) af[ks] = *(const LAS bf16x8*)(xcb + (16 * mt + fr) * 72 + 32 * ks + 8 * fq);
#pragma unroll
            for (int dg = 0; dg < 4; ++dg)
#pragma unroll
                for (int nt = 0; nt < 2; ++nt)
#pragma unroll
                    for (int ks = 0; ks < 2; ++ks) { const bf16x8 bfm = *(const LAS bf16x8*)(wt + (dg * 64 + 32 * nh + 16 * nt + fr) * 72 + 32 * ks + 8 * fq);
                        acc[dg][nt] = __builtin_amdgcn_mfma_f32_16x16x32_bf16(af[ks], bfm, acc[dg][nt], 0, 0, 0); }
#pragma unroll
            for (int dir = 0; dir < 2; ++dir)
#pragma unroll
                for (int nt = 0; nt < 2; ++nt) { const int d = 32 * nh + 16 * nt + fr, ch = nblk * 64 + d;
                    const float br = gbr[dir][nt], bi = gbi[dir][nt], sp = gsp[dir][nt];
#pragma unroll
                    for (int r = 0; r < 4; ++r) { const int t = 16 * mt + 4 * fq + r;
                        const float rr = fsigmoid(acc[dir * 2 + 0][nt][r] + br), ii = fsigmoid(acc[dir * 2 + 1][nt][r] + bi);
                        const float la = -8.0f * 1.4426950408889634f * rr * sp; const float av = __builtin_amdgcn_exp2f(la);
                        const float uv = __builtin_amdgcn_sqrtf(fmaxf(1.0f - av * av, 0.f)) * (ii * xc[t * 64 + d]);
                        au[((dir * 2 + 0) * 64 + t) * 64 + d] = av; au[((dir * 2 + 1) * 64 + t) * 64 + d] = uv; } }
        }
        __syncthreads();
        {
            const int seg = tid >> 7, dir = (tid >> 6) & 1, c = tid & 63, ch = nblk * 64 + c;
            const LAS float* ap = au + ((dir * 2 + 0) * 64) * 64 + c; LAS float* up = au + ((dir * 2 + 1) * 64) * 64 + c;
            float A = 1.f, H = 0.f;
#pragma unroll 4
            for (int s = seg * 16; s < seg * 16 + 16; ++s) { const int t = dir ? 63 - s : s; const float av = ap[t * 64], uv = up[t * 64]; H = av * H + uv; A *= av; }
            sg[((0 * 4 + seg) * 2 + dir) * 64 + c] = A; sg[((1 * 4 + seg) * 2 + dir) * 64 + c] = H;
            __syncthreads();
            const size_t idx = ((size_t)((b * 2 + dir) * 68 + slot)) * 512 + ch;
            if (PASS == 1) {
                if (seg == 0) { float At = 1.f, Ht = 0.f;
#pragma unroll
                    for (int q = 0; q < 4; ++q) { const float Aq = sg[((0 * 4 + q) * 2 + dir) * 64 + c], Hq = sg[((1 * 4 + q) * 2 + dir) * 64 + c]; Ht = Aq * Ht + Hq; At *= Aq; }
                    TOTA[idx] = At; TOTH[idx] = Ht; }
            } else {
                float Hin = CARRY[idx];
                for (int q = 0; q < seg; ++q) { const float Aq = sg[((0 * 4 + q) * 2 + dir) * 64 + c], Hq = sg[((1 * 4 + q) * 2 + dir) * 64 + c]; Hin = Aq * Hin + Hq; }
#pragma unroll 4
                for (int s = seg * 16; s < seg * 16 + 16; ++s) { const int t = dir ? 63 - s : s; const float av = ap[t * 64], uv = up[t * 64]; Hin = av * Hin + uv; up[t * 64] = Hin; }
            }
        }
        __syncthreads();
        if (PASS == 2) {
            { const int t = rrA; float gt[8], y[8]; unpack8(gt4, gt);
              const LAS float* hf = au + ((0 * 2 + 1) * 64 + t) * 64 + c8; const LAS float* hb = au + ((1 * 2 + 1) * 64 + t) * 64 + c8;
              const f32x4 f0 = *(const LAS f32x4*)(hf), f1 = *(const LAS f32x4*)(hf + 4), b0 = *(const LAS f32x4*)(hb), b1 = *(const LAS f32x4*)(hb + 4);
#pragma unroll
              for (int e = 0; e < 8; ++e) { const float hs = (e < 4 ? f0[e & 3] + b0[e & 3] : f1[e & 3] + b1[e & 3]); const float g = gt[e];
                  y[e] = hs * g * fsigmoid(1.5957691216057308f * (g + 0.044715f * g * g * g)); }
              *(u32x4*)(U + (size_t)(rowbase + t0 + t) * D + 512 + nblk * 64 + c8) = pack8(y); }
            __syncthreads();
        }
        xa = nxa; xb = nxb; gt4 = ngt;
    }
#undef LR_FETCH
}

constexpr int GS_NS = 32, GS_K = 0, GS_Q = 16384, GS_V = 32768, GS_EG = 36864, GS_BTO = 36992, GS_BUF = 37120;
__device__ __forceinline__ void gdn_scan(KA a, LAS unsigned char* lds, int bid, int G, int tid, int wave, int lane) {
    const bf16_t* QN = (const bf16_t*)(a->ws + WS_U); const bf16_t* KN = QN + (size_t)MT * 512; const bf16_t* V = (const bf16_t*)(a->ws + WS_V);
    const float* Gb = (const float*)(a->ws + WS_G); const float* Bt = (const float*)(a->ws + WS_BT);
    for (int u = bid; u < 256; u += G) {
        const int chain = u >> 2, qd = u & 3, b = chain >> 3, h = (chain >> 1) & 3, dir = chain & 1;
        bf16_t* OD = (bf16_t*)(a->ws + (dir ? WS_OB : WS_OF));
        const int kg = lane & 7, cl = (wave & 3) * 8 + (lane >> 3), col = h * 128 + qd * 32 + cl;
        f32x2 S[8];
#pragma unroll
        for (int i = 0; i < 8; ++i) S[i] = (f32x2){0.f, 0.f};
#define GS_ROW(s) ((s) < CTXL ? (ML + b * CTXL + (dir ? CTXL - 1 - (s) : (s))) : (b * SEQ + (dir ? SEQ - 1 - ((s) - CTXL) : ((s) - CTXL))))
        const int lsl = tid >> 4, lc = tid & 15;
        u32x4 rk, rq, rv; float rg = 0.f;
#define GS_LOAD(blk) do { const int s_ = (blk) * GS_NS + lsl; const size_t row_ = (size_t)GS_ROW(s_); \
        rk = *(const u32x4*)(KN + row_ * 512 + h * 128 + lc * 8); rq = *(const u32x4*)(QN + row_ * 512 + h * 128 + lc * 8); \
        if (tid < 128) { const int s2_ = (blk) * GS_NS + (tid >> 2); const size_t r2_ = (size_t)GS_ROW(s2_); rv = *(const u32x4*)(V + r2_ * 512 + h * 128 + qd * 32 + (tid & 3) * 8); } \
        else if (tid < 160) { const int s2_ = (blk) * GS_NS + (tid - 128); rg = expf(Gb[(size_t)GS_ROW(s2_) * 8 + dir * 4 + h]); } \
        else if (tid < 192) { const int s2_ = (blk) * GS_NS + (tid - 160); rg = Bt[(size_t)GS_ROW(s2_) * 8 + dir * 4 + h]; } } while (0)
#define GS_ST8(dst, r) do { float f_[8]; unpack8(r, f_); *(LAS f32x4*)(dst) = (f32x4){f_[0], f_[1], f_[2], f_[3]}; *(LAS f32x4*)((dst) + 16) = (f32x4){f_[4], f_[5], f_[6], f_[7]}; } while (0)
#define GS_STORE(buf) do { LAS unsigned char* p_ = lds + (buf) * GS_BUF; \
        GS_ST8(p_ + GS_K + lsl * 512 + lc * 32, rk); GS_ST8(p_ + GS_Q + lsl * 512 + lc * 32, rq); \
        if (tid < 128) GS_ST8(p_ + GS_V + (tid >> 2) * 128 + (tid & 3) * 32, rv); \
        else if (tid < 160) *(LAS float*)(p_ + GS_EG + (tid - 128) * 4) = rg; \
        else if (tid < 192) *(LAS float*)(p_ + GS_BTO + (tid - 160) * 4) = rg; } while (0)
        GS_LOAD(0); GS_STORE(0);
        __syncthreads();
        constexpr int NBLK = NKV / GS_NS;
        for (int blk = 0; blk < NBLK; ++blk) {
            const bool more = blk + 1 < NBLK;
            if (more) GS_LOAD(blk + 1);
            const LAS unsigned char* p = lds + (blk & 1) * GS_BUF;
            if (wave < 4) {
              f32x4 k4[4], q4[4]; float vv, eg, bt;
#define GS_FETCH(K4, Q4, VV, EG, BT, sl_) do { _Pragma("unroll") for (int i = 0; i < 4; ++i) { K4[i] = *(const LAS f32x4*)(p + GS_K + (sl_) * 512 + kg * 64 + i * 16); Q4[i] = *(const LAS f32x4*)(p + GS_Q + (sl_) * 512 + kg * 64 + i * 16); } \
                VV = *(const LAS float*)(p + GS_V + (sl_) * 128 + cl * 4); EG = *(const LAS float*)(p + GS_EG + (sl_) * 4); BT = *(const LAS float*)(p + GS_BTO + (sl_) * 4); } while (0)
              GS_FETCH(k4, q4, vv, eg, bt, 0);
              bf16_t* odp = OD + (size_t)GS_ROW(blk * GS_NS) * 512 + col; const int ostep = dir ? -512 : 512;
#pragma unroll 2
              for (int sl = 0; sl < GS_NS; ++sl) {
                f32x4 nk4[4], nq4[4]; float nvv, neg, nbt;
                const int sn = sl + 1 < GS_NS ? sl + 1 : sl;
                GS_FETCH(nk4, nq4, nvv, neg, nbt, sn);
                f32x2 pa = {0.f, 0.f}, pb = {0.f, 0.f};
#pragma unroll
                for (int i = 0; i < 4; ++i) { pa += (f32x2){k4[i][0], k4[i][1]} * S[2 * i]; pb += (f32x2){k4[i][2], k4[i][3]} * S[2 * i + 1]; }
                const f32x2 pab = pa + pb; float pp = pab[0] + pab[1];
                pp += dppf(pp, 0); pp += dppf(pp, 1); pp += dppf(pp, 2);
                const float dl = bt * (vv - eg * pp);
                f32x2 oa = {0.f, 0.f}, ob = {0.f, 0.f};
#pragma unroll
                for (int i = 0; i < 4; ++i) {
                    S[2 * i] = S[2 * i] * eg + (f32x2){k4[i][0], k4[i][1]} * dl; S[2 * i + 1] = S[2 * i + 1] * eg + (f32x2){k4[i][2], k4[i][3]} * dl;
                    oa += (f32x2){q4[i][0], q4[i][1]} * S[2 * i]; ob += (f32x2){q4[i][2], q4[i][3]} * S[2 * i + 1]; }
                const f32x2 oab = oa + ob; float oo = oab[0] + oab[1];
                oo += dppf(oo, 0); oo += dppf(oo, 1); oo += dppf(oo, 2);
                if (kg == 0) odp[(ptrdiff_t)sl * ostep] = (bf16_t)f2bf(oo);
#pragma unroll
                for (int i = 0; i < 4; ++i) { k4[i] = nk4[i]; q4[i] = nq4[i]; }
                vv = nvv; eg = neg; bt = nbt;
              }
#undef GS_FETCH
            }
            if (more) GS_STORE((blk + 1) & 1);
            __syncthreads();
        }
#undef GS_ROW
#undef GS_LOAD
#undef GS_STORE
#undef GS_ST8
    }
    { const int gid = bid * 512 + tid;
      if (gid < NB * 2 * 512) { const int ch = gid & 511, dir = (gid >> 9) & 1, b = gid >> 10;
        const float* TOTA = (const float*)(a->ws + WS_TOTA); const float* TOTH = (const float*)(a->ws + WS_TOTH); float* CARRY = (float*)(a->ws + WS_CARRY);
        float carry = 0.f;
        for (int s = 0; s < 68; ++s) { const int slot = dir ? (s < 4 ? 3 - s : 67 - (s - 4)) : s; const size_t idx = ((size_t)((b * 2 + dir) * 68 + slot)) * 512 + ch;
            CARRY[idx] = carry; carry = TOTA[idx] * carry + TOTH[idx]; } } }
}


__device__ __forceinline__ int gs_row(int b, int dir, int s) { return s < CTXL ? (ML + b * CTXL + (dir ? CTXL - 1 - s : s)) : (b * SEQ + (dir ? SEQ - 1 - (s - CTXL) : (s - CTXL))); }
__device__ __forceinline__ float fexp(float x) { return __builtin_amdgcn_exp2f(1.4426950408889634f * x); }
constexpr int CP_WAVE = 64 * 68 * 4 + 512;
__device__ __forceinline__ void gdn_chunk_prep(KA a, LAS unsigned char* lds, int gw, int NGW, int wave, int lane) {
    const bf16_t* QN = (const bf16_t*)(a->ws + WS_U); const bf16_t* KN = QN + (size_t)MT * 512;
    const float* Gb = (const float*)(a->ws + WS_G); const float* Bt = (const float*)(a->ws + WS_BT);
    bf16_t* Tb = (bf16_t*)(a->ws + WS_TB); bf16_t* QKb = (bf16_t*)(a->ws + WS_QKB); float* GAM = (float*)(a->ws + WS_GAM);
    LAS float* Am = (LAS float*)(lds + wave * CP_WAVE); LAS float* gl = Am + 64 * 68; LAS float* bl = gl + 64;
    const int r32 = lane & 31, hi = lane >> 5;
    bf16x8 kf[2][8]; float gi_raw = 0.f, bt_raw = 0.f;
#define CP_FETCH(cu_) do { const int ch_ = (cu_) / 68, n_ = (cu_) % 68, b_ = ch_ >> 3, h_ = (ch_ >> 1) & 3, d_ = ch_ & 1; const int r0_ = gs_row(b_, d_, 64 * n_), rs_ = d_ ? -1 : 1; \
        _Pragma("unroll") for (int blk = 0; blk < 2; ++blk) _Pragma("unroll") for (int ks = 0; ks < 8; ++ks) \
            kf[blk][ks] = *(const bf16x8*)(KN + (size_t)(r0_ + rs_ * (32 * blk + r32)) * 512 + h_ * 128 + 16 * ks + 8 * hi); \
        const size_t rl_ = (size_t)(r0_ + rs_ * lane); gi_raw = Gb[rl_ * 8 + d_ * 4 + h_]; bt_raw = Bt[rl_ * 8 + d_ * 4 + h_]; } while (0)
    if (gw < 64 * 68) CP_FETCH(gw);
    for (int cu = gw; cu < 64 * 68; cu += NGW) {
        const int chain = cu / 68, n = cu % 68, b = chain >> 3, h = (chain >> 1) & 3, dir = chain & 1;
        const int row0 = gs_row(b, dir, 64 * n), rs = dir ? -1 : 1;
        { float gi = gi_raw;
#pragma unroll
          for (int o = 1; o < 64; o <<= 1) { const float t = __shfl_up(gi, o); if (lane >= o) gi += t; }
          gl[lane] = gi; bl[lane] = bt_raw; GAM[(size_t)cu * 64 + lane] = gi; }
        LDS_WAIT();
        const float gj0 = gl[r32], gj1 = gl[32 + r32];
#pragma unroll
        for (int tl = 0; tl < 3; ++tl) { const int mb = tl == 0 ? 0 : 1, nb = tl == 2 ? 1 : 0;
            f32x16 acc;
#pragma unroll
            for (int r = 0; r < 16; ++r) acc[r] = 0.f;
#pragma unroll
            for (int ks = 0; ks < 8; ++ks) acc = __builtin_amdgcn_mfma_f32_32x32x16_bf16(kf[mb][ks], kf[nb][ks], acc, 0, 0, 0);
            const int j = 32 * nb + r32; const float gj = nb ? gj1 : gj0;
#pragma unroll
            for (int q = 0; q < 4; ++q) { const int i0 = 32 * mb + 8 * q + 4 * hi; const f32x4 gmi = *(const LAS f32x4*)(gl + i0), bti = *(const LAS f32x4*)(bl + i0);
#pragma unroll
                for (int e = 0; e < 4; ++e) { const int i = i0 + e; Am[i * 68 + j] = (i > j) ? bti[e] * acc[4 * q + e] * fexp(gmi[e] - gj) : 0.f; } }
        }
        asm volatile("" ::: "memory");
        {
            bf16_t* qko = QKb + (size_t)cu * 4096;
#pragma unroll
            for (int mb = 0; mb < 2; ++mb) {
                bf16x8 qf[8];
#pragma unroll
                for (int ks = 0; ks < 8; ++ks) qf[ks] = *(const bf16x8*)(QN + (size_t)(row0 + rs * (32 * mb + r32)) * 512 + h * 128 + 16 * ks + 8 * hi);
#pragma unroll
                for (int nb = 0; nb <= mb; ++nb) {
                    f32x16 acc;
#pragma unroll
                    for (int r = 0; r < 16; ++r) acc[r] = 0.f;
#pragma unroll
                    for (int ks = 0; ks < 8; ++ks) acc = __builtin_amdgcn_mfma_f32_32x32x16_bf16(qf[ks], kf[nb][ks], acc, 0, 0, 0);
                    const int j = 32 * nb + r32; const float gj = nb ? gj1 : gj0;
#pragma unroll
                    for (int q = 0; q < 4; ++q) { const int i0 = 32 * mb + 8 * q + 4 * hi; const f32x4 gmi = *(const LAS f32x4*)(gl + i0);
#pragma unroll
                        for (int e = 0; e < 4; ++e) { const int i = i0 + e; qko[i * 64 + j] = (bf16_t)f2bf((i >= j) ? acc[4 * q + e] * fexp(gmi[e] - gj) : 0.f); } }
                }
                asm volatile("" ::: "memory");
            }
#pragma unroll
            for (int q = 0; q < 4; ++q)
#pragma unroll
                for (int e = 0; e < 4; ++e) qko[(8 * q + 4 * hi + e) * 64 + 32 + r32] = (bf16_t)0;
        }
        asm volatile("" ::: "memory");
        LDS_WAIT();
        { const int cn = cu + NGW < 64 * 68 ? cu + NGW : cu; CP_FETCH(cn); }
        {
            float Tc[64]; int ln = lane;
#pragma unroll
            for (int i = 0; i < 64; ++i) {
                if ((i & 3) == 0) asm volatile("" : "+v"(ln));
                float acc = (i == ln) ? 1.f : 0.f, acc1 = 0.f;
#pragma unroll
                for (int jj = 0; jj < (i + 3) / 4; ++jj) { const f32x4 a4 = *(const LAS f32x4*)(Am + i * 68 + 4 * jj);
#pragma unroll
                    for (int e = 0; e < 4; ++e) if (4 * jj + e < i) { if (e & 1) acc1 -= a4[e] * Tc[4 * jj + e]; else acc -= a4[e] * Tc[4 * jj + e]; } }
                Tc[i] = acc + acc1;
                if ((i & 1) == 1) asm volatile("" ::: "memory");
            }
            bf16_t* to = Tb + (size_t)cu * 4096 + lane;
#pragma unroll
            for (int i = 0; i < 64; ++i) to[i * 64] = (bf16_t)f2bf(Tc[i]);
        }
        LDS_WAIT();
    }
#undef CP_FETCH
}

constexpr int CS_KN = 0, CS_QN = 17408, CS_KT = 34816, CS_T = 53248, CS_QK = 62464, CS_VT = 71680, CS_GB = 76288, CS_ST = 77312, CS_RT = 86016, CS_VNT = 90624, CS_VDT = 95232, CS_END = 99840;
__device__ __forceinline__ void cs_compute(LAS unsigned char* lds, int wave, int r32, int hi, f32x16& acc, f32x16& Sreg, bf16_t* op, int row0, int rs) {
    const LAS float* gamL = (const LAS float*)(lds + CS_GB); const LAS float* betL = gamL + 64;
    const int mb = wave & 1;
    if (wave < 4) {
        const LAS unsigned char* X = lds + ((wave >> 1) ? CS_QN : CS_KN) + (32 * mb + r32) * 272 + 16 * hi; const LAS unsigned char* Sb = lds + CS_ST + r32 * 272 + 16 * hi;
#pragma unroll
        for (int r = 0; r < 16; ++r) acc[r] = 0.f;
#pragma unroll
        for (int ks = 0; ks < 8; ++ks) acc = __builtin_amdgcn_mfma_f32_32x32x16_bf16(*(const LAS bf16x8*)(X + 32 * ks), *(const LAS bf16x8*)(Sb + 32 * ks), acc, 0, 0, 0);
    }
    if (wave < 2) {
#pragma unroll
        for (int q = 0; q < 4; ++q) { const int t0 = 32 * mb + 8 * q + 4 * hi; const f32x4 gm = *(const LAS f32x4*)(gamL + t0), bt = *(const LAS f32x4*)(betL + t0);
            const u32x2 vv = *(const LAS u32x2*)(lds + CS_VT + r32 * 144 + t0 * 2);
            const float v0 = __uint_as_float(vv.x << 16), v1 = __uint_as_float(vv.x & 0xffff0000u), v2 = __uint_as_float(vv.y << 16), v3 = __uint_as_float(vv.y & 0xffff0000u);
            u32x2 w; w.x = pk2(bt[0] * (v0 - fexp(gm[0]) * acc[4 * q]), bt[1] * (v1 - fexp(gm[1]) * acc[4 * q + 1]));
            w.y = pk2(bt[2] * (v2 - fexp(gm[2]) * acc[4 * q + 2]), bt[3] * (v3 - fexp(gm[3]) * acc[4 * q + 3]));
            *(LAS u32x2*)(lds + CS_RT + r32 * 144 + t0 * 2) = w; }
    }
    __syncthreads();
    if (wave < 2) {
        f32x16 vn;
#pragma unroll
        for (int r = 0; r < 16; ++r) vn[r] = 0.f;
        const LAS unsigned char* Ta = lds + CS_T + (32 * mb + r32) * 144 + 16 * hi; const LAS unsigned char* Rb = lds + CS_RT + r32 * 144 + 16 * hi;
#pragma unroll
        for (int ks = 0; ks < 4; ++ks) vn = __builtin_amdgcn_mfma_f32_32x32x16_bf16(*(const LAS bf16x8*)(Ta + 32 * ks), *(const LAS bf16x8*)(Rb + 32 * ks), vn, 0, 0, 0);
        const float glast = gamL[63];
#pragma unroll
        for (int q = 0; q < 4; ++q) { const int t0 = 32 * mb + 8 * q + 4 * hi; const f32x4 gm = *(const LAS f32x4*)(gamL + t0);
            u32x2 w; w.x = pk2(vn[4 * q], vn[4 * q + 1]); w.y = pk2(vn[4 * q + 2], vn[4 * q + 3]);
            *(LAS u32x2*)(lds + CS_VNT + r32 * 144 + t0 * 2) = w;
            w.x = pk2(vn[4 * q] * fexp(glast - gm[0]), vn[4 * q + 1] * fexp(glast - gm[1])); w.y = pk2(vn[4 * q + 2] * fexp(glast - gm[2]), vn[4 * q + 3] * fexp(glast - gm[3]));
            *(LAS u32x2*)(lds + CS_VDT + r32 * 144 + t0 * 2) = w; }
    }
    __syncthreads();
    if (wave == 2 || wave == 3) {
#pragma unroll
        for (int q = 0; q < 4; ++q) { const int t0 = 32 * mb + 8 * q + 4 * hi; const f32x4 gm = *(const LAS f32x4*)(gamL + t0);
#pragma unroll
            for (int e = 0; e < 4; ++e) acc[4 * q + e] *= fexp(gm[e]); }
        const LAS unsigned char* Qa = lds + CS_QK + (32 * mb + r32) * 144 + 16 * hi; const LAS unsigned char* Vb = lds + CS_VNT + r32 * 144 + 16 * hi;
#pragma unroll
        for (int ks = 0; ks < 4; ++ks) acc = __builtin_amdgcn_mfma_f32_32x32x16_bf16(*(const LAS bf16x8*)(Qa + 32 * ks), *(const LAS bf16x8*)(Vb + 32 * ks), acc, 0, 0, 0);
#pragma unroll
        for (int r = 0; r < 16; ++r) { const int tok = 32 * mb + (r & 3) + 8 * (r >> 2) + 4 * hi; op[(ptrdiff_t)(row0 + rs * tok) * 512] = (bf16_t)f2bf(acc[r]); }
    } else if (wave >= 4) {
        const int mk = wave - 4; const float cd = fexp(gamL[63]);
#pragma unroll
        for (int r = 0; r < 16; ++r) Sreg[r] *= cd;
        const LAS unsigned char* Ka = lds + CS_KT + (32 * mk + r32) * 144 + 16 * hi; const LAS unsigned char* Db = lds + CS_VDT + r32 * 144 + 16 * hi;
#pragma unroll
        for (int ks = 0; ks < 4; ++ks) Sreg = __builtin_amdgcn_mfma_f32_32x32x16_bf16(*(const LAS bf16x8*)(Ka + 32 * ks), *(const LAS bf16x8*)(Db + 32 * ks), Sreg, 0, 0, 0);
#pragma unroll
        for (int q = 0; q < 4; ++q) { u32x2 w; w.x = pk2(Sreg[4 * q], Sreg[4 * q + 1]); w.y = pk2(Sreg[4 * q + 2], Sreg[4 * q + 3]);
            *(LAS u32x2*)(lds + CS_ST + r32 * 272 + (32 * mk + 8 * q + 4 * hi) * 2) = w; }
    }
    __syncthreads();
}
__device__ __forceinline__ void gdn_chunk_scan(KA a, LAS unsigned char* lds, int bid, int G, int tid, int wave, int lane) {
    const bf16_t* QN = (const bf16_t*)(a->ws + WS_U); const bf16_t* KN = QN + (size_t)MT * 512; const bf16_t* V = (const bf16_t*)(a->ws + WS_V);
    const float* Bt = (const float*)(a->ws + WS_BT);
    const bf16_t* Tb = (const bf16_t*)(a->ws + WS_TB); const bf16_t* QKb = (const bf16_t*)(a->ws + WS_QKB); const float* GAM = (const float*)(a->ws + WS_GAM);
    const int r32 = lane & 31, hi = lane >> 5;
    for (int u = bid; u < 256; u += G) {
        const int chain = (u & 7) * 8 + (u >> 5), qd = (u >> 3) & 3;
        const int b = chain >> 3, h = (chain >> 1) & 3, dir = chain & 1, rs = dir ? -1 : 1;
        bf16_t* op = (bf16_t*)(a->ws + (dir ? WS_OB : WS_OF)) + h * 128 + qd * 32 + r32;
        u32x4 rkA[2], rqA[2], rTA, rQKA, rVA; float rgbA = 0.f;
        u32x4 rkB[2], rqB[2], rTB, rQKB, rVB; float rgbB = 0.f;
#define CS_LOAD(S_, n_) do { const int row0_ = gs_row(b, dir, 64 * (n_)); const size_t cu_ = (size_t)(chain * 68 + (n_)); const size_t rowl_ = (size_t)(row0_ + rs * lane); \
        _Pragma("unroll") for (int i_ = 0; i_ < 2; ++i_) { const int c16_ = wave + 8 * i_; \
            rk##S_[i_] = *(const u32x4*)(KN + rowl_ * 512 + h * 128 + c16_ * 8); rq##S_[i_] = *(const u32x4*)(QN + rowl_ * 512 + h * 128 + c16_ * 8); } \
        rT##S_ = *(const u32x4*)(Tb + cu_ * 4096 + tid * 8); rQK##S_ = *(const u32x4*)(QKb + cu_ * 4096 + tid * 8); \
        if (wave < 4) rV##S_ = *(const u32x4*)(V + rowl_ * 512 + h * 128 + qd * 32 + wave * 8); \
        if (tid < 64) rgb##S_ = GAM[cu_ * 64 + tid]; else if (tid < 128) rgb##S_ = Bt[(size_t)(row0_ + rs * (tid - 64)) * 8 + dir * 4 + h]; } while (0)
#define CS_T16(base, v, col0, tok) do { const unsigned w_[4] = {(v).x, (v).y, (v).z, (v).w}; _Pragma("unroll") for (int e_ = 0; e_ < 8; ++e_) \
        *(LAS bf16_t*)(lds + (base) + ((col0) + e_) * 144 + (tok) * 2) = (bf16_t)((e_ & 1) ? (w_[e_ >> 1] >> 16) : (w_[e_ >> 1] & 0xffffu)); } while (0)
#define CS_STORE(S_) do { \
        _Pragma("unroll") for (int i_ = 0; i_ < 2; ++i_) { const int c16_ = wave + 8 * i_; \
            *(LAS u32x4*)(lds + CS_KN + lane * 272 + c16_ * 16) = rk##S_[i_]; *(LAS u32x4*)(lds + CS_QN + lane * 272 + c16_ * 16) = rq##S_[i_]; CS_T16(CS_KT, rk##S_[i_], c16_ * 8, lane); } \
        *(LAS u32x4*)(lds + CS_T + (tid >> 3) * 144 + (tid & 7) * 16) = rT##S_; *(LAS u32x4*)(lds + CS_QK + (tid >> 3) * 144 + (tid & 7) * 16) = rQK##S_; \
        if (wave < 4) CS_T16(CS_VT, rV##S_, wave * 8, lane); \
        if (tid < 128) *(LAS float*)(lds + CS_GB + tid * 4) = rgb##S_; } while (0)
        CS_LOAD(A, 0);
        for (int i = tid; i < 32 * 272 / 4; i += 512) *(LAS unsigned*)(lds + CS_ST + i * 4) = 0u;
        CS_STORE(A);
        __syncthreads();
        CS_LOAD(A, 1);
        f32x16 Sreg, acc;
#pragma unroll
        for (int r = 0; r < 16; ++r) { Sreg[r] = 0.f; acc[r] = 0.f; }
        for (int n = 0; n < 68; n += 2) {
            if (n + 2 < 68) CS_LOAD(B, n + 2);
            cs_compute(lds, wave, r32, hi, acc, Sreg, op, gs_row(b, dir, 64 * n), rs);
            CS_STORE(A);
            __syncthreads();
            if (n + 3 < 68) CS_LOAD(A, n + 3);
            cs_compute(lds, wave, r32, hi, acc, Sreg, op, gs_row(b, dir, 64 * (n + 1)), rs);
            if (n + 2 < 68) CS_STORE(B);
            __syncthreads();
        }
#undef CS_LOAD
#undef CS_T16
#undef CS_STORE
    }
    if (wave == 0 && lane < 32) {
      const float* TOTA = (const float*)(a->ws + WS_TOTA); const float* TOTH = (const float*)(a->ws + WS_TOTH); float* CARRY = (float*)(a->ws + WS_CARRY);
      for (int gid = bid * 32 + lane; gid < NB * 2 * 512; gid += G * 32) { const int ch = gid & 511, dir = (gid >> 9) & 1, b = gid >> 10;
        float carry = 0.f;
        for (int s0 = 0; s0 < 68; s0 += 17) {
            float ta[17], th[17];
#pragma unroll
            for (int k = 0; k < 17; ++k) { const int s = s0 + k; const int slot = dir ? (s < 4 ? 3 - s : 67 - (s - 4)) : s; const size_t idx = ((size_t)((b * 2 + dir) * 68 + slot)) * 512 + ch; ta[k] = TOTA[idx]; th[k] = TOTH[idx]; }
#pragma unroll
            for (int k = 0; k < 17; ++k) { const int s = s0 + k; const int slot = dir ? (s < 4 ? 3 - s : 67 - (s - 4)) : s; const size_t idx = ((size_t)((b * 2 + dir) * 68 + slot)) * 512 + ch; CARRY[idx] = carry; carry = ta[k] * carry + th[k]; }
        } } }
}

__device__ __forceinline__ void gdn_merge(KA a, int L, int gw, int NGW, int lane) {
    const int j2 = L >> 1;
    const bf16_t* P = (const bf16_t*)(a->ws + WS_P); bf16_t* U = (bf16_t*)(a->ws + WS_U);
    const bf16_t* OF = (const bf16_t*)(a->ws + WS_OF); const bf16_t* OB = (const bf16_t*)(a->ws + WS_OB);
    const float* gn = a->in[I_EVGDNNORM] + j2 * 128 + ((8 * lane) & 127);
    float g8[8];
#pragma unroll
    for (int e = 0; e < 8; ++e) g8[e] = gn[e];
    for (int row = gw; row < MT; row += NGW) {
        float of[8], ob[8], z[8], y[8];
        unpack8(*(const u32x4*)(OF + (size_t)row * 512 + 8 * lane), of); unpack8(*(const u32x4*)(OB + (size_t)row * 512 + 8 * lane), ob);
        unpack8(*(const u32x4*)(P + (size_t)row * EVNP + 1536 + 8 * lane), z);
        float ssq = 0.f;
#pragma unroll
        for (int e = 0; e < 8; ++e) { of[e] += ob[e]; ssq += of[e] * of[e]; }
        ssq = rowsum16(ssq);
        const float rms = 1.0f / sqrtf(ssq * (1.f / 128.f) + EPS);
#pragma unroll
        for (int e = 0; e < 8; ++e) y[e] = of[e] * rms * g8[e] * fsilu(z[e]);
        *(u32x4*)(U + (size_t)row * D + 8 * lane) = pack8(y);
    }
}


#define XB_TMO      128
#define XB_XCNT(j)  (256  + 64 * (j))
#define XB_XSUB(j)  (1280 + 64 * (j))
#define XB_XGEN(j)  (2304 + 64 * (j))
#define XB_TOP      3328
#define XB_TOPGEN   3392
#define XCD_BAR_WORDS 3456
#define XB_SPIN_CAP (1u << 20)
__device__ __forceinline__ unsigned xb_ld(unsigned* p)              { return __hip_atomic_load(p, __ATOMIC_RELAXED, __HIP_MEMORY_SCOPE_AGENT); }
__device__ __forceinline__ unsigned xb_add(unsigned* p, unsigned v) { return __hip_atomic_fetch_add(p, v, __ATOMIC_RELAXED, __HIP_MEMORY_SCOPE_AGENT); }
__device__ __forceinline__ unsigned xb_xcc_id() { return (unsigned)__builtin_amdgcn_s_getreg((3 << 11) | 20) & 0xFu; }
#define XB_SPIN(cond, bar) do { unsigned _sp = 0; while (cond) { __builtin_amdgcn_s_sleep(1); \
    if ((++_sp & 255u) == 0u) { if (xb_ld(&(bar)[XB_TMO])) break; if (_sp > XB_SPIN_CAP) { atomicAdd(&(bar)[XB_TMO], 1u); break; } } } } while (0)
struct XcdBarrier { unsigned* bar; unsigned x; volatile LAS unsigned* st; };
__device__ __forceinline__ XcdBarrier xcd_barrier_post(unsigned* bar, volatile LAS unsigned* st) {
    XcdBarrier b; b.bar = bar; b.x = xb_xcc_id(); b.st = st;
    if (threadIdx.x == 0) (void)xb_add(&bar[XB_XCNT(b.x)], 1u);
    return b;
}
__device__ __forceinline__ void xcd_barrier_complete(unsigned* bar, unsigned x, unsigned& nloc, unsigned& nx) {
    const unsigned G = gridDim.x * gridDim.y * gridDim.z;
    unsigned sum, cnt, mine, sp = 0u;
    for (;;) {
        sum = 0u; cnt = 0u; mine = 0u;
#pragma unroll
        for (unsigned j = 0; j < 16; ++j) { const unsigned c = xb_ld(&bar[XB_XCNT(j)]); sum += c; cnt += (c > 0u) ? 1u : 0u; mine = (j == x) ? c : mine; }
        if (sum == G) break;
        __builtin_amdgcn_s_sleep(1);
        if ((++sp & 255u) == 0u) { if (xb_ld(&bar[XB_TMO])) break; if (sp > XB_SPIN_CAP) { atomicAdd(&bar[XB_TMO], 1u); break; } }
    }
    nloc = mine > 0u ? mine : 1u; nx = cnt > 0u ? cnt : 1u;
}
__device__ __forceinline__ void xcd_barrier(const XcdBarrier& b) {
    asm volatile("s_waitcnt vmcnt(0)" ::: "memory");
    __syncthreads();
    if (threadIdx.x == 0) {
        unsigned* bar = b.bar;
        __builtin_amdgcn_s_waitcnt(0);
        unsigned nloc = b.st[0], nx = b.st[1];
        if (nloc == 0u) { xcd_barrier_complete(bar, b.x, nloc, nx); b.st[0] = nloc; b.st[1] = nx; }
        const unsigned old = xb_add(&bar[XB_XSUB(b.x)], 1u);
        const unsigned gen = old / nloc;
        if (old + 1u == (gen + 1u) * nloc) {
            __builtin_amdgcn_fence(__ATOMIC_RELEASE, "agent");
            asm volatile("s_waitcnt vmcnt(0)" ::: "memory");
            const unsigned og = xb_add(&bar[XB_TOP], 1u);
            const unsigned tg = og / nx;
            if (og + 1u == (tg + 1u) * nx) xb_add(&bar[XB_TOPGEN], 1u);
            else XB_SPIN(xb_ld(&bar[XB_TOPGEN]) == tg, bar);
            __builtin_amdgcn_fence(__ATOMIC_ACQUIRE, "agent");
            xb_add(&bar[XB_XGEN(b.x)], 1u);
            asm volatile("s_waitcnt vmcnt(0)" ::: "memory");
        } else {
            XB_SPIN(xb_ld(&bar[XB_XGEN(b.x)]) == gen, bar);
            __builtin_amdgcn_fence(__ATOMIC_ACQUIRE, "agent");
            asm volatile("s_waitcnt vmcnt(0)" ::: "memory");
        }
    }
    __syncthreads();
}

__device__ __forceinline__ void decode_phase(int ph, int& L, int& kind) {
    if (ph == 0) { L = 0; kind = K_PROA; return; }
    if (ph == 1) { L = 0; kind = K_PROB; return; }
    int p = ph - 2;
    if (p < 10) { L = 0; } else if (p < 18) { L = 1; p -= 10; } else if (p < 28) { L = 2; p -= 18; } else { L = 3; p -= 28; }
    if ((L & 1) == 0) { kind = p == 0 ? K_PROJ : p == 1 ? K_E2 : p == 2 ? K_E2B : p == 3 ? K_E3 : p == 4 ? K_E4 : p == 5 ? K_WOUT : p == 6 ? K_LN1 : p == 7 ? K_MLP1 : p == 8 ? K_MLP2 : K_LN2; }
    else { kind = p == 0 ? K_PROJ : p == 1 ? K_O2 : p == 2 ? K_O3 : p == 3 ? K_WOUT : p == 4 ? K_LN1 : p == 5 ? K_MLP1 : p == 6 ? K_MLP2 : K_LN2; }
}

#ifndef MK_DUP_GEMM
#define MK_DUP_GEMM 0
#endif
#ifndef MK_DUP_KIND
#define MK_DUP_KIND -1
#endif
#ifndef MK_SKIP1
#define MK_SKIP1 1
#endif
#ifndef MK_K2
#define MK_K2 1024
#endif
#ifndef MK_PHM
#define MK_PHM 0xffffu
#endif
#define EN(k) ((MK_PHM >> (k)) & 1u)
__global__ void __launch_bounds__(512, 2) fwd_kernel(Args args) {
    extern __shared__ __attribute__((aligned(16))) unsigned char lds_raw[];
    LAS unsigned char* lds = (LAS unsigned char*)lds_raw;
    cg::grid_group grid = cg::this_grid();
    const int G = gridDim.x;
    volatile LAS unsigned* bst = (volatile LAS unsigned*)(lds + LDS_BYTES - 16);
    if (threadIdx.x < 2) bst[threadIdx.x] = 0u;
    __syncthreads();
    const XcdBarrier xbar = xcd_barrier_post((unsigned*)(args.ws + WS_BAR), bst);
    const int ph_lo = args.ph_lo, ph_hi = args.ph_hi;
    bool second = false;
    for (int ph = ph_lo; ph < ph_hi; ) {
        KA a = (KA)__builtin_amdgcn_kernarg_segment_ptr(); asm volatile("" : "+s"(a));
        int tid = threadIdx.x; asm volatile("" : "+v"(tid));
        int bid = blockIdx.x; asm volatile("" : "+s"(bid));
        const int lane = tid & 63, wave = __builtin_amdgcn_readfirstlane(tid >> 6), gw = bid * 8 + wave, NGW = G * 8;
        bf16_t* U = (bf16_t*)(a->ws + WS_U); bf16_t* P = (bf16_t*)(a->ws + WS_P); float* HC = (float*)(a->ws + WS_HC);
        const float* MOD = (const float*)(a->ws + WS_MOD);
        int L, kind; decode_phase(ph, L, kind);
        const bool even = (L & 1) == 0; const bool last = L == 3;
        const int Mrows = last ? ML : MT;
        const bool isgemm = kind == K_PROJ || kind == K_MLP1 || kind == K_WOUT || kind == K_MLP2;
        const bool dup = (MK_DUP_GEMM && isgemm) || kind == MK_DUP_KIND;
        if (EN(K_PROA) && kind == K_PROA) prologue_a(a, lds, bid, G, tid, wave, lane);
        else if (EN(K_PROB) && kind == K_PROB) prologue_b(a, gw, NGW, lane);
        else if (EN(K_PROJ) && (kind == K_PROJ || kind == K_MLP1 || kind == K_WOUT || kind == K_MLP2)) {
            const float* modL = MOD + (size_t)L * 9 * 6144;
            const bool split = (kind == K_WOUT || kind == K_MLP2) && !last;
            const int ncall = split ? 2 : 1;
            for (int call = 0; call < ncall; ++call) {
                pg8::Gemm g; pg8::EpiBf16 E;
                if (kind == K_PROJ) { g = pg8::Gemm{U, (const bf16_t*)(a->ws + WS_WA), MT, even ? EVNP : ODN, D, D, D, 1}; E = pg8::EpiBf16{P, even ? EVNP : ODN, 0, nullptr, -1, 0}; }
                else if (kind == K_MLP1) { g = pg8::Gemm{U, (const bf16_t*)(a->ws + WS_W1), Mrows, FF, D, D, D, 1}; E = pg8::EpiBf16{P, FF, 2, nullptr, -1, 0}; }
                else if (kind == K_WOUT) { const bf16_t* A = even ? U : P; const int lda = even ? D : ODN;
                    if (call == 0) { g = pg8::Gemm{A, (const bf16_t*)(a->ws + WS_WO), ML, D, D, lda, D, 1}; E = pg8::EpiBf16{even ? P : U, D, 0, modL + 2 * D, -1, 0}; }
                    else { g = pg8::Gemm{A + (size_t)ML * lda, (const bf16_t*)(a->ws + WS_WO), MC, D, D / 4, lda, D, 4}; E = pg8::EpiBf16{(bf16_t*)(a->ws + WS_PART), D, 0, modL + 2 * D, 8, (size_t)MC * D}; } }
                else { if (call == 0) { g = pg8::Gemm{P, (const bf16_t*)(a->ws + WS_W2), ML, D, FF, FF, FF, 1}; E = pg8::EpiBf16{U, D, 0, modL + 5 * D, -1, 0}; }
                    else { g = pg8::Gemm{P + (size_t)ML * FF, (const bf16_t*)(a->ws + WS_W2), MC, D, FF / 8, FF, FF, 8}; E = pg8::EpiBf16{(bf16_t*)(a->ws + WS_PART), D, 0, modL + 5 * D, 8, (size_t)MC * D}; } }
                pg8::StaticOrder S; S.init(g.M, g.N, G, bid, g.nks);
                pg8::gemm_phase<pg8::EpiBf16>(lds, g, S, E, tid);
            }
        }
        else if (EN(K_LN1) && kind == K_LN1) ln_pass(a, L, 0, Mrows, true, L, 3, even ? P : U, last ? 0 : 4, gw, NGW, lane);
        else if (EN(K_LN2) && kind == K_LN2) {
            ln_pass(a, L, 1, Mrows, !last, L + 1, 0, U, last ? 0 : 8, gw, NGW, lane);
            if (!last) conv_weights(a, L + 1, lds, gw, NGW, wave, lane);
        }
        else if (EN(K_E2) && kind == K_E2) { gdn_prep(a, L, lds, gw, NGW, tid, lane); lru_units<1>(a, L, lds, bid, G, tid); }
        else if (EN(K_E2B) && kind == K_E2B) gdn_chunk_prep(a, lds, gw, NGW, wave, lane);
        else if (EN(K_E3) && kind == K_E3) gdn_chunk_scan(a, lds, bid, G, tid, wave, lane);
        else if (EN(K_E4) && kind == K_E4) { gdn_merge(a, L, gw, NGW, lane); lru_units<2>(a, L, lds, bid, G, tid); }
        else if (EN(K_O2) && kind == K_O2) attn_prep(a, lds, bid, G, tid);
        else if (EN(K_O3) && kind == K_O3) attn_phase(a, L, lds, bid, G, tid, wave, lane, !dup || second);
        if (dup && !second) { second = true; grid.sync(); continue; }
        second = false; ++ph;
        if (ph < ph_hi) { if (ph == ph_lo + 1) grid.sync(); else xcd_barrier(xbar); }
    }
}

#ifndef MK_PH_HI
#define MK_PH_HI N_PHASES
#endif
#ifndef MK_PER_PHASE
#define MK_PER_PHASE 0
#endif
extern "C" void kernel_launch(void* const* d_in, const int* in_sizes, int n_in, void* d_out, int out_size, void* d_ws, size_t ws_size, hipStream_t stream) {
    static int grid = 0;
    if (grid == 0) {
        if (n_in != 24 || ws_size < WS_END) { fprintf(stderr, "kernel_launch: unexpected n_in %d / ws_size %zu\n", n_in, ws_size); grid = -1; return; }
        int dev = 0, cus = 0, per_cu = 0;
        (void)hipGetDevice(&dev); (void)hipDeviceGetAttribute(&cus, hipDeviceAttributeMultiprocessorCount, dev);
        if (hipFuncSetAttribute((const void*)fwd_kernel, hipFuncAttributeMaxDynamicSharedMemorySize, LDS_BYTES) != hipSuccess) { fprintf(stderr, "kernel_launch: hipFuncSetAttribute failed\n"); grid = -1; return; }
        (void)hipOccupancyMaxActiveBlocksPerMultiprocessor(&per_cu, (const void*)fwd_kernel, 512, LDS_BYTES);
        (void)hipGetLastError();
        if (per_cu < 1) per_cu = 1;
        grid = cus;
        fprintf(stderr, "kernel_launch: cus %d per_cu %d grid %d\n", cus, per_cu, grid);
    }
    if (grid < 0) return;
    Args a{};
    for (int i = 0; i < 24; ++i) a.in[i] = (const float*)d_in[i];
    a.out = (float*)d_out; a.ws = (unsigned char*)d_ws;
#if MK_PER_PHASE
    for (int ph = 0; ph < N_PHASES; ++ph) { a.ph_lo = ph; a.ph_hi = ph + 1; hipLaunchKernelGGL(fwd_kernel, dim3(grid), dim3(512), LDS_BYTES, stream, a); }
#else
    a.ph_lo = 0; a.ph_hi = MK_PH_HI;
    (void)hipMemsetAsync((unsigned char*)d_ws + WS_BAR, 0, 16384, stream);
    void* args[] = {&a};
    hipError_t e = hipLaunchCooperativeKernel((const void*)fwd_kernel, dim3(grid), dim3(512), args, LDS_BYTES, stream);
    if (e != hipSuccess) fprintf(stderr, "kernel_launch: cooperative launch failed: %s (grid %d)\n", hipGetErrorString(e), grid);
#endif
}
```

```cpp
#include <hip/hip_runtime.h>
#include <hip/hip_cooperative_groups.h>
#include <cstdio>
#include <cstdint>
namespace cg = cooperative_groups;

#define LAS __attribute__((address_space(3)))
typedef unsigned short bf16_t;
typedef short bf16x8 __attribute__((ext_vector_type(8)));
typedef float f32x4 __attribute__((ext_vector_type(4)));
typedef float f32x2 __attribute__((ext_vector_type(2)));
typedef float f32x16 __attribute__((ext_vector_type(16)));
typedef unsigned u32x4 __attribute__((ext_vector_type(4)));
typedef unsigned u32x2 __attribute__((ext_vector_type(2)));
typedef __bf16 bf16x2_t __attribute__((ext_vector_type(2)));

constexpr int D = 1024, NB = 8, SEQ = 4096, CTXL = 256, FF = 4096;
constexpr int ML = NB * SEQ, MC = NB * CTXL, MT = ML + MC;
constexpr int EVN = 3088, EVNP = 3328, ODN = 3072;
constexpr float ALPHA = 1.6817928305074292f;
constexpr float EPS = 1e-6f;
constexpr int NKV = CTXL + SEQ;
constexpr float QSCALE = 0.125f * 1.4426950408889634f;

constexpr size_t MiB = 1u << 20;
constexpr size_t WS_MISC = 0;
constexpr size_t WS_BAR = 65536;
constexpr size_t WS_MOD = 1 * MiB;
constexpr size_t WS_WA = 2 * MiB;
constexpr size_t WS_WO = 9 * MiB;
constexpr size_t WS_W1 = 11 * MiB;
constexpr size_t WS_W2 = 19 * MiB;
constexpr size_t WS_HC = 27 * MiB;
constexpr size_t WS_U = 35 * MiB;
constexpr size_t WS_P = 103 * MiB;
constexpr size_t WS_X = 324 * MiB;
constexpr size_t WS_V = WS_X;
constexpr size_t WS_OF = WS_X + 34 * MiB;
constexpr size_t WS_OB = WS_X + 68 * MiB;
constexpr size_t WS_G = WS_X + 102 * MiB;
constexpr size_t WS_BT = WS_X + 104 * MiB;
constexpr size_t WS_TOTA = WS_X + 106 * MiB;
constexpr size_t WS_TOTH = WS_X + 109 * MiB;
constexpr size_t WS_CARRY = WS_X + 112 * MiB;
constexpr size_t WS_HLAST = 375 * MiB;
constexpr size_t WS_PART = 376 * MiB;
constexpr size_t WS_TB = WS_X + 116 * MiB;
constexpr size_t WS_QKB = WS_X + 150 * MiB;
constexpr size_t WS_GAM = WS_X + 184 * MiB;
constexpr size_t WS_END = WS_X + 186 * MiB;

constexpr int LDS_BYTES = 147456;

__device__ __forceinline__ float bf2f(unsigned v) { return __uint_as_float(v << 16); }
__device__ __forceinline__ unsigned pk2(float lo, float hi) { f32x2 v = {lo, hi}; bf16x2_t b = __builtin_convertvector(v, bf16x2_t); return __builtin_bit_cast(unsigned, b); }
__device__ __forceinline__ unsigned f2bf(float f) { return pk2(f, 0.f) & 0xffffu; }
__device__ __forceinline__ void unpack8(const u32x4 r, float* o) {
    o[0] = __uint_as_float(r.x << 16); o[1] = __uint_as_float(r.x & 0xffff0000u);
    o[2] = __uint_as_float(r.y << 16); o[3] = __uint_as_float(r.y & 0xffff0000u);
    o[4] = __uint_as_float(r.z << 16); o[5] = __uint_as_float(r.z & 0xffff0000u);
    o[6] = __uint_as_float(r.w << 16); o[7] = __uint_as_float(r.w & 0xffff0000u);
}
__device__ __forceinline__ u32x4 pack8(const float* v) { u32x4 o; o.x = pk2(v[0], v[1]); o.y = pk2(v[2], v[3]); o.z = pk2(v[4], v[5]); o.w = pk2(v[6], v[7]); return o; }
__device__ __forceinline__ float sigmoidf_(float x) { return 1.f / (1.f + expf(-x)); }
__device__ __forceinline__ float siluf_(float x) { return x / (1.f + expf(-x)); }
__device__ __forceinline__ float fsigmoid(float x) { return __builtin_amdgcn_rcpf(1.0f + __builtin_amdgcn_exp2f(-1.4426950408889634f * x)); }
__device__ __forceinline__ float fsilu(float x) { return x * fsigmoid(x); }
__device__ __forceinline__ float softplusf_(float x) { return fmaxf(x, 0.f) + log1pf(expf(-fabsf(x))); }
__device__ __forceinline__ float gelu_tanh(float x) { const float u = 0.7978845608028654f * (x + 0.044715f * x * x * x); return 0.5f * x * (1.f + tanhf(u)); }
__device__ __forceinline__ float dppf(float v, const int ctrl_sel) {
    int r;
    if (ctrl_sel == 0) r = __builtin_amdgcn_update_dpp(0, __float_as_int(v), 0xB1, 0xF, 0xF, true);
    else if (ctrl_sel == 1) r = __builtin_amdgcn_update_dpp(0, __float_as_int(v), 0x4E, 0xF, 0xF, true);
    else if (ctrl_sel == 2) r = __builtin_amdgcn_update_dpp(0, __float_as_int(v), 0x141, 0xF, 0xF, true);
    else r = __builtin_amdgcn_update_dpp(0, __float_as_int(v), 0x140, 0xF, 0xF, true);
    return __int_as_float(r);
}
__device__ __forceinline__ float rowsum16(float v) { v += dppf(v, 0); v += dppf(v, 1); v += dppf(v, 2); v += dppf(v, 3); return v; }
__device__ __forceinline__ float wave_sum(float v) {
#pragma unroll
    for (int o = 1; o < 64; o <<= 1) v += __shfl_xor(v, o);
    return v;
}
__device__ __forceinline__ float xhalf_max(float v) { auto rr = __builtin_amdgcn_permlane32_swap(__float_as_uint(v), __float_as_uint(v), false, false); return fmaxf(__uint_as_float(rr[0]), __uint_as_float(rr[1])); }
__device__ __forceinline__ float xhalf_sum(float v) { auto rr = __builtin_amdgcn_permlane32_swap(__float_as_uint(v), __float_as_uint(v), false, false); return __uint_as_float(rr[0]) + __uint_as_float(rr[1]); }
#define LDS_WAIT() asm volatile("s_waitcnt lgkmcnt(0)" ::: "memory")

namespace pg8 {
constexpr int BM = 256, BK = 64, HALF = 128, HTB = HALF * BK * 2, STAGE_BYTES = 8 * HTB, NXCD = 8, WGM = 8;
__host__ __device__ __forceinline__ int lds_byte(int r, int c) { const int st = (r >> 4) * 2 + (c >> 5), rr = r & 15, cc = c & 31, ob = rr * 64 + cc * 2; return st * 1024 + (ob ^ (((ob >> 9) & 1) << 5)); }
__host__ __device__ __forceinline__ void stage_rc(int b, int& R, int& C) { const int st = b / 1024, sb = b % 1024, swz = sb ^ (((sb >> 9) & 1) << 5); R = (st >> 1) * 16 + swz / 64; C = (st & 1) * 32 + (swz % 64) / 2; }
__host__ __device__ __forceinline__ int perm32(int rho) { const int n = rho >> 4, i = rho & 15; return 8 * (i >> 2) + 4 * n + (i & 3); }
struct Unit { int pm, pn, ks; };
struct Gemm { const bf16_t* A; const bf16_t* Bt; int M, N, K, lda, ldb, nks; };
struct StaticOrder {
    int nM, nN, nwg, G, c;
    int nks;
    __device__ void init(int M, int N, int G_, int c_, int nks_) { nM = M / BM; nN = N / BM; nwg = nM * nN; G = G_; c = c_; nks = nks_; }
    __device__ bool next(int i, Unit& u) const {
        const long L = (long)i * G + c; if (L >= (long)nwg * nks) return false;
        u.ks = (int)(L % nks); int wgid = (int)(L / nks); { const int q = nwg / NXCD, r = nwg % NXCD, xcd = wgid % NXCD, off = wgid / NXCD; wgid = (xcd < r ? xcd * (q + 1) : r * (q + 1) + (xcd - r) * q) + off; }
        const int nig = WGM * nN, gid = wgid / nig, fm = gid * WGM, gsz = (nM - fm) < WGM ? (nM - fm) : WGM;
        u.pm = fm + ((wgid % nig) % gsz); u.pn = (wgid % nig) / gsz; return true;
    }
};
struct EpiBf16 {
    static constexpr bool PERM = true;
    bf16_t* O; int ldc; int act; const float* gate; int bb_force; size_t ks_stride;
    __device__ __forceinline__ void operator()(const f32x4 (&acc)[2][2][4][2], const Unit& u, int wr, int wc, int fr, int fq) const {
        const int rt = u.pm * BM; const int bb = bb_force >= 0 ? bb_force : (rt >= ML ? 8 : (rt >> 12));
        const int row0 = rt + wr * 64 + fr; const int col0 = u.pn * BM + wc * 32 + 8 * fq;
        f32x4 gv[2][2];
#pragma unroll
        for (int bj = 0; bj < 2; ++bj)
#pragma unroll
            for (int n = 0; n < 2; ++n) gv[bj][n] = gate ? *(const f32x4*)(gate + bb * 6144 + col0 + bj * HALF + 4 * n) : (f32x4){1.f, 1.f, 1.f, 1.f};
#pragma unroll
        for (int ai = 0; ai < 2; ++ai)
#pragma unroll
            for (int m = 0; m < 4; ++m) { bf16_t* rowp = O + (size_t)u.ks * ks_stride + (size_t)(row0 + ai * HALF + m * 16) * ldc + col0;
#pragma unroll
                for (int bj = 0; bj < 2; ++bj) { f32x4 v0 = acc[ai][bj][m][0], v1 = acc[ai][bj][m][1];
                    if (act == 2) {
#pragma unroll
                        for (int e = 0; e < 4; ++e) { float a0 = fmaxf(v0[e], 0.f), a1 = fmaxf(v1[e], 0.f); v0[e] = a0 * a0; v1[e] = a1 * a1; } }
                    v0 = v0 * gv[bj][0]; v1 = v1 * gv[bj][1];
                    u32x4 w; w.x = pk2(v0[0], v0[1]); w.y = pk2(v0[2], v0[3]); w.z = pk2(v1[0], v1[1]); w.w = pk2(v1[2], v1[3]);
                    *(u32x4*)(rowp + bj * HALF) = w; } }
    }
};

template <class Epi>
__device__ __forceinline__ void gemm_phase(LAS unsigned char* lds, const Gemm g, const StaticOrder& S, const Epi& E, const int tid) {
    const int wid = __builtin_amdgcn_readfirstlane(tid >> 6), lane = tid & 63, wr = wid >> 2, wc = wid & 3, fr = lane & 15, fq = lane >> 4;
    const int K = g.K, nt = K / BK;
    unsigned voffA[2], voffB[2];
#pragma unroll
    for (int i = 0; i < 2; ++i) { int R, C; stage_rc(tid * 16 + i * 8192, R, C); const int Rb = Epi::PERM ? ((R & ~31) + perm32(R & 31)) : R;
        voffA[i] = (unsigned)(R * g.lda + C) * 2u; voffB[i] = (unsigned)(Rb * g.ldb + C) * 2u; }
    const size_t kstep = (size_t)(BK * 2);
    const size_t hA = (size_t)HALF * g.lda * 2, hB = (size_t)HALF * g.ldb * 2, kso = (size_t)K * 2;
    const size_t tA = 2 * hA, tB = 2 * hB;
    const unsigned ldsw = (unsigned)wid * 1024u;
    const int aoff = lds_byte(wr * 64 + fr, fq * 8), boff = lds_byte(wc * 32 + fr, fq * 8);
#define PG8_SA(b, h) (((b) * 2 + (h)) * HTB)
#define PG8_SB(b, h) ((4 + (b) * 2 + (h)) * HTB)
#define PG8_STAGE(bufoff, gbase, voff) do { _Pragma("unroll") for (int _i = 0; _i < 2; ++_i) \
        __builtin_amdgcn_global_load_lds((const unsigned*)((const char*)(gbase) + (voff)[_i]), (LAS unsigned*)(lds + (bufoff) + ldsw + _i * 8192), 16, 0, 0); } while (0)
#define PG8_LDA(dst, b, h) do { _Pragma("unroll") for (int m = 0; m < 4; ++m) _Pragma("unroll") for (int k = 0; k < 2; ++k) dst[m][k] = *(const LAS bf16x8*)(lds + PG8_SA(b, h) + aoff + m * 2048 + k * 1024); } while (0)
#define PG8_LDB(dst, b, h) do { _Pragma("unroll") for (int n = 0; n < 2; ++n) _Pragma("unroll") for (int k = 0; k < 2; ++k) dst[n][k] = *(const LAS bf16x8*)(lds + PG8_SB(b, h) + boff + n * 2048 + k * 1024); } while (0)
#define PG8_MMA(ai, bj, At, Bt) do { __builtin_amdgcn_s_setprio(1); _Pragma("unroll") for (int m = 0; m < 4; ++m) _Pragma("unroll") for (int n = 0; n < 2; ++n) _Pragma("unroll") for (int k = 0; k < 2; ++k) \
        acc[ai][bj][m][n] = __builtin_amdgcn_mfma_f32_16x16x32_bf16(Bt[n][k], At[m][k], acc[ai][bj][m][n], 0, 0, 0); __builtin_amdgcn_s_setprio(0); } while (0)
#define PG8_WAIT_V(n) asm volatile("s_waitcnt vmcnt(" #n ")" ::: "memory")
#define PG8_WAIT_L(n) asm volatile("s_waitcnt lgkmcnt(" #n ")" ::: "memory")
#define PG8_BAR __builtin_amdgcn_s_barrier()
#define PG8_SCHED __builtin_amdgcn_sched_barrier(0)
    Unit cur, nxt; int ui = 0;
    if (!S.next(0, cur)) return;
    f32x4 acc[2][2][4][2];
#pragma unroll
    for (int a = 0; a < 2; ++a)
#pragma unroll
        for (int b = 0; b < 2; ++b)
#pragma unroll
            for (int m = 0; m < 4; ++m)
#pragma unroll
                for (int n = 0; n < 2; ++n) acc[a][b][m][n] = (f32x4){0.f, 0.f, 0.f, 0.f};
    bf16x8 At[4][2], B0[2][2], B1[2][2];
    const char* cA = (const char*)g.A + (size_t)cur.pm * tA + cur.ks * kso; const char* cB = (const char*)g.Bt + (size_t)cur.pn * tB + cur.ks * kso;
    PG8_STAGE(PG8_SB(0, 0), cB, voffB); PG8_STAGE(PG8_SB(0, 1), cB + hB, voffB); PG8_STAGE(PG8_SA(0, 0), cA, voffA); PG8_STAGE(PG8_SA(0, 1), cA + hA, voffA);
    if (wr == 1) PG8_BAR;
    PG8_WAIT_V(2); PG8_BAR;
    PG8_STAGE(PG8_SB(1, 0), cB + kstep, voffB); PG8_STAGE(PG8_SA(1, 0), cA + kstep, voffA); PG8_STAGE(PG8_SB(1, 1), cB + hB + kstep, voffB);
    PG8_WAIT_V(6); PG8_BAR;
    for (;;) {
        const bool has_next = S.next(ui + 1, nxt);
        const char* nA = has_next ? (const char*)g.A + (size_t)nxt.pm * tA + nxt.ks * kso : cA; const char* nB = has_next ? (const char*)g.Bt + (size_t)nxt.pn * tB + nxt.ks * kso : cB;
        for (int t = 0; t < nt; t += 2) {
            const bool last = (t == nt - 2);
            const char* a1 = cA + (size_t)(t + 1) * kstep;
            const char* a2 = last ? nA : cA + (size_t)(t + 2) * kstep; const char* b2 = last ? nB : cB + (size_t)(t + 2) * kstep;
            const char* a3 = a2 + kstep; const char* b3 = b2 + kstep;
            PG8_LDB(B0, 0, 0); PG8_LDB(B1, 0, 1); PG8_SCHED; PG8_LDA(At, 0, 0); PG8_STAGE(PG8_SA(1, 1), a1 + hA, voffA);
            PG8_WAIT_V(8); PG8_WAIT_L(0); PG8_BAR; PG8_MMA(0, 0, At, B0); PG8_MMA(0, 1, At, B1); PG8_BAR; PG8_SCHED;
            PG8_LDA(At, 0, 1); PG8_STAGE(PG8_SB(0, 0), b2, voffB); PG8_STAGE(PG8_SB(0, 1), b2 + hB, voffB); PG8_STAGE(PG8_SA(0, 0), a2, voffA);
            PG8_WAIT_V(8); PG8_WAIT_L(0); PG8_BAR; PG8_MMA(1, 0, At, B0); PG8_MMA(1, 1, At, B1); PG8_BAR; PG8_SCHED;
            PG8_LDB(B0, 1, 0); PG8_LDB(B1, 1, 1); PG8_SCHED; PG8_LDA(At, 1, 0); PG8_STAGE(PG8_SA(0, 1), a2 + hA, voffA);
            PG8_WAIT_V(8); PG8_WAIT_L(0); PG8_BAR; PG8_MMA(0, 0, At, B0); PG8_MMA(0, 1, At, B1); PG8_BAR; PG8_SCHED;
            PG8_LDA(At, 1, 1); PG8_STAGE(PG8_SB(1, 0), b3, voffB); PG8_STAGE(PG8_SB(1, 1), b3 + hB, voffB); PG8_STAGE(PG8_SA(1, 0), a3, voffA);
            PG8_WAIT_V(8); PG8_WAIT_L(0); PG8_BAR; PG8_MMA(1, 0, At, B0); PG8_MMA(1, 1, At, B1); PG8_BAR; PG8_SCHED;
        }
        if (wr == 0) PG8_BAR;
        E(acc, cur, wr, wc, fr, fq);
        if (!has_next) break;
#pragma unroll
        for (int a = 0; a < 2; ++a)
#pragma unroll
            for (int b = 0; b < 2; ++b)
#pragma unroll
                for (int m = 0; m < 4; ++m)
#pragma unroll
                    for (int n = 0; n < 2; ++n) acc[a][b][m][n] = (f32x4){0.f, 0.f, 0.f, 0.f};
        cur = nxt; cA = nA; cB = nB; ++ui;
        if (wr == 1) PG8_BAR;
    }
    PG8_WAIT_V(0);
    PG8_BAR;
#undef PG8_SA
#undef PG8_SB
#undef PG8_STAGE
#undef PG8_LDA
#undef PG8_LDB
#undef PG8_MMA
#undef PG8_WAIT_V
#undef PG8_WAIT_L
#undef PG8_BAR
#undef PG8_SCHED
}
}

struct Args { const float* in[24]; float* out; unsigned char* ws; int ph_lo, ph_hi; };
typedef const __attribute__((address_space(4))) Args* KA;
enum { I_X = 0, I_C, I_CTX, I_CCTX, I_ADAW, I_ADAB, I_LNG, I_LNB, I_W1, I_W2, I_WOUT, I_EVWIN, I_EVQKVCONV, I_EVALOG, I_EVDTB, I_EVGDNNORM,
       I_LRUCW, I_LRUCB, I_LRUGW, I_LRUGB, I_LRULAM, I_ODWQKV, I_ODLAM, I_ODSUBLN };
enum { K_PROA = 0, K_PROB, K_PROJ, K_E2, K_E3, K_E4, K_O2, K_O3, K_WOUT, K_LN1, K_MLP1, K_MLP2, K_LN2, K_E2B };
constexpr int N_PHASES = 2 + 10 + 8 + 10 + 8;

__device__ __forceinline__ void transpose_item(const float* W, int K, int N, int Npad, bf16_t* WT, LAS float* scr, int item, int lane) {
    const int nblk = Npad / 32, kb = item / nblk, nb = item % nblk, k0 = 64 * kb, n0 = 32 * nb;
    const int n = n0 + (lane & 31);
    { float wv[32];
#pragma unroll
      for (int i = 0; i < 32; ++i) { const int kk = 2 * i + (lane >> 5); wv[i] = (n < N) ? W[(size_t)(k0 + kk) * N + n] : 0.f; }
#pragma unroll
      for (int i = 0; i < 32; ++i) { const int kk = 2 * i + (lane >> 5); scr[kk * 33 + (lane & 31)] = wv[i]; } }
    LDS_WAIT();
    const int c = lane & 7;
#pragma unroll
    for (int j = 0; j < 4; ++j) { const int nn = (lane >> 3) + 8 * j; const LAS float* s = scr + (8 * c) * 33 + nn;
        u32x4 o; o.x = pk2(s[0 * 33], s[1 * 33]); o.y = pk2(s[2 * 33], s[3 * 33]); o.z = pk2(s[4 * 33], s[5 * 33]); o.w = pk2(s[6 * 33], s[7 * 33]);
        *(u32x4*)(WT + (size_t)(n0 + nn) * K + k0 + 8 * c) = o; }
    LDS_WAIT();
}
__device__ __forceinline__ void conv_weights(KA a, int L, LAS unsigned char* lds, int gw, int NGW, int wave, int lane) {
    LAS float* scr = (LAS float*)(lds + wave * 16384);
    const bool even = (L & 1) == 0; const int j2 = L >> 1;
    const float* Wa = even ? a->in[I_EVWIN] + (size_t)j2 * D * EVN : a->in[I_ODWQKV] + (size_t)j2 * D * ODN;
    const int Na = even ? EVN : ODN, Nap = even ? EVNP : ODN;
    const int IA = (D / 64) * (Nap / 32), IO = (D / 64) * (D / 32), I1 = (D / 64) * (FF / 32), I2 = (FF / 64) * (D / 32);
    bf16_t* WA = (bf16_t*)(a->ws + WS_WA); bf16_t* WO = (bf16_t*)(a->ws + WS_WO); bf16_t* W1 = (bf16_t*)(a->ws + WS_W1); bf16_t* W2 = (bf16_t*)(a->ws + WS_W2);
    for (int it = gw; it < IA + IO + I1 + I2; it += NGW) {
        int r = it;
        if (r < IA) { transpose_item(Wa, D, Na, Nap, WA, scr, r, lane); continue; } r -= IA;
        if (r < IO) { transpose_item(a->in[I_WOUT] + (size_t)L * D * D, D, D, D, WO, scr, r, lane); continue; } r -= IO;
        if (r < I1) { transpose_item(a->in[I_W1] + (size_t)L * D * FF, D, FF, FF, W1, scr, r, lane); continue; } r -= I1;
        transpose_item(a->in[I_W2] + (size_t)L * FF * D, FF, D, D, W2, scr, r, lane);
    }
}

__device__ __forceinline__ void modulate_row_store(const f32x4 (&v)[4], const float* mod_bb, int sidx, bf16_t* urow, int lane) {
#pragma unroll
    for (int j = 0; j < 4; ++j) { const int c = 4 * (lane + 64 * j);
        const f32x4 sh = *(const f32x4*)(mod_bb + sidx * D + c), sc = *(const f32x4*)(mod_bb + (sidx + 1) * D + c);
        const f32x4 u = v[j] * (sc + 1.0f) + sh; u32x2 w; w.x = pk2(u[0], u[1]); w.y = pk2(u[2], u[3]); *(u32x2*)(urow + c) = w; }
}
__device__ __forceinline__ void prologue_b(KA a, int gw, int NGW, int lane) {
    const float* MOD = (const float*)(a->ws + WS_MOD); bf16_t* U = (bf16_t*)(a->ws + WS_U);
    for (int row = gw; row < MT; row += NGW) {
        const bool isctx = row >= ML; const int bb = isctx ? 8 : (row >> 12);
        const float* hp = isctx ? a->in[I_CTX] + (size_t)(row - ML) * D : a->in[I_X] + (size_t)row * D;
        f32x4 v[4];
#pragma unroll
        for (int j = 0; j < 4; ++j) v[j] = *(const f32x4*)(hp + 4 * (lane + 64 * j));
        modulate_row_store(v, MOD + (size_t)(0 * 9 + bb) * 6144, 0, U + (size_t)row * D, lane);
    }
}
__device__ __forceinline__ void ln_row_finish(f32x4 (&v)[4], float s, const float* lg, const float* lb, bf16_t* hp16, float* hp32, bool do_u, const float* mod_bb, int sidx, bf16_t* urow, int lane) {
    const float mean = wave_sum(s) * (1.f / D); float s2 = 0.f;
#pragma unroll
    for (int j = 0; j < 4; ++j) { v[j] = v[j] - mean; s2 += (v[j][0] * v[j][0] + v[j][1] * v[j][1]) + (v[j][2] * v[j][2] + v[j][3] * v[j][3]); }
    const float rstd = 1.0f / sqrtf(wave_sum(s2) * (1.f / D) + EPS);
#pragma unroll
    for (int j = 0; j < 4; ++j) { const int c = 4 * (lane + 64 * j); const f32x4 gg = *(const f32x4*)(lg + c), bbv = *(const f32x4*)(lb + c);
        v[j] = v[j] * rstd * gg + bbv;
        if (hp32) __builtin_nontemporal_store(v[j], (f32x4*)(hp32 + c));
        else { typedef _Float16 h4_t __attribute__((ext_vector_type(4))); const u32x2 w = __builtin_bit_cast(u32x2, __builtin_convertvector(v[j], h4_t)); __builtin_nontemporal_store(w, (u32x2*)(hp16 + c)); } }
    if (do_u) modulate_row_store(v, mod_bb, sidx, urow, lane);
}
typedef _Float16 h16x4 __attribute__((ext_vector_type(4)));
__device__ __forceinline__ f32x4 hf4(const u32x2 w) { return __builtin_convertvector(__builtin_bit_cast(h16x4, w), f32x4); }
__device__ __forceinline__ u32x2 f4h(const f32x4 v) { return __builtin_bit_cast(u32x2, __builtin_convertvector(v, h16x4)); }
__device__ __forceinline__ f32x4 bf4(const u32x2 w) { return (f32x4){__uint_as_float(w.x << 16), __uint_as_float(w.x & 0xffff0000u), __uint_as_float(w.y << 16), __uint_as_float(w.y & 0xffff0000u)}; }
__device__ __forceinline__ void ln_pass(KA a, int L, int which, int nrows, bool do_u, int Lm, int sidx, const bf16_t* T, int npart, int gw, int NGW, int lane) {
    const float* MOD = (const float*)(a->ws + WS_MOD); bf16_t* U = (bf16_t*)(a->ws + WS_U); bf16_t* HC = (bf16_t*)(a->ws + WS_HC);
    const float* lg = a->in[I_LNG] + (size_t)(L * 2 + which) * D; const float* lb = a->in[I_LNB] + (size_t)(L * 2 + which) * D;
    const bool first = (L == 0 && which == 0), fin = (L == 3 && which == 1);
    bf16_t* HL = (bf16_t*)((unsigned char*)a->out + (size_t)64 * MiB); bf16_t* HX = (bf16_t*)(a->ws + WS_HLAST);
    const bf16_t* hin16 = fin ? HX : HL;
    bf16_t* hout16 = (L == 3 && which == 0) ? HX : HL;
    const int nmain = npart > 0 ? ML : nrows;
    if (first) {
        f32x4 hv[4]; u32x2 tw[4];
#define LN_FETCH(HV, TW, row_) do { const int r_ = (row_); const float* hin_ = a->in[I_X] + (size_t)r_ * D; const bf16_t* tp_ = T + (size_t)r_ * D; \
        _Pragma("unroll") for (int j = 0; j < 4; ++j) { const int c = 4 * (lane + 64 * j); HV[j] = __builtin_nontemporal_load((const f32x4*)(hin_ + c)); TW[j] = __builtin_nontemporal_load((const u32x2*)(tp_ + c)); } } while (0)
        if (gw < nmain) LN_FETCH(hv, tw, gw);
#pragma unroll 2
        for (int row = gw; row < nmain; row += NGW) {
            f32x4 hn[4]; u32x2 tn[4]; const int nrow = row + NGW < nmain ? row + NGW : row;
            LN_FETCH(hn, tn, nrow);
            f32x4 v[4]; float s = 0.f;
#pragma unroll
            for (int j = 0; j < 4; ++j) { v[j] = hv[j] * ALPHA + bf4(tw[j]); s += (v[j][0] + v[j][1]) + (v[j][2] + v[j][3]); }
            ln_row_finish(v, s, lg, lb, hout16 + (size_t)row * D, nullptr, do_u, MOD + (size_t)(Lm * 9 + (row >> 12)) * 6144, sidx, U + (size_t)row * D, lane);
#pragma unroll
            for (int j = 0; j < 4; ++j) { hv[j] = hn[j]; tw[j] = tn[j]; }
        }
#undef LN_FETCH
    } else {
        u32x2 hv[4], tw[4];
#define LN_FETCH(HV, TW, row_) do { const int r_ = (row_); const bf16_t* hin_ = hin16 + (size_t)r_ * D; const bf16_t* tp_ = T + (size_t)r_ * D; \
        _Pragma("unroll") for (int j = 0; j < 4; ++j) { const int c = 4 * (lane + 64 * j); HV[j] = __builtin_nontemporal_load((const u32x2*)(hin_ + c)); TW[j] = __builtin_nontemporal_load((const u32x2*)(tp_ + c)); } } while (0)
        if (gw < nmain) LN_FETCH(hv, tw, gw);
#pragma unroll 2
        for (int row = gw; row < nmain; row += NGW) {
            u32x2 hn[4], tn[4]; const int nrow = row + NGW < nmain ? row + NGW : row;
            LN_FETCH(hn, tn, nrow);
            f32x4 v[4]; float s = 0.f;
#pragma unroll
            for (int j = 0; j < 4; ++j) { v[j] = hf4(hv[j]) * ALPHA + bf4(tw[j]); s += (v[j][0] + v[j][1]) + (v[j][2] + v[j][3]); }
            ln_row_finish(v, s, lg, lb, hout16 + (size_t)row * D, fin ? a->out + (size_t)row * D : nullptr, do_u, MOD + (size_t)(Lm * 9 + (row >> 12)) * 6144, sidx, U + (size_t)row * D, lane);
#pragma unroll
            for (int j = 0; j < 4; ++j) { hv[j] = hn[j]; tw[j] = tn[j]; }
        }
#undef LN_FETCH
    }
    if (npart > 0) {
        const bf16_t* PART = (const bf16_t*)(a->ws + WS_PART);
        for (int row = ML + gw; row < nrows; row += NGW) {
            const size_t rc = (size_t)(row - ML); bf16_t* hp = HC + rc * D;
            f32x4 v[4]; float s = 0.f;
#pragma unroll
            for (int j = 0; j < 4; ++j) { const int c = 4 * (lane + 64 * j); f32x4 tv = {0.f, 0.f, 0.f, 0.f};
                for (int ks = 0; ks < npart; ++ks) tv += bf4(*(const u32x2*)(PART + (size_t)ks * MC * D + rc * D + c));
                const f32x4 hh = first ? *(const f32x4*)(a->in[I_CTX] + rc * D + c) : hf4(*(const u32x2*)(hp + c));
                v[j] = hh * ALPHA + tv; s += (v[j][0] + v[j][1]) + (v[j][2] + v[j][3]); }
            ln_row_finish(v, s, lg, lb, hp, nullptr, do_u, MOD + (size_t)(Lm * 9 + 8) * 6144, sidx, U + (size_t)row * D, lane);
        }
    }
}

__device__ __forceinline__ void prologue_a(KA a, LAS unsigned char* lds, int bid, int G, int tid, int wave, int lane) {
    float* MOD = (float*)(a->ws + WS_MOD); float* MISC = (float*)(a->ws + WS_MISC);
    LAS float* sv = (LAS float*)lds;
    LAS float* red = (LAS float*)(lds + 9 * 1024 * 4);
    for (int i = tid; i < 9 * 1024; i += 512) { const int bb = i >> 10, k = i & 1023; const float v = bb < 8 ? a->in[I_C][bb * 1024 + k] : a->in[I_CCTX][k]; sv[i] = siluf_(v); }
    __syncthreads();
    for (int unit = bid; unit < 192; unit += G) {
        const int L = unit / 48, cb = unit % 48, col = tid & 127, kq = tid >> 7;
        const float* w = a->in[I_ADAW] + (size_t)L * D * 6144 + cb * 128 + col;
        float acc[9];
#pragma unroll
        for (int bb = 0; bb < 9; ++bb) acc[bb] = 0.f;
        for (int k0 = kq * 256; k0 < kq * 256 + 256; k0 += 16) { float wv[16];
#pragma unroll
            for (int i = 0; i < 16; ++i) wv[i] = w[(size_t)(k0 + i) * 6144];
#pragma unroll
            for (int i = 0; i < 16; ++i)
#pragma unroll
                for (int bb = 0; bb < 9; ++bb) acc[bb] += sv[bb * 1024 + k0 + i] * wv[i]; }
#pragma unroll
        for (int bb = 0; bb < 9; ++bb) red[(kq * 9 + bb) * 128 + col] = acc[bb];
        __syncthreads();
        for (int i = tid; i < 9 * 128; i += 512) { const int bb = i >> 7, cc = i & 127;
            float s = (red[(0 * 9 + bb) * 128 + cc] + red[(1 * 9 + bb) * 128 + cc]) + (red[(2 * 9 + bb) * 128 + cc] + red[(3 * 9 + bb) * 128 + cc]);
            s += a->in[I_ADAB][L * 6144 + cb * 128 + cc]; MOD[(size_t)(L * 9 + bb) * 6144 + cb * 128 + cc] = s; }
        __syncthreads();
    }
    if (bid == G - 1) {
        if (tid < 16) {
            double th = 1.0; for (int j = 0; j < tid; ++j) th *= 0.56234132519034908;
            const double t2 = th * th; double sn = th, term = th, cs = 1.0, tc = 1.0;
            for (int k = 1; k < 12; ++k) { tc *= -t2 / ((2.0 * k - 1.0) * (2.0 * k)); cs += tc; term *= -t2 / ((2.0 * k) * (2.0 * k + 1.0)); sn += term; }
            double c = 1.0, s = 0.0;
            for (int p = 0; p < 64; ++p) { MISC[64 + p * 16 + tid] = (float)c; MISC[1088 + p * 16 + tid] = (float)s; const double c2 = c * cs - s * sn, s2 = s * cs + c * sn; c = c2; s = s2; }
        }
        if (tid >= 64 && tid < 66) { const int j = tid - 64; const float* lv = a->in[I_ODLAM] + j * 256; float d0 = 0.f, d1 = 0.f;
            for (int i = 0; i < 64; ++i) { d0 += lv[i] * lv[64 + i]; d1 += lv[128 + i] * lv[192 + i]; }
            const float li = 0.8f - 0.6f * expf(-0.3f * (float)(2 * j + 1)); MISC[j] = expf(d0) - expf(d1) + li; MISC[2 + j] = li; }
    }
    __syncthreads();
    conv_weights(a, 0, lds, bid * 8 + wave, G * 8, wave, lane);
}

__device__ __forceinline__ void attn_prep(KA a, LAS unsigned char* lds, int bid, int G, int tid) {
    bf16_t* P = (bf16_t*)(a->ws + WS_P); bf16_t* VT = (bf16_t*)(a->ws + WS_V); const float* MISC = (const float*)(a->ws + WS_MISC);
    const float* tabc = MISC + 64; const float* tabs = MISC + 1088;
    constexpr int VP = 2064;
    for (int u = bid; u < 2 * NB * 68; u += G) {
        const bool vpart = u >= NB * 68; const int uu = vpart ? u - NB * 68 : u;
        const int b = uu / 68, tl = uu % 68; const bool isctx = tl < 4; const int t0 = isctx ? tl * 64 : (tl - 4) * 64;
        const int rowbase = isctx ? ML + b * CTXL + t0 : b * SEQ + t0; const int kv0 = isctx ? t0 : CTXL + t0;
        if (!vpart) {
#pragma unroll 1
            for (int half = 0; half < 2; ++half) {
                u32x4 r1[4], r2[4], r3[4], r4[4];
#pragma unroll
                for (int k = 0; k < 4; ++k) { const int it = tid + 512 * (4 * half + k); const int r = it >> 6, rem = it & 63, vec = rem >> 1, part = rem & 1;
                    const bf16_t* p = P + (size_t)(rowbase + r) * ODN + vec * 64 + part * 8;
                    r1[k] = *(const u32x4*)(p); r2[k] = *(const u32x4*)(p + 16); r3[k] = *(const u32x4*)(p + 32); r4[k] = *(const u32x4*)(p + 48); }
#pragma unroll
                for (int k = 0; k < 4; ++k) { const int it = tid + 512 * (4 * half + k); const int r = it >> 6, rem = it & 63, vec = rem >> 1, part = rem & 1; const bool isq = vec < 16;
                    if (isctx && !isq) continue;
                    bf16_t* p = P + (size_t)(rowbase + r) * ODN + vec * 64 + part * 8;
                    float t1[8], t2[8], t3[8], t4[8];
                    unpack8(r1[k], t1); unpack8(r2[k], t2); unpack8(r3[k], t3); unpack8(r4[k], t4);
                    const float sc = isq ? QSCALE : 1.0f;
                    if (!isctx) {
                        const int pos = t0 + r, rp = pos >> 6, cp = pos & 63;
#pragma unroll
                        for (int j = 0; j < 8; ++j) { const int jj = part * 8 + j;
                            const float cr = tabc[rp * 16 + jj], sr = tabs[rp * 16 + jj], cc = tabc[cp * 16 + jj], ss = tabs[cp * 16 + jj];
                            const float o1 = t1[j] * cr - t2[j] * sr, o2 = t2[j] * cr + t1[j] * sr, o3 = t3[j] * cc - t4[j] * ss, o4 = t4[j] * cc + t3[j] * ss;
                            t1[j] = o1 * sc; t2[j] = o2 * sc; t3[j] = o3 * sc; t4[j] = o4 * sc; }
                    } else {
#pragma unroll
                        for (int j = 0; j < 8; ++j) { t1[j] *= sc; t2[j] *= sc; t3[j] *= sc; t4[j] *= sc; }
                    }
                    *(u32x4*)(p) = pack8(t1); *(u32x4*)(p + 16) = pack8(t2); *(u32x4*)(p + 32) = pack8(t3); *(u32x4*)(p + 48) = pack8(t4);
                }
            }
        } else {
            { u32x4 rv[16];
#pragma unroll
              for (int k = 0; k < 16; ++k) { const int id = tid + 512 * k; rv[k] = *(const u32x4*)(P + (size_t)(rowbase + (id >> 7)) * ODN + 2048 + (id & 127) * 8); }
#pragma unroll
              for (int k = 0; k < 16; ++k) { const int id = tid + 512 * k; *(LAS u32x4*)(lds + (id >> 7) * VP + (id & 127) * 16) = rv[k]; } }
            __syncthreads();
#pragma unroll 4
            for (int k = 0; k < 16; ++k) { const int oc = tid + 512 * k; const int col = oc & 1023, c = oc >> 10;
                unsigned w[4];
#pragma unroll
                for (int j = 0; j < 4; ++j) { const unsigned lo = *(const LAS bf16_t*)(lds + (8 * c + 2 * j) * VP + col * 2), hi = *(const LAS bf16_t*)(lds + (8 * c + 2 * j + 1) * VP + col * 2); w[j] = lo | (hi << 16); }
                u32x4 o; o.x = w[0]; o.y = w[1]; o.z = w[2]; o.w = w[3];
                *(u32x4*)(VT + ((size_t)(b * 8 * 128 + col)) * NKV + kv0 + 8 * c) = o; }
            __syncthreads();
        }
    }
}

constexpr int AT_KB = 64 * 272, AT_VB = 128 * 144, AT_BUF = AT_KB + AT_VB, AT_OX = 0;
static_assert(3 * AT_BUF <= LDS_BYTES - 16 && 128 * 132 * 4 <= 3 * AT_BUF, "attention lds");
__device__ __forceinline__ void at_qk(const LAS unsigned char* Kb, const bf16x8 (&qf)[4], f32x16& s0, f32x16& s1, int m, int krow, int hi) {
#pragma unroll
    for (int r = 0; r < 16; ++r) { s0[r] = 0.f; s1[r] = 0.f; }
#pragma unroll
    for (int ks = 0; ks < 4; ++ks) {
        const bf16x8 a0 = *(const LAS bf16x8*)(Kb + krow * 272 + (m * 64 + ks * 16 + hi * 8) * 2);
        const bf16x8 a1 = *(const LAS bf16x8*)(Kb + (krow + 32) * 272 + (m * 64 + ks * 16 + hi * 8) * 2);
        s0 = __builtin_amdgcn_mfma_f32_32x32x16_bf16(a0, qf[ks], s0, 0, 0, 0);
        s1 = __builtin_amdgcn_mfma_f32_32x32x16_bf16(a1, qf[ks], s1, 0, 0, 0);
    }
}
template <bool HAS_NEXT>
__device__ __forceinline__ void at_step(const LAS unsigned char* Kn, const LAS unsigned char* Vc, const bf16x8 (&qf)[4], f32x16 (&o)[4], f32x16& s0, f32x16& s1, float& mrun, float& lsum, int m, int krow, int r32, int hi) {
    f32x16 n0, n1;
#pragma unroll
    for (int r = 0; r < 16; ++r) { n0[r] = 0.f; n1[r] = 0.f; }
    float ps = 0.f;
#pragma unroll
    for (int ks = 0; ks < 4; ++ks) {
        if (HAS_NEXT) {
            const bf16x8 a0 = *(const LAS bf16x8*)(Kn + krow * 272 + (m * 64 + ks * 16 + hi * 8) * 2);
            const bf16x8 a1 = *(const LAS bf16x8*)(Kn + (krow + 32) * 272 + (m * 64 + ks * 16 + hi * 8) * 2);
            n0 = __builtin_amdgcn_mfma_f32_32x32x16_bf16(a0, qf[ks], n0, 0, 0, 0);
            n1 = __builtin_amdgcn_mfma_f32_32x32x16_bf16(a1, qf[ks], n1, 0, 0, 0);
        }
#pragma unroll
        for (int r = 4 * ks; r < 4 * ks + 4; ++r) { s0[r] = __builtin_amdgcn_exp2f(s0[r] - mrun); s1[r] = __builtin_amdgcn_exp2f(s1[r] - mrun); ps += s0[r] + s1[r]; }
    }
    lsum += ps;
    bf16x8 pb[4];
    { u32x4 w;
      w.x = pk2(s0[0], s0[1]); w.y = pk2(s0[2], s0[3]); w.z = pk2(s0[4], s0[5]); w.w = pk2(s0[6], s0[7]); pb[0] = __builtin_bit_cast(bf16x8, w);
      w.x = pk2(s0[8], s0[9]); w.y = pk2(s0[10], s0[11]); w.z = pk2(s0[12], s0[13]); w.w = pk2(s0[14], s0[15]); pb[1] = __builtin_bit_cast(bf16x8, w);
      w.x = pk2(s1[0], s1[1]); w.y = pk2(s1[2], s1[3]); w.z = pk2(s1[4], s1[5]); w.w = pk2(s1[6], s1[7]); pb[2] = __builtin_bit_cast(bf16x8, w);
      w.x = pk2(s1[8], s1[9]); w.y = pk2(s1[10], s1[11]); w.z = pk2(s1[12], s1[13]); w.w = pk2(s1[14], s1[15]); pb[3] = __builtin_bit_cast(bf16x8, w); }
    float mx = -3.0e38f;
#pragma unroll
    for (int db = 0; db < 4; ++db) {
#pragma unroll
        for (int i = 0; i < 4; ++i) {
            const bf16x8 av = *(const LAS bf16x8*)(Vc + (32 * db + r32) * 144 + (16 * i + 8 * hi) * 2);
            o[db] = __builtin_amdgcn_mfma_f32_32x32x16_bf16(av, pb[i], o[db], 0, 0, 0);
        }
        if (HAS_NEXT) {
#pragma unroll
            for (int r = 4 * db; r < 4 * db + 4; ++r) mx = fmaxf(mx, fmaxf(n0[r], n1[r]));
        }
    }
    if (HAS_NEXT) {
        mx = xhalf_max(mx);
        const float mnew = (mx > mrun + 8.0f) ? mx : mrun;
        if (__any(mnew > mrun)) {
            const float al = __builtin_amdgcn_exp2f(mrun - mnew); lsum *= al;
#pragma unroll
            for (int db = 0; db < 4; ++db)
#pragma unroll
                for (int r = 0; r < 16; ++r) o[db][r] *= al;
            mrun = mnew;
        }
        s0 = n0; s1 = n1;
    }
}
__device__ __forceinline__ void attn_phase(KA a, int L, LAS unsigned char* lds, int bid, int G, int tid, int wave, int lane, bool do_store) {
    bf16_t* P = (bf16_t*)(a->ws + WS_P); const bf16_t* VT = (const bf16_t*)(a->ws + WS_V); const float* MISC = (const float*)(a->ws + WS_MISC);
    const int j2 = L >> 1; const float lam = MISC[j2], lam_init = MISC[2 + j2];
    const float* subln = a->in[I_ODSUBLN] + j2 * 128;
    const int nunits = 2048 + (L == 1 ? 128 : 0);
    const int m = wave & 1, qs = wave >> 1, r32 = lane & 31, hi = lane >> 5;
    const int krow = (r32 & 0x13) | ((r32 & 4) << 1) | ((r32 & 8) >> 1);
    for (int u = bid; u < nunits; u += G) {
        int bh, qb; const bool isctx = u >= 2048;
        if (!isctx) { bh = (u >> 8) * 8 + (u & 7); qb = (u >> 3) & 31; } else { const int u2 = u - 2048; bh = u2 >> 1; qb = u2 & 1; }
        const int b = bh >> 3, h = bh & 7;
        const int qrow = (isctx ? ML + b * CTXL : b * SEQ) + qb * 128 + qs * 32 + r32;
        const int ntiles = isctx ? 4 : 68;
        bf16x8 qf[4];
#pragma unroll
        for (int ks = 0; ks < 4; ++ks) qf[ks] = *(const bf16x8*)(P + (size_t)qrow * ODN + h * 128 + m * 64 + ks * 16 + hi * 8);
        const int kr0 = tid >> 4, kc = tid & 15;
        const int vd0 = tid >> 3, vc = tid & 7;
        const bf16_t* vsrc0 = VT + ((size_t)(bh * 128 + vd0)) * NKV + 8 * vc; const bf16_t* vsrc1 = vsrc0 + (size_t)64 * NKV;
        u32x4 rk0, rk1, rv0, rv1;
#define AT_LOAD(t) do { const int kv_ = 64 * (t) + kr0; const int g0_ = kv_ < CTXL ? ML + b * CTXL + kv_ : b * SEQ + kv_ - CTXL; const int kv1_ = kv_ + 32; const int g1_ = kv1_ < CTXL ? ML + b * CTXL + kv1_ : b * SEQ + kv1_ - CTXL; \
        rk0 = *(const u32x4*)(P + (size_t)g0_ * ODN + 1024 + h * 128 + kc * 8); rk1 = *(const u32x4*)(P + (size_t)g1_ * ODN + 1024 + h * 128 + kc * 8); \
        rv0 = *(const u32x4*)(vsrc0 + 64 * (t)); rv1 = *(const u32x4*)(vsrc1 + 64 * (t)); } while (0)
#define AT_STORE(boff) do { LAS unsigned char* kb_ = lds + (boff); LAS unsigned char* vb_ = kb_ + AT_KB; \
        *(LAS u32x4*)(kb_ + kr0 * 272 + kc * 16) = rk0; *(LAS u32x4*)(kb_ + (kr0 + 32) * 272 + kc * 16) = rk1; \
        *(LAS u32x4*)(vb_ + vd0 * 144 + vc * 16) = rv0; *(LAS u32x4*)(vb_ + (vd0 + 64) * 144 + vc * 16) = rv1; } while (0)
        { AT_LOAD(0); const u32x4 k0_ = rk0, k1_ = rk1, v0_ = rv0, v1_ = rv1;
          AT_LOAD(1);
          { LAS unsigned char* kb_ = lds; LAS unsigned char* vb_ = kb_ + AT_KB;
            *(LAS u32x4*)(kb_ + kr0 * 272 + kc * 16) = k0_; *(LAS u32x4*)(kb_ + (kr0 + 32) * 272 + kc * 16) = k1_;
            *(LAS u32x4*)(vb_ + vd0 * 144 + vc * 16) = v0_; *(LAS u32x4*)(vb_ + (vd0 + 64) * 144 + vc * 16) = v1_; }
          AT_STORE(AT_BUF); }
        __syncthreads();
        f32x16 o[4];
#pragma unroll
        for (int db = 0; db < 4; ++db)
#pragma unroll
            for (int r = 0; r < 16; ++r) o[db][r] = 0.f;
        f32x16 s0, s1;
        at_qk(lds, qf, s0, s1, m, krow, hi);
        float mrun, lsum = 0.f;
        { float mx = fmaxf(s0[0], s1[0]);
#pragma unroll
          for (int r = 1; r < 16; ++r) mx = fmaxf(mx, fmaxf(s0[r], s1[r]));
          mrun = xhalf_max(mx); }
        int bc = 0, bn = AT_BUF, bs = 2 * AT_BUF;
        for (int t = 0; t + 1 < ntiles; ++t) {
            const bool stage = t + 2 < ntiles;
            if (stage) AT_LOAD(t + 2);
            at_step<true>(lds + bn, lds + bc + AT_KB, qf, o, s0, s1, mrun, lsum, m, krow, r32, hi);
            if (stage) AT_STORE(bs);
            __syncthreads();
            const int tmp = bc; bc = bn; bn = bs; bs = tmp;
        }
        at_step<false>(lds, lds + bc + AT_KB, qf, o, s0, s1, mrun, lsum, m, krow, r32, hi);
        __syncthreads();
#undef AT_LOAD
#undef AT_STORE
        lsum = xhalf_sum(lsum);
        const float inv = 1.0f / lsum;
        LAS float* ox = (LAS float*)(lds + AT_OX) + (qs * 32 + r32) * 132;
        if (m == 1) {
#pragma unroll
            for (int db = 0; db < 4; ++db)
#pragma unroll
                for (int r4 = 0; r4 < 4; ++r4) { f32x4 v = {o[db][4 * r4] * inv, o[db][4 * r4 + 1] * inv, o[db][4 * r4 + 2] * inv, o[db][4 * r4 + 3] * inv};
                    *(LAS f32x4*)(ox + 32 * db + 8 * r4 + 4 * hi) = v; }
        }
        __syncthreads();
        if (m == 0) {
            float ssq = 0.f;
#pragma unroll
            for (int db = 0; db < 4; ++db)
#pragma unroll
                for (int r4 = 0; r4 < 4; ++r4) { const f32x4 v1 = *(const LAS f32x4*)(ox + 32 * db + 8 * r4 + 4 * hi);
#pragma unroll
                    for (int e = 0; e < 4; ++e) { const float v = o[db][4 * r4 + e] * inv - lam * v1[e]; o[db][4 * r4 + e] = v; ssq += v * v; } }
            ssq = xhalf_sum(ssq);
            const float sc = (1.0f / sqrtf(ssq * (1.f / 128.f) + EPS)) * (1.0f - lam_init);
            bf16_t* op = P + (size_t)qrow * ODN + h * 128;
#pragma unroll
            for (int db = 0; db < 4; ++db)
#pragma unroll
                for (int r4 = 0; r4 < 4; ++r4) { const int dv = 32 * db + 8 * r4 + 4 * hi; const f32x4 g4 = *(const f32x4*)(subln + dv);
                    u32x2 w; w.x = pk2(o[db][4 * r4] * sc * g4[0], o[db][4 * r4 + 1] * sc * g4[1]); w.y = pk2(o[db][4 * r4 + 2] * sc * g4[2], o[db][4 * r4 + 3] * sc * g4[3]);
                    if (do_store) *(u32x2*)(op + dv) = w; }
        }
        __syncthreads();
    }
}

__device__ __forceinline__ void gdn_prep(KA a, int L, LAS unsigned char* lds, int gw, int NGW, int tid, int lane) {
    const int j2 = L >> 1;
    const bf16_t* P = (const bf16_t*)(a->ws + WS_P);
    bf16_t* QN = (bf16_t*)(a->ws + WS_U); bf16_t* KN = QN + (size_t)MT * 512; bf16_t* V = (bf16_t*)(a->ws + WS_V);
    float* Gb = (float*)(a->ws + WS_G); float* Bt = (float*)(a->ws + WS_BT);
    const float* cw = a->in[I_EVQKVCONV] + (size_t)j2 * 4 * 1536;
    LAS float* cwl = (LAS float*)lds;
    for (int i = tid; i < 4 * 1536 / 4; i += 512) *(LAS f32x4*)(cwl + 4 * i) = *(const f32x4*)(cw + 4 * i);
    __syncthreads();
    float alog = 0.f, dtb = 0.f;
    if (lane < 8) { alog = -expf(a->in[I_EVALOG][j2 * 8 + lane]); dtb = a->in[I_EVDTB][j2 * 8 + lane]; }
    for (int blk = gw; blk < MT / 17; blk += NGW) {
        const int r0 = 17 * blk;
        u32x4 R[20][3]; unsigned ab[17];
#define GP_LOAD(k_) do { const int row_ = r0 - 2 + (k_); const bool ok_ = row_ >= 0 && row_ < MT; \
        _Pragma("unroll") for (int p = 0; p < 3; ++p) R[k_][p] = ok_ ? *(const u32x4*)(P + (size_t)row_ * EVNP + p * 512 + 8 * lane) : (u32x4){0u, 0u, 0u, 0u}; } while (0)
#pragma unroll
        for (int k = 0; k < 6; ++k) GP_LOAD(k);
#pragma unroll
        for (int i = 0; i < 17; ++i) ab[i] = lane < 16 ? (unsigned)P[(size_t)(r0 + i) * EVNP + 2048 + lane] : 0u;
#pragma unroll
        for (int i = 0; i < 17; ++i) {
            if (i + 6 < 20) GP_LOAD(i + 6);
            const int row = r0 + i;
            const bool isctx = row >= ML; const int t = isctx ? ((row - ML) & (CTXL - 1)) : (row & (SEQ - 1)); const int len = isctx ? CTXL : SEQ;
            float val[3][8];
#pragma unroll
            for (int p = 0; p < 3; ++p) {
                float acc[8];
#pragma unroll
                for (int e = 0; e < 8; ++e) acc[e] = 0.f;
#pragma unroll
                for (int j = 0; j < 4; ++j) { const int tt = t + j - 2;
                    if (tt >= 0 && tt < len) { float x[8]; unpack8(R[i + j][p], x);
                        const f32x4 w0 = *(const LAS f32x4*)(cwl + j * 1536 + p * 512 + 8 * lane), w1 = *(const LAS f32x4*)(cwl + j * 1536 + p * 512 + 8 * lane + 4);
#pragma unroll
                        for (int e = 0; e < 8; ++e) acc[e] += (e < 4 ? w0[e & 3] : w1[e & 3]) * x[e]; } }
#pragma unroll
                for (int e = 0; e < 8; ++e) val[p][e] = fsilu(acc[e]);
            }
            float sq = 0.f, sk = 0.f;
#pragma unroll
            for (int e = 0; e < 8; ++e) { sq += val[0][e] * val[0][e]; sk += val[1][e] * val[1][e]; }
            sq = rowsum16(sq); sk = rowsum16(sk);
            const float rq = (1.0f / sqrtf(sq + EPS)) * 0.08838834764831845f, rk = 1.0f / sqrtf(sk + EPS);
#pragma unroll
            for (int e = 0; e < 8; ++e) { val[0][e] *= rq; val[1][e] *= rk; }
            *(u32x4*)(QN + (size_t)row * 512 + 8 * lane) = pack8(val[0]);
            *(u32x4*)(KN + (size_t)row * 512 + 8 * lane) = pack8(val[1]);
            *(u32x4*)(V + (size_t)row * 512 + 8 * lane) = pack8(val[2]);
            if (lane < 8) Gb[(size_t)row * 8 + lane] = alog * softplusf_(bf2f(ab[i]) + dtb);
            else if (lane < 16) Bt[(size_t)row * 8 + lane - 8] = sigmoidf_(bf2f(ab[i]));
        }
#undef GP_LOAD
    }
    __syncthreads();
}

constexpr int LR_XIN = 0, LR_XC = 17152, LR_XCB = LR_XC + 16384, LR_AU = LR_XCB + 9216, LR_WT = LR_AU + 65536, LR_END = LR_WT + 36864;
static_assert(LR_END <= LDS_BYTES, "lru lds");
template <int PASS>
__device__ __forceinline__ void lru_units(KA a, int L, LAS unsigned char* lds, int bid, int G, int tid) {
    const int j2 = L >> 1;
    const bf16_t* P = (const bf16_t*)(a->ws + WS_P); bf16_t* U = (bf16_t*)(a->ws + WS_U);
    float* TOTA = (float*)(a->ws + WS_TOTA); float* TOTH = (float*)(a->ws + WS_TOTH); const float* CARRY = (const float*)(a->ws + WS_CARRY);
    const float* cw = a->in[I_LRUCW] + (size_t)j2 * 4 * 512; const float* cb = a->in[I_LRUCB] + (size_t)j2 * 512;
    const float* gw_ = a->in[I_LRUGW] + (size_t)j2 * 2 * 2 * 8 * 64 * 64; const float* gb_ = a->in[I_LRUGB] + (size_t)j2 * 2 * 2 * 512; const float* lam_ = a->in[I_LRULAM] + (size_t)j2 * 2 * 512;
    LAS float* xin = (LAS float*)(lds + LR_XIN);
    LAS float* xc = (LAS float*)(lds + LR_XC);
    LAS bf16_t* xcb = (LAS bf16_t*)(lds + LR_XCB);
    LAS float* au = (LAS float*)(lds + LR_AU);
    LAS bf16_t* wt = (LAS bf16_t*)(lds + LR_WT);
    LAS float* sg = (LAS float*)(lds + LR_XIN);
    const int lane = tid & 63, w = tid >> 6, mt = w & 3, nh = w >> 2, fr = lane & 15, fq = lane >> 4;
    int cur_nblk = -1;
    const int cc = tid & 63;
    float cbv = 0.f, cwv[4] = {0.f, 0.f, 0.f, 0.f};
    float gbr[2][2], gbi[2][2], gsp[2][2];
#pragma unroll
    for (int q = 0; q < 2; ++q)
#pragma unroll
        for (int r = 0; r < 2; ++r) { gbr[q][r] = 0.f; gbi[q][r] = 0.f; gsp[q][r] = 0.f; }
    const int rrA = tid >> 3, c8 = (tid & 7) * 8, rrB = 64 + (tid >> 3);
    u32x4 xa = {0u, 0u, 0u, 0u}, xb = {0u, 0u, 0u, 0u}, gt4 = {0u, 0u, 0u, 0u};
#define LR_FETCH(XA, XB, GT, u_) do { const int nb_ = (u_) & 7, cs_ = (u_) >> 3, b_ = cs_ / 68, sl_ = cs_ % 68; const bool ic_ = sl_ < 4; const int t0_ = ic_ ? sl_ * 64 : (sl_ - 4) * 64; \
        const int len_ = ic_ ? CTXL : SEQ; const int rb_ = ic_ ? ML + b_ * CTXL : b_ * SEQ; const int ta_ = t0_ + rrA - 2, tb_ = t0_ + rrB - 2; \
        XA = (u32x4){0u, 0u, 0u, 0u}; XB = (u32x4){0u, 0u, 0u, 0u}; \
        if (ta_ >= 0 && ta_ < len_) XA = *(const u32x4*)(P + (size_t)(rb_ + ta_) * EVNP + 2064 + nb_ * 64 + c8); \
        if (tid < 24 && tb_ < len_) XB = *(const u32x4*)(P + (size_t)(rb_ + tb_) * EVNP + 2064 + nb_ * 64 + c8); \
        if (PASS == 2) GT = *(const u32x4*)(P + (size_t)(rb_ + t0_ + rrA) * EVNP + 2576 + nb_ * 64 + c8); } while (0)
    if (bid < NB * 68 * 8) LR_FETCH(xa, xb, gt4, bid);
    for (int u = bid; u < NB * 68 * 8; u += G) {
        const int nblk = u & 7, cs = u >> 3, b = cs / 68, slot = cs % 68; const bool isctx = slot < 4; const int t0 = isctx ? slot * 64 : (slot - 4) * 64;
        const int rowbase = isctx ? ML + b * CTXL : b * SEQ;
        u32x4 nxa, nxb, ngt = {0u, 0u, 0u, 0u};
        { const int un = u + G < NB * 68 * 8 ? u + G : u; LR_FETCH(nxa, nxb, ngt, un); }
        if (nblk != cur_nblk) {
            for (int i0 = tid; i0 < 4 * 4096; i0 += 512 * 8) { float wv[8];
#pragma unroll
                for (int k = 0; k < 8; ++k) { const int i = i0 + 512 * k; wv[k] = gw_[((size_t)((i >> 12) * 8 + nblk)) * 4096 + (i & 4095)]; }
#pragma unroll
                for (int k = 0; k < 8; ++k) { const int i = i0 + 512 * k; const int dg = i >> 12, c = (i >> 6) & 63, d = i & 63; wt[(dg * 64 + d) * 72 + c] = (bf16_t)f2bf(wv[k]); } }
            cbv = cb[nblk * 64 + cc];
#pragma unroll
            for (int dir = 0; dir < 2; ++dir)
#pragma unroll
                for (int nt = 0; nt < 2; ++nt) { const int ch = nblk * 64 + 32 * nh + 16 * nt + fr;
                    gbr[dir][nt] = gb_[(dir * 2 + 0) * 512 + ch]; gbi[dir][nt] = gb_[(dir * 2 + 1) * 512 + ch]; gsp[dir][nt] = softplusf_(-lam_[dir * 512 + ch]); }
#pragma unroll
            for (int j = 0; j < 4; ++j) cwv[j] = cw[j * 512 + nblk * 64 + cc];
            cur_nblk = nblk;
        }
        { float f[8]; unpack8(xa, f); *(LAS f32x4*)(xin + rrA * 64 + c8) = (f32x4){f[0], f[1], f[2], f[3]}; *(LAS f32x4*)(xin + rrA * 64 + c8 + 4) = (f32x4){f[4], f[5], f[6], f[7]};
          if (tid < 24) { unpack8(xb, f); *(LAS f32x4*)(xin + rrB * 64 + c8) = (f32x4){f[0], f[1], f[2], f[3]}; *(LAS f32x4*)(xin + rrB * 64 + c8 + 4) = (f32x4){f[4], f[5], f[6], f[7]}; } }
        __syncthreads();
#pragma unroll
        for (int k = 0; k < 8; ++k) { const int t = (tid >> 6) + 8 * k;
            float v = cbv;
#pragma unroll
            for (int j = 0; j < 4; ++j) v += cwv[j] * xin[(t + j) * 64 + cc];
            xc[t * 64 + cc] = v; xcb[t * 72 + cc] = (bf16_t)f2bf(v); }
        __syncthreads();
        {
            f32x4 acc[4][2];
#pragma unroll
            for (int dg = 0; dg < 4; ++dg)
#pragma unroll
                for (int nt = 0; nt < 2; ++nt) acc[dg][nt] = (f32x4){0.f, 0.f, 0.f, 0.f};
            bf16x8 af[2];
#pragma unroll
            for (int ks = 0; ks < 2; ++ks) af[ks] = *(const LAS bf16x8*)(xcb + (16 * mt + fr) * 72 + 32 * ks + 8 * fq);
#pragma unroll
            for (int dg = 0; dg < 4; ++dg)
#pragma unroll
                for (int nt = 0; nt < 2; ++nt)
#pragma unroll
                    for (int ks = 0; ks < 2; ++ks) { const bf16x8 bfm = *(const LAS bf16x8*)(wt + (dg * 64 + 32 * nh + 16 * nt + fr) * 72 + 32 * ks + 8 * fq);
                        acc[dg][nt] = __builtin_amdgcn_mfma_f32_16x16x32_bf16(af[ks], bfm, acc[dg][nt], 0, 0, 0); }
#pragma unroll
            for (int dir = 0; dir < 2; ++dir)
#pragma unroll
                for (int nt = 0; nt < 2; ++nt) { const int d = 32 * nh + 16 * nt + fr, ch = nblk * 64 + d;
                    const float br = gbr[dir][nt], bi = gbi[dir][nt], sp = gsp[dir][nt];
#pragma unroll
                    for (int r = 0; r < 4; ++r) { const int t = 16 * mt + 4 * fq + r;
                        const float rr = fsigmoid(acc[dir * 2 + 0][nt][r] + br), ii = fsigmoid(acc[dir * 2 + 1][nt][r] + bi);
                        const float la = -8.0f * 1.4426950408889634f * rr * sp; const float av = __builtin_amdgcn_exp2f(la);
                        const float uv = __builtin_amdgcn_sqrtf(fmaxf(1.0f - av * av, 0.f)) * (ii * xc[t * 64 + d]);
                        au[((dir * 2 + 0) * 64 + t) * 64 + d] = av; au[((dir * 2 + 1) * 64 + t) * 64 + d] = uv; } }
        }
        __syncthreads();
        {
            const int seg = tid >> 7, dir = (tid >> 6) & 1, c = tid & 63, ch = nblk * 64 + c;
            const LAS float* ap = au + ((dir * 2 + 0) * 64) * 64 + c; LAS float* up = au + ((dir * 2 + 1) * 64) * 64 + c;
            float A = 1.f, H = 0.f;
#pragma unroll 4
            for (int s = seg * 16; s < seg * 16 + 16; ++s) { const int t = dir ? 63 - s : s; const float av = ap[t * 64], uv = up[t * 64]; H = av * H + uv; A *= av; }
            sg[((0 * 4 + seg) * 2 + dir) * 64 + c] = A; sg[((1 * 4 + seg) * 2 + dir) * 64 + c] = H;
            __syncthreads();
            const size_t idx = ((size_t)((b * 2 + dir) * 68 + slot)) * 512 + ch;
            if (PASS == 1) {
                if (seg == 0) { float At = 1.f, Ht = 0.f;
#pragma unroll
                    for (int q = 0; q < 4; ++q) { const float Aq = sg[((0 * 4 + q) * 2 + dir) * 64 + c], Hq = sg[((1 * 4 + q) * 2 + dir) * 64 + c]; Ht = Aq * Ht + Hq; At *= Aq; }
                    TOTA[idx] = At; TOTH[idx] = Ht; }
            } else {
                float Hin = CARRY[idx];
                for (int q = 0; q < seg; ++q) { const float Aq = sg[((0 * 4 + q) * 2 + dir) * 64 + c], Hq = sg[((1 * 4 + q) * 2 + dir) * 64 + c]; Hin = Aq * Hin + Hq; }
#pragma unroll 4
                for (int s = seg * 16; s < seg * 16 + 16; ++s) { const int t = dir ? 63 - s : s; const float av = ap[t * 64], uv = up[t * 64]; Hin = av * Hin + uv; up[t * 64] = Hin; }
            }
        }
        __syncthreads();
        if (PASS == 2) {
            { const int t = rrA; float gt[8], y[8]; unpack8(gt4, gt);
              const LAS float* hf = au + ((0 * 2 + 1) * 64 + t) * 64 + c8; const LAS float* hb = au + ((1 * 2 + 1) * 64 + t) * 64 + c8;
              const f32x4 f0 = *(const LAS f32x4*)(hf), f1 = *(const LAS f32x4*)(hf + 4), b0 = *(const LAS f32x4*)(hb), b1 = *(const LAS f32x4*)(hb + 4);
#pragma unroll
              for (int e = 0; e < 8; ++e) { const float hs = (e < 4 ? f0[e & 3] + b0[e & 3] : f1[e & 3] + b1[e & 3]); const float g = gt[e];
                  y[e] = hs * g * fsigmoid(1.5957691216057308f * (g + 0.044715f * g * g * g)); }
              *(u32x4*)(U + (size_t)(rowbase + t0 + t) * D + 512 + nblk * 64 + c8) = pack8(y); }
            __syncthreads();
        }
        xa = nxa; xb = nxb; gt4 = ngt;
    }
#undef LR_FETCH
}

constexpr int GS_NS = 32, GS_K = 0, GS_Q = 16384, GS_V = 32768, GS_EG = 36864, GS_BTO = 36992, GS_BUF = 37120;
__device__ __forceinline__ void gdn_scan(KA a, LAS unsigned char* lds, int bid, int G, int tid, int wave, int lane) {
    const bf16_t* QN = (const bf16_t*)(a->ws + WS_U); const bf16_t* KN = QN + (size_t)MT * 512; const bf16_t* V = (const bf16_t*)(a->ws + WS_V);
    const float* Gb = (const float*)(a->ws + WS_G); const float* Bt = (const float*)(a->ws + WS_BT);
    for (int u = bid; u < 256; u += G) {
        const int chain = u >> 2, qd = u & 3, b = chain >> 3, h = (chain >> 1) & 3, dir = chain & 1;
        bf16_t* OD = (bf16_t*)(a->ws + (dir ? WS_OB : WS_OF));
        const int kg = lane & 7, cl = (wave & 3) * 8 + (lane >> 3), col = h * 128 + qd * 32 + cl;
        f32x2 S[8];
#pragma unroll
        for (int i = 0; i < 8; ++i) S[i] = (f32x2){0.f, 0.f};
#define GS_ROW(s) ((s) < CTXL ? (ML + b * CTXL + (dir ? CTXL - 1 - (s) : (s))) : (b * SEQ + (dir ? SEQ - 1 - ((s) - CTXL) : ((s) - CTXL))))
        const int lsl = tid >> 4, lc = tid & 15;
        u32x4 rk, rq, rv; float rg = 0.f;
#define GS_LOAD(blk) do { const int s_ = (blk) * GS_NS + lsl; const size_t row_ = (size_t)GS_ROW(s_); \
        rk = *(const u32x4*)(KN + row_ * 512 + h * 128 + lc * 8); rq = *(const u32x4*)(QN + row_ * 512 + h * 128 + lc * 8); \
        if (tid < 128) { const int s2_ = (blk) * GS_NS + (tid >> 2); const size_t r2_ = (size_t)GS_ROW(s2_); rv = *(const u32x4*)(V + r2_ * 512 + h * 128 + qd * 32 + (tid & 3) * 8); } \
        else if (tid < 160) { const int s2_ = (blk) * GS_NS + (tid - 128); rg = expf(Gb[(size_t)GS_ROW(s2_) * 8 + dir * 4 + h]); } \
        else if (tid < 192) { const int s2_ = (blk) * GS_NS + (tid - 160); rg = Bt[(size_t)GS_ROW(s2_) * 8 + dir * 4 + h]; } } while (0)
#define GS_ST8(dst, r) do { float f_[8]; unpack8(r, f_); *(LAS f32x4*)(dst) = (f32x4){f_[0], f_[1], f_[2], f_[3]}; *(LAS f32x4*)((dst) + 16) = (f32x4){f_[4], f_[5], f_[6], f_[7]}; } while (0)
#define GS_STORE(buf) do { LAS unsigned char* p_ = lds + (buf) * GS_BUF; \
        GS_ST8(p_ + GS_K + lsl * 512 + lc * 32, rk); GS_ST8(p_ + GS_Q + lsl * 512 + lc * 32, rq); \
        if (tid < 128) GS_ST8(p_ + GS_V + (tid >> 2) * 128 + (tid & 3) * 32, rv); \
        else if (tid < 160) *(LAS float*)(p_ + GS_EG + (tid - 128) * 4) = rg; \
        else if (tid < 192) *(LAS float*)(p_ + GS_BTO + (tid - 160) * 4) = rg; } while (0)
        GS_LOAD(0); GS_STORE(0);
        __syncthreads();
        constexpr int NBLK = NKV / GS_NS;
        for (int blk = 0; blk < NBLK; ++blk) {
            const bool more = blk + 1 < NBLK;
            if (more) GS_LOAD(blk + 1);
            const LAS unsigned char* p = lds + (blk & 1) * GS_BUF;
            if (wave < 4) {
              f32x4 k4[4], q4[4]; float vv, eg, bt;
#define GS_FETCH(K4, Q4, VV, EG, BT, sl_) do { _Pragma("unroll") for (int i = 0; i < 4; ++i) { K4[i] = *(const LAS f32x4*)(p + GS_K + (sl_) * 512 + kg * 64 + i * 16); Q4[i] = *(const LAS f32x4*)(p + GS_Q + (sl_) * 512 + kg * 64 + i * 16); } \
                VV = *(const LAS float*)(p + GS_V + (sl_) * 128 + cl * 4); EG = *(const LAS float*)(p + GS_EG + (sl_) * 4); BT = *(const LAS float*)(p + GS_BTO + (sl_) * 4); } while (0)
              GS_FETCH(k4, q4, vv, eg, bt, 0);
              bf16_t* odp = OD + (size_t)GS_ROW(blk * GS_NS) * 512 + col; const int ostep = dir ? -512 : 512;
#pragma unroll 2
              for (int sl = 0; sl < GS_NS; ++sl) {
                f32x4 nk4[4], nq4[4]; float nvv, neg, nbt;
                const int sn = sl + 1 < GS_NS ? sl + 1 : sl;
                GS_FETCH(nk4, nq4, nvv, neg, nbt, sn);
                f32x2 pa = {0.f, 0.f}, pb = {0.f, 0.f};
#pragma unroll
                for (int i = 0; i < 4; ++i) { pa += (f32x2){k4[i][0], k4[i][1]} * S[2 * i]; pb += (f32x2){k4[i][2], k4[i][3]} * S[2 * i + 1]; }
                const f32x2 pab = pa + pb; float pp = pab[0] + pab[1];
                pp += dppf(pp, 0); pp += dppf(pp, 1); pp += dppf(pp, 2);
                const float dl = bt * (vv - eg * pp);
                f32x2 oa = {0.f, 0.f}, ob = {0.f, 0.f};
#pragma unroll
                for (int i = 0; i < 4; ++i) {
                    S[2 * i] = S[2 * i] * eg + (f32x2){k4[i][0], k4[i][1]} * dl; S[2 * i + 1] = S[2 * i + 1] * eg + (f32x2){k4[i][2], k4[i][3]} * dl;
                    oa += (f32x2){q4[i][0], q4[i][1]} * S[2 * i]; ob += (f32x2){q4[i][2], q4[i][3]} * S[2 * i + 1]; }
                const f32x2 oab = oa + ob; float oo = oab[0] + oab[1];
                oo += dppf(oo, 0); oo += dppf(oo, 1); oo += dppf(oo, 2);
                if (kg == 0) odp[(ptrdiff_t)sl * ostep] = (bf16_t)f2bf(oo);
#pragma unroll
                for (int i = 0; i < 4; ++i) { k4[i] = nk4[i]; q4[i] = nq4[i]; }
                vv = nvv; eg = neg; bt = nbt;
              }
#undef GS_FETCH
            }
            if (more) GS_STORE((blk + 1) & 1);
            __syncthreads();
        }
#undef GS_ROW
#undef GS_LOAD
#undef GS_STORE
#undef GS_ST8
    }
    { const int gid = bid * 512 + tid;
      if (gid < NB * 2 * 512) { const int ch = gid & 511, dir = (gid >> 9) & 1, b = gid >> 10;
        const float* TOTA = (const float*)(a->ws + WS_TOTA); const float* TOTH = (const float*)(a->ws + WS_TOTH); float* CARRY = (float*)(a->ws + WS_CARRY);
        float carry = 0.f;
        for (int s = 0; s < 68; ++s) { const int slot = dir ? (s < 4 ? 3 - s : 67 - (s - 4)) : s; const size_t idx = ((size_t)((b * 2 + dir) * 68 + slot)) * 512 + ch;
            CARRY[idx] = carry; carry = TOTA[idx] * carry + TOTH[idx]; } } }
}


__device__ __forceinline__ int gs_row(int b, int dir, int s) { return s < CTXL ? (ML + b * CTXL + (dir ? CTXL - 1 - s : s)) : (b * SEQ + (dir ? SEQ - 1 - (s - CTXL) : (s - CTXL))); }
__device__ __forceinline__ float fexp(float x) { return __builtin_amdgcn_exp2f(1.4426950408889634f * x); }
constexpr int CP_WAVE = 64 * 68 * 4 + 512;
__device__ __forceinline__ void gdn_chunk_prep(KA a, LAS unsigned char* lds, int gw, int NGW, int wave, int lane) {
    const bf16_t* QN = (const bf16_t*)(a->ws + WS_U); const bf16_t* KN = QN + (size_t)MT * 512;
    const float* Gb = (const float*)(a->ws + WS_G); const float* Bt = (const float*)(a->ws + WS_BT);
    bf16_t* Tb = (bf16_t*)(a->ws + WS_TB); bf16_t* QKb = (bf16_t*)(a->ws + WS_QKB); float* GAM = (float*)(a->ws + WS_GAM);
    LAS float* Am = (LAS float*)(lds + wave * CP_WAVE); LAS float* gl = Am + 64 * 68; LAS float* bl = gl + 64;
    const int r32 = lane & 31, hi = lane >> 5;
    bf16x8 kf[2][8]; float gi_raw = 0.f, bt_raw = 0.f;
#define CP_FETCH(cu_) do { const int ch_ = (cu_) / 68, n_ = (cu_) % 68, b_ = ch_ >> 3, h_ = (ch_ >> 1) & 3, d_ = ch_ & 1; const int r0_ = gs_row(b_, d_, 64 * n_), rs_ = d_ ? -1 : 1; \
        _Pragma("unroll") for (int blk = 0; blk < 2; ++blk) _Pragma("unroll") for (int ks = 0; ks < 8; ++ks) \
            kf[blk][ks] = *(const bf16x8*)(KN + (size_t)(r0_ + rs_ * (32 * blk + r32)) * 512 + h_ * 128 + 16 * ks + 8 * hi); \
        const size_t rl_ = (size_t)(r0_ + rs_ * lane); gi_raw = Gb[rl_ * 8 + d_ * 4 + h_]; bt_raw = Bt[rl_ * 8 + d_ * 4 + h_]; } while (0)
    if (gw < 64 * 68) CP_FETCH(gw);
    for (int cu = gw; cu < 64 * 68; cu += NGW) {
        const int chain = cu / 68, n = cu % 68, b = chain >> 3, h = (chain >> 1) & 3, dir = chain & 1;
        const int row0 = gs_row(b, dir, 64 * n), rs = dir ? -1 : 1;
        { float gi = gi_raw;
#pragma unroll
          for (int o = 1; o < 64; o <<= 1) { const float t = __shfl_up(gi, o); if (lane >= o) gi += t; }
          gl[lane] = gi; bl[lane] = bt_raw; GAM[(size_t)cu * 64 + lane] = gi; }
        LDS_WAIT();
        const float gj0 = gl[r32], gj1 = gl[32 + r32];
#pragma unroll
        for (int tl = 0; tl < 3; ++tl) { const int mb = tl == 0 ? 0 : 1, nb = tl == 2 ? 1 : 0;
            f32x16 acc;
#pragma unroll
            for (int r = 0; r < 16; ++r) acc[r] = 0.f;
#pragma unroll
            for (int ks = 0; ks < 8; ++ks) acc = __builtin_amdgcn_mfma_f32_32x32x16_bf16(kf[mb][ks], kf[nb][ks], acc, 0, 0, 0);
            const int j = 32 * nb + r32; const float gj = nb ? gj1 : gj0;
#pragma unroll
            for (int q = 0; q < 4; ++q) { const int i0 = 32 * mb + 8 * q + 4 * hi; const f32x4 gmi = *(const LAS f32x4*)(gl + i0), bti = *(const LAS f32x4*)(bl + i0);
#pragma unroll
                for (int e = 0; e < 4; ++e) { const int i = i0 + e; Am[i * 68 + j] = (i > j) ? bti[e] * acc[4 * q + e] * fexp(gmi[e] - gj) : 0.f; } }
        }
        asm volatile("" ::: "memory");
        {
            bf16_t* qko = QKb + (size_t)cu * 4096;
#pragma unroll
            for (int mb = 0; mb < 2; ++mb) {
                bf16x8 qf[8];
#pragma unroll
                for (int ks = 0; ks < 8; ++ks) qf[ks] = *(const bf16x8*)(QN + (size_t)(row0 + rs * (32 * mb + r32)) * 512 + h * 128 + 16 * ks + 8 * hi);
#pragma unroll
                for (int nb = 0; nb <= mb; ++nb) {
                    f32x16 acc;
#pragma unroll
                    for (int r = 0; r < 16; ++r) acc[r] = 0.f;
#pragma unroll
                    for (int ks = 0; ks < 8; ++ks) acc = __builtin_amdgcn_mfma_f32_32x32x16_bf16(qf[ks], kf[nb][ks], acc, 0, 0, 0);
                    const int j = 32 * nb + r32; const float gj = nb ? gj1 : gj0;
#pragma unroll
                    for (int q = 0; q < 4; ++q) { const int i0 = 32 * mb + 8 * q + 4 * hi; const f32x4 gmi = *(const LAS f32x4*)(gl + i0);
#pragma unroll
                        for (int e = 0; e < 4; ++e) { const int i = i0 + e; qko[i * 64 + j] = (bf16_t)f2bf((i >= j) ? acc[4 * q + e] * fexp(gmi[e] - gj) : 0.f); } }
                }
                asm volatile("" ::: "memory");
            }
#pragma unroll
            for (int q = 0; q < 4; ++q)
#pragma unroll
                for (int e = 0; e < 4; ++e) qko[(8 * q + 4 * hi + e) * 64 + 32 + r32] = (bf16_t)0;
        }
        asm volatile("" ::: "memory");
        LDS_WAIT();
        { const int cn = cu + NGW < 64 * 68 ? cu + NGW : cu; CP_FETCH(cn); }
        {
            float Tc[64]; int ln = lane;
#pragma unroll
            for (int i = 0; i < 64; ++i) {
                if ((i & 3) == 0) asm volatile("" : "+v"(ln));
                float acc = (i == ln) ? 1.f : 0.f, acc1 = 0.f;
#pragma unroll
                for (int jj = 0; jj < (i + 3) / 4; ++jj) { const f32x4 a4 = *(const LAS f32x4*)(Am + i * 68 + 4 * jj);
#pragma unroll
                    for (int e = 0; e < 4; ++e) if (4 * jj + e < i) { if (e & 1) acc1 -= a4[e] * Tc[4 * jj + e]; else acc -= a4[e] * Tc[4 * jj + e]; } }
                Tc[i] = acc + acc1;
                if ((i & 1) == 1) asm volatile("" ::: "memory");
            }
            bf16_t* to = Tb + (size_t)cu * 4096 + lane;
#pragma unroll
            for (int i = 0; i < 64; ++i) to[i * 64] = (bf16_t)f2bf(Tc[i]);
        }
        LDS_WAIT();
    }
#undef CP_FETCH
}

constexpr int CS_KN = 0, CS_QN = 17408, CS_KT = 34816, CS_T = 53248, CS_QK = 62464, CS_VT = 71680, CS_GB = 76288, CS_ST = 77312, CS_RT = 86016, CS_VNT = 90624, CS_VDT = 95232, CS_END = 99840;
__device__ __forceinline__ void cs_compute(LAS unsigned char* lds, int wave, int r32, int hi, f32x16& acc, f32x16& Sreg, bf16_t* op, int row0, int rs) {
    const LAS float* gamL = (const LAS float*)(lds + CS_GB); const LAS float* betL = gamL + 64;
    const int mb = wave & 1;
    if (wave < 4) {
        const LAS unsigned char* X = lds + ((wave >> 1) ? CS_QN : CS_KN) + (32 * mb + r32) * 272 + 16 * hi; const LAS unsigned char* Sb = lds + CS_ST + r32 * 272 + 16 * hi;
#pragma unroll
        for (int r = 0; r < 16; ++r) acc[r] = 0.f;
#pragma unroll
        for (int ks = 0; ks < 8; ++ks) acc = __builtin_amdgcn_mfma_f32_32x32x16_bf16(*(const LAS bf16x8*)(X + 32 * ks), *(const LAS bf16x8*)(Sb + 32 * ks), acc, 0, 0, 0);
    }
    if (wave < 2) {
#pragma unroll
        for (int q = 0; q < 4; ++q) { const int t0 = 32 * mb + 8 * q + 4 * hi; const f32x4 gm = *(const LAS f32x4*)(gamL + t0), bt = *(const LAS f32x4*)(betL + t0);
            const u32x2 vv = *(const LAS u32x2*)(lds + CS_VT + r32 * 144 + t0 * 2);
            const float v0 = __uint_as_float(vv.x << 16), v1 = __uint_as_float(vv.x & 0xffff0000u), v2 = __uint_as_float(vv.y << 16), v3 = __uint_as_float(vv.y & 0xffff0000u);
            u32x2 w; w.x = pk2(bt[0] * (v0 - fexp(gm[0]) * acc[4 * q]), bt[1] * (v1 - fexp(gm[1]) * acc[4 * q + 1]));
            w.y = pk2(bt[2] * (v2 - fexp(gm[2]) * acc[4 * q + 2]), bt[3] * (v3 - fexp(gm[3]) * acc[4 * q + 3]));
            *(LAS u32x2*)(lds + CS_RT + r32 * 144 + t0 * 2) = w; }
    }
    __syncthreads();
    if (wave < 2) {
        f32x16 vn;
#pragma unroll
        for (int r = 0; r < 16; ++r) vn[r] = 0.f;
        const LAS unsigned char* Ta = lds + CS_T + (32 * mb + r32) * 144 + 16 * hi; const LAS unsigned char* Rb = lds + CS_RT + r32 * 144 + 16 * hi;
#pragma unroll
        for (int ks = 0; ks < 4; ++ks) vn = __builtin_amdgcn_mfma_f32_32x32x16_bf16(*(const LAS bf16x8*)(Ta + 32 * ks), *(const LAS bf16x8*)(Rb + 32 * ks), vn, 0, 0, 0);
        const float glast = gamL[63];
#pragma unroll
        for (int q = 0; q < 4; ++q) { const int t0 = 32 * mb + 8 * q + 4 * hi; const f32x4 gm = *(const LAS f32x4*)(gamL + t0);
            u32x2 w; w.x = pk2(vn[4 * q], vn[4 * q + 1]); w.y = pk2(vn[4 * q + 2], vn[4 * q + 3]);
            *(LAS u32x2*)(lds + CS_VNT + r32 * 144 + t0 * 2) = w;
            w.x = pk2(vn[4 * q] * fexp(glast - gm[0]), vn[4 * q + 1] * fexp(glast - gm[1])); w.y = pk2(vn[4 * q + 2] * fexp(glast - gm[2]), vn[4 * q + 3] * fexp(glast - gm[3]));
            *(LAS u32x2*)(lds + CS_VDT + r32 * 144 + t0 * 2) = w; }
    }
    __syncthreads();
    if (wave == 2 || wave == 3) {
#pragma unroll
        for (int q = 0; q < 4; ++q) { const int t0 = 32 * mb + 8 * q + 4 * hi; const f32x4 gm = *(const LAS f32x4*)(gamL + t0);
#pragma unroll
            for (int e = 0; e < 4; ++e) acc[4 * q + e] *= fexp(gm[e]); }
        const LAS unsigned char* Qa = lds + CS_QK + (32 * mb + r32) * 144 + 16 * hi; const LAS unsigned char* Vb = lds + CS_VNT + r32 * 144 + 16 * hi;
#pragma unroll
        for (int ks = 0; ks < 4; ++ks) acc = __builtin_amdgcn_mfma_f32_32x32x16_bf16(*(const LAS bf16x8*)(Qa + 32 * ks), *(const LAS bf16x8*)(Vb + 32 * ks), acc, 0, 0, 0);
#pragma unroll
        for (int r = 0; r < 16; ++r) { const int tok = 32 * mb + (r & 3) + 8 * (r >> 2) + 4 * hi; op[(ptrdiff_t)(row0 + rs * tok) * 512] = (bf16_t)f2bf(acc[r]); }
    } else if (wave >= 4) {
        const int mk = wave - 4; const float cd = fexp(gamL[63]);
#pragma unroll
        for (int r = 0; r < 16; ++r) Sreg[r] *= cd;
        const LAS unsigned char* Ka = lds + CS_KT + (32 * mk + r32) * 144 + 16 * hi; const LAS unsigned char* Db = lds + CS_VDT + r32 * 144 + 16 * hi;
#pragma unroll
        for (int ks = 0; ks < 4; ++ks) Sreg = __builtin_amdgcn_mfma_f32_32x32x16_bf16(*(const LAS bf16x8*)(Ka + 32 * ks), *(const LAS bf16x8*)(Db + 32 * ks), Sreg, 0, 0, 0);
#pragma unroll
        for (int q = 0; q < 4; ++q) { u32x2 w; w.x = pk2(Sreg[4 * q], Sreg[4 * q + 1]); w.y = pk2(Sreg[4 * q + 2], Sreg[4 * q + 3]);
            *(LAS u32x2*)(lds + CS_ST + r32 * 272 + (32 * mk + 8 * q + 4 * hi) * 2) = w; }
    }
    __syncthreads();
}
__device__ __forceinline__ void gdn_chunk_scan(KA a, LAS unsigned char* lds, int bid, int G, int tid, int wave, int lane) {
    const bf16_t* QN = (const bf16_t*)(a->ws + WS_U); const bf16_t* KN = QN + (size_t)MT * 512; const bf16_t* V = (const bf16_t*)(a->ws + WS_V);
    const float* Bt = (const float*)(a->ws + WS_BT);
    const bf16_t* Tb = (const bf16_t*)(a->ws + WS_TB); const bf16_t* QKb = (const bf16_t*)(a->ws + WS_QKB); const float* GAM = (const float*)(a->ws + WS_GAM);
    const int r32 = lane & 31, hi = lane >> 5;
    for (int u = bid; u < 256; u += G) {
        const int chain = (u & 7) * 8 + (u >> 5), qd = (u >> 3) & 3;
        const int b = chain >> 3, h = (chain >> 1) & 3, dir = chain & 1, rs = dir ? -1 : 1;
        bf16_t* op = (bf16_t*)(a->ws + (dir ? WS_OB : WS_OF)) + h * 128 + qd * 32 + r32;
        u32x4 rkA[2], rqA[2], rTA, rQKA, rVA; float rgbA = 0.f;
        u32x4 rkB[2], rqB[2], rTB, rQKB, rVB; float rgbB = 0.f;
#define CS_LOAD(S_, n_) do { const int row0_ = gs_row(b, dir, 64 * (n_)); const size_t cu_ = (size_t)(chain * 68 + (n_)); const size_t rowl_ = (size_t)(row0_ + rs * lane); \
        _Pragma("unroll") for (int i_ = 0; i_ < 2; ++i_) { const int c16_ = wave + 8 * i_; \
            rk##S_[i_] = *(const u32x4*)(KN + rowl_ * 512 + h * 128 + c16_ * 8); rq##S_[i_] = *(const u32x4*)(QN + rowl_ * 512 + h * 128 + c16_ * 8); } \
        rT##S_ = *(const u32x4*)(Tb + cu_ * 4096 + tid * 8); rQK##S_ = *(const u32x4*)(QKb + cu_ * 4096 + tid * 8); \
        if (wave < 4) rV##S_ = *(const u32x4*)(V + rowl_ * 512 + h * 128 + qd * 32 + wave * 8); \
        if (tid < 64) rgb##S_ = GAM[cu_ * 64 + tid]; else if (tid < 128) rgb##S_ = Bt[(size_t)(row0_ + rs * (tid - 64)) * 8 + dir * 4 + h]; } while (0)
#define CS_T16(base, v, col0, tok) do { const unsigned w_[4] = {(v).x, (v).y, (v).z, (v).w}; _Pragma("unroll") for (int e_ = 0; e_ < 8; ++e_) \
        *(LAS bf16_t*)(lds + (base) + ((col0) + e_) * 144 + (tok) * 2) = (bf16_t)((e_ & 1) ? (w_[e_ >> 1] >> 16) : (w_[e_ >> 1] & 0xffffu)); } while (0)
#define CS_STORE(S_) do { \
        _Pragma("unroll") for (int i_ = 0; i_ < 2; ++i_) { const int c16_ = wave + 8 * i_; \
            *(LAS u32x4*)(lds + CS_KN + lane * 272 + c16_ * 16) = rk##S_[i_]; *(LAS u32x4*)(lds + CS_QN + lane * 272 + c16_ * 16) = rq##S_[i_]; CS_T16(CS_KT, rk##S_[i_], c16_ * 8, lane); } \
        *(LAS u32x4*)(lds + CS_T + (tid >> 3) * 144 + (tid & 7) * 16) = rT##S_; *(LAS u32x4*)(lds + CS_QK + (tid >> 3) * 144 + (tid & 7) * 16) = rQK##S_; \
        if (wave < 4) CS_T16(CS_VT, rV##S_, wave * 8, lane); \
        if (tid < 128) *(LAS float*)(lds + CS_GB + tid * 4) = rgb##S_; } while (0)
        CS_LOAD(A, 0);
        for (int i = tid; i < 32 * 272 / 4; i += 512) *(LAS unsigned*)(lds + CS_ST + i * 4) = 0u;
        CS_STORE(A);
        __syncthreads();
        CS_LOAD(A, 1);
        f32x16 Sreg, acc;
#pragma unroll
        for (int r = 0; r < 16; ++r) { Sreg[r] = 0.f; acc[r] = 0.f; }
        for (int n = 0; n < 68; n += 2) {
            if (n + 2 < 68) CS_LOAD(B, n + 2);
            cs_compute(lds, wave, r32, hi, acc, Sreg, op, gs_row(b, dir, 64 * n), rs);
            CS_STORE(A);
            __syncthreads();
            if (n + 3 < 68) CS_LOAD(A, n + 3);
            cs_compute(lds, wave, r32, hi, acc, Sreg, op, gs_row(b, dir, 64 * (n + 1)), rs);
            if (n + 2 < 68) CS_STORE(B);
            __syncthreads();
        }
#undef CS_LOAD
#undef CS_T16
#undef CS_STORE
    }
    if (wave == 0 && lane < 32) {
      const float* TOTA = (const float*)(a->ws + WS_TOTA); const float* TOTH = (const float*)(a->ws + WS_TOTH); float* CARRY = (float*)(a->ws + WS_CARRY);
      for (int gid = bid * 32 + lane; gid < NB * 2 * 512; gid += G * 32) { const int ch = gid & 511, dir = (gid >> 9) & 1, b = gid >> 10;
        float carry = 0.f;
        for (int s0 = 0; s0 < 68; s0 += 17) {
            float ta[17], th[17];
#pragma unroll
            for (int k = 0; k < 17; ++k) { const int s = s0 + k; const int slot = dir ? (s < 4 ? 3 - s : 67 - (s - 4)) : s; const size_t idx = ((size_t)((b * 2 + dir) * 68 + slot)) * 512 + ch; ta[k] = TOTA[idx]; th[k] = TOTH[idx]; }
#pragma unroll
            for (int k = 0; k < 17; ++k) { const int s = s0 + k; const int slot = dir ? (s < 4 ? 3 - s : 67 - (s - 4)) : s; const size_t idx = ((size_t)((b * 2 + dir) * 68 + slot)) * 512 + ch; CARRY[idx] = carry; carry = ta[k] * carry + th[k]; }
        } } }
}

__device__ __forceinline__ void gdn_merge(KA a, int L, int gw, int NGW, int lane) {
    const int j2 = L >> 1;
    const bf16_t* P = (const bf16_t*)(a->ws + WS_P); bf16_t* U = (bf16_t*)(a->ws + WS_U);
    const bf16_t* OF = (const bf16_t*)(a->ws + WS_OF); const bf16_t* OB = (const bf16_t*)(a->ws + WS_OB);
    const float* gn = a->in[I_EVGDNNORM] + j2 * 128 + ((8 * lane) & 127);
    float g8[8];
#pragma unroll
    for (int e = 0; e < 8; ++e) g8[e] = gn[e];
    for (int row = gw; row < MT; row += NGW) {
        float of[8], ob[8], z[8], y[8];
        unpack8(*(const u32x4*)(OF + (size_t)row * 512 + 8 * lane), of); unpack8(*(const u32x4*)(OB + (size_t)row * 512 + 8 * lane), ob);
        unpack8(*(const u32x4*)(P + (size_t)row * EVNP + 1536 + 8 * lane), z);
        float ssq = 0.f;
#pragma unroll
        for (int e = 0; e < 8; ++e) { of[e] += ob[e]; ssq += of[e] * of[e]; }
        ssq = rowsum16(ssq);
        const float rms = 1.0f / sqrtf(ssq * (1.f / 128.f) + EPS);
#pragma unroll
        for (int e = 0; e < 8; ++e) y[e] = of[e] * rms * g8[e] * fsilu(z[e]);
        *(u32x4*)(U + (size_t)row * D + 8 * lane) = pack8(y);
    }
}


#define XB_TMO      128
#define XB_XCNT(j)  (256  + 64 * (j))
#define XB_XSUB(j)  (1280 + 64 * (j))
#define XB_XGEN(j)  (2304 + 64 * (j))
#define XB_TOP      3328
#define XB_TOPGEN   3392
#define XCD_BAR_WORDS 3456
#define XB_SPIN_CAP (1u << 20)
__device__ __forceinline__ unsigned xb_ld(unsigned* p)              { return __hip_atomic_load(p, __ATOMIC_RELAXED, __HIP_MEMORY_SCOPE_AGENT); }
__device__ __forceinline__ unsigned xb_add(unsigned* p, unsigned v) { return __hip_atomic_fetch_add(p, v, __ATOMIC_RELAXED, __HIP_MEMORY_SCOPE_AGENT); }
__device__ __forceinline__ unsigned xb_xcc_id() { return (unsigned)__builtin_amdgcn_s_getreg((3 << 11) | 20) & 0xFu; }
#define XB_SPIN(cond, bar) do { unsigned _sp = 0; while (cond) { __builtin_amdgcn_s_sleep(1); \
    if ((++_sp & 255u) == 0u) { if (xb_ld(&(bar)[XB_TMO])) break; if (_sp > XB_SPIN_CAP) { atomicAdd(&(bar)[XB_TMO], 1u); break; } } } } while (0)
struct XcdBarrier { unsigned* bar; unsigned x; volatile LAS unsigned* st; };
__device__ __forceinline__ XcdBarrier xcd_barrier_post(unsigned* bar, volatile LAS unsigned* st) {
    XcdBarrier b; b.bar = bar; b.x = xb_xcc_id(); b.st = st;
    if (threadIdx.x == 0) (void)xb_add(&bar[XB_XCNT(b.x)], 1u);
    return b;
}
__device__ __forceinline__ void xcd_barrier_complete(unsigned* bar, unsigned x, unsigned& nloc, unsigned& nx) {
    const unsigned G = gridDim.x * gridDim.y * gridDim.z;
    unsigned sum, cnt, mine, sp = 0u;
    for (;;) {
        sum = 0u; cnt = 0u; mine = 0u;
#pragma unroll
        for (unsigned j = 0; j < 16; ++j) { const unsigned c = xb_ld(&bar[XB_XCNT(j)]); sum += c; cnt += (c > 0u) ? 1u : 0u; mine = (j == x) ? c : mine; }
        if (sum == G) break;
        __builtin_amdgcn_s_sleep(1);
        if ((++sp & 255u) == 0u) { if (xb_ld(&bar[XB_TMO])) break; if (sp > XB_SPIN_CAP) { atomicAdd(&bar[XB_TMO], 1u); break; } }
    }
    nloc = mine > 0u ? mine : 1u; nx = cnt > 0u ? cnt : 1u;
}
__device__ __forceinline__ void xcd_barrier(const XcdBarrier& b) {
    asm volatile("s_waitcnt vmcnt(0)" ::: "memory");
    __syncthreads();
    if (threadIdx.x == 0) {
        unsigned* bar = b.bar;
        __builtin_amdgcn_s_waitcnt(0);
        unsigned nloc = b.st[0], nx = b.st[1];
        if (nloc == 0u) { xcd_barrier_complete(bar, b.x, nloc, nx); b.st[0] = nloc; b.st[1] = nx; }
        const unsigned old = xb_add(&bar[XB_XSUB(b.x)], 1u);
        const unsigned gen = old / nloc;
        if (old + 1u == (gen + 1u) * nloc) {
            __builtin_amdgcn_fence(__ATOMIC_RELEASE, "agent");
            asm volatile("s_waitcnt vmcnt(0)" ::: "memory");
            const unsigned og = xb_add(&bar[XB_TOP], 1u);
            const unsigned tg = og / nx;
            if (og + 1u == (tg + 1u) * nx) xb_add(&bar[XB_TOPGEN], 1u);
            else XB_SPIN(xb_ld(&bar[XB_TOPGEN]) == tg, bar);
            __builtin_amdgcn_fence(__ATOMIC_ACQUIRE, "agent");
            xb_add(&bar[XB_XGEN(b.x)], 1u);
            asm volatile("s_waitcnt vmcnt(0)" ::: "memory");
        } else {
            XB_SPIN(xb_ld(&bar[XB_XGEN(b.x)]) == gen, bar);
            __builtin_amdgcn_fence(__ATOMIC_ACQUIRE, "agent");
            asm volatile("s_waitcnt vmcnt(0)" ::: "memory");
        }
    }
    __syncthreads();
}

__device__ __forceinline__ void decode_phase(int ph, int& L, int& kind) {
    if (ph == 0) { L = 0; kind = K_PROA; return; }
    if (ph == 1) { L = 0; kind = K_PROB; return; }
    int p = ph - 2;
    if (p < 10) { L = 0; } else if (p < 18) { L = 1; p -= 10; } else if (p < 28) { L = 2; p -= 18; } else { L = 3; p -= 28; }
    if ((L & 1) == 0) { kind = p == 0 ? K_PROJ : p == 1 ? K_E2 : p == 2 ? K_E2B : p == 3 ? K_E3 : p == 4 ? K_E4 : p == 5 ? K_WOUT : p == 6 ? K_LN1 : p == 7 ? K_MLP1 : p == 8 ? K_MLP2 : K_LN2; }
    else { kind = p == 0 ? K_PROJ : p == 1 ? K_O2 : p == 2 ? K_O3 : p == 3 ? K_WOUT : p == 4 ? K_LN1 : p == 5 ? K_MLP1 : p == 6 ? K_MLP2 : K_LN2; }
}

#ifndef MK_DUP_GEMM
#define MK_DUP_GEMM 0
#endif
#ifndef MK_DUP_KIND
#define MK_DUP_KIND -1
#endif
#ifndef MK_SKIP1
#define MK_SKIP1 1
#endif
#ifndef MK_K2
#define MK_K2 1024
#endif
#ifndef MK_PHM
#define MK_PHM 0xffffu
#endif
#define EN(k) ((MK_PHM >> (k)) & 1u)
__global__ void __launch_bounds__(512, 2) fwd_kernel(Args args) {
    extern __shared__ __attribute__((aligned(16))) unsigned char lds_raw[];
    LAS unsigned char* lds = (LAS unsigned char*)lds_raw;
    cg::grid_group grid = cg::this_grid();
    const int G = gridDim.x;
    volatile LAS unsigned* bst = (volatile LAS unsigned*)(lds + LDS_BYTES - 16);
    if (threadIdx.x < 2) bst[threadIdx.x] = 0u;
    __syncthreads();
    const XcdBarrier xbar = xcd_barrier_post((unsigned*)(args.ws + WS_BAR), bst);
    const int ph_lo = args.ph_lo, ph_hi = args.ph_hi;
    bool second = false;
    for (int ph = ph_lo; ph < ph_hi; ) {
        KA a = (KA)__builtin_amdgcn_kernarg_segment_ptr(); asm volatile("" : "+s"(a));
        int tid = threadIdx.x; asm volatile("" : "+v"(tid));
        int bid = blockIdx.x; asm volatile("" : "+s"(bid));
        const int lane = tid & 63, wave = __builtin_amdgcn_readfirstlane(tid >> 6), gw = bid * 8 + wave, NGW = G * 8;
        bf16_t* U = (bf16_t*)(a->ws + WS_U); bf16_t* P = (bf16_t*)(a->ws + WS_P); float* HC = (float*)(a->ws + WS_HC);
        const float* MOD = (const float*)(a->ws + WS_MOD);
        int L, kind; decode_phase(ph, L, kind);
        const bool even = (L & 1) == 0; const bool last = L == 3;
        const int Mrows = last ? ML : MT;
        const bool isgemm = kind == K_PROJ || kind == K_MLP1 || kind == K_WOUT || kind == K_MLP2;
        const bool dup = (MK_DUP_GEMM && isgemm) || kind == MK_DUP_KIND;
        if (EN(K_PROA) && kind == K_PROA) prologue_a(a, lds, bid, G, tid, wave, lane);
        else if (EN(K_PROB) && kind == K_PROB) prologue_b(a, gw, NGW, lane);
        else if (EN(K_PROJ) && (kind == K_PROJ || kind == K_MLP1 || kind == K_WOUT || kind == K_MLP2)) {
            const float* modL = MOD + (size_t)L * 9 * 6144;
            const bool split = (kind == K_WOUT || kind == K_MLP2) && !last;
            const int ncall = split ? 2 : 1;
            for (int call = 0; call < ncall; ++call) {
                pg8::Gemm g; pg8::EpiBf16 E;
                if (kind == K_PROJ) { g = pg8::Gemm{U, (const bf16_t*)(a->ws + WS_WA), MT, even ? EVNP : ODN, D, D, D, 1}; E = pg8::EpiBf16{P, even ? EVNP : ODN, 0, nullptr, -1, 0}; }
                else if (kind == K_MLP1) { g = pg8::Gemm{U, (const bf16_t*)(a->ws + WS_W1), Mrows, FF, D, D, D, 1}; E = pg8::EpiBf16{P, FF, 2, nullptr, -1, 0}; }
                else if (kind == K_WOUT) { const bf16_t* A = even ? U : P; const int lda = even ? D : ODN;
                    if (call == 0) { g = pg8::Gemm{A, (const bf16_t*)(a->ws + WS_WO), ML, D, D, lda, D, 1}; E = pg8::EpiBf16{even ? P : U, D, 0, modL + 2 * D, -1, 0}; }
                    else { g = pg8::Gemm{A + (size_t)ML * lda, (const bf16_t*)(a->ws + WS_WO), MC, D, D / 4, lda, D, 4}; E = pg8::EpiBf16{(bf16_t*)(a->ws + WS_PART), D, 0, modL + 2 * D, 8, (size_t)MC * D}; } }
                else { if (call == 0) { g = pg8::Gemm{P, (const bf16_t*)(a->ws + WS_W2), ML, D, FF, FF, FF, 1}; E = pg8::EpiBf16{U, D, 0, modL + 5 * D, -1, 0}; }
                    else { g = pg8::Gemm{P + (size_t)ML * FF, (const bf16_t*)(a->ws + WS_W2), MC, D, FF / 8, FF, FF, 8}; E = pg8::EpiBf16{(bf16_t*)(a->ws + WS_PART), D, 0, modL + 5 * D, 8, (size_t)MC * D}; } }
                pg8::StaticOrder S; S.init(g.M, g.N, G, bid, g.nks);
                pg8::gemm_phase<pg8::EpiBf16>(lds, g, S, E, tid);
            }
        }
        else if (EN(K_LN1) && kind == K_LN1) ln_pass(a, L, 0, Mrows, true, L, 3, even ? P : U, last ? 0 : 4, gw, NGW, lane);
        else if (EN(K_LN2) && kind == K_LN2) {
            ln_pass(a, L, 1, Mrows, !last, L + 1, 0, U, last ? 0 : 8, gw, NGW, lane);
            if (!last) conv_weights(a, L + 1, lds, gw, NGW, wave, lane);
        }
        else if (EN(K_E2) && kind == K_E2) { gdn_prep(a, L, lds, gw, NGW, tid, lane); lru_units<1>(a, L, lds, bid, G, tid); }
        else if (EN(K_E2B) && kind == K_E2B) gdn_chunk_prep(a, lds, gw, NGW, wave, lane);
        else if (EN(K_E3) && kind == K_E3) gdn_chunk_scan(a, lds, bid, G, tid, wave, lane);
        else if (EN(K_E4) && kind == K_E4) { gdn_merge(a, L, gw, NGW, lane); lru_units<2>(a, L, lds, bid, G, tid); }
        else if (EN(K_O2) && kind == K_O2) attn_prep(a, lds, bid, G, tid);
        else if (EN(K_O3) && kind == K_O3) attn_phase(a, L, lds, bid, G, tid, wave, lane, !dup || second);
        if (dup && !second) { second = true; grid.sync(); continue; }
        second = false; ++ph;
        if (ph < ph_hi) { if (ph == ph_lo + 1) grid.sync(); else xcd_barrier(xbar); }
    }
}

#ifndef MK_PH_HI
#define MK_PH_HI N_PHASES
#endif
#ifndef MK_PER_PHASE
#define MK_PER_PHASE 0
#endif
extern "C" void kernel_launch(void* const* d_in, const int* in_sizes, int n_in, void* d_out, int out_size, void* d_ws, size_t ws_size, hipStream_t stream) {
    static int grid = 0;
    if (grid == 0) {
        if (n_in != 24 || ws_size < WS_END) { fprintf(stderr, "kernel_launch: unexpected n_in %d / ws_size %zu\n", n_in, ws_size); grid = -1; return; }
        int dev = 0, cus = 0, per_cu = 0;
        (void)hipGetDevice(&dev); (void)hipDeviceGetAttribute(&cus, hipDeviceAttributeMultiprocessorCount, dev);
        if (hipFuncSetAttribute((const void*)fwd_kernel, hipFuncAttributeMaxDynamicSharedMemorySize, LDS_BYTES) != hipSuccess) { fprintf(stderr, "kernel_launch: hipFuncSetAttribute failed\n"); grid = -1; return; }
        (void)hipOccupancyMaxActiveBlocksPerMultiprocessor(&per_cu, (const void*)fwd_kernel, 512, LDS_BYTES);
        (void)hipGetLastError();
        if (per_cu < 1) per_cu = 1;
        grid = cus;
        fprintf(stderr, "kernel_launch: cus %d per_cu %d grid %d\n", cus, per_cu, grid);
    }
    if (grid < 0) return;
    Args a{};
    for (int i = 0; i < 24; ++i) a.in[i] = (const float*)d_in[i];
    a.out = (float*)d_out; a.ws = (unsigned char*)d_ws;
#if MK_PER_PHASE
    for (int ph = 0; ph < N_PHASES; ++ph) { a.ph_lo = ph; a.ph_hi = ph + 1; hipLaunchKernelGGL(fwd_kernel, dim3(grid), dim3(512), LDS_BYTES, stream, a); }
#else
    a.ph_lo = 0; a.ph_hi = MK_PH_HI;
    (void)hipMemsetAsync((unsigned char*)d_ws + WS_BAR, 0, 16384, stream);
    void* args[] = {&a};
    hipError_t e = hipLaunchCooperativeKernel((const void*)fwd_kernel, dim3(grid), dim3(512), args, LDS_BYTES, stream);
    if (e != hipSuccess) fprintf(stderr, "kernel_launch: cooperative launch failed: %s (grid %d)\n", hipGetErrorString(e), grid);
#endif
}
```

```cpp
#include <hip/hip_runtime.h>
#include <hip/hip_cooperative_groups.h>
#include <cstdio>
#include <cstdint>
namespace cg = cooperative_groups;

#define LAS __attribute__((address_space(3)))
typedef unsigned short bf16_t;
typedef short bf16x8 __attribute__((ext_vector_type(8)));
typedef float f32x4 __attribute__((ext_vector_type(4)));
typedef float f32x2 __attribute__((ext_vector_type(2)));
typedef float f32x16 __attribute__((ext_vector_type(16)));
typedef unsigned u32x4 __attribute__((ext_vector_type(4)));
typedef unsigned u32x2 __attribute__((ext_vector_type(2)));
typedef __bf16 bf16x2_t __attribute__((ext_vector_type(2)));

constexpr int D = 1024, NB = 8, SEQ = 4096, CTXL = 256, FF = 4096;
constexpr int ML = NB * SEQ, MC = NB * CTXL, MT = ML + MC;
constexpr int EVN = 3088, EVNP = 3328, ODN = 3072;
constexpr float ALPHA = 1.6817928305074292f;
constexpr float EPS = 1e-6f;
constexpr int NKV = CTXL + SEQ;
constexpr float QSCALE = 0.125f * 1.4426950408889634f;

constexpr size_t MiB = 1u << 20;
constexpr size_t WS_MISC = 0;
constexpr size_t WS_BAR = 65536;
constexpr size_t WS_MOD = 1 * MiB;
constexpr size_t WS_WA = 2 * MiB;
constexpr size_t WS_WO = 9 * MiB;
constexpr size_t WS_W1 = 11 * MiB;
constexpr size_t WS_W2 = 19 * MiB;
constexpr size_t WS_HC = 27 * MiB;
constexpr size_t WS_U = 35 * MiB;
constexpr size_t WS_P = 103 * MiB;
constexpr size_t WS_X = 324 * MiB;
constexpr size_t WS_V = WS_X;
constexpr size_t WS_OF = WS_X + 34 * MiB;
constexpr size_t WS_OB = WS_X + 68 * MiB;
constexpr size_t WS_G = WS_X + 102 * MiB;
constexpr size_t WS_BT = WS_X + 104 * MiB;
constexpr size_t WS_TOTA = WS_X + 106 * MiB;
constexpr size_t WS_TOTH = WS_X + 109 * MiB;
constexpr size_t WS_CARRY = WS_X + 112 * MiB;
constexpr size_t WS_HLAST = 375 * MiB;
constexpr size_t WS_PART = 376 * MiB;
constexpr size_t WS_TB = WS_X + 116 * MiB;
constexpr size_t WS_QKB = WS_X + 150 * MiB;
constexpr size_t WS_GAM = WS_X + 184 * MiB;
constexpr size_t WS_END = WS_X + 186 * MiB;

constexpr int LDS_BYTES = 147456;

__device__ __forceinline__ float bf2f(unsigned v) { return __uint_as_float(v << 16); }
__device__ __forceinline__ unsigned pk2(float lo, float hi) { f32x2 v = {lo, hi}; bf16x2_t b = __builtin_convertvector(v, bf16x2_t); return __builtin_bit_cast(unsigned, b); }
__device__ __forceinline__ unsigned f2bf(float f) { return pk2(f, 0.f) & 0xffffu; }
__device__ __forceinline__ void unpack8(const u32x4 r, float* o) {
    o[0] = __uint_as_float(r.x << 16); o[1] = __uint_as_float(r.x & 0xffff0000u);
    o[2] = __uint_as_float(r.y << 16); o[3] = __uint_as_float(r.y & 0xffff0000u);
    o[4] = __uint_as_float(r.z << 16); o[5] = __uint_as_float(r.z & 0xffff0000u);
    o[6] = __uint_as_float(r.w << 16); o[7] = __uint_as_float(r.w & 0xffff0000u);
}
__device__ __forceinline__ u32x4 pack8(const float* v) { u32x4 o; o.x = pk2(v[0], v[1]); o.y = pk2(v[2], v[3]); o.z = pk2(v[4], v[5]); o.w = pk2(v[6], v[7]); return o; }
__device__ __forceinline__ float sigmoidf_(float x) { return 1.f / (1.f + expf(-x)); }
__device__ __forceinline__ float siluf_(float x) { return x / (1.f + expf(-x)); }
__device__ __forceinline__ float fsigmoid(float x) { return __builtin_amdgcn_rcpf(1.0f + __builtin_amdgcn_exp2f(-1.4426950408889634f * x)); }
__device__ __forceinline__ float fsilu(float x) { return x * fsigmoid(x); }
__device__ __forceinline__ float softplusf_(float x) { return fmaxf(x, 0.f) + log1pf(expf(-fabsf(x))); }
__device__ __forceinline__ float gelu_tanh(float x) { const float u = 0.7978845608028654f * (x + 0.044715f * x * x * x); return 0.5f * x * (1.f + tanhf(u)); }
__device__ __forceinline__ float dppf(float v, const int ctrl_sel) {
    int r;
    if (ctrl_sel == 0) r = __builtin_amdgcn_update_dpp(0, __float_as_int(v), 0xB1, 0xF, 0xF, true);
    else if (ctrl_sel == 1) r = __builtin_amdgcn_update_dpp(0, __float_as_int(v), 0x4E, 0xF, 0xF, true);
    else if (ctrl_sel == 2) r = __builtin_amdgcn_update_dpp(0, __float_as_int(v), 0x141, 0xF, 0xF, true);
    else r = __builtin_amdgcn_update_dpp(0, __float_as_int(v), 0x140, 0xF, 0xF, true);
    return __int_as_float(r);
}
__device__ __forceinline__ float rowsum16(float v) { v += dppf(v, 0); v += dppf(v, 1); v += dppf(v, 2); v += dppf(v, 3); return v; }
__device__ __forceinline__ float wave_sum(float v) {
#pragma unroll
    for (int o = 1; o < 64; o <<= 1) v += __shfl_xor(v, o);
    return v;
}
__device__ __forceinline__ float xhalf_max(float v) { auto rr = __builtin_amdgcn_permlane32_swap(__float_as_uint(v), __float_as_uint(v), false, false); return fmaxf(__uint_as_float(rr[0]), __uint_as_float(rr[1])); }
__device__ __forceinline__ float xhalf_sum(float v) { auto rr = __builtin_amdgcn_permlane32_swap(__float_as_uint(v), __float_as_uint(v), false, false); return __uint_as_float(rr[0]) + __uint_as_float(rr[1]); }
#define LDS_WAIT() asm volatile("s_waitcnt lgkmcnt(0)" ::: "memory")

namespace pg8 {
constexpr int BM = 256, BK = 64, HALF = 128, HTB = HALF * BK * 2, STAGE_BYTES = 8 * HTB, NXCD = 8, WGM = 8;
__host__ __device__ __forceinline__ int lds_byte(int r, int c) { const int st = (r >> 4) * 2 + (c >> 5), rr = r & 15, cc = c & 31, ob = rr * 64 + cc * 2; return st * 1024 + (ob ^ (((ob >> 9) & 1) << 5)); }
__host__ __device__ __forceinline__ void stage_rc(int b, int& R, int& C) { const int st = b / 1024, sb = b % 1024, swz = sb ^ (((sb >> 9) & 1) << 5); R = (st >> 1) * 16 + swz / 64; C = (st & 1) * 32 + (swz % 64) / 2; }
__host__ __device__ __forceinline__ int perm32(int rho) { const int n = rho >> 4, i = rho & 15; return 8 * (i >> 2) + 4 * n + (i & 3); }
struct Unit { int pm, pn, ks; };
struct Gemm { const bf16_t* A; const bf16_t* Bt; int M, N, K, lda, ldb, nks; };
struct StaticOrder {
    int nM, nN, nwg, G, c;
    int nks;
    __device__ void init(int M, int N, int G_, int c_, int nks_) { nM = M / BM; nN = N / BM; nwg = nM * nN; G = G_; c = c_; nks = nks_; }
    __device__ bool next(int i, Unit& u) const {
        const long L = (long)i * G + c; if (L >= (long)nwg * nks) return false;
        u.ks = (int)(L % nks); int wgid = (int)(L / nks); { const int q = nwg / NXCD, r = nwg % NXCD, xcd = wgid % NXCD, off = wgid / NXCD; wgid = (xcd < r ? xcd * (q + 1) : r * (q + 1) + (xcd - r) * q) + off; }
        const int nig = WGM * nN, gid = wgid / nig, fm = gid * WGM, gsz = (nM - fm) < WGM ? (nM - fm) : WGM;
        u.pm = fm + ((wgid % nig) % gsz); u.pn = (wgid % nig) / gsz; return true;
    }
};
struct EpiBf16 {
    static constexpr bool PERM = true;
    bf16_t* O; int ldc; int act; const float* gate; int bb_force; size_t ks_stride;
    __device__ __forceinline__ void operator()(const f32x4 (&acc)[2][2][4][2], const Unit& u, int wr, int wc, int fr, int fq) const {
        const int rt = u.pm * BM; const int bb = bb_force >= 0 ? bb_force : (rt >= ML ? 8 : (rt >> 12));
        const int row0 = rt + wr * 64 + fr; const int col0 = u.pn * BM + wc * 32 + 8 * fq;
        f32x4 gv[2][2];
#pragma unroll
        for (int bj = 0; bj < 2; ++bj)
#pragma unroll
            for (int n = 0; n < 2; ++n) gv[bj][n] = gate ? *(const f32x4*)(gate + bb * 6144 + col0 + bj * HALF + 4 * n) : (f32x4){1.f, 1.f, 1.f, 1.f};
#pragma unroll
        for (int ai = 0; ai < 2; ++ai)
#pragma unroll
            for (int m = 0; m < 4; ++m) { bf16_t* rowp = O + (size_t)u.ks * ks_stride + (size_t)(row0 + ai * HALF + m * 16) * ldc + col0;
#pragma unroll
                for (int bj = 0; bj < 2; ++bj) { f32x4 v0 = acc[ai][bj][m][0], v1 = acc[ai][bj][m][1];
                    if (act == 2) {
#pragma unroll
                        for (int e = 0; e < 4; ++e) { float a0 = fmaxf(v0[e], 0.f), a1 = fmaxf(v1[e], 0.f); v0[e] = a0 * a0; v1[e] = a1 * a1; } }
                    v0 = v0 * gv[bj][0]; v1 = v1 * gv[bj][1];
                    u32x4 w; w.x = pk2(v0[0], v0[1]); w.y = pk2(v0[2], v0[3]); w.z = pk2(v1[0], v1[1]); w.w = pk2(v1[2], v1[3]);
                    *(u32x4*)(rowp + bj * HALF) = w; } }
    }
};

template <class Epi>
__device__ __forceinline__ void gemm_phase(LAS unsigned char* lds, const Gemm g, const StaticOrder& S, const Epi& E, const int tid) {
    const int wid = __builtin_amdgcn_readfirstlane(tid >> 6), lane = tid & 63, wr = wid >> 2, wc = wid & 3, fr = lane & 15, fq = lane >> 4;
    const int K = g.K, nt = K / BK;
    unsigned voffA[2], voffB[2];
#pragma unroll
    for (int i = 0; i < 2; ++i) { int R, C; stage_rc(tid * 16 + i * 8192, R, C); const int Rb = Epi::PERM ? ((R & ~31) + perm32(R & 31)) : R;
        voffA[i] = (unsigned)(R * g.lda + C) * 2u; voffB[i] = (unsigned)(Rb * g.ldb + C) * 2u; }
    const size_t kstep = (size_t)(BK * 2);
    const size_t hA = (size_t)HALF * g.lda * 2, hB = (size_t)HALF * g.ldb * 2, kso = (size_t)K * 2;
    const size_t tA = 2 * hA, tB = 2 * hB;
    const unsigned ldsw = (unsigned)wid * 1024u;
    const int aoff = lds_byte(wr * 64 + fr, fq * 8), boff = lds_byte(wc * 32 + fr, fq * 8);
#define PG8_SA(b, h) (((b) * 2 + (h)) * HTB)
#define PG8_SB(b, h) ((4 + (b) * 2 + (h)) * HTB)
#define PG8_STAGE(bufoff, gbase, voff) do { _Pragma("unroll") for (int _i = 0; _i < 2; ++_i) \
        __builtin_amdgcn_global_load_lds((const unsigned*)((const char*)(gbase) + (voff)[_i]), (LAS unsigned*)(lds + (bufoff) + ldsw + _i * 8192), 16, 0, 0); } while (0)
#define PG8_LDA(dst, b, h) do { _Pragma("unroll") for (int m = 0; m < 4; ++m) _Pragma("unroll") for (int k = 0; k < 2; ++k) dst[m][k] = *(const LAS bf16x8*)(lds + PG8_SA(b, h) + aoff + m * 2048 + k * 1024); } while (0)
#define PG8_LDB(dst, b, h) do { _Pragma("unroll") for (int n = 0; n < 2; ++n) _Pragma("unroll") for (int k = 0; k < 2; ++k) dst[n][k] = *(const LAS bf16x8*)(lds + PG8_SB(b, h) + boff + n * 2048 + k * 1024); } while (0)
#define PG8_MMA(ai, bj, At, Bt) do { __builtin_amdgcn_s_setprio(1); _Pragma("unroll") for (int m = 0; m < 4; ++m) _Pragma("unroll") for (int n = 0; n < 2; ++n) _Pragma("unroll") for (int k = 0; k < 2; ++k) \
        acc[ai][bj][m][n] = __builtin_amdgcn_mfma_f32_16x16x32_bf16(Bt[n][k], At[m][k], acc[ai][bj][m][n], 0, 0, 0); __builtin_amdgcn_s_setprio(0); } while (0)
#define PG8_WAIT_V(n) asm volatile("s_waitcnt vmcnt(" #n ")" ::: "memory")
#define PG8_WAIT_L(n) asm volatile("s_waitcnt lgkmcnt(" #n ")" ::: "memory")
#define PG8_BAR __builtin_amdgcn_s_barrier()
#define PG8_SCHED __builtin_amdgcn_sched_barrier(0)
    Unit cur, nxt; int ui = 0;
    if (!S.next(0, cur)) return;
    f32x4 acc[2][2][4][2];
#pragma unroll
    for (int a = 0; a < 2; ++a)
#pragma unroll
        for (int b = 0; b < 2; ++b)
#pragma unroll
            for (int m = 0; m < 4; ++m)
#pragma unroll
                for (int n = 0; n < 2; ++n) acc[a][b][m][n] = (f32x4){0.f, 0.f, 0.f, 0.f};
    bf16x8 At[4][2], B0[2][2], B1[2][2];
    const char* cA = (const char*)g.A + (size_t)cur.pm * tA + cur.ks * kso; const char* cB = (const char*)g.Bt + (size_t)cur.pn * tB + cur.ks * kso;
    PG8_STAGE(PG8_SB(0, 0), cB, voffB); PG8_STAGE(PG8_SB(0, 1), cB + hB, voffB); PG8_STAGE(PG8_SA(0, 0), cA, voffA); PG8_STAGE(PG8_SA(0, 1), cA + hA, voffA);
    if (wr == 1) PG8_BAR;
    PG8_WAIT_V(2); PG8_BAR;
    PG8_STAGE(PG8_SB(1, 0), cB + kstep, voffB); PG8_STAGE(PG8_SA(1, 0), cA + kstep, voffA); PG8_STAGE(PG8_SB(1, 1), cB + hB + kstep, voffB);
    PG8_WAIT_V(6); PG8_BAR;
    for (;;) {
        const bool has_next = S.next(ui + 1, nxt);
        const char* nA = has_next ? (const char*)g.A + (size_t)nxt.pm * tA + nxt.ks * kso : cA; const char* nB = has_next ? (const char*)g.Bt + (size_t)nxt.pn * tB + nxt.ks * kso : cB;
        for (int t = 0; t < nt; t += 2) {
            const bool last = (t == nt - 2);
            const char* a1 = cA + (size_t)(t + 1) * kstep;
            const char* a2 = last ? nA : cA + (size_t)(t + 2) * kstep; const char* b2 = last ? nB : cB + (size_t)(t + 2) * kstep;
            const char* a3 = a2 + kstep; const char* b3 = b2 + kstep;
            PG8_LDB(B0, 0, 0); PG8_LDB(B1, 0, 1); PG8_SCHED; PG8_LDA(At, 0, 0); PG8_STAGE(PG8_SA(1, 1), a1 + hA, voffA);
            PG8_WAIT_V(8); PG8_WAIT_L(0); PG8_BAR; PG8_MMA(0, 0, At, B0); PG8_MMA(0, 1, At, B1); PG8_BAR; PG8_SCHED;
            PG8_LDA(At, 0, 1); PG8_STAGE(PG8_SB(0, 0), b2, voffB); PG8_STAGE(PG8_SB(0, 1), b2 + hB, voffB); PG8_STAGE(PG8_SA(0, 0), a2, voffA);
            PG8_WAIT_V(8); PG8_WAIT_L(0); PG8_BAR; PG8_MMA(1, 0, At, B0); PG8_MMA(1, 1, At, B1); PG8_BAR; PG8_SCHED;
            PG8_LDB(B0, 1, 0); PG8_LDB(B1, 1, 1); PG8_SCHED; PG8_LDA(At, 1, 0); PG8_STAGE(PG8_SA(0, 1), a2 + hA, voffA);
            PG8_WAIT_V(8); PG8_WAIT_L(0); PG8_BAR; PG8_MMA(0, 0, At, B0); PG8_MMA(0, 1, At, B1); PG8_BAR; PG8_SCHED;
            PG8_LDA(At, 1, 1); PG8_STAGE(PG8_SB(1, 0), b3, voffB); PG8_STAGE(PG8_SB(1, 1), b3 + hB, voffB); PG8_STAGE(PG8_SA(1, 0), a3, voffA);
            PG8_WAIT_V(8); PG8_WAIT_L(0); PG8_BAR; PG8_MMA(1, 0, At, B0); PG8_MMA(1, 1, At, B1); PG8_BAR; PG8_SCHED;
        }
        if (wr == 0) PG8_BAR;
        E(acc, cur, wr, wc, fr, fq);
        if (!has_next) break;
#pragma unroll
        for (int a = 0; a < 2; ++a)
#pragma unroll
            for (int b = 0; b < 2; ++b)
#pragma unroll
                for (int m = 0; m < 4; ++m)
#pragma unroll
                    for (int n = 0; n < 2; ++n) acc[a][b][m][n] = (f32x4){0.f, 0.f, 0.f, 0.f};
        cur = nxt; cA = nA; cB = nB; ++ui;
        if (wr == 1) PG8_BAR;
    }
    PG8_WAIT_V(0);
    PG8_BAR;
#undef PG8_SA
#undef PG8_SB
#undef PG8_STAGE
#undef PG8_LDA
#undef PG8_LDB
#undef PG8_MMA
#undef PG8_WAIT_V
#undef PG8_WAIT_L
#undef PG8_BAR
#undef PG8_SCHED
}
}

struct Args { const float* in[24]; float* out; unsigned char* ws; int ph_lo, ph_hi; };
typedef const __attribute__((address_space(4))) Args* KA;
enum { I_X = 0, I_C, I_CTX, I_CCTX, I_ADAW, I_ADAB, I_LNG, I_LNB, I_W1, I_W2, I_WOUT, I_EVWIN, I_EVQKVCONV, I_EVALOG, I_EVDTB, I_EVGDNNORM,
       I_LRUCW, I_LRUCB, I_LRUGW, I_LRUGB, I_LRULAM, I_ODWQKV, I_ODLAM, I_ODSUBLN };
enum { K_PROA = 0, K_PROB, K_PROJ, K_E2, K_E3, K_E4, K_O2, K_O3, K_WOUT, K_LN1, K_MLP1, K_MLP2, K_LN2, K_E2B };
constexpr int N_PHASES = 2 + 10 + 8 + 10 + 8;

__device__ __forceinline__ void transpose_item(const float* W, int K, int N, int Npad, bf16_t* WT, LAS float* scr, int item, int lane) {
    const int nblk = Npad / 32, kb = item / nblk, nb = item % nblk, k0 = 64 * kb, n0 = 32 * nb;
    const int n = n0 + (lane & 31);
    { float wv[32];
#pragma unroll
      for (int i = 0; i < 32; ++i) { const int kk = 2 * i + (lane >> 5); wv[i] = (n < N) ? W[(size_t)(k0 + kk) * N + n] : 0.f; }
#pragma unroll
      for (int i = 0; i < 32; ++i) { const int kk = 2 * i + (lane >> 5); scr[kk * 33 + (lane & 31)] = wv[i]; } }
    LDS_WAIT();
    const int c = lane & 7;
#pragma unroll
    for (int j = 0; j < 4; ++j) { const int nn = (lane >> 3) + 8 * j; const LAS float* s = scr + (8 * c) * 33 + nn;
        u32x4 o; o.x = pk2(s[0 * 33], s[1 * 33]); o.y = pk2(s[2 * 33], s[3 * 33]); o.z = pk2(s[4 * 33], s[5 * 33]); o.w = pk2(s[6 * 33], s[7 * 33]);
        *(u32x4*)(WT + (size_t)(n0 + nn) * K + k0 + 8 * c) = o; }
    LDS_WAIT();
}
__device__ __forceinline__ void conv_weights(KA a, int L, LAS unsigned char* lds, int gw, int NGW, int wave, int lane) {
    LAS float* scr = (LAS float*)(lds + wave * 16384);
    const bool even = (L & 1) == 0; const int j2 = L >> 1;
    const float* Wa = even ? a->in[I_EVWIN] + (size_t)j2 * D * EVN : a->in[I_ODWQKV] + (size_t)j2 * D * ODN;
    const int Na = even ? EVN : ODN, Nap = even ? EVNP : ODN;
    const int IA = (D / 64) * (Nap / 32), IO = (D / 64) * (D / 32), I1 = (D / 64) * (FF / 32), I2 = (FF / 64) * (D / 32);
    bf16_t* WA = (bf16_t*)(a->ws + WS_WA); bf16_t* WO = (bf16_t*)(a->ws + WS_WO); bf16_t* W1 = (bf16_t*)(a->ws + WS_W1); bf16_t* W2 = (bf16_t*)(a->ws + WS_W2);
    for (int it = gw; it < IA + IO + I1 + I2; it += NGW) {
        int r = it;
        if (r < IA) { transpose_item(Wa, D, Na, Nap, WA, scr, r, lane); continue; } r -= IA;
        if (r < IO) { transpose_item(a->in[I_WOUT] + (size_t)L * D * D, D, D, D, WO, scr, r, lane); continue; } r -= IO;
        if (r < I1) { transpose_item(a->in[I_W1] + (size_t)L * D * FF, D, FF, FF, W1, scr, r, lane); continue; } r -= I1;
        transpose_item(a->in[I_W2] + (size_t)L * FF * D, FF, D, D, W2, scr, r, lane);
    }
}

__device__ __forceinline__ void modulate_row_store(const f32x4 (&v)[4], const float* mod_bb, int sidx, bf16_t* urow, int lane) {
#pragma unroll
    for (int j = 0; j < 4; ++j) { const int c = 4 * (lane + 64 * j);
        const f32x4 sh = *(const f32x4*)(mod_bb + sidx * D + c), sc = *(const f32x4*)(mod_bb + (sidx + 1) * D + c);
        const f32x4 u = v[j] * (sc + 1.0f) + sh; u32x2 w; w.x = pk2(u[0], u[1]); w.y = pk2(u[2], u[3]); *(u32x2*)(urow + c) = w; }
}
__device__ __forceinline__ void prologue_b(KA a, int gw, int NGW, int lane) {
    const float* MOD = (const float*)(a->ws + WS_MOD); bf16_t* U = (bf16_t*)(a->ws + WS_U);
    for (int row = gw; row < MT; row += NGW) {
        const bool isctx = row >= ML; const int bb = isctx ? 8 : (row >> 12);
        const float* hp = isctx ? a->in[I_CTX] + (size_t)(row - ML) * D : a->in[I_X] + (size_t)row * D;
        f32x4 v[4];
#pragma unroll
        for (int j = 0; j < 4; ++j) v[j] = *(const f32x4*)(hp + 4 * (lane + 64 * j));
        modulate_row_store(v, MOD + (size_t)(0 * 9 + bb) * 6144, 0, U + (size_t)row * D, lane);
    }
}
__device__ __forceinline__ void ln_row_finish(f32x4 (&v)[4], float s, const float* lg, const float* lb, bf16_t* hp16, float* hp32, bool do_u, const float* mod_bb, int sidx, bf16_t* urow, int lane) {
    const float mean = wave_sum(s) * (1.f / D); float s2 = 0.f;
#pragma unroll
    for (int j = 0; j < 4; ++j) { v[j] = v[j] - mean; s2 += (v[j][0] * v[j][0] + v[j][1] * v[j][1]) + (v[j][2] * v[j][2] + v[j][3] * v[j][3]); }
    const float rstd = 1.0f / sqrtf(wave_sum(s2) * (1.f / D) + EPS);
#pragma unroll
    for (int j = 0; j < 4; ++j) { const int c = 4 * (lane + 64 * j); const f32x4 gg = *(const f32x4*)(lg + c), bbv = *(const f32x4*)(lb + c);
        v[j] = v[j] * rstd * gg + bbv;
        if (hp32) __builtin_nontemporal_store(v[j], (f32x4*)(hp32 + c));
        else { typedef _Float16 h4_t __attribute__((ext_vector_type(4))); const u32x2 w = __builtin_bit_cast(u32x2, __builtin_convertvector(v[j], h4_t)); __builtin_nontemporal_store(w, (u32x2*)(hp16 + c)); } }
    if (do_u) modulate_row_store(v, mod_bb, sidx, urow, lane);
}
typedef _Float16 h16x4 __attribute__((ext_vector_type(4)));
__device__ __forceinline__ f32x4 hf4(const u32x2 w) { return __builtin_convertvector(__builtin_bit_cast(h16x4, w), f32x4); }
__device__ __forceinline__ u32x2 f4h(const f32x4 v) { return __builtin_bit_cast(u32x2, __builtin_convertvector(v, h16x4)); }
__device__ __forceinline__ f32x4 bf4(const u32x2 w) { return (f32x4){__uint_as_float(w.x << 16), __uint_as_float(w.x & 0xffff0000u), __uint_as_float(w.y << 16), __uint_as_float(w.y & 0xffff0000u)}; }
__device__ __forceinline__ void ln_pass(KA a, int L, int which, int nrows, bool do_u, int Lm, int sidx, const bf16_t* T, int npart, int gw, int NGW, int lane) {
    const float* MOD = (const float*)(a->ws + WS_MOD); bf16_t* U = (bf16_t*)(a->ws + WS_U); bf16_t* HC = (bf16_t*)(a->ws + WS_HC);
    const float* lg = a->in[I_LNG] + (size_t)(L * 2 + which) * D; const float* lb = a->in[I_LNB] + (size_t)(L * 2 + which) * D;
    const bool first = (L == 0 && which == 0), fin = (L == 3 && which == 1);
    bf16_t* HL = (bf16_t*)((unsigned char*)a->out + (size_t)64 * MiB); bf16_t* HX = (bf16_t*)(a->ws + WS_HLAST);
    const bf16_t* hin16 = fin ? HX : HL;
    bf16_t* hout16 = (L == 3 && which == 0) ? HX : HL;
    const int nmain = npart > 0 ? ML : nrows;
    if (first) {
        f32x4 hv[4]; u32x2 tw[4];
#define LN_FETCH(HV, TW, row_) do { const int r_ = (row_); const float* hin_ = a->in[I_X] + (size_t)r_ * D; const bf16_t* tp_ = T + (size_t)r_ * D; \
        _Pragma("unroll") for (int j = 0; j < 4; ++j) { const int c = 4 * (lane + 64 * j); HV[j] = __builtin_nontemporal_load((const f32x4*)(hin_ + c)); TW[j] = __builtin_nontemporal_load((const u32x2*)(tp_ + c)); } } while (0)
        if (gw < nmain) LN_FETCH(hv, tw, gw);
#pragma unroll 2
        for (int row = gw; row < nmain; row += NGW) {
            f32x4 hn[4]; u32x2 tn[4]; const int nrow = row + NGW < nmain ? row + NGW : row;
            LN_FETCH(hn, tn, nrow);
            f32x4 v[4]; float s = 0.f;
#pragma unroll
            for (int j = 0; j < 4; ++j) { v[j] = hv[j] * ALPHA + bf4(tw[j]); s += (v[j][0] + v[j][1]) + (v[j][2] + v[j][3]); }
            ln_row_finish(v, s, lg, lb, hout16 + (size_t)row * D, nullptr, do_u, MOD + (size_t)(Lm * 9 + (row >> 12)) * 6144, sidx, U + (size_t)row * D, lane);
#pragma unroll
            for (int j = 0; j < 4; ++j) { hv[j] = hn[j]; tw[j] = tn[j]; }
        }
#undef LN_FETCH
    } else {
        u32x2 hv[4], tw[4];
#define LN_FETCH(HV, TW, row_) do { const int r_ = (row_); const bf16_t* hin_ = hin16 + (size_t)r_ * D; const bf16_t* tp_ = T + (size_t)r_ * D; \
        _Pragma("unroll") for (int j = 0; j < 4; ++j) { const int c = 4 * (lane + 64 * j); HV[j] = __builtin_nontemporal_load((const u32x2*)(hin_ + c)); TW[j] = __builtin_nontemporal_load((const u32x2*)(tp_ + c)); } } while (0)
        if (gw < nmain) LN_FETCH(hv, tw, gw);
#pragma unroll 2
        for (int row = gw; row < nmain; row += NGW) {
            u32x2 hn[4], tn[4]; const int nrow = row + NGW < nmain ? row + NGW : row;
            LN_FETCH(hn, tn, nrow);
            f32x4 v[4]; float s = 0.f;
#pragma unroll
            for (int j = 0; j < 4; ++j) { v[j] = hf4(hv[j]) * ALPHA + bf4(tw[j]); s += (v[j][0] + v[j][1]) + (v[j][2] + v[j][3]); }
            ln_row_finish(v, s, lg, lb, hout16 + (size_t)row * D, fin ? a->out + (size_t)row * D : nullptr, do_u, MOD + (size_t)(Lm * 9 + (row >> 12)) * 6144, sidx, U + (size_t)row * D, lane);
#pragma unroll
            for (int j = 0; j < 4; ++j) { hv[j] = hn[j]; tw[j] = tn[j]; }
        }
#undef LN_FETCH
    }
    if (npart > 0) {
        const bf16_t* PART = (const bf16_t*)(a->ws + WS_PART);
        for (int row = ML + gw; row < nrows; row += NGW) {
            const size_t rc = (size_t)(row - ML); bf16_t* hp = HC + rc * D;
            f32x4 v[4]; float s = 0.f;
#pragma unroll
            for (int j = 0; j < 4; ++j) { const int c = 4 * (lane + 64 * j); f32x4 tv = {0.f, 0.f, 0.f, 0.f};
                for (int ks = 0; ks < npart; ++ks) tv += bf4(*(const u32x2*)(PART + (size_t)ks * MC * D + rc * D + c));
                const f32x4 hh = first ? *(const f32x4*)(a->in[I_CTX] + rc * D + c) : hf4(*(const u32x2*)(hp + c));
                v[j] = hh * ALPHA + tv; s += (v[j][0] + v[j][1]) + (v[j][2] + v[j][3]); }
            ln_row_finish(v, s, lg, lb, hp, nullptr, do_u, MOD + (size_t)(Lm * 9 + 8) * 6144, sidx, U + (size_t)row * D, lane);
        }
    }
}

__device__ __forceinline__ void prologue_a(KA a, LAS unsigned char* lds, int bid, int G, int tid, int wave, int lane) {
    float* MOD = (float*)(a->ws + WS_MOD); float* MISC = (float*)(a->ws + WS_MISC);
    LAS float* sv = (LAS float*)lds;
    LAS float* red = (LAS float*)(lds + 9 * 1024 * 4);
    for (int i = tid; i < 9 * 1024; i += 512) { const int bb = i >> 10, k = i & 1023; const float v = bb < 8 ? a->in[I_C][bb * 1024 + k] : a->in[I_CCTX][k]; sv[i] = siluf_(v); }
    __syncthreads();
    for (int unit = bid; unit < 192; unit += G) {
        const int L = unit / 48, cb = unit % 48, col = tid & 127, kq = tid >> 7;
        const float* w = a->in[I_ADAW] + (size_t)L * D * 6144 + cb * 128 + col;
        float acc[9];
#pragma unroll
        for (int bb = 0; bb < 9; ++bb) acc[bb] = 0.f;
        for (int k0 = kq * 256; k0 < kq * 256 + 256; k0 += 16) { float wv[16];
#pragma unroll
            for (int i = 0; i < 16; ++i) wv[i] = w[(size_t)(k0 + i) * 6144];
#pragma unroll
            for (int i = 0; i < 16; ++i)
#pragma unroll
                for (int bb = 0; bb < 9; ++bb) acc[bb] += sv[bb * 1024 + k0 + i] * wv[i]; }
#pragma unroll
        for (int bb = 0; bb < 9; ++bb) red[(kq * 9 + bb) * 128 + col] = acc[bb];
        __syncthreads();
        for (int i = tid; i < 9 * 128; i += 512) { const int bb = i >> 7, cc = i & 127;
            float s = (red[(0 * 9 + bb) * 128 + cc] + red[(1 * 9 + bb) * 128 + cc]) + (red[(2 * 9 + bb) * 128 + cc] + red[(3 * 9 + bb) * 128 + cc]);
            s += a->in[I_ADAB][L * 6144 + cb * 128 + cc]; MOD[(size_t)(L * 9 + bb) * 6144 + cb * 128 + cc] = s; }
        __syncthreads();
    }
    if (bid == G - 1) {
        if (tid < 16) {
            double th = 1.0; for (int j = 0; j < tid; ++j) th *= 0.56234132519034908;
            const double t2 = th * th; double sn = th, term = th, cs = 1.0, tc = 1.0;
            for (int k = 1; k < 12; ++k) { tc *= -t2 / ((2.0 * k - 1.0) * (2.0 * k)); cs += tc; term *= -t2 / ((2.0 * k) * (2.0 * k + 1.0)); sn += term; }
            double c = 1.0, s = 0.0;
            for (int p = 0; p < 64; ++p) { MISC[64 + p * 16 + tid] = (float)c; MISC[1088 + p * 16 + tid] = (float)s; const double c2 = c * cs - s * sn, s2 = s * cs + c * sn; c = c2; s = s2; }
        }
        if (tid >= 64 && tid < 66) { const int j = tid - 64; const float* lv = a->in[I_ODLAM] + j * 256; float d0 = 0.f, d1 = 0.f;
            for (int i = 0; i < 64; ++i) { d0 += lv[i] * lv[64 + i]; d1 += lv[128 + i] * lv[192 + i]; }
            const float li = 0.8f - 0.6f * expf(-0.3f * (float)(2 * j + 1)); MISC[j] = expf(d0) - expf(d1) + li; MISC[2 + j] = li; }
    }
    __syncthreads();
    conv_weights(a, 0, lds, bid * 8 + wave, G * 8, wave, lane);
}

__device__ __forceinline__ void attn_prep(KA a, LAS unsigned char* lds, int bid, int G, int tid) {
    bf16_t* P = (bf16_t*)(a->ws + WS_P); bf16_t* VT = (bf16_t*)(a->ws + WS_V); const float* MISC = (const float*)(a->ws + WS_MISC);
    const float* tabc = MISC + 64; const float* tabs = MISC + 1088;
    constexpr int VP = 2064;
    for (int u = bid; u < 2 * NB * 68; u += G) {
        const bool vpart = u >= NB * 68; const int uu = vpart ? u - NB * 68 : u;
        const int b = uu / 68, tl = uu % 68; const bool isctx = tl < 4; const int t0 = isctx ? tl * 64 : (tl - 4) * 64;
        const int rowbase = isctx ? ML + b * CTXL + t0 : b * SEQ + t0; const int kv0 = isctx ? t0 : CTXL + t0;
        if (!vpart) {
#pragma unroll 1
            for (int half = 0; half < 2; ++half) {
                u32x4 r1[4], r2[4], r3[4], r4[4];
#pragma unroll
                for (int k = 0; k < 4; ++k) { const int it = tid + 512 * (4 * half + k); const int r = it >> 6, rem = it & 63, vec = rem >> 1, part = rem & 1;
                    const bf16_t* p = P + (size_t)(rowbase + r) * ODN + vec * 64 + part * 8;
                    r1[k] = *(const u32x4*)(p); r2[k] = *(const u32x4*)(p + 16); r3[k] = *(const u32x4*)(p + 32); r4[k] = *(const u32x4*)(p + 48); }
#pragma unroll
                for (int k = 0; k < 4; ++k) { const int it = tid + 512 * (4 * half + k); const int r = it >> 6, rem = it & 63, vec = rem >> 1, part = rem & 1; const bool isq = vec < 16;
                    if (isctx && !isq) continue;
                    bf16_t* p = P + (size_t)(rowbase + r) * ODN + vec * 64 + part * 8;
                    float t1[8], t2[8], t3[8], t4[8];
                    unpack8(r1[k], t1); unpack8(r2[k], t2); unpack8(r3[k], t3); unpack8(r4[k], t4);
                    const float sc = isq ? QSCALE : 1.0f;
                    if (!isctx) {
                        const int pos = t0 + r, rp = pos >> 6, cp = pos & 63;
#pragma unroll
                        for (int j = 0; j < 8; ++j) { const int jj = part * 8 + j;
                            const float cr = tabc[rp * 16 + jj], sr = tabs[rp * 16 + jj], cc = tabc[cp * 16 + jj], ss = tabs[cp * 16 + jj];
                            const float o1 = t1[j] * cr - t2[j] * sr, o2 = t2[j] * cr + t1[j] * sr, o3 = t3[j] * cc - t4[j] * ss, o4 = t4[j] * cc + t3[j] * ss;
                            t1[j] = o1 * sc; t2[j] = o2 * sc; t3[j] = o3 * sc; t4[j] = o4 * sc; }
                    } else {
#pragma unroll
                        for (int j = 0; j < 8; ++j) { t1[j] *= sc; t2[j] *= sc; t3[j] *= sc; t4[j] *= sc; }
                    }
                    *(u32x4*)(p) = pack8(t1); *(u32x4*)(p + 16) = pack8(t2); *(u32x4*)(p + 32) = pack8(t3); *(u32x4*)(p + 48) = pack8(t4);
                }
            }
        } else {
            { u32x4 rv[16];
#pragma unroll
              for (int k = 0; k < 16; ++k) { const int id = tid + 512 * k; rv[k] = *(const u32x4*)(P + (size_t)(rowbase + (id >> 7)) * ODN + 2048 + (id & 127) * 8); }
#pragma unroll
              for (int k = 0; k < 16; ++k) { const int id = tid + 512 * k; *(LAS u32x4*)(lds + (id >> 7) * VP + (id & 127) * 16) = rv[k]; } }
            __syncthreads();
#pragma unroll 4
            for (int k = 0; k < 16; ++k) { const int oc = tid + 512 * k; const int col = oc & 1023, c = oc >> 10;
                unsigned w[4];
#pragma unroll
                for (int j = 0; j < 4; ++j) { const unsigned lo = *(const LAS bf16_t*)(lds + (8 * c + 2 * j) * VP + col * 2), hi = *(const LAS bf16_t*)(lds + (8 * c + 2 * j + 1) * VP + col * 2); w[j] = lo | (hi << 16); }
                u32x4 o; o.x = w[0]; o.y = w[1]; o.z = w[2]; o.w = w[3];
                *(u32x4*)(VT + ((size_t)(b * 8 * 128 + col)) * NKV + kv0 + 8 * c) = o; }
            __syncthreads();
        }
    }
}

constexpr int AT_KB = 64 * 272, AT_VB = 128 * 144, AT_BUF = AT_KB + AT_VB, AT_OX = 0;
static_assert(3 * AT_BUF <= LDS_BYTES - 16 && 128 * 132 * 4 <= 3 * AT_BUF, "attention lds");
__device__ __forceinline__ void at_qk(const LAS unsigned char* Kb, const bf16x8 (&qf)[4], f32x16& s0, f32x16& s1, int m, int krow, int hi) {
#pragma unroll
    for (int r = 0; r < 16; ++r) { s0[r] = 0.f; s1[r] = 0.f; }
#pragma unroll
    for (int ks = 0; ks < 4; ++ks) {
        const bf16x8 a0 = *(const LAS bf16x8*)(Kb + krow * 272 + (m * 64 + ks * 16 + hi * 8) * 2);
        const bf16x8 a1 = *(const LAS bf16x8*)(Kb + (krow + 32) * 272 + (m * 64 + ks * 16 + hi * 8) * 2);
        s0 = __builtin_amdgcn_mfma_f32_32x32x16_bf16(a0, qf[ks], s0, 0, 0, 0);
        s1 = __builtin_amdgcn_mfma_f32_32x32x16_bf16(a1, qf[ks], s1, 0, 0, 0);
    }
}
template <bool HAS_NEXT>
__device__ __forceinline__ void at_step(const LAS unsigned char* Kn, const LAS unsigned char* Vc, const bf16x8 (&qf)[4], f32x16 (&o)[4], f32x16& s0, f32x16& s1, f32x16& negm, float& mrun, float& lsum, int m, int krow, int r32, int hi) {
    f32x16 n0, n1;
    float ps = 0.f;
#pragma unroll
    for (int ks = 0; ks < 4; ++ks) {
        if (HAS_NEXT) {
            const bf16x8 a0 = *(const LAS bf16x8*)(Kn + krow * 272 + (m * 64 + ks * 16 + hi * 8) * 2);
            const bf16x8 a1 = *(const LAS bf16x8*)(Kn + (krow + 32) * 272 + (m * 64 + ks * 16 + hi * 8) * 2);
            if (ks == 0) { n0 = __builtin_amdgcn_mfma_f32_32x32x16_bf16(a0, qf[0], negm, 0, 0, 0); n1 = __builtin_amdgcn_mfma_f32_32x32x16_bf16(a1, qf[0], negm, 0, 0, 0); }
            else { n0 = __builtin_amdgcn_mfma_f32_32x32x16_bf16(a0, qf[ks], n0, 0, 0, 0); n1 = __builtin_amdgcn_mfma_f32_32x32x16_bf16(a1, qf[ks], n1, 0, 0, 0); }
        }
#pragma unroll
        for (int r = 4 * ks; r < 4 * ks + 4; ++r) { s0[r] = __builtin_amdgcn_exp2f(s0[r]); s1[r] = __builtin_amdgcn_exp2f(s1[r]); ps += s0[r] + s1[r]; }
    }
    lsum += ps;
    bf16x8 pb[4];
    { u32x4 w;
      w.x = pk2(s0[0], s0[1]); w.y = pk2(s0[2], s0[3]); w.z = pk2(s0[4], s0[5]); w.w = pk2(s0[6], s0[7]); pb[0] = __builtin_bit_cast(bf16x8, w);
      w.x = pk2(s0[8], s0[9]); w.y = pk2(s0[10], s0[11]); w.z = pk2(s0[12], s0[13]); w.w = pk2(s0[14], s0[15]); pb[1] = __builtin_bit_cast(bf16x8, w);
      w.x = pk2(s1[0], s1[1]); w.y = pk2(s1[2], s1[3]); w.z = pk2(s1[4], s1[5]); w.w = pk2(s1[6], s1[7]); pb[2] = __builtin_bit_cast(bf16x8, w);
      w.x = pk2(s1[8], s1[9]); w.y = pk2(s1[10], s1[11]); w.z = pk2(s1[12], s1[13]); w.w = pk2(s1[14], s1[15]); pb[3] = __builtin_bit_cast(bf16x8, w); }
    float mx = -3.0e38f;
#pragma unroll
    for (int db = 0; db < 4; ++db) {
#pragma unroll
        for (int i = 0; i < 4; ++i) {
            const bf16x8 av = *(const LAS bf16x8*)(Vc + (32 * db + r32) * 144 + (16 * i + 8 * hi) * 2);
            o[db] = __builtin_amdgcn_mfma_f32_32x32x16_bf16(av, pb[i], o[db], 0, 0, 0);
        }
        if (HAS_NEXT) {
#pragma unroll
            for (int r = 4 * db; r < 4 * db + 4; ++r) mx = fmaxf(mx, fmaxf(n0[r], n1[r]));
        }
    }
    if (HAS_NEXT) {
        mx = xhalf_max(mx);
        if (__any(mx > 8.0f)) {
            const float delta = (mx > 8.0f) ? mx : 0.f; const float al = __builtin_amdgcn_exp2f(-delta); lsum *= al;
#pragma unroll
            for (int db = 0; db < 4; ++db)
#pragma unroll
                for (int r = 0; r < 16; ++r) o[db][r] *= al;
            mrun += delta;
#pragma unroll
            for (int r = 0; r < 16; ++r) { n0[r] -= delta; n1[r] -= delta; negm[r] = -mrun; }
        }
        s0 = n0; s1 = n1;
    }
}
__device__ __forceinline__ void attn_phase(KA a, int L, LAS unsigned char* lds, int bid, int G, int tid, int wave, int lane, bool do_store) {
    bf16_t* P = (bf16_t*)(a->ws + WS_P); const bf16_t* VT = (const bf16_t*)(a->ws + WS_V); const float* MISC = (const float*)(a->ws + WS_MISC);
    const int j2 = L >> 1; const float lam = MISC[j2], lam_init = MISC[2 + j2];
    const float* subln = a->in[I_ODSUBLN] + j2 * 128;
    const int nunits = 2048 + (L == 1 ? 128 : 0);
    const int m = wave & 1, qs = wave >> 1, r32 = lane & 31, hi = lane >> 5;
    const int krow = (r32 & 0x13) | ((r32 & 4) << 1) | ((r32 & 8) >> 1);
    for (int u = bid; u < nunits; u += G) {
        int bh, qb; const bool isctx = u >= 2048;
        if (!isctx) { bh = (u >> 8) * 8 + (u & 7); qb = (u >> 3) & 31; } else { const int u2 = u - 2048; bh = u2 >> 1; qb = u2 & 1; }
        const int b = bh >> 3, h = bh & 7;
        const int qrow = (isctx ? ML + b * CTXL : b * SEQ) + qb * 128 + qs * 32 + r32;
        const int ntiles = isctx ? 4 : 68;
        bf16x8 qf[4];
#pragma unroll
        for (int ks = 0; ks < 4; ++ks) qf[ks] = *(const bf16x8*)(P + (size_t)qrow * ODN + h * 128 + m * 64 + ks * 16 + hi * 8);
        const int kr0 = tid >> 4, kc = tid & 15;
        const int vd0 = tid >> 3, vc = tid & 7;
        const bf16_t* vsrc0 = VT + ((size_t)(bh * 128 + vd0)) * NKV + 8 * vc; const bf16_t* vsrc1 = vsrc0 + (size_t)64 * NKV;
        u32x4 rk0, rk1, rv0, rv1;
#define AT_LOAD(t) do { const int kv_ = 64 * (t) + kr0; const int g0_ = kv_ < CTXL ? ML + b * CTXL + kv_ : b * SEQ + kv_ - CTXL; const int kv1_ = kv_ + 32; const int g1_ = kv1_ < CTXL ? ML + b * CTXL + kv1_ : b * SEQ + kv1_ - CTXL; \
        rk0 = *(const u32x4*)(P + (size_t)g0_ * ODN + 1024 + h * 128 + kc * 8); rk1 = *(const u32x4*)(P + (size_t)g1_ * ODN + 1024 + h * 128 + kc * 8); \
        rv0 = *(const u32x4*)(vsrc0 + 64 * (t)); rv1 = *(const u32x4*)(vsrc1 + 64 * (t)); } while (0)
#define AT_STORE(boff) do { LAS unsigned char* kb_ = lds + (boff); LAS unsigned char* vb_ = kb_ + AT_KB; \
        *(LAS u32x4*)(kb_ + kr0 * 272 + kc * 16) = rk0; *(LAS u32x4*)(kb_ + (kr0 + 32) * 272 + kc * 16) = rk1; \
        *(LAS u32x4*)(vb_ + vd0 * 144 + vc * 16) = rv0; *(LAS u32x4*)(vb_ + (vd0 + 64) * 144 + vc * 16) = rv1; } while (0)
        { AT_LOAD(0); const u32x4 k0_ = rk0, k1_ = rk1, v0_ = rv0, v1_ = rv1;
          AT_LOAD(1);
          { LAS unsigned char* kb_ = lds; LAS unsigned char* vb_ = kb_ + AT_KB;
            *(LAS u32x4*)(kb_ + kr0 * 272 + kc * 16) = k0_; *(LAS u32x4*)(kb_ + (kr0 + 32) * 272 + kc * 16) = k1_;
            *(LAS u32x4*)(vb_ + vd0 * 144 + vc * 16) = v0_; *(LAS u32x4*)(vb_ + (vd0 + 64) * 144 + vc * 16) = v1_; }
          AT_STORE(AT_BUF); }
        __syncthreads();
        f32x16 o[4];
#pragma unroll
        for (int db = 0; db < 4; ++db)
#pragma unroll
            for (int r = 0; r < 16; ++r) o[db][r] = 0.f;
        f32x16 s0, s1;
        at_qk(lds, qf, s0, s1, m, krow, hi);
        float mrun, lsum = 0.f;
        { float mx = fmaxf(s0[0], s1[0]);
#pragma unroll
          for (int r = 1; r < 16; ++r) mx = fmaxf(mx, fmaxf(s0[r], s1[r]));
          mrun = xhalf_max(mx); }
        f32x16 negm;
#pragma unroll
        for (int r = 0; r < 16; ++r) { s0[r] -= mrun; s1[r] -= mrun; negm[r] = -mrun; }
        int bc = 0, bn = AT_BUF, bs = 2 * AT_BUF;
        for (int t = 0; t + 1 < ntiles; ++t) {
            const bool stage = t + 2 < ntiles;
            if (stage) AT_LOAD(t + 2);
            at_step<true>(lds + bn, lds + bc + AT_KB, qf, o, s0, s1, negm, mrun, lsum, m, krow, r32, hi);
            if (stage) AT_STORE(bs);
            __syncthreads();
            const int tmp = bc; bc = bn; bn = bs; bs = tmp;
        }
        at_step<false>(lds, lds + bc + AT_KB, qf, o, s0, s1, negm, mrun, lsum, m, krow, r32, hi);
        __syncthreads();
#undef AT_LOAD
#undef AT_STORE
        lsum = xhalf_sum(lsum);
        const float inv = 1.0f / lsum;
        LAS float* ox = (LAS float*)(lds + AT_OX) + (qs * 32 + r32) * 132;
        if (m == 1) {
#pragma unroll
            for (int db = 0; db < 4; ++db)
#pragma unroll
                for (int r4 = 0; r4 < 4; ++r4) { f32x4 v = {o[db][4 * r4] * inv, o[db][4 * r4 + 1] * inv, o[db][4 * r4 + 2] * inv, o[db][4 * r4 + 3] * inv};
                    *(LAS f32x4*)(ox + 32 * db + 8 * r4 + 4 * hi) = v; }
        }
        __syncthreads();
        if (m == 0) {
            float ssq = 0.f;
#pragma unroll
            for (int db = 0; db < 4; ++db)
#pragma unroll
                for (int r4 = 0; r4 < 4; ++r4) { const f32x4 v1 = *(const LAS f32x4*)(ox + 32 * db + 8 * r4 + 4 * hi);
#pragma unroll
                    for (int e = 0; e < 4; ++e) { const float v = o[db][4 * r4 + e] * inv - lam * v1[e]; o[db][4 * r4 + e] = v; ssq += v * v; } }
            ssq = xhalf_sum(ssq);
            const float sc = (1.0f / sqrtf(ssq * (1.f / 128.f) + EPS)) * (1.0f - lam_init);
            bf16_t* op = P + (size_t)qrow * ODN + h * 128;
#pragma unroll
            for (int db = 0; db < 4; ++db)
#pragma unroll
                for (int r4 = 0; r4 < 4; ++r4) { const int dv = 32 * db + 8 * r4 + 4 * hi; const f32x4 g4 = *(const f32x4*)(subln + dv);
                    u32x2 w; w.x = pk2(o[db][4 * r4] * sc * g4[0], o[db][4 * r4 + 1] * sc * g4[1]); w.y = pk2(o[db][4 * r4 + 2] * sc * g4[2], o[db][4 * r4 + 3] * sc * g4[3]);
                    if (do_store) *(u32x2*)(op + dv) = w; }
        }
        __syncthreads();
    }
}

__device__ __forceinline__ void gdn_prep(KA a, int L, LAS unsigned char* lds, int gw, int NGW, int tid, int lane) {
    const int j2 = L >> 1;
    const bf16_t* P = (const bf16_t*)(a->ws + WS_P);
    bf16_t* QN = (bf16_t*)(a->ws + WS_U); bf16_t* KN = QN + (size_t)MT * 512; bf16_t* V = (bf16_t*)(a->ws + WS_V);
    float* Gb = (float*)(a->ws + WS_G); float* Bt = (float*)(a->ws + WS_BT);
    const float* cw = a->in[I_EVQKVCONV] + (size_t)j2 * 4 * 1536;
    LAS float* cwl = (LAS float*)lds;
    for (int i = tid; i < 4 * 1536 / 4; i += 512) *(LAS f32x4*)(cwl + 4 * i) = *(const f32x4*)(cw + 4 * i);
    __syncthreads();
    float alog = 0.f, dtb = 0.f;
    if (lane < 8) { alog = -expf(a->in[I_EVALOG][j2 * 8 + lane]); dtb = a->in[I_EVDTB][j2 * 8 + lane]; }
    for (int blk = gw; blk < MT / 17; blk += NGW) {
        const int r0 = 17 * blk;
        u32x4 R[20][3]; unsigned ab[17];
#define GP_LOAD(k_) do { const int row_ = r0 - 2 + (k_); const bool ok_ = row_ >= 0 && row_ < MT; \
        _Pragma("unroll") for (int p = 0; p < 3; ++p) R[k_][p] = ok_ ? *(const u32x4*)(P + (size_t)row_ * EVNP + p * 512 + 8 * lane) : (u32x4){0u, 0u, 0u, 0u}; } while (0)
#pragma unroll
        for (int k = 0; k < 6; ++k) GP_LOAD(k);
#pragma unroll
        for (int i = 0; i < 17; ++i) ab[i] = lane < 16 ? (unsigned)P[(size_t)(r0 + i) * EVNP + 2048 + lane] : 0u;
#pragma unroll
        for (int i = 0; i < 17; ++i) {
            if (i + 6 < 20) GP_LOAD(i + 6);
            const int row = r0 + i;
            const bool isctx = row >= ML; const int t = isctx ? ((row - ML) & (CTXL - 1)) : (row & (SEQ - 1)); const int len = isctx ? CTXL : SEQ;
            float val[3][8];
#pragma unroll
            for (int p = 0; p < 3; ++p) {
                float acc[8];
#pragma unroll
                for (int e = 0; e < 8; ++e) acc[e] = 0.f;
#pragma unroll
                for (int j = 0; j < 4; ++j) { const int tt = t + j - 2;
                    if (tt >= 0 && tt < len) { float x[8]; unpack8(R[i + j][p], x);
                        const f32x4 w0 = *(const LAS f32x4*)(cwl + j * 1536 + p * 512 + 8 * lane), w1 = *(const LAS f32x4*)(cwl + j * 1536 + p * 512 + 8 * lane + 4);
#pragma unroll
                        for (int e = 0; e < 8; ++e) acc[e] += (e < 4 ? w0[e & 3] : w1[e & 3]) * x[e]; } }
#pragma unroll
                for (int e = 0; e < 8; ++e) val[p][e] = fsilu(acc[e]);
            }
            float sq = 0.f, sk = 0.f;
#pragma unroll
            for (int e = 0; e < 8; ++e) { sq += val[0][e] * val[0][e]; sk += val[1][e] * val[1][e]; }
            sq = rowsum16(sq); sk = rowsum16(sk);
            const float rq = (1.0f / sqrtf(sq + EPS)) * 0.08838834764831845f, rk = 1.0f / sqrtf(sk + EPS);
#pragma unroll
            for (int e = 0; e < 8; ++e) { val[0][e] *= rq; val[1][e] *= rk; }
            *(u32x4*)(QN + (size_t)row * 512 + 8 * lane) = pack8(val[0]);
            *(u32x4*)(KN + (size_t)row * 512 + 8 * lane) = pack8(val[1]);
            *(u32x4*)(V + (size_t)row * 512 + 8 * lane) = pack8(val[2]);
            if (lane < 8) Gb[(size_t)row * 8 + lane] = alog * softplusf_(bf2f(ab[i]) + dtb);
            else if (lane < 16) Bt[(size_t)row * 8 + lane - 8] = sigmoidf_(bf2f(ab[i]));
        }
#undef GP_LOAD
    }
    __syncthreads();
}

constexpr int LR_XIN = 0, LR_XC = 17152, LR_XCB = LR_XC + 16384, LR_AU = LR_XCB + 9216, LR_WT = LR_AU + 65536, LR_END = LR_WT + 36864;
static_assert(LR_END <= LDS_BYTES, "lru lds");
template <int PASS>
__device__ __forceinline__ void lru_units(KA a, int L, LAS unsigned char* lds, int bid, int G, int tid) {
    const int j2 = L >> 1;
    const bf16_t* P = (const bf16_t*)(a->ws + WS_P); bf16_t* U = (bf16_t*)(a->ws + WS_U);
    float* TOTA = (float*)(a->ws + WS_TOTA); float* TOTH = (float*)(a->ws + WS_TOTH); const float* CARRY = (const float*)(a->ws + WS_CARRY);
    const float* cw = a->in[I_LRUCW] + (size_t)j2 * 4 * 512; const float* cb = a->in[I_LRUCB] + (size_t)j2 * 512;
    const float* gw_ = a->in[I_LRUGW] + (size_t)j2 * 2 * 2 * 8 * 64 * 64; const float* gb_ = a->in[I_LRUGB] + (size_t)j2 * 2 * 2 * 512; const float* lam_ = a->in[I_LRULAM] + (size_t)j2 * 2 * 512;
    LAS float* xin = (LAS float*)(lds + LR_XIN);
    LAS float* xc = (LAS float*)(lds + LR_XC);
    LAS bf16_t* xcb = (LAS bf16_t*)(lds + LR_XCB);
    LAS float* au = (LAS float*)(lds + LR_AU);
    LAS bf16_t* wt = (LAS bf16_t*)(lds + LR_WT);
    LAS float* sg = (LAS float*)(lds + LR_XIN);
    const int lane = tid & 63, w = tid >> 6, mt = w & 3, nh = w >> 2, fr = lane & 15, fq = lane >> 4;
    int cur_nblk = -1;
    const int cc = tid & 63;
    float cbv = 0.f, cwv[4] = {0.f, 0.f, 0.f, 0.f};
    float gbr[2][2], gbi[2][2], gsp[2][2];
#pragma unroll
    for (int q = 0; q < 2; ++q)
#pragma unroll
        for (int r = 0; r < 2; ++r) { gbr[q][r] = 0.f; gbi[q][r] = 0.f; gsp[q][r] = 0.f; }
    const int rrA = tid >> 3, c8 = (tid & 7) * 8, rrB = 64 + (tid >> 3);
    u32x4 xa = {0u, 0u, 0u, 0u}, xb = {0u, 0u, 0u, 0u}, gt4 = {0u, 0u, 0u, 0u};
#define LR_FETCH(XA, XB, GT, u_) do { const int nb_ = (u_) & 7, cs_ = (u_) >> 3, b_ = cs_ / 68, sl_ = cs_ % 68; const bool ic_ = sl_ < 4; const int t0_ = ic_ ? sl_ * 64 : (sl_ - 4) * 64; \
        const int len_ = ic_ ? CTXL : SEQ; const int rb_ = ic_ ? ML + b_ * CTXL : b_ * SEQ; const int ta_ = t0_ + rrA - 2, tb_ = t0_ + rrB - 2; \
        XA = (u32x4){0u, 0u, 0u, 0u}; XB = (u32x4){0u, 0u, 0u, 0u}; \
        if (ta_ >= 0 && ta_ < len_) XA = *(const u32x4*)(P + (size_t)(rb_ + ta_) * EVNP + 2064 + nb_ * 64 + c8); \
        if (tid < 24 && tb_ < len_) XB = *(const u32x4*)(P + (size_t)(rb_ + tb_) * EVNP + 2064 + nb_ * 64 + c8); \
        if (PASS == 2) GT = *(const u32x4*)(P + (size_t)(rb_ + t0_ + rrA) * EVNP + 2576 + nb_ * 64 + c8); } while (0)
    if (bid < NB * 68 * 8) LR_FETCH(xa, xb, gt4, bid);
    for (int u = bid; u < NB * 68 * 8; u += G) {
        const int nblk = u & 7, cs = u >> 3, b = cs / 68, slot = cs % 68; const bool isctx = slot < 4; const int t0 = isctx ? slot * 64 : (slot - 4) * 64;
        const int rowbase = isctx ? ML + b * CTXL : b * SEQ;
        u32x4 nxa, nxb, ngt = {0u, 0u, 0u, 0u};
        { const int un = u + G < NB * 68 * 8 ? u + G : u; LR_FETCH(nxa, nxb, ngt, un); }
        if (nblk != cur_nblk) {
            for (int i0 = tid; i0 < 4 * 4096; i0 += 512 * 8) { float wv[8];
#pragma unroll
                for (int k = 0; k < 8; ++k) { const int i = i0 + 512 * k; wv[k] = gw_[((size_t)((i >> 12) * 8 + nblk)) * 4096 + (i & 4095)]; }
#pragma unroll
                for (int k = 0; k < 8; ++k) { const int i = i0 + 512 * k; const int dg = i >> 12, c = (i >> 6) & 63, d = i & 63; wt[(dg * 64 + d) * 72 + c] = (bf16_t)f2bf(wv[k]); } }
            cbv = cb[nblk * 64 + cc];
#pragma unroll
            for (int dir = 0; dir < 2; ++dir)
#pragma unroll
                for (int nt = 0; nt < 2; ++nt) { const int ch = nblk * 64 + 32 * nh + 16 * nt + fr;
                    gbr[dir][nt] = gb_[(dir * 2 + 0) * 512 + ch]; gbi[dir][nt] = gb_[(dir * 2 + 1) * 512 + ch]; gsp[dir][nt] = softplusf_(-lam_[dir * 512 + ch]); }
#pragma unroll
            for (int j = 0; j < 4; ++j) cwv[j] = cw[j * 512 + nblk * 64 + cc];
            cur_nblk = nblk;
        }
        { float f[8]; unpack8(xa, f); *(LAS f32x4*)(xin + rrA * 64 + c8) = (f32x4){f[0], f[1], f[2], f[3]}; *(LAS f32x4*)(xin + rrA * 64 + c8 + 4) = (f32x4){f[4], f[5], f[6], f[7]};
          if (tid < 24) { unpack8(xb, f); *(LAS f32x4*)(xin + rrB * 64 + c8) = (f32x4){f[0], f[1], f[2], f[3]}; *(LAS f32x4*)(xin + rrB * 64 + c8 + 4) = (f32x4){f[4], f[5], f[6], f[7]}; } }
        __syncthreads();
#pragma unroll
        for (int k = 0; k < 8; ++k) { const int t = (tid >> 6) + 8 * k;
            float v = cbv;
#pragma unroll
            for (int j = 0; j < 4; ++j) v += cwv[j] * xin[(t + j) * 64 + cc];
            xc[t * 64 + cc] = v; xcb[t * 72 + cc] = (bf16_t)f2bf(v); }
        __syncthreads();
        {
            f32x4 acc[4][2];
#pragma unroll
            for (int dg = 0; dg < 4; ++dg)
#pragma unroll
                for (int nt = 0; nt < 2; ++nt) acc[dg][nt] = (f32x4){0.f, 0.f, 0.f, 0.f};
            bf16x8 af[2];
#pragma unroll
            for (int ks = 0; ks < 2; ++ks) af[ks] = *(const LAS bf16x8*)(xcb + (16 * mt + fr) * 72 + 32 * ks + 8 * fq);
#pragma unroll
            for (int dg = 0; dg < 4; ++dg)
#pragma unroll
                for (int nt = 0; nt < 2; ++nt)
#pragma unroll
                    for (int ks = 0; ks < 2; ++ks) { const bf16x8 bfm = *(const LAS bf16x8*)(wt + (dg * 64 + 32 * nh + 16 * nt + fr) * 72 + 32 * ks + 8 * fq);
                        acc[dg][nt] = __builtin_amdgcn_mfma_f32_16x16x32_bf16(af[ks], bfm, acc[dg][nt], 0, 0, 0); }
#pragma unroll
            for (int dir = 0; dir < 2; ++dir)
#pragma unroll
                for (int nt = 0; nt < 2; ++nt) { const int d = 32 * nh + 16 * nt + fr, ch = nblk * 64 + d;
                    const float br = gbr[dir][nt], bi = gbi[dir][nt], sp = gsp[dir][nt];
#pragma unroll
                    for (int r = 0; r < 4; ++r) { const int t = 16 * mt + 4 * fq + r;
                        const float rr = fsigmoid(acc[dir * 2 + 0][nt][r] + br), ii = fsigmoid(acc[dir * 2 + 1][nt][r] + bi);
                        const float la = -8.0f * 1.4426950408889634f * rr * sp; const float av = __builtin_amdgcn_exp2f(la);
                        const float uv = __builtin_amdgcn_sqrtf(fmaxf(1.0f - av * av, 0.f)) * (ii * xc[t * 64 + d]);
                        au[((dir * 2 + 0) * 64 + t) * 64 + d] = av; au[((dir * 2 + 1) * 64 + t) * 64 + d] = uv; } }
        }
        __syncthreads();
        {
            const int seg = tid >> 7, dir = (tid >> 6) & 1, c = tid & 63, ch = nblk * 64 + c;
            const LAS float* ap = au + ((dir * 2 + 0) * 64) * 64 + c; LAS float* up = au + ((dir * 2 + 1) * 64) * 64 + c;
            float A = 1.f, H = 0.f;
#pragma unroll 4
            for (int s = seg * 16; s < seg * 16 + 16; ++s) { const int t = dir ? 63 - s : s; const float av = ap[t * 64], uv = up[t * 64]; H = av * H + uv; A *= av; }
            sg[((0 * 4 + seg) * 2 + dir) * 64 + c] = A; sg[((1 * 4 + seg) * 2 + dir) * 64 + c] = H;
            __syncthreads();
            const size_t idx = ((size_t)((b * 2 + dir) * 68 + slot)) * 512 + ch;
            if (PASS == 1) {
                if (seg == 0) { float At = 1.f, Ht = 0.f;
#pragma unroll
                    for (int q = 0; q < 4; ++q) { const float Aq = sg[((0 * 4 + q) * 2 + dir) * 64 + c], Hq = sg[((1 * 4 + q) * 2 + dir) * 64 + c]; Ht = Aq * Ht + Hq; At *= Aq; }
                    TOTA[idx] = At; TOTH[idx] = Ht; }
            } else {
                float Hin = CARRY[idx];
                for (int q = 0; q < seg; ++q) { const float Aq = sg[((0 * 4 + q) * 2 + dir) * 64 + c], Hq = sg[((1 * 4 + q) * 2 + dir) * 64 + c]; Hin = Aq * Hin + Hq; }
#pragma unroll 4
                for (int s = seg * 16; s < seg * 16 + 16; ++s) { const int t = dir ? 63 - s : s; const float av = ap[t * 64], uv = up[t * 64]; Hin = av * Hin + uv; up[t * 64] = Hin; }
            }
        }
        __syncthreads();
        if (PASS == 2) {
            { const int t = rrA; float gt[8], y[8]; unpack8(gt4, gt);
              const LAS float* hf = au + ((0 * 2 + 1) * 64 + t) * 64 + c8; const LAS float* hb = au + ((1 * 2 + 1) * 64 + t) * 64 + c8;
              const f32x4 f0 = *(const LAS f32x4*)(hf), f1 = *(const LAS f32x4*)(hf + 4), b0 = *(const LAS f32x4*)(hb), b1 = *(const LAS f32x4*)(hb + 4);
#pragma unroll
              for (int e = 0; e < 8; ++e) { const float hs = (e < 4 ? f0[e & 3] + b0[e & 3] : f1[e & 3] + b1[e & 3]); const float g = gt[e];
                  y[e] = hs * g * fsigmoid(1.5957691216057308f * (g + 0.044715f * g * g * g)); }
              *(u32x4*)(U + (size_t)(rowbase + t0 + t) * D + 512 + nblk * 64 + c8) = pack8(y); }
            __syncthreads();
        }
        xa = nxa; xb = nxb; gt4 = ngt;
    }
#undef LR_FETCH
}

constexpr int GS_NS = 32, GS_K = 0, GS_Q = 16384, GS_V = 32768, GS_EG = 36864, GS_BTO = 36992, GS_BUF = 37120;
__device__ __forceinline__ void gdn_scan(KA a, LAS unsigned char* lds, int bid, int G, int tid, int wave, int lane) {
    const bf16_t* QN = (const bf16_t*)(a->ws + WS_U); const bf16_t* KN = QN + (size_t)MT * 512; const bf16_t* V = (const bf16_t*)(a->ws + WS_V);
    const float* Gb = (const float*)(a->ws + WS_G); const float* Bt = (const float*)(a->ws + WS_BT);
    for (int u = bid; u < 256; u += G) {
        const int chain = u >> 2, qd = u & 3, b = chain >> 3, h = (chain >> 1) & 3, dir = chain & 1;
        bf16_t* OD = (bf16_t*)(a->ws + (dir ? WS_OB : WS_OF));
        const int kg = lane & 7, cl = (wave & 3) * 8 + (lane >> 3), col = h * 128 + qd * 32 + cl;
        f32x2 S[8];
#pragma unroll
        for (int i = 0; i < 8; ++i) S[i] = (f32x2){0.f, 0.f};
#define GS_ROW(s) ((s) < CTXL ? (ML + b * CTXL + (dir ? CTXL - 1 - (s) : (s))) : (b * SEQ + (dir ? SEQ - 1 - ((s) - CTXL) : ((s) - CTXL))))
        const int lsl = tid >> 4, lc = tid & 15;
        u32x4 rk, rq, rv; float rg = 0.f;
#define GS_LOAD(blk) do { const int s_ = (blk) * GS_NS + lsl; const size_t row_ = (size_t)GS_ROW(s_); \
        rk = *(const u32x4*)(KN + row_ * 512 + h * 128 + lc * 8); rq = *(const u32x4*)(QN + row_ * 512 + h * 128 + lc * 8); \
        if (tid < 128) { const int s2_ = (blk) * GS_NS + (tid >> 2); const size_t r2_ = (size_t)GS_ROW(s2_); rv = *(const u32x4*)(V + r2_ * 512 + h * 128 + qd * 32 + (tid & 3) * 8); } \
        else if (tid < 160) { const int s2_ = (blk) * GS_NS + (tid - 128); rg = expf(Gb[(size_t)GS_ROW(s2_) * 8 + dir * 4 + h]); } \
        else if (tid < 192) { const int s2_ = (blk) * GS_NS + (tid - 160); rg = Bt[(size_t)GS_ROW(s2_) * 8 + dir * 4 + h]; } } while (0)
#define GS_ST8(dst, r) do { float f_[8]; unpack8(r, f_); *(LAS f32x4*)(dst) = (f32x4){f_[0], f_[1], f_[2], f_[3]}; *(LAS f32x4*)((dst) + 16) = (f32x4){f_[4], f_[5], f_[6], f_[7]}; } while (0)
#define GS_STORE(buf) do { LAS unsigned char* p_ = lds + (buf) * GS_BUF; \
        GS_ST8(p_ + GS_K + lsl * 512 + lc * 32, rk); GS_ST8(p_ + GS_Q + lsl * 512 + lc * 32, rq); \
        if (tid < 128) GS_ST8(p_ + GS_V + (tid >> 2) * 128 + (tid & 3) * 32, rv); \
        else if (tid < 160) *(LAS float*)(p_ + GS_EG + (tid - 128) * 4) = rg; \
        else if (tid < 192) *(LAS float*)(p_ + GS_BTO + (tid - 160) * 4) = rg; } while (0)
        GS_LOAD(0); GS_STORE(0);
        __syncthreads();
        constexpr int NBLK = NKV / GS_NS;
        for (int blk = 0; blk < NBLK; ++blk) {
            const bool more = blk + 1 < NBLK;
            if (more) GS_LOAD(blk + 1);
            const LAS unsigned char* p = lds + (blk & 1) * GS_BUF;
            if (wave < 4) {
              f32x4 k4[4], q4[4]; float vv, eg, bt;
#define GS_FETCH(K4, Q4, VV, EG, BT, sl_) do { _Pragma("unroll") for (int i = 0; i < 4; ++i) { K4[i] = *(const LAS f32x4*)(p + GS_K + (sl_) * 512 + kg * 64 + i * 16); Q4[i] = *(const LAS f32x4*)(p + GS_Q + (sl_) * 512 + kg * 64 + i * 16); } \
                VV = *(const LAS float*)(p + GS_V + (sl_) * 128 + cl * 4); EG = *(const LAS float*)(p + GS_EG + (sl_) * 4); BT = *(const LAS float*)(p + GS_BTO + (sl_) * 4); } while (0)
              GS_FETCH(k4, q4, vv, eg, bt, 0);
              bf16_t* odp = OD + (size_t)GS_ROW(blk * GS_NS) * 512 + col; const int ostep = dir ? -512 : 512;
#pragma unroll 2
              for (int sl = 0; sl < GS_NS; ++sl) {
                f32x4 nk4[4], nq4[4]; float nvv, neg, nbt;
                const int sn = sl + 1 < GS_NS ? sl + 1 : sl;
                GS_FETCH(nk4, nq4, nvv, neg, nbt, sn);
                f32x2 pa = {0.f, 0.f}, pb = {0.f, 0.f};
#pragma unroll
                for (int i = 0; i < 4; ++i) { pa += (f32x2){k4[i][0], k4[i][1]} * S[2 * i]; pb += (f32x2){k4[i][2], k4[i][3]} * S[2 * i + 1]; }
                const f32x2 pab = pa + pb; float pp = pab[0] + pab[1];
                pp += dppf(pp, 0); pp += dppf(pp, 1); pp += dppf(pp, 2);
                const float dl = bt * (vv - eg * pp);
                f32x2 oa = {0.f, 0.f}, ob = {0.f, 0.f};
#pragma unroll
                for (int i = 0; i < 4; ++i) {
                    S[2 * i] = S[2 * i] * eg + (f32x2){k4[i][0], k4[i][1]} * dl; S[2 * i + 1] = S[2 * i + 1] * eg + (f32x2){k4[i][2], k4[i][3]} * dl;
                    oa += (f32x2){q4[i][0], q4[i][1]} * S[2 * i]; ob += (f32x2){q4[i][2], q4[i][3]} * S[2 * i + 1]; }
                const f32x2 oab = oa + ob; float oo = oab[0] + oab[1];
                oo += dppf(oo, 0); oo += dppf(oo, 1); oo += dppf(oo, 2);
                if (kg == 0) odp[(ptrdiff_t)sl * ostep] = (bf16_t)f2bf(oo);
#pragma unroll
                for (int i = 0; i < 4; ++i) { k4[i] = nk4[i]; q4[i] = nq4[i]; }
                vv = nvv; eg = neg; bt = nbt;
              }
#undef GS_FETCH
            }
            if (more) GS_STORE((blk + 1) & 1);
            __syncthreads();
        }
#undef GS_ROW
#undef GS_LOAD
#undef GS_STORE
#undef GS_ST8
    }
    { const int gid = bid * 512 + tid;
      if (gid < NB * 2 * 512) { const int ch = gid & 511, dir = (gid >> 9) & 1, b = gid >> 10;
        const float* TOTA = (const float*)(a->ws + WS_TOTA); const float* TOTH = (const float*)(a->ws + WS_TOTH); float* CARRY = (float*)(a->ws + WS_CARRY);
        float carry = 0.f;
        for (int s = 0; s < 68; ++s) { const int slot = dir ? (s < 4 ? 3 - s : 67 - (s - 4)) : s; const size_t idx = ((size_t)((b * 2 + dir) * 68 + slot)) * 512 + ch;
            CARRY[idx] = carry; carry = TOTA[idx] * carry + TOTH[idx]; } } }
}


__device__ __forceinline__ int gs_row(int b, int dir, int s) { return s < CTXL ? (ML + b * CTXL + (dir ? CTXL - 1 - s : s)) : (b * SEQ + (dir ? SEQ - 1 - (s - CTXL) : (s - CTXL))); }
__device__ __forceinline__ float fexp(float x) { return __builtin_amdgcn_exp2f(1.4426950408889634f * x); }
constexpr int CP_WAVE = 64 * 68 * 4 + 512;
__device__ __forceinline__ void gdn_chunk_prep(KA a, LAS unsigned char* lds, int gw, int NGW, int wave, int lane) {
    const bf16_t* QN = (const bf16_t*)(a->ws + WS_U); const bf16_t* KN = QN + (size_t)MT * 512;
    const float* Gb = (const float*)(a->ws + WS_G); const float* Bt = (const float*)(a->ws + WS_BT);
    bf16_t* Tb = (bf16_t*)(a->ws + WS_TB); bf16_t* QKb = (bf16_t*)(a->ws + WS_QKB); float* GAM = (float*)(a->ws + WS_GAM);
    LAS float* Am = (LAS float*)(lds + wave * CP_WAVE); LAS float* gl = Am + 64 * 68; LAS float* bl = gl + 64;
    const int r32 = lane & 31, hi = lane >> 5;
    bf16x8 kf[2][8]; float gi_raw = 0.f, bt_raw = 0.f;
#define CP_FETCH(cu_) do { const int ch_ = (cu_) / 68, n_ = (cu_) % 68, b_ = ch_ >> 3, h_ = (ch_ >> 1) & 3, d_ = ch_ & 1; const int r0_ = gs_row(b_, d_, 64 * n_), rs_ = d_ ? -1 : 1; \
        _Pragma("unroll") for (int blk = 0; blk < 2; ++blk) _Pragma("unroll") for (int ks = 0; ks < 8; ++ks) \
            kf[blk][ks] = *(const bf16x8*)(KN + (size_t)(r0_ + rs_ * (32 * blk + r32)) * 512 + h_ * 128 + 16 * ks + 8 * hi); \
        const size_t rl_ = (size_t)(r0_ + rs_ * lane); gi_raw = Gb[rl_ * 8 + d_ * 4 + h_]; bt_raw = Bt[rl_ * 8 + d_ * 4 + h_]; } while (0)
    if (gw < 64 * 68) CP_FETCH(gw);
    for (int cu = gw; cu < 64 * 68; cu += NGW) {
        const int chain = cu / 68, n = cu % 68, b = chain >> 3, h = (chain >> 1) & 3, dir = chain & 1;
        const int row0 = gs_row(b, dir, 64 * n), rs = dir ? -1 : 1;
        { float gi = gi_raw;
#pragma unroll
          for (int o = 1; o < 64; o <<= 1) { const float t = __shfl_up(gi, o); if (lane >= o) gi += t; }
          gl[lane] = gi; bl[lane] = bt_raw; GAM[(size_t)cu * 64 + lane] = gi; }
        LDS_WAIT();
        const float gj0 = gl[r32], gj1 = gl[32 + r32];
#pragma unroll
        for (int tl = 0; tl < 3; ++tl) { const int mb = tl == 0 ? 0 : 1, nb = tl == 2 ? 1 : 0;
            f32x16 acc;
#pragma unroll
            for (int r = 0; r < 16; ++r) acc[r] = 0.f;
#pragma unroll
            for (int ks = 0; ks < 8; ++ks) acc = __builtin_amdgcn_mfma_f32_32x32x16_bf16(kf[mb][ks], kf[nb][ks], acc, 0, 0, 0);
            const int j = 32 * nb + r32; const float gj = nb ? gj1 : gj0;
#pragma unroll
            for (int q = 0; q < 4; ++q) { const int i0 = 32 * mb + 8 * q + 4 * hi; const f32x4 gmi = *(const LAS f32x4*)(gl + i0), bti = *(const LAS f32x4*)(bl + i0);
#pragma unroll
                for (int e = 0; e < 4; ++e) { const int i = i0 + e; Am[i * 68 + j] = (i > j) ? bti[e] * acc[4 * q + e] * fexp(gmi[e] - gj) : 0.f; } }
        }
        asm volatile("" ::: "memory");
        {
            bf16_t* qko = QKb + (size_t)cu * 4096;
#pragma unroll
            for (int mb = 0; mb < 2; ++mb) {
                bf16x8 qf[8];
#pragma unroll
                for (int ks = 0; ks < 8; ++ks) qf[ks] = *(const bf16x8*)(QN + (size_t)(row0 + rs * (32 * mb + r32)) * 512 + h * 128 + 16 * ks + 8 * hi);
#pragma unroll
                for (int nb = 0; nb <= mb; ++nb) {
                    f32x16 acc;
#pragma unroll
                    for (int r = 0; r < 16; ++r) acc[r] = 0.f;
#pragma unroll
                    for (int ks = 0; ks < 8; ++ks) acc = __builtin_amdgcn_mfma_f32_32x32x16_bf16(qf[ks], kf[nb][ks], acc, 0, 0, 0);
                    const int j = 32 * nb + r32; const float gj = nb ? gj1 : gj0;
#pragma unroll
                    for (int q = 0; q < 4; ++q) { const int i0 = 32 * mb + 8 * q + 4 * hi; const f32x4 gmi = *(const LAS f32x4*)(gl + i0);
#pragma unroll
                        for (int e = 0; e < 4; ++e) { const int i = i0 + e; qko[i * 64 + j] = (bf16_t)f2bf((i >= j) ? acc[4 * q + e] * fexp(gmi[e] - gj) : 0.f); } }
                }
                asm volatile("" ::: "memory");
            }
#pragma unroll
            for (int q = 0; q < 4; ++q)
#pragma unroll
                for (int e = 0; e < 4; ++e) qko[(8 * q + 4 * hi + e) * 64 + 32 + r32] = (bf16_t)0;
        }
        asm volatile("" ::: "memory");
        LDS_WAIT();
        { const int cn = cu + NGW < 64 * 68 ? cu + NGW : cu; CP_FETCH(cn); }
        {
            float Tc[64]; int ln = lane;
#pragma unroll
            for (int i = 0; i < 64; ++i) {
                if ((i & 3) == 0) asm volatile("" : "+v"(ln));
                float acc = (i == ln) ? 1.f : 0.f, acc1 = 0.f;
#pragma unroll
                for (int jj = 0; jj < (i + 3) / 4; ++jj) { const f32x4 a4 = *(const LAS f32x4*)(Am + i * 68 + 4 * jj);
#pragma unroll
                    for (int e = 0; e < 4; ++e) if (4 * jj + e < i) { if (e & 1) acc1 -= a4[e] * Tc[4 * jj + e]; else acc -= a4[e] * Tc[4 * jj + e]; } }
                Tc[i] = acc + acc1;
                if ((i & 1) == 1) asm volatile("" ::: "memory");
            }
            bf16_t* to = Tb + (size_t)cu * 4096 + lane;
#pragma unroll
            for (int i = 0; i < 64; ++i) to[i * 64] = (bf16_t)f2bf(Tc[i]);
        }
        LDS_WAIT();
    }
#undef CP_FETCH
}

constexpr int CS_KN = 0, CS_QN = 17408, CS_KT = 34816, CS_T = 53248, CS_QK = 62464, CS_VT = 71680, CS_GB = 76288, CS_ST = 77312, CS_RT = 86016, CS_VNT = 90624, CS_VDT = 95232, CS_END = 99840;
__device__ __forceinline__ void cs_compute(LAS unsigned char* lds, int wave, int r32, int hi, f32x16& acc, f32x16& Sreg, bf16_t* op, int row0, int rs) {
    const LAS float* gamL = (const LAS float*)(lds + CS_GB); const LAS float* betL = gamL + 64;
    const int mb = wave & 1;
    if (wave < 4) {
        const LAS unsigned char* X = lds + ((wave >> 1) ? CS_QN : CS_KN) + (32 * mb + r32) * 272 + 16 * hi; const LAS unsigned char* Sb = lds + CS_ST + r32 * 272 + 16 * hi;
#pragma unroll
        for (int r = 0; r < 16; ++r) acc[r] = 0.f;
#pragma unroll
        for (int ks = 0; ks < 8; ++ks) acc = __builtin_amdgcn_mfma_f32_32x32x16_bf16(*(const LAS bf16x8*)(X + 32 * ks), *(const LAS bf16x8*)(Sb + 32 * ks), acc, 0, 0, 0);
    }
    if (wave < 2) {
#pragma unroll
        for (int q = 0; q < 4; ++q) { const int t0 = 32 * mb + 8 * q + 4 * hi; const f32x4 gm = *(const LAS f32x4*)(gamL + t0), bt = *(const LAS f32x4*)(betL + t0);
            const u32x2 vv = *(const LAS u32x2*)(lds + CS_VT + r32 * 144 + t0 * 2);
            const float v0 = __uint_as_float(vv.x << 16), v1 = __uint_as_float(vv.x & 0xffff0000u), v2 = __uint_as_float(vv.y << 16), v3 = __uint_as_float(vv.y & 0xffff0000u);
            u32x2 w; w.x = pk2(bt[0] * (v0 - fexp(gm[0]) * acc[4 * q]), bt[1] * (v1 - fexp(gm[1]) * acc[4 * q + 1]));
            w.y = pk2(bt[2] * (v2 - fexp(gm[2]) * acc[4 * q + 2]), bt[3] * (v3 - fexp(gm[3]) * acc[4 * q + 3]));
            *(LAS u32x2*)(lds + CS_RT + r32 * 144 + t0 * 2) = w; }
    }
    __syncthreads();
    if (wave < 2) {
        f32x16 vn;
#pragma unroll
        for (int r = 0; r < 16; ++r) vn[r] = 0.f;
        const LAS unsigned char* Ta = lds + CS_T + (32 * mb + r32) * 144 + 16 * hi; const LAS unsigned char* Rb = lds + CS_RT + r32 * 144 + 16 * hi;
#pragma unroll
        for (int ks = 0; ks < 4; ++ks) vn = __builtin_amdgcn_mfma_f32_32x32x16_bf16(*(const LAS bf16x8*)(Ta + 32 * ks), *(const LAS bf16x8*)(Rb + 32 * ks), vn, 0, 0, 0);
        const float glast = gamL[63];
#pragma unroll
        for (int q = 0; q < 4; ++q) { const int t0 = 32 * mb + 8 * q + 4 * hi; const f32x4 gm = *(const LAS f32x4*)(gamL + t0);
            u32x2 w; w.x = pk2(vn[4 * q], vn[4 * q + 1]); w.y = pk2(vn[4 * q + 2], vn[4 * q + 3]);
            *(LAS u32x2*)(lds + CS_VNT + r32 * 144 + t0 * 2) = w;
            w.x = pk2(vn[4 * q] * fexp(glast - gm[0]), vn[4 * q + 1] * fexp(glast - gm[1])); w.y = pk2(vn[4 * q + 2] * fexp(glast - gm[2]), vn[4 * q + 3] * fexp(glast - gm[3]));
            *(LAS u32x2*)(lds + CS_VDT + r32 * 144 + t0 * 2) = w; }
    }
    __syncthreads();
    if (wave == 2 || wave == 3) {
#pragma unroll
        for (int q = 0; q < 4; ++q) { const int t0 = 32 * mb + 8 * q + 4 * hi; const f32x4 gm = *(const LAS f32x4*)(gamL + t0);
#pragma unroll
            for (int e = 0; e < 4; ++e) acc[4 * q + e] *= fexp(gm[e]); }
        const LAS unsigned char* Qa = lds + CS_QK + (32 * mb + r32) * 144 + 16 * hi; const LAS unsigned char* Vb = lds + CS_VNT + r32 * 144 + 16 * hi;
#pragma unroll
        for (int ks = 0; ks < 4; ++ks) acc = __builtin_amdgcn_mfma_f32_32x32x16_bf16(*(const LAS bf16x8*)(Qa + 32 * ks), *(const LAS bf16x8*)(Vb + 32 * ks), acc, 0, 0, 0);
#pragma unroll
        for (int r = 0; r < 16; ++r) { const int tok = 32 * mb + (r & 3) + 8 * (r >> 2) + 4 * hi; op[(ptrdiff_t)(row0 + rs * tok) * 512] = (bf16_t)f2bf(acc[r]); }
    } else if (wave >= 4) {
        const int mk = wave - 4; const float cd = fexp(gamL[63]);
#pragma unroll
        for (int r = 0; r < 16; ++r) Sreg[r] *= cd;
        const LAS unsigned char* Ka = lds + CS_KT + (32 * mk + r32) * 144 + 16 * hi; const LAS unsigned char* Db = lds + CS_VDT + r32 * 144 + 16 * hi;
#pragma unroll
        for (int ks = 0; ks < 4; ++ks) Sreg = __builtin_amdgcn_mfma_f32_32x32x16_bf16(*(const LAS bf16x8*)(Ka + 32 * ks), *(const LAS bf16x8*)(Db + 32 * ks), Sreg, 0, 0, 0);
#pragma unroll
        for (int q = 0; q < 4; ++q) { u32x2 w; w.x = pk2(Sreg[4 * q], Sreg[4 * q + 1]); w.y = pk2(Sreg[4 * q + 2], Sreg[4 * q + 3]);
            *(LAS u32x2*)(lds + CS_ST + r32 * 272 + (32 * mk + 8 * q + 4 * hi) * 2) = w; }
    }
    __syncthreads();
}
__device__ __forceinline__ void gdn_chunk_scan(KA a, LAS unsigned char* lds, int bid, int G, int tid, int wave, int lane) {
    const bf16_t* QN = (const bf16_t*)(a->ws + WS_U); const bf16_t* KN = QN + (size_t)MT * 512; const bf16_t* V = (const bf16_t*)(a->ws + WS_V);
    const float* Bt = (const float*)(a->ws + WS_BT);
    const bf16_t* Tb = (const bf16_t*)(a->ws + WS_TB); const bf16_t* QKb = (const bf16_t*)(a->ws + WS_QKB); const float* GAM = (const float*)(a->ws + WS_GAM);
    const int r32 = lane & 31, hi = lane >> 5;
    for (int u = bid; u < 256; u += G) {
        const int chain = (u & 7) * 8 + (u >> 5), qd = (u >> 3) & 3;
        const int b = chain >> 3, h = (chain >> 1) & 3, dir = chain & 1, rs = dir ? -1 : 1;
        bf16_t* op = (bf16_t*)(a->ws + (dir ? WS_OB : WS_OF)) + h * 128 + qd * 32 + r32;
        u32x4 rkA[2], rqA[2], rTA, rQKA, rVA; float rgbA = 0.f;
        u32x4 rkB[2], rqB[2], rTB, rQKB, rVB; float rgbB = 0.f;
#define CS_LOAD(S_, n_) do { const int row0_ = gs_row(b, dir, 64 * (n_)); const size_t cu_ = (size_t)(chain * 68 + (n_)); const size_t rowl_ = (size_t)(row0_ + rs * lane); \
        _Pragma("unroll") for (int i_ = 0; i_ < 2; ++i_) { const int c16_ = wave + 8 * i_; \
            rk##S_[i_] = *(const u32x4*)(KN + rowl_ * 512 + h * 128 + c16_ * 8); rq##S_[i_] = *(const u32x4*)(QN + rowl_ * 512 + h * 128 + c16_ * 8); } \
        rT##S_ = *(const u32x4*)(Tb + cu_ * 4096 + tid * 8); rQK##S_ = *(const u32x4*)(QKb + cu_ * 4096 + tid * 8); \
        if (wave < 4) rV##S_ = *(const u32x4*)(V + rowl_ * 512 + h * 128 + qd * 32 + wave * 8); \
        if (tid < 64) rgb##S_ = GAM[cu_ * 64 + tid]; else if (tid < 128) rgb##S_ = Bt[(size_t)(row0_ + rs * (tid - 64)) * 8 + dir * 4 + h]; } while (0)
#define CS_T16(base, v, col0, tok) do { const unsigned w_[4] = {(v).x, (v).y, (v).z, (v).w}; _Pragma("unroll") for (int e_ = 0; e_ < 8; ++e_) \
        *(LAS bf16_t*)(lds + (base) + ((col0) + e_) * 144 + (tok) * 2) = (bf16_t)((e_ & 1) ? (w_[e_ >> 1] >> 16) : (w_[e_ >> 1] & 0xffffu)); } while (0)
#define CS_STORE(S_) do { \
        _Pragma("unroll") for (int i_ = 0; i_ < 2; ++i_) { const int c16_ = wave + 8 * i_; \
            *(LAS u32x4*)(lds + CS_KN + lane * 272 + c16_ * 16) = rk##S_[i_]; *(LAS u32x4*)(lds + CS_QN + lane * 272 + c16_ * 16) = rq##S_[i_]; CS_T16(CS_KT, rk##S_[i_], c16_ * 8, lane); } \
        *(LAS u32x4*)(lds + CS_T + (tid >> 3) * 144 + (tid & 7) * 16) = rT##S_; *(LAS u32x4*)(lds + CS_QK + (tid >> 3) * 144 + (tid & 7) * 16) = rQK##S_; \
        if (wave < 4) CS_T16(CS_VT, rV##S_, wave * 8, lane); \
        if (tid < 128) *(LAS float*)(lds + CS_GB + tid * 4) = rgb##S_; } while (0)
        CS_LOAD(A, 0);
        for (int i = tid; i < 32 * 272 / 4; i += 512) *(LAS unsigned*)(lds + CS_ST + i * 4) = 0u;
        CS_STORE(A);
        __syncthreads();
        CS_LOAD(A, 1);
        f32x16 Sreg, acc;
#pragma unroll
        for (int r = 0; r < 16; ++r) { Sreg[r] = 0.f; acc[r] = 0.f; }
        for (int n = 0; n < 68; n += 2) {
            if (n + 2 < 68) CS_LOAD(B, n + 2);
            cs_compute(lds, wave, r32, hi, acc, Sreg, op, gs_row(b, dir, 64 * n), rs);
            CS_STORE(A);
            __syncthreads();
            if (n + 3 < 68) CS_LOAD(A, n + 3);
            cs_compute(lds, wave, r32, hi, acc, Sreg, op, gs_row(b, dir, 64 * (n + 1)), rs);
            if (n + 2 < 68) CS_STORE(B);
            __syncthreads();
        }
#undef CS_LOAD
#undef CS_T16
#undef CS_STORE
    }
    if (wave == 0 && lane < 32) {
      const float* TOTA = (const float*)(a->ws + WS_TOTA); const float* TOTH = (const float*)(a->ws + WS_TOTH); float* CARRY = (float*)(a->ws + WS_CARRY);
      for (int gid = bid * 32 + lane; gid < NB * 2 * 512; gid += G * 32) { const int ch = gid & 511, dir = (gid >> 9) & 1, b = gid >> 10;
        float carry = 0.f;
        for (int s0 = 0; s0 < 68; s0 += 17) {
            float ta[17], th[17];
#pragma unroll
            for (int k = 0; k < 17; ++k) { const int s = s0 + k; const int slot = dir ? (s < 4 ? 3 - s : 67 - (s - 4)) : s; const size_t idx = ((size_t)((b * 2 + dir) * 68 + slot)) * 512 + ch; ta[k] = TOTA[idx]; th[k] = TOTH[idx]; }
#pragma unroll
            for (int k = 0; k < 17; ++k) { const int s = s0 + k; const int slot = dir ? (s < 4 ? 3 - s : 67 - (s - 4)) : s; const size_t idx = ((size_t)((b * 2 + dir) * 68 + slot)) * 512 + ch; CARRY[idx] = carry; carry = ta[k] * carry + th[k]; }
        } } }
}

__device__ __forceinline__ void gdn_merge(KA a, int L, int gw, int NGW, int lane) {
    const int j2 = L >> 1;
    const bf16_t* P = (const bf16_t*)(a->ws + WS_P); bf16_t* U = (bf16_t*)(a->ws + WS_U);
    const bf16_t* OF = (const bf16_t*)(a->ws + WS_OF); const bf16_t* OB = (const bf16_t*)(a->ws + WS_OB);
    const float* gn = a->in[I_EVGDNNORM] + j2 * 128 + ((8 * lane) & 127);
    float g8[8];
#pragma unroll
    for (int e = 0; e < 8; ++e) g8[e] = gn[e];
    for (int row = gw; row < MT; row += NGW) {
        float of[8], ob[8], z[8], y[8];
        unpack8(*(const u32x4*)(OF + (size_t)row * 512 + 8 * lane), of); unpack8(*(const u32x4*)(OB + (size_t)row * 512 + 8 * lane), ob);
        unpack8(*(const u32x4*)(P + (size_t)row * EVNP + 1536 + 8 * lane), z);
        float ssq = 0.f;
#pragma unroll
        for (int e = 0; e < 8; ++e) { of[e] += ob[e]; ssq += of[e] * of[e]; }
        ssq = rowsum16(ssq);
        const float rms = 1.0f / sqrtf(ssq * (1.f / 128.f) + EPS);
#pragma unroll
        for (int e = 0; e < 8; ++e) y[e] = of[e] * rms * g8[e] * fsilu(z[e]);
        *(u32x4*)(U + (size_t)row * D + 8 * lane) = pack8(y);
    }
}


#define XB_TMO      128
#define XB_XCNT(j)  (256  + 64 * (j))
#define XB_XSUB(j)  (1280 + 64 * (j))
#define XB_XGEN(j)  (2304 + 64 * (j))
#define XB_TOP      3328
#define XB_TOPGEN   3392
#define XCD_BAR_WORDS 3456
#define XB_SPIN_CAP (1u << 20)
__device__ __forceinline__ unsigned xb_ld(unsigned* p)              { return __hip_atomic_load(p, __ATOMIC_RELAXED, __HIP_MEMORY_SCOPE_AGENT); }
__device__ __forceinline__ unsigned xb_add(unsigned* p, unsigned v) { return __hip_atomic_fetch_add(p, v, __ATOMIC_RELAXED, __HIP_MEMORY_SCOPE_AGENT); }
__device__ __forceinline__ unsigned xb_xcc_id() { return (unsigned)__builtin_amdgcn_s_getreg((3 << 11) | 20) & 0xFu; }
#define XB_SPIN(cond, bar) do { unsigned _sp = 0; while (cond) { __builtin_amdgcn_s_sleep(1); \
    if ((++_sp & 255u) == 0u) { if (xb_ld(&(bar)[XB_TMO])) break; if (_sp > XB_SPIN_CAP) { atomicAdd(&(bar)[XB_TMO], 1u); break; } } } } while (0)
struct XcdBarrier { unsigned* bar; unsigned x; volatile LAS unsigned* st; };
__device__ __forceinline__ XcdBarrier xcd_barrier_post(unsigned* bar, volatile LAS unsigned* st) {
    XcdBarrier b; b.bar = bar; b.x = xb_xcc_id(); b.st = st;
    if (threadIdx.x == 0) (void)xb_add(&bar[XB_XCNT(b.x)], 1u);
    return b;
}
__device__ __forceinline__ void xcd_barrier_complete(unsigned* bar, unsigned x, unsigned& nloc, unsigned& nx) {
    const unsigned G = gridDim.x * gridDim.y * gridDim.z;
    unsigned sum, cnt, mine, sp = 0u;
    for (;;) {
        sum = 0u; cnt = 0u; mine = 0u;
#pragma unroll
        for (unsigned j = 0; j < 16; ++j) { const unsigned c = xb_ld(&bar[XB_XCNT(j)]); sum += c; cnt += (c > 0u) ? 1u : 0u; mine = (j == x) ? c : mine; }
        if (sum == G) break;
        __builtin_amdgcn_s_sleep(1);
        if ((++sp & 255u) == 0u) { if (xb_ld(&bar[XB_TMO])) break; if (sp > XB_SPIN_CAP) { atomicAdd(&bar[XB_TMO], 1u); break; } }
    }
    nloc = mine > 0u ? mine : 1u; nx = cnt > 0u ? cnt : 1u;
}
__device__ __forceinline__ void xcd_barrier(const XcdBarrier& b) {
    asm volatile("s_waitcnt vmcnt(0)" ::: "memory");
    __syncthreads();
    if (threadIdx.x == 0) {
        unsigned* bar = b.bar;
        __builtin_amdgcn_s_waitcnt(0);
        unsigned nloc = b.st[0], nx = b.st[1];
        if (nloc == 0u) { xcd_barrier_complete(bar, b.x, nloc, nx); b.st[0] = nloc; b.st[1] = nx; }
        const unsigned old = xb_add(&bar[XB_XSUB(b.x)], 1u);
        const unsigned gen = old / nloc;
        if (old + 1u == (gen + 1u) * nloc) {
            __builtin_amdgcn_fence(__ATOMIC_RELEASE, "agent");
            asm volatile("s_waitcnt vmcnt(0)" ::: "memory");
            const unsigned og = xb_add(&bar[XB_TOP], 1u);
            const unsigned tg = og / nx;
            if (og + 1u == (tg + 1u) * nx) xb_add(&bar[XB_TOPGEN], 1u);
            else XB_SPIN(xb_ld(&bar[XB_TOPGEN]) == tg, bar);
            __builtin_amdgcn_fence(__ATOMIC_ACQUIRE, "agent");
            xb_add(&bar[XB_XGEN(b.x)], 1u);
            asm volatile("s_waitcnt vmcnt(0)" ::: "memory");
        } else {
            XB_SPIN(xb_ld(&bar[XB_XGEN(b.x)]) == gen, bar);
            __builtin_amdgcn_fence(__ATOMIC_ACQUIRE, "agent");
            asm volatile("s_waitcnt vmcnt(0)" ::: "memory");
        }
    }
    __syncthreads();
}

__device__ __forceinline__ void decode_phase(int ph, int& L, int& kind) {
    if (ph == 0) { L = 0; kind = K_PROA; return; }
    if (ph == 1) { L = 0; kind = K_PROB; return; }
    int p = ph - 2;
    if (p < 10) { L = 0; } else if (p < 18) { L = 1; p -= 10; } else if (p < 28) { L = 2; p -= 18; } else { L = 3; p -= 28; }
    if ((L & 1) == 0) { kind = p == 0 ? K_PROJ : p == 1 ? K_E2 : p == 2 ? K_E2B : p == 3 ? K_E3 : p == 4 ? K_E4 : p == 5 ? K_WOUT : p == 6 ? K_LN1 : p == 7 ? K_MLP1 : p == 8 ? K_MLP2 : K_LN2; }
    else { kind = p == 0 ? K_PROJ : p == 1 ? K_O2 : p == 2 ? K_O3 : p == 3 ? K_WOUT : p == 4 ? K_LN1 : p == 5 ? K_MLP1 : p == 6 ? K_MLP2 : K_LN2; }
}

#ifndef MK_DUP_GEMM
#define MK_DUP_GEMM 0
#endif
#ifndef MK_DUP_KIND
#define MK_DUP_KIND -1
#endif
#ifndef MK_SKIP1
#define MK_SKIP1 1
#endif
#ifndef MK_K2
#define MK_K2 1024
#endif
#ifndef MK_PHM
#define MK_PHM 0xffffu
#endif
#define EN(k) ((MK_PHM >> (k)) & 1u)
__global__ void __launch_bounds__(512, 2) fwd_kernel(Args args) {
    extern __shared__ __attribute__((aligned(16))) unsigned char lds_raw[];
    LAS unsigned char* lds = (LAS unsigned char*)lds_raw;
    cg::grid_group grid = cg::this_grid();
    const int G = gridDim.x;
    volatile LAS unsigned* bst = (volatile LAS unsigned*)(lds + LDS_BYTES - 16);
    if (threadIdx.x < 2) bst[threadIdx.x] = 0u;
    __syncthreads();
    const XcdBarrier xbar = xcd_barrier_post((unsigned*)(args.ws + WS_BAR), bst);
    const int ph_lo = args.ph_lo, ph_hi = args.ph_hi;
    bool second = false;
    for (int ph = ph_lo; ph < ph_hi; ) {
        KA a = (KA)__builtin_amdgcn_kernarg_segment_ptr(); asm volatile("" : "+s"(a));
        int tid = threadIdx.x; asm volatile("" : "+v"(tid));
        int bid = blockIdx.x; asm volatile("" : "+s"(bid));
        const int lane = tid & 63, wave = __builtin_amdgcn_readfirstlane(tid >> 6), gw = bid * 8 + wave, NGW = G * 8;
        bf16_t* U = (bf16_t*)(a->ws + WS_U); bf16_t* P = (bf16_t*)(a->ws + WS_P); float* HC = (float*)(a->ws + WS_HC);
        const float* MOD = (const float*)(a->ws + WS_MOD);
        int L, kind; decode_phase(ph, L, kind);
        const bool even = (L & 1) == 0; const bool last = L == 3;
        const int Mrows = last ? ML : MT;
        const bool isgemm = kind == K_PROJ || kind == K_MLP1 || kind == K_WOUT || kind == K_MLP2;
        const bool dup = (MK_DUP_GEMM && isgemm) || kind == MK_DUP_KIND;
        if (EN(K_PROA) && kind == K_PROA) prologue_a(a, lds, bid, G, tid, wave, lane);
        else if (EN(K_PROB) && kind == K_PROB) prologue_b(a, gw, NGW, lane);
        else if (EN(K_PROJ) && (kind == K_PROJ || kind == K_MLP1 || kind == K_WOUT || kind == K_MLP2)) {
            const float* modL = MOD + (size_t)L * 9 * 6144;
            const bool split = (kind == K_WOUT || kind == K_MLP2) && !last;
            const int ncall = split ? 2 : 1;
            for (int call = 0; call < ncall; ++call) {
                pg8::Gemm g; pg8::EpiBf16 E;
                if (kind == K_PROJ) { g = pg8::Gemm{U, (const bf16_t*)(a->ws + WS_WA), MT, even ? EVNP : ODN, D, D, D, 1}; E = pg8::EpiBf16{P, even ? EVNP : ODN, 0, nullptr, -1, 0}; }
                else if (kind == K_MLP1) { g = pg8::Gemm{U, (const bf16_t*)(a->ws + WS_W1), Mrows, FF, D, D, D, 1}; E = pg8::EpiBf16{P, FF, 2, nullptr, -1, 0}; }
                else if (kind == K_WOUT) { const bf16_t* A = even ? U : P; const int lda = even ? D : ODN;
                    if (call == 0) { g = pg8::Gemm{A, (const bf16_t*)(a->ws + WS_WO), ML, D, D, lda, D, 1}; E = pg8::EpiBf16{even ? P : U, D, 0, modL + 2 * D, -1, 0}; }
                    else { g = pg8::Gemm{A + (size_t)ML * lda, (const bf16_t*)(a->ws + WS_WO), MC, D, D / 4, lda, D, 4}; E = pg8::EpiBf16{(bf16_t*)(a->ws + WS_PART), D, 0, modL + 2 * D, 8, (size_t)MC * D}; } }
                else { if (call == 0) { g = pg8::Gemm{P, (const bf16_t*)(a->ws + WS_W2), ML, D, FF, FF, FF, 1}; E = pg8::EpiBf16{U, D, 0, modL + 5 * D, -1, 0}; }
                    else { g = pg8::Gemm{P + (size_t)ML * FF, (const bf16_t*)(a->ws + WS_W2), MC, D, FF / 8, FF, FF, 8}; E = pg8::EpiBf16{(bf16_t*)(a->ws + WS_PART), D, 0, modL + 5 * D, 8, (size_t)MC * D}; } }
                pg8::StaticOrder S; S.init(g.M, g.N, G, bid, g.nks);
                pg8::gemm_phase<pg8::EpiBf16>(lds, g, S, E, tid);
            }
        }
        else if (EN(K_LN1) && kind == K_LN1) ln_pass(a, L, 0, Mrows, true, L, 3, even ? P : U, last ? 0 : 4, gw, NGW, lane);
        else if (EN(K_LN2) && kind == K_LN2) {
            ln_pass(a, L, 1, Mrows, !last, L + 1, 0, U, last ? 0 : 8, gw, NGW, lane);
            if (!last) conv_weights(a, L + 1, lds, gw, NGW, wave, lane);
        }
        else if (EN(K_E2) && kind == K_E2) { gdn_prep(a, L, lds, gw, NGW, tid, lane); lru_units<1>(a, L, lds, bid, G, tid); }
        else if (EN(K_E2B) && kind == K_E2B) gdn_chunk_prep(a, lds, gw, NGW, wave, lane);
        else if (EN(K_E3) && kind == K_E3) gdn_chunk_scan(a, lds, bid, G, tid, wave, lane);
        else if (EN(K_E4) && kind == K_E4) { gdn_merge(a, L, gw, NGW, lane); lru_units<2>(a, L, lds, bid, G, tid); }
        else if (EN(K_O2) && kind == K_O2) attn_prep(a, lds, bid, G, tid);
        else if (EN(K_O3) && kind == K_O3) attn_phase(a, L, lds, bid, G, tid, wave, lane, !dup || second);
        if (dup && !second) { second = true; grid.sync(); continue; }
        second = false; ++ph;
        if (ph < ph_hi) { if (ph == ph_lo + 1) grid.sync(); else xcd_barrier(xbar); }
    }
}

#ifndef MK_PH_HI
#define MK_PH_HI N_PHASES
#endif
#ifndef MK_PER_PHASE
#define MK_PER_PHASE 0
#endif
extern "C" void kernel_launch(void* const* d_in, const int* in_sizes, int n_in, void* d_out, int out_size, void* d_ws, size_t ws_size, hipStream_t stream) {
    static int grid = 0;
    if (grid == 0) {
        if (n_in != 24 || ws_size < WS_END) { fprintf(stderr, "kernel_launch: unexpected n_in %d / ws_size %zu\n", n_in, ws_size); grid = -1; return; }
        int dev = 0, cus = 0, per_cu = 0;
        (void)hipGetDevice(&dev); (void)hipDeviceGetAttribute(&cus, hipDeviceAttributeMultiprocessorCount, dev);
        if (hipFuncSetAttribute((const void*)fwd_kernel, hipFuncAttributeMaxDynamicSharedMemorySize, LDS_BYTES) != hipSuccess) { fprintf(stderr, "kernel_launch: hipFuncSetAttribute failed\n"); grid = -1; return; }
        (void)hipOccupancyMaxActiveBlocksPerMultiprocessor(&per_cu, (const void*)fwd_kernel, 512, LDS_BYTES);
        (void)hipGetLastError();
        if (per_cu < 1) per_cu = 1;
        grid = cus;
        fprintf(stderr, "kernel_launch: cus %d per_cu %d grid %d\n", cus, per_cu, grid);
    }
    if (grid < 0) return;
    Args a{};
    for (int i = 0; i < 24; ++i) a.in[i] = (const float*)d_in[i];
    a.out = (float*)d_out; a.ws = (unsigned char*)d_ws;
#if MK_PER_PHASE
    for (int ph = 0; ph < N_PHASES; ++ph) { a.ph_lo = ph; a.ph_hi = ph + 1; hipLaunchKernelGGL(fwd_kernel, dim3(grid), dim3(512), LDS_BYTES, stream, a); }
#else
    a.ph_lo = 0; a.ph_hi = MK_PH_HI;
    (void)hipMemsetAsync((unsigned char*)d_ws + WS_BAR, 0, 16384, stream);
    void* args[] = {&a};
    hipError_t e = hipLaunchCooperativeKernel((const void*)fwd_kernel, dim3(grid), dim3(512), args, LDS_BYTES, stream);
    if (e != hipSuccess) fprintf(stderr, "kernel_launch: cooperative launch failed: %s (grid %d)\n", hipGetErrorString(e), grid);
#endif
}
```

```cpp
#include <hip/hip_runtime.h>
#include <hip/hip_cooperative_groups.h>
#include <cstdio>
#include <cstdint>
namespace cg = cooperative_groups;

#define LAS __attribute__((address_space(3)))
typedef unsigned short bf16_t;
typedef short bf16x8 __attribute__((ext_vector_type(8)));
typedef float f32x4 __attribute__((ext_vector_type(4)));
typedef float f32x2 __attribute__((ext_vector_type(2)));
typedef float f32x16 __attribute__((ext_vector_type(16)));
typedef unsigned u32x4 __attribute__((ext_vector_type(4)));
typedef unsigned u32x2 __attribute__((ext_vector_type(2)));
typedef __bf16 bf16x2_t __attribute__((ext_vector_type(2)));

constexpr int D = 1024, NB = 8, SEQ = 4096, CTXL = 256, FF = 4096;
constexpr int ML = NB * SEQ, MC = NB * CTXL, MT = ML + MC;
constexpr int EVN = 3088, EVNP = 3328, ODN = 3072;
constexpr float ALPHA = 1.6817928305074292f;
constexpr float EPS = 1e-6f;
constexpr int NKV = CTXL + SEQ;
constexpr float QSCALE = 0.125f * 1.4426950408889634f;

constexpr size_t MiB = 1u << 20;
constexpr size_t WS_MISC = 0;
constexpr size_t WS_BAR = 65536;
constexpr size_t WS_MOD = 1 * MiB;
constexpr size_t WS_WA = 2 * MiB;
constexpr size_t WS_WO = 9 * MiB;
constexpr size_t WS_W1 = 11 * MiB;
constexpr size_t WS_W2 = 19 * MiB;
constexpr size_t WS_HC = 27 * MiB;
constexpr size_t WS_U = 35 * MiB;
constexpr size_t WS_P = 103 * MiB;
constexpr size_t WS_X = 324 * MiB;
constexpr size_t WS_V = WS_X;
constexpr size_t WS_OF = WS_X + 34 * MiB;
constexpr size_t WS_OB = WS_X + 68 * MiB;
constexpr size_t WS_G = WS_X + 102 * MiB;
constexpr size_t WS_BT = WS_X + 104 * MiB;
constexpr size_t WS_TOTA = WS_X + 106 * MiB;
constexpr size_t WS_TOTH = WS_X + 109 * MiB;
constexpr size_t WS_CARRY = WS_X + 112 * MiB;
constexpr size_t WS_HLAST = 375 * MiB;
constexpr size_t WS_PART = 376 * MiB;
constexpr size_t WS_TB = WS_X + 116 * MiB;
constexpr size_t WS_QKB = WS_X + 150 * MiB;
constexpr size_t WS_GAM = WS_X + 184 * MiB;
constexpr size_t WS_END = WS_X + 186 * MiB;

constexpr int LDS_BYTES = 147456;

__device__ __forceinline__ float bf2f(unsigned v) { return __uint_as_float(v << 16); }
__device__ __forceinline__ unsigned pk2(float lo, float hi) { f32x2 v = {lo, hi}; bf16x2_t b = __builtin_convertvector(v, bf16x2_t); return __builtin_bit_cast(unsigned, b); }
__device__ __forceinline__ unsigned f2bf(float f) { return pk2(f, 0.f) & 0xffffu; }
__device__ __forceinline__ void unpack8(const u32x4 r, float* o) {
    o[0] = __uint_as_float(r.x << 16); o[1] = __uint_as_float(r.x & 0xffff0000u);
    o[2] = __uint_as_float(r.y << 16); o[3] = __uint_as_float(r.y & 0xffff0000u);
    o[4] = __uint_as_float(r.z << 16); o[5] = __uint_as_float(r.z & 0xffff0000u);
    o[6] = __uint_as_float(r.w << 16); o[7] = __uint_as_float(r.w & 0xffff0000u);
}
__device__ __forceinline__ u32x4 pack8(const float* v) { u32x4 o; o.x = pk2(v[0], v[1]); o.y = pk2(v[2], v[3]); o.z = pk2(v[4], v[5]); o.w = pk2(v[6], v[7]); return o; }
__device__ __forceinline__ float sigmoidf_(float x) { return 1.f / (1.f + expf(-x)); }
__device__ __forceinline__ float siluf_(float x) { return x / (1.f + expf(-x)); }
__device__ __forceinline__ float fsigmoid(float x) { return __builtin_amdgcn_rcpf(1.0f + __builtin_amdgcn_exp2f(-1.4426950408889634f * x)); }
__device__ __forceinline__ float fsilu(float x) { return x * fsigmoid(x); }
__device__ __forceinline__ float softplusf_(float x) { return fmaxf(x, 0.f) + log1pf(expf(-fabsf(x))); }
__device__ __forceinline__ float gelu_tanh(float x) { const float u = 0.7978845608028654f * (x + 0.044715f * x * x * x); return 0.5f * x * (1.f + tanhf(u)); }
__device__ __forceinline__ float dppf(float v, const int ctrl_sel) {
    int r;
    if (ctrl_sel == 0) r = __builtin_amdgcn_update_dpp(0, __float_as_int(v), 0xB1, 0xF, 0xF, true);
    else if (ctrl_sel == 1) r = __builtin_amdgcn_update_dpp(0, __float_as_int(v), 0x4E, 0xF, 0xF, true);
    else if (ctrl_sel == 2) r = __builtin_amdgcn_update_dpp(0, __float_as_int(v), 0x141, 0xF, 0xF, true);
    else r = __builtin_amdgcn_update_dpp(0, __float_as_int(v), 0x140, 0xF, 0xF, true);
    return __int_as_float(r);
}
__device__ __forceinline__ float rowsum16(float v) { v += dppf(v, 0); v += dppf(v, 1); v += dppf(v, 2); v += dppf(v, 3); return v; }
__device__ __forceinline__ float wave_sum(float v) {
#pragma unroll
    for (int o = 1; o < 64; o <<= 1) v += __shfl_xor(v, o);
    return v;
}
__device__ __forceinline__ float xhalf_max(float v) { auto rr = __builtin_amdgcn_permlane32_swap(__float_as_uint(v), __float_as_uint(v), false, false); return fmaxf(__uint_as_float(rr[0]), __uint_as_float(rr[1])); }
__device__ __forceinline__ float xhalf_sum(float v) { auto rr = __builtin_amdgcn_permlane32_swap(__float_as_uint(v), __float_as_uint(v), false, false); return __uint_as_float(rr[0]) + __uint_as_float(rr[1]); }
#define LDS_WAIT() asm volatile("s_waitcnt lgkmcnt(0)" ::: "memory")

namespace pg8 {
constexpr int BM = 256, BK = 64, HALF = 128, HTB = HALF * BK * 2, STAGE_BYTES = 8 * HTB, NXCD = 8, WGM = 8;
__host__ __device__ __forceinline__ int lds_byte(int r, int c) { const int st = (r >> 4) * 2 + (c >> 5), rr = r & 15, cc = c & 31, ob = rr * 64 + cc * 2; return st * 1024 + (ob ^ (((ob >> 9) & 1) << 5)); }
__host__ __device__ __forceinline__ void stage_rc(int b, int& R, int& C) { const int st = b / 1024, sb = b % 1024, swz = sb ^ (((sb >> 9) & 1) << 5); R = (st >> 1) * 16 + swz / 64; C = (st & 1) * 32 + (swz % 64) / 2; }
__host__ __device__ __forceinline__ int perm32(int rho) { const int n = rho >> 4, i = rho & 15; return 8 * (i >> 2) + 4 * n + (i & 3); }
struct Unit { int pm, pn, ks; };
struct Gemm { const bf16_t* A; const bf16_t* Bt; int M, N, K, lda, ldb, nks; };
struct StaticOrder {
    int nM, nN, nwg, G, c;
    int nks;
    __device__ void init(int M, int N, int G_, int c_, int nks_) { nM = M / BM; nN = N / BM; nwg = nM * nN; G = G_; c = c_; nks = nks_; }
    __device__ bool next(int i, Unit& u) const {
        const long L = (long)i * G + c; if (L >= (long)nwg * nks) return false;
        u.ks = (int)(L % nks); int wgid = (int)(L / nks); { const int q = nwg / NXCD, r = nwg % NXCD, xcd = wgid % NXCD, off = wgid / NXCD; wgid = (xcd < r ? xcd * (q + 1) : r * (q + 1) + (xcd - r) * q) + off; }
        const int nig = WGM * nN, gid = wgid / nig, fm = gid * WGM, gsz = (nM - fm) < WGM ? (nM - fm) : WGM;
        u.pm = fm + ((wgid % nig) % gsz); u.pn = (wgid % nig) / gsz; return true;
    }
};
struct EpiBf16 {
    static constexpr bool PERM = true;
    bf16_t* O; int ldc; int act; const float* gate; int bb_force; size_t ks_stride;
    __device__ __forceinline__ void operator()(const f32x4 (&acc)[2][2][4][2], const Unit& u, int wr, int wc, int fr, int fq) const {
        const int rt = u.pm * BM; const int bb = bb_force >= 0 ? bb_force : (rt >= ML ? 8 : (rt >> 12));
        const int row0 = rt + wr * 64 + fr; const int col0 = u.pn * BM + wc * 32 + 8 * fq;
        f32x4 gv[2][2];
#pragma unroll
        for (int bj = 0; bj < 2; ++bj)
#pragma unroll
            for (int n = 0; n < 2; ++n) gv[bj][n] = gate ? *(const f32x4*)(gate + bb * 6144 + col0 + bj * HALF + 4 * n) : (f32x4){1.f, 1.f, 1.f, 1.f};
#pragma unroll
        for (int ai = 0; ai < 2; ++ai)
#pragma unroll
            for (int m = 0; m < 4; ++m) { bf16_t* rowp = O + (size_t)u.ks * ks_stride + (size_t)(row0 + ai * HALF + m * 16) * ldc + col0;
#pragma unroll
                for (int bj = 0; bj < 2; ++bj) { f32x4 v0 = acc[ai][bj][m][0], v1 = acc[ai][bj][m][1];
                    if (act == 2) {
#pragma unroll
                        for (int e = 0; e < 4; ++e) { float a0 = fmaxf(v0[e], 0.f), a1 = fmaxf(v1[e], 0.f); v0[e] = a0 * a0; v1[e] = a1 * a1; } }
                    v0 = v0 * gv[bj][0]; v1 = v1 * gv[bj][1];
                    u32x4 w; w.x = pk2(v0[0], v0[1]); w.y = pk2(v0[2], v0[3]); w.z = pk2(v1[0], v1[1]); w.w = pk2(v1[2], v1[3]);
                    *(u32x4*)(rowp + bj * HALF) = w; } }
    }
};

template <class Epi>
__device__ __forceinline__ void gemm_phase(LAS unsigned char* lds, const Gemm g, const StaticOrder& S, const Epi& E, const int tid) {
    const int wid = __builtin_amdgcn_readfirstlane(tid >> 6), lane = tid & 63, wr = wid >> 2, wc = wid & 3, fr = lane & 15, fq = lane >> 4;
    const int K = g.K, nt = K / BK;
    unsigned voffA[2], voffB[2];
#pragma unroll
    for (int i = 0; i < 2; ++i) { int R, C; stage_rc(tid * 16 + i * 8192, R, C); const int Rb = Epi::PERM ? ((R & ~31) + perm32(R & 31)) : R;
        voffA[i] = (unsigned)(R * g.lda + C) * 2u; voffB[i] = (unsigned)(Rb * g.ldb + C) * 2u; }
    const size_t kstep = (size_t)(BK * 2);
    const size_t hA = (size_t)HALF * g.lda * 2, hB = (size_t)HALF * g.ldb * 2, kso = (size_t)K * 2;
    const size_t tA = 2 * hA, tB = 2 * hB;
    const unsigned ldsw = (unsigned)wid * 1024u;
    const int aoff = lds_byte(wr * 64 + fr, fq * 8), boff = lds_byte(wc * 32 + fr, fq * 8);
#define PG8_SA(b, h) (((b) * 2 + (h)) * HTB)
#define PG8_SB(b, h) ((4 + (b) * 2 + (h)) * HTB)
#define PG8_STAGE(bufoff, gbase, voff) do { _Pragma("unroll") for (int _i = 0; _i < 2; ++_i) \
        __builtin_amdgcn_global_load_lds((const unsigned*)((const char*)(gbase) + (voff)[_i]), (LAS unsigned*)(lds + (bufoff) + ldsw + _i * 8192), 16, 0, 0); } while (0)
#define PG8_LDA(dst, b, h) do { _Pragma("unroll") for (int m = 0; m < 4; ++m) _Pragma("unroll") for (int k = 0; k < 2; ++k) dst[m][k] = *(const LAS bf16x8*)(lds + PG8_SA(b, h) + aoff + m * 2048 + k * 1024); } while (0)
#define PG8_LDB(dst, b, h) do { _Pragma("unroll") for (int n = 0; n < 2; ++n) _Pragma("unroll") for (int k = 0; k < 2; ++k) dst[n][k] = *(const LAS bf16x8*)(lds + PG8_SB(b, h) + boff + n * 2048 + k * 1024); } while (0)
#define PG8_MMA(ai, bj, At, Bt) do { __builtin_amdgcn_s_setprio(1); _Pragma("unroll") for (int m = 0; m < 4; ++m) _Pragma("unroll") for (int n = 0; n < 2; ++n) _Pragma("unroll") for (int k = 0; k < 2; ++k) \
        acc[ai][bj][m][n] = __builtin_amdgcn_mfma_f32_16x16x32_bf16(Bt[n][k], At[m][k], acc[ai][bj][m][n], 0, 0, 0); __builtin_amdgcn_s_setprio(0); } while (0)
#define PG8_WAIT_V(n) asm volatile("s_waitcnt vmcnt(" #n ")" ::: "memory")
#define PG8_WAIT_L(n) asm volatile("s_waitcnt lgkmcnt(" #n ")" ::: "memory")
#define PG8_BAR __builtin_amdgcn_s_barrier()
#define PG8_SCHED __builtin_amdgcn_sched_barrier(0)
    Unit cur, nxt; int ui = 0;
    if (!S.next(0, cur)) return;
    f32x4 acc[2][2][4][2];
#pragma unroll
    for (int a = 0; a < 2; ++a)
#pragma unroll
        for (int b = 0; b < 2; ++b)
#pragma unroll
            for (int m = 0; m < 4; ++m)
#pragma unroll
                for (int n = 0; n < 2; ++n) acc[a][b][m][n] = (f32x4){0.f, 0.f, 0.f, 0.f};
    bf16x8 At[4][2], B0[2][2], B1[2][2];
    const char* cA = (const char*)g.A + (size_t)cur.pm * tA + cur.ks * kso; const char* cB = (const char*)g.Bt + (size_t)cur.pn * tB + cur.ks * kso;
    PG8_STAGE(PG8_SB(0, 0), cB, voffB); PG8_STAGE(PG8_SB(0, 1), cB + hB, voffB); PG8_STAGE(PG8_SA(0, 0), cA, voffA); PG8_STAGE(PG8_SA(0, 1), cA + hA, voffA);
    if (wr == 1) PG8_BAR;
    PG8_WAIT_V(2); PG8_BAR;
    PG8_STAGE(PG8_SB(1, 0), cB + kstep, voffB); PG8_STAGE(PG8_SA(1, 0), cA + kstep, voffA); PG8_STAGE(PG8_SB(1, 1), cB + hB + kstep, voffB);
    PG8_WAIT_V(6); PG8_BAR;
    for (;;) {
        const bool has_next = S.next(ui + 1, nxt);
        const char* nA = has_next ? (const char*)g.A + (size_t)nxt.pm * tA + nxt.ks * kso : cA; const char* nB = has_next ? (const char*)g.Bt + (size_t)nxt.pn * tB + nxt.ks * kso : cB;
        for (int t = 0; t < nt; t += 2) {
            const bool last = (t == nt - 2);
            const char* a1 = cA + (size_t)(t + 1) * kstep;
            const char* a2 = last ? nA : cA + (size_t)(t + 2) * kstep; const char* b2 = last ? nB : cB + (size_t)(t + 2) * kstep;
            const char* a3 = a2 + kstep; const char* b3 = b2 + kstep;
            PG8_LDB(B0, 0, 0); PG8_LDB(B1, 0, 1); PG8_SCHED; PG8_LDA(At, 0, 0); PG8_STAGE(PG8_SA(1, 1), a1 + hA, voffA);
            PG8_WAIT_V(8); PG8_WAIT_L(0); PG8_BAR; PG8_MMA(0, 0, At, B0); PG8_MMA(0, 1, At, B1); PG8_BAR; PG8_SCHED;
            PG8_LDA(At, 0, 1); PG8_STAGE(PG8_SB(0, 0), b2, voffB); PG8_STAGE(PG8_SB(0, 1), b2 + hB, voffB); PG8_STAGE(PG8_SA(0, 0), a2, voffA);
            PG8_WAIT_V(8); PG8_WAIT_L(0); PG8_BAR; PG8_MMA(1, 0, At, B0); PG8_MMA(1, 1, At, B1); PG8_BAR; PG8_SCHED;
            PG8_LDB(B0, 1, 0); PG8_LDB(B1, 1, 1); PG8_SCHED; PG8_LDA(At, 1, 0); PG8_STAGE(PG8_SA(0, 1), a2 + hA, voffA);
            PG8_WAIT_V(8); PG8_WAIT_L(0); PG8_BAR; PG8_MMA(0, 0, At, B0); PG8_MMA(0, 1, At, B1); PG8_BAR; PG8_SCHED;
            PG8_LDA(At, 1, 1); PG8_STAGE(PG8_SB(1, 0), b3, voffB); PG8_STAGE(PG8_SB(1, 1), b3 + hB, voffB); PG8_STAGE(PG8_SA(1, 0), a3, voffA);
            PG8_WAIT_V(8); PG8_WAIT_L(0); PG8_BAR; PG8_MMA(1, 0, At, B0); PG8_MMA(1, 1, At, B1); PG8_BAR; PG8_SCHED;
        }
        if (wr == 0) PG8_BAR;
        E(acc, cur, wr, wc, fr, fq);
        if (!has_next) break;
#pragma unroll
        for (int a = 0; a < 2; ++a)
#pragma unroll
            for (int b = 0; b < 2; ++b)
#pragma unroll
                for (int m = 0; m < 4; ++m)
#pragma unroll
                    for (int n = 0; n < 2; ++n) acc[a][b][m][n] = (f32x4){0.f, 0.f, 0.f, 0.f};
        cur = nxt; cA = nA; cB = nB; ++ui;
        if (wr == 1) PG8_BAR;
    }
    PG8_WAIT_V(0);
    PG8_BAR;
#undef PG8_SA
#undef PG8_SB
#undef PG8_STAGE
#undef PG8_LDA
#undef PG8_LDB
#undef PG8_MMA
#undef PG8_WAIT_V
#undef PG8_WAIT_L
#undef PG8_BAR
#undef PG8_SCHED
}
}

struct Args { const float* in[24]; float* out; unsigned char* ws; int ph_lo, ph_hi; };
typedef const __attribute__((address_space(4))) Args* KA;
enum { I_X = 0, I_C, I_CTX, I_CCTX, I_ADAW, I_ADAB, I_LNG, I_LNB, I_W1, I_W2, I_WOUT, I_EVWIN, I_EVQKVCONV, I_EVALOG, I_EVDTB, I_EVGDNNORM,
       I_LRUCW, I_LRUCB, I_LRUGW, I_LRUGB, I_LRULAM, I_ODWQKV, I_ODLAM, I_ODSUBLN };
enum { K_PROA = 0, K_PROB, K_PROJ, K_E2, K_E3, K_E4, K_O2, K_O3, K_WOUT, K_LN1, K_MLP1, K_MLP2, K_LN2, K_E2B };
constexpr int N_PHASES = 2 + 10 + 8 + 10 + 8;

__device__ __forceinline__ void transpose_item(const float* W, int K, int N, int Npad, bf16_t* WT, LAS float* scr, int item, int lane) {
    const int nblk = Npad / 32, kb = item / nblk, nb = item % nblk, k0 = 64 * kb, n0 = 32 * nb;
    const int n = n0 + (lane & 31);
    { float wv[32];
#pragma unroll
      for (int i = 0; i < 32; ++i) { const int kk = 2 * i + (lane >> 5); wv[i] = (n < N) ? W[(size_t)(k0 + kk) * N + n] : 0.f; }
#pragma unroll
      for (int i = 0; i < 32; ++i) { const int kk = 2 * i + (lane >> 5); scr[kk * 33 + (lane & 31)] = wv[i]; } }
    LDS_WAIT();
    const int c = lane & 7;
#pragma unroll
    for (int j = 0; j < 4; ++j) { const int nn = (lane >> 3) + 8 * j; const LAS float* s = scr + (8 * c) * 33 + nn;
        u32x4 o; o.x = pk2(s[0 * 33], s[1 * 33]); o.y = pk2(s[2 * 33], s[3 * 33]); o.z = pk2(s[4 * 33], s[5 * 33]); o.w = pk2(s[6 * 33], s[7 * 33]);
        *(u32x4*)(WT + (size_t)(n0 + nn) * K + k0 + 8 * c) = o; }
    LDS_WAIT();
}
__device__ __forceinline__ void conv_weights(KA a, int L, LAS unsigned char* lds, int gw, int NGW, int wave, int lane) {
    LAS float* scr = (LAS float*)(lds + wave * 16384);
    const bool even = (L & 1) == 0; const int j2 = L >> 1;
    const float* Wa = even ? a->in[I_EVWIN] + (size_t)j2 * D * EVN : a->in[I_ODWQKV] + (size_t)j2 * D * ODN;
    const int Na = even ? EVN : ODN, Nap = even ? EVNP : ODN;
    const int IA = (D / 64) * (Nap / 32), IO = (D / 64) * (D / 32), I1 = (D / 64) * (FF / 32), I2 = (FF / 64) * (D / 32);
    bf16_t* WA = (bf16_t*)(a->ws + WS_WA); bf16_t* WO = (bf16_t*)(a->ws + WS_WO); bf16_t* W1 = (bf16_t*)(a->ws + WS_W1); bf16_t* W2 = (bf16_t*)(a->ws + WS_W2);
    for (int it = gw; it < IA + IO + I1 + I2; it += NGW) {
        int r = it;
        if (r < IA) { transpose_item(Wa, D, Na, Nap, WA, scr, r, lane); continue; } r -= IA;
        if (r < IO) { transpose_item(a->in[I_WOUT] + (size_t)L * D * D, D, D, D, WO, scr, r, lane); continue; } r -= IO;
        if (r < I1) { transpose_item(a->in[I_W1] + (size_t)L * D * FF, D, FF, FF, W1, scr, r, lane); continue; } r -= I1;
        transpose_item(a->in[I_W2] + (size_t)L * FF * D, FF, D, D, W2, scr, r, lane);
    }
}

__device__ __forceinline__ void modulate_row_store(const f32x4 (&v)[4], const float* mod_bb, int sidx, bf16_t* urow, int lane) {
#pragma unroll
    for (int j = 0; j < 4; ++j) { const int c = 4 * (lane + 64 * j);
        const f32x4 sh = *(const f32x4*)(mod_bb + sidx * D + c), sc = *(const f32x4*)(mod_bb + (sidx + 1) * D + c);
        const f32x4 u = v[j] * (sc + 1.0f) + sh; u32x2 w; w.x = pk2(u[0], u[1]); w.y = pk2(u[2], u[3]); *(u32x2*)(urow + c) = w; }
}
__device__ __forceinline__ void prologue_b(KA a, int gw, int NGW, int lane) {
    const float* MOD = (const float*)(a->ws + WS_MOD); bf16_t* U = (bf16_t*)(a->ws + WS_U);
    for (int row = gw; row < MT; row += NGW) {
        const bool isctx = row >= ML; const int bb = isctx ? 8 : (row >> 12);
        const float* hp = isctx ? a->in[I_CTX] + (size_t)(row - ML) * D : a->in[I_X] + (size_t)row * D;
        f32x4 v[4];
#pragma unroll
        for (int j = 0; j < 4; ++j) v[j] = *(const f32x4*)(hp + 4 * (lane + 64 * j));
        modulate_row_store(v, MOD + (size_t)(0 * 9 + bb) * 6144, 0, U + (size_t)row * D, lane);
    }
}
__device__ __forceinline__ void ln_row_finish(f32x4 (&v)[4], float s, const float* lg, const float* lb, bf16_t* hp16, float* hp32, bool do_u, const float* mod_bb, int sidx, bf16_t* urow, int lane) {
    const float mean = wave_sum(s) * (1.f / D); float s2 = 0.f;
#pragma unroll
    for (int j = 0; j < 4; ++j) { v[j] = v[j] - mean; s2 += (v[j][0] * v[j][0] + v[j][1] * v[j][1]) + (v[j][2] * v[j][2] + v[j][3] * v[j][3]); }
    const float rstd = 1.0f / sqrtf(wave_sum(s2) * (1.f / D) + EPS);
#pragma unroll
    for (int j = 0; j < 4; ++j) { const int c = 4 * (lane + 64 * j); const f32x4 gg = *(const f32x4*)(lg + c), bbv = *(const f32x4*)(lb + c);
        v[j] = v[j] * rstd * gg + bbv;
        if (hp32) __builtin_nontemporal_store(v[j], (f32x4*)(hp32 + c));
        else { typedef _Float16 h4_t __attribute__((ext_vector_type(4))); const u32x2 w = __builtin_bit_cast(u32x2, __builtin_convertvector(v[j], h4_t)); __builtin_nontemporal_store(w, (u32x2*)(hp16 + c)); } }
    if (do_u) modulate_row_store(v, mod_bb, sidx, urow, lane);
}
typedef _Float16 h16x4 __attribute__((ext_vector_type(4)));
__device__ __forceinline__ f32x4 hf4(const u32x2 w) { return __builtin_convertvector(__builtin_bit_cast(h16x4, w), f32x4); }
__device__ __forceinline__ u32x2 f4h(const f32x4 v) { return __builtin_bit_cast(u32x2, __builtin_convertvector(v, h16x4)); }
__device__ __forceinline__ f32x4 bf4(const u32x2 w) { return (f32x4){__uint_as_float(w.x << 16), __uint_as_float(w.x & 0xffff0000u), __uint_as_float(w.y << 16), __uint_as_float(w.y & 0xffff0000u)}; }
__device__ __forceinline__ void ln_pass(KA a, int L, int which, int nrows, bool do_u, int Lm, int sidx, const bf16_t* T, int npart, int gw, int NGW, int lane) {
    const float* MOD = (const float*)(a->ws + WS_MOD); bf16_t* U = (bf16_t*)(a->ws + WS_U); bf16_t* HC = (bf16_t*)(a->ws + WS_HC);
    const float* lg = a->in[I_LNG] + (size_t)(L * 2 + which) * D; const float* lb = a->in[I_LNB] + (size_t)(L * 2 + which) * D;
    const bool first = (L == 0 && which == 0), fin = (L == 3 && which == 1);
    bf16_t* HL = (bf16_t*)((unsigned char*)a->out + (size_t)64 * MiB); bf16_t* HX = (bf16_t*)(a->ws + WS_HLAST);
    const bf16_t* hin16 = fin ? HX : HL;
    bf16_t* hout16 = (L == 3 && which == 0) ? HX : HL;
    const int nmain = npart > 0 ? ML : nrows;
    if (first) {
        f32x4 hv[4]; u32x2 tw[4];
#define LN_FETCH(HV, TW, row_) do { const int r_ = (row_); const float* hin_ = a->in[I_X] + (size_t)r_ * D; const bf16_t* tp_ = T + (size_t)r_ * D; \
        _Pragma("unroll") for (int j = 0; j < 4; ++j) { const int c = 4 * (lane + 64 * j); HV[j] = __builtin_nontemporal_load((const f32x4*)(hin_ + c)); TW[j] = __builtin_nontemporal_load((const u32x2*)(tp_ + c)); } } while (0)
        if (gw < nmain) LN_FETCH(hv, tw, gw);
#pragma unroll 2
        for (int row = gw; row < nmain; row += NGW) {
            f32x4 hn[4]; u32x2 tn[4]; const int nrow = row + NGW < nmain ? row + NGW : row;
            LN_FETCH(hn, tn, nrow);
            f32x4 v[4]; float s = 0.f;
#pragma unroll
            for (int j = 0; j < 4; ++j) { v[j] = hv[j] * ALPHA + bf4(tw[j]); s += (v[j][0] + v[j][1]) + (v[j][2] + v[j][3]); }
            ln_row_finish(v, s, lg, lb, hout16 + (size_t)row * D, nullptr, do_u, MOD + (size_t)(Lm * 9 + (row >> 12)) * 6144, sidx, U + (size_t)row * D, lane);
#pragma unroll
            for (int j = 0; j < 4; ++j) { hv[j] = hn[j]; tw[j] = tn[j]; }
        }
#undef LN_FETCH
    } else {
        u32x2 hv[4], tw[4];
#define LN_FETCH(HV, TW, row_) do { const int r_ = (row_); const bf16_t* hin_ = hin16 + (size_t)r_ * D; const bf16_t* tp_ = T + (size_t)r_ * D; \
        _Pragma("unroll") for (int j = 0; j < 4; ++j) { const int c = 4 * (lane + 64 * j); HV[j] = __builtin_nontemporal_load((const u32x2*)(hin_ + c)); TW[j] = __builtin_nontemporal_load((const u32x2*)(tp_ + c)); } } while (0)
        if (gw < nmain) LN_FETCH(hv, tw, gw);
#pragma unroll 2
        for (int row = gw; row < nmain; row += NGW) {
            u32x2 hn[4], tn[4]; const int nrow = row + NGW < nmain ? row + NGW : row;
            LN_FETCH(hn, tn, nrow);
            f32x4 v[4]; float s = 0.f;
#pragma unroll
            for (int j = 0; j < 4; ++j) { v[j] = hf4(hv[j]) * ALPHA + bf4(tw[j]); s += (v[j][0] + v[j][1]) + (v[j][2] + v[j][3]); }
            ln_row_finish(v, s, lg, lb, hout16 + (size_t)row * D, fin ? a->out + (size_t)row * D : nullptr, do_u, MOD + (size_t)(Lm * 9 + (row >> 12)) * 6144, sidx, U + (size_t)row * D, lane);
#pragma unroll
            for (int j = 0; j < 4; ++j) { hv[j] = hn[j]; tw[j] = tn[j]; }
        }
#undef LN_FETCH
    }
    if (npart > 0) {
        const bf16_t* PART = (const bf16_t*)(a->ws + WS_PART);
        for (int row = ML + gw; row < nrows; row += NGW) {
            const size_t rc = (size_t)(row - ML); bf16_t* hp = HC + rc * D;
            f32x4 v[4]; float s = 0.f;
#pragma unroll
            for (int j = 0; j < 4; ++j) { const int c = 4 * (lane + 64 * j); f32x4 tv = {0.f, 0.f, 0.f, 0.f};
                for (int ks = 0; ks < npart; ++ks) tv += bf4(*(const u32x2*)(PART + (size_t)ks * MC * D + rc * D + c));
                const f32x4 hh = first ? *(const f32x4*)(a->in[I_CTX] + rc * D + c) : hf4(*(const u32x2*)(hp + c));
                v[j] = hh * ALPHA + tv; s += (v[j][0] + v[j][1]) + (v[j][2] + v[j][3]); }
            ln_row_finish(v, s, lg, lb, hp, nullptr, do_u, MOD + (size_t)(Lm * 9 + 8) * 6144, sidx, U + (size_t)row * D, lane);
        }
    }
}

__device__ __forceinline__ void prologue_a(KA a, LAS unsigned char* lds, int bid, int G, int tid, int wave, int lane) {
    float* MOD = (float*)(a->ws + WS_MOD); float* MISC = (float*)(a->ws + WS_MISC);
    LAS float* sv = (LAS float*)lds;
    LAS float* red = (LAS float*)(lds + 9 * 1024 * 4);
    for (int i = tid; i < 9 * 1024; i += 512) { const int bb = i >> 10, k = i & 1023; const float v = bb < 8 ? a->in[I_C][bb * 1024 + k] : a->in[I_CCTX][k]; sv[i] = siluf_(v); }
    __syncthreads();
    for (int unit = bid; unit < 192; unit += G) {
        const int L = unit / 48, cb = unit % 48, col = tid & 127, kq = tid >> 7;
        const float* w = a->in[I_ADAW] + (size_t)L * D * 6144 + cb * 128 + col;
        float acc[9];
#pragma unroll
        for (int bb = 0; bb < 9; ++bb) acc[bb] = 0.f;
        for (int k0 = kq * 256; k0 < kq * 256 + 256; k0 += 16) { float wv[16];
#pragma unroll
            for (int i = 0; i < 16; ++i) wv[i] = w[(size_t)(k0 + i) * 6144];
#pragma unroll
            for (int i = 0; i < 16; ++i)
#pragma unroll
                for (int bb = 0; bb < 9; ++bb) acc[bb] += sv[bb * 1024 + k0 + i] * wv[i]; }
#pragma unroll
        for (int bb = 0; bb < 9; ++bb) red[(kq * 9 + bb) * 128 + col] = acc[bb];
        __syncthreads();
        for (int i = tid; i < 9 * 128; i += 512) { const int bb = i >> 7, cc = i & 127;
            float s = (red[(0 * 9 + bb) * 128 + cc] + red[(1 * 9 + bb) * 128 + cc]) + (red[(2 * 9 + bb) * 128 + cc] + red[(3 * 9 + bb) * 128 + cc]);
            s += a->in[I_ADAB][L * 6144 + cb * 128 + cc]; MOD[(size_t)(L * 9 + bb) * 6144 + cb * 128 + cc] = s; }
        __syncthreads();
    }
    if (bid == G - 1) {
        if (tid < 16) {
            double th = 1.0; for (int j = 0; j < tid; ++j) th *= 0.56234132519034908;
            const double t2 = th * th; double sn = th, term = th, cs = 1.0, tc = 1.0;
            for (int k = 1; k < 12; ++k) { tc *= -t2 / ((2.0 * k - 1.0) * (2.0 * k)); cs += tc; term *= -t2 / ((2.0 * k) * (2.0 * k + 1.0)); sn += term; }
            double c = 1.0, s = 0.0;
            for (int p = 0; p < 64; ++p) { MISC[64 + p * 16 + tid] = (float)c; MISC[1088 + p * 16 + tid] = (float)s; const double c2 = c * cs - s * sn, s2 = s * cs + c * sn; c = c2; s = s2; }
        }
        if (tid >= 64 && tid < 66) { const int j = tid - 64; const float* lv = a->in[I_ODLAM] + j * 256; float d0 = 0.f, d1 = 0.f;
            for (int i = 0; i < 64; ++i) { d0 += lv[i] * lv[64 + i]; d1 += lv[128 + i] * lv[192 + i]; }
            const float li = 0.8f - 0.6f * expf(-0.3f * (float)(2 * j + 1)); MISC[j] = expf(d0) - expf(d1) + li; MISC[2 + j] = li; }
    }
    __syncthreads();
    conv_weights(a, 0, lds, bid * 8 + wave, G * 8, wave, lane);
}

__device__ __forceinline__ void attn_prep(KA a, LAS unsigned char* lds, int bid, int G, int tid) {
    bf16_t* P = (bf16_t*)(a->ws + WS_P); bf16_t* VT = (bf16_t*)(a->ws + WS_V); const float* MISC = (const float*)(a->ws + WS_MISC);
    const float* tabc = MISC + 64; const float* tabs = MISC + 1088;
    constexpr int VP = 2064;
    for (int u = bid; u < 2 * NB * 68; u += G) {
        const bool vpart = u >= NB * 68; const int uu = vpart ? u - NB * 68 : u;
        const int b = uu / 68, tl = uu % 68; const bool isctx = tl < 4; const int t0 = isctx ? tl * 64 : (tl - 4) * 64;
        const int rowbase = isctx ? ML + b * CTXL + t0 : b * SEQ + t0; const int kv0 = isctx ? t0 : CTXL + t0;
        if (!vpart) {
#pragma unroll 1
            for (int half = 0; half < 2; ++half) {
                u32x4 r1[4], r2[4], r3[4], r4[4];
#pragma unroll
                for (int k = 0; k < 4; ++k) { const int it = tid + 512 * (4 * half + k); const int r = it >> 6, rem = it & 63, vec = rem >> 1, part = rem & 1;
                    const bf16_t* p = P + (size_t)(rowbase + r) * ODN + vec * 64 + part * 8;
                    r1[k] = *(const u32x4*)(p); r2[k] = *(const u32x4*)(p + 16); r3[k] = *(const u32x4*)(p + 32); r4[k] = *(const u32x4*)(p + 48); }
#pragma unroll
                for (int k = 0; k < 4; ++k) { const int it = tid + 512 * (4 * half + k); const int r = it >> 6, rem = it & 63, vec = rem >> 1, part = rem & 1; const bool isq = vec < 16;
                    if (isctx && !isq) continue;
                    bf16_t* p = P + (size_t)(rowbase + r) * ODN + vec * 64 + part * 8;
                    float t1[8], t2[8], t3[8], t4[8];
                    unpack8(r1[k], t1); unpack8(r2[k], t2); unpack8(r3[k], t3); unpack8(r4[k], t4);
                    const float sc = isq ? QSCALE : 1.0f;
                    if (!isctx) {
                        const int pos = t0 + r, rp = pos >> 6, cp = pos & 63;
#pragma unroll
                        for (int j = 0; j < 8; ++j) { const int jj = part * 8 + j;
                            const float cr = tabc[rp * 16 + jj], sr = tabs[rp * 16 + jj], cc = tabc[cp * 16 + jj], ss = tabs[cp * 16 + jj];
                            const float o1 = t1[j] * cr - t2[j] * sr, o2 = t2[j] * cr + t1[j] * sr, o3 = t3[j] * cc - t4[j] * ss, o4 = t4[j] * cc + t3[j] * ss;
                            t1[j] = o1 * sc; t2[j] = o2 * sc; t3[j] = o3 * sc; t4[j] = o4 * sc; }
                    } else {
#pragma unroll
                        for (int j = 0; j < 8; ++j) { t1[j] *= sc; t2[j] *= sc; t3[j] *= sc; t4[j] *= sc; }
                    }
                    *(u32x4*)(p) = pack8(t1); *(u32x4*)(p + 16) = pack8(t2); *(u32x4*)(p + 32) = pack8(t3); *(u32x4*)(p + 48) = pack8(t4);
                }
            }
        } else {
            { u32x4 rv[16];
#pragma unroll
              for (int k = 0; k < 16; ++k) { const int id = tid + 512 * k; rv[k] = *(const u32x4*)(P + (size_t)(rowbase + (id >> 7)) * ODN + 2048 + (id & 127) * 8); }
#pragma unroll
              for (int k = 0; k < 16; ++k) { const int id = tid + 512 * k; *(LAS u32x4*)(lds + (id >> 7) * VP + (id & 127) * 16) = rv[k]; } }
            __syncthreads();
#pragma unroll 4
            for (int k = 0; k < 16; ++k) { const int oc = tid + 512 * k; const int col = oc & 1023, c = oc >> 10;
                unsigned w[4];
#pragma unroll
                for (int j = 0; j < 4; ++j) { const unsigned lo = *(const LAS bf16_t*)(lds + (8 * c + 2 * j) * VP + col * 2), hi = *(const LAS bf16_t*)(lds + (8 * c + 2 * j + 1) * VP + col * 2); w[j] = lo | (hi << 16); }
                u32x4 o; o.x = w[0]; o.y = w[1]; o.z = w[2]; o.w = w[3];
                *(u32x4*)(VT + ((size_t)(b * 8 * 128 + col)) * NKV + kv0 + 8 * c) = o; }
            __syncthreads();
        }
    }
}

constexpr int AT_KB = 64 * 272, AT_VB = 128 * 144, AT_BUF = AT_KB + AT_VB, AT_OX = 0;
static_assert(3 * AT_BUF <= LDS_BYTES - 16 && 128 * 132 * 4 <= 3 * AT_BUF, "attention lds");
__device__ __forceinline__ void at_qk(const LAS unsigned char* Kb, const bf16x8 (&qf)[4], f32x16& s0, f32x16& s1, int m, int krow, int hi) {
#pragma unroll
    for (int r = 0; r < 16; ++r) { s0[r] = 0.f; s1[r] = 0.f; }
#pragma unroll
    for (int ks = 0; ks < 4; ++ks) {
        const bf16x8 a0 = *(const LAS bf16x8*)(Kb + krow * 272 + (m * 64 + ks * 16 + hi * 8) * 2);
        const bf16x8 a1 = *(const LAS bf16x8*)(Kb + (krow + 32) * 272 + (m * 64 + ks * 16 + hi * 8) * 2);
        s0 = __builtin_amdgcn_mfma_f32_32x32x16_bf16(a0, qf[ks], s0, 0, 0, 0);
        s1 = __builtin_amdgcn_mfma_f32_32x32x16_bf16(a1, qf[ks], s1, 0, 0, 0);
    }
}
template <bool HAS_NEXT>
__device__ __forceinline__ void at_step(const LAS unsigned char* Kn, const LAS unsigned char* Vc, const bf16x8 (&qf)[4], f32x16 (&o)[4], f32x16& s0, f32x16& s1, f32x16& negm, float& mrun, f32x16& lacc, int m, int krow, int r32, int hi) {
    f32x16 n0, n1;
#pragma unroll
    for (int ks = 0; ks < 4; ++ks) {
        if (HAS_NEXT) {
            const bf16x8 a0 = *(const LAS bf16x8*)(Kn + krow * 272 + (m * 64 + ks * 16 + hi * 8) * 2);
            const bf16x8 a1 = *(const LAS bf16x8*)(Kn + (krow + 32) * 272 + (m * 64 + ks * 16 + hi * 8) * 2);
            if (ks == 0) { n0 = __builtin_amdgcn_mfma_f32_32x32x16_bf16(a0, qf[0], negm, 0, 0, 0); n1 = __builtin_amdgcn_mfma_f32_32x32x16_bf16(a1, qf[0], negm, 0, 0, 0); }
            else { n0 = __builtin_amdgcn_mfma_f32_32x32x16_bf16(a0, qf[ks], n0, 0, 0, 0); n1 = __builtin_amdgcn_mfma_f32_32x32x16_bf16(a1, qf[ks], n1, 0, 0, 0); }
        }
#pragma unroll
        for (int r = 4 * ks; r < 4 * ks + 4; ++r) { s0[r] = __builtin_amdgcn_exp2f(s0[r]); s1[r] = __builtin_amdgcn_exp2f(s1[r]); }
    }
    bf16x8 pb[4];
    { u32x4 w;
      w.x = pk2(s0[0], s0[1]); w.y = pk2(s0[2], s0[3]); w.z = pk2(s0[4], s0[5]); w.w = pk2(s0[6], s0[7]); pb[0] = __builtin_bit_cast(bf16x8, w);
      w.x = pk2(s0[8], s0[9]); w.y = pk2(s0[10], s0[11]); w.z = pk2(s0[12], s0[13]); w.w = pk2(s0[14], s0[15]); pb[1] = __builtin_bit_cast(bf16x8, w);
      w.x = pk2(s1[0], s1[1]); w.y = pk2(s1[2], s1[3]); w.z = pk2(s1[4], s1[5]); w.w = pk2(s1[6], s1[7]); pb[2] = __builtin_bit_cast(bf16x8, w);
      w.x = pk2(s1[8], s1[9]); w.y = pk2(s1[10], s1[11]); w.z = pk2(s1[12], s1[13]); w.w = pk2(s1[14], s1[15]); pb[3] = __builtin_bit_cast(bf16x8, w); }
    const bf16x8 ones = {(short)0x3F80, (short)0x3F80, (short)0x3F80, (short)0x3F80, (short)0x3F80, (short)0x3F80, (short)0x3F80, (short)0x3F80};
    float mx = -3.0e38f;
#pragma unroll
    for (int db = 0; db < 4; ++db) {
#pragma unroll
        for (int i = 0; i < 4; ++i) {
            const bf16x8 av = *(const LAS bf16x8*)(Vc + (32 * db + r32) * 144 + (16 * i + 8 * hi) * 2);
            o[db] = __builtin_amdgcn_mfma_f32_32x32x16_bf16(av, pb[i], o[db], 0, 0, 0);
        }
        lacc = __builtin_amdgcn_mfma_f32_32x32x16_bf16(ones, pb[db], lacc, 0, 0, 0);
        if (HAS_NEXT) {
#pragma unroll
            for (int r = 4 * db; r < 4 * db + 4; ++r) mx = fmaxf(mx, fmaxf(n0[r], n1[r]));
        }
    }
    if (HAS_NEXT) {
        mx = xhalf_max(mx);
        if (__any(mx > 8.0f)) {
            const float delta = (mx > 8.0f) ? mx : 0.f; const float al = __builtin_amdgcn_exp2f(-delta);
#pragma unroll
            for (int db = 0; db < 4; ++db)
#pragma unroll
                for (int r = 0; r < 16; ++r) o[db][r] *= al;
            mrun += delta;
#pragma unroll
            for (int r = 0; r < 16; ++r) { n0[r] -= delta; n1[r] -= delta; negm[r] = -mrun; lacc[r] *= al; }
        }
        s0 = n0; s1 = n1;
    }
}
__device__ __forceinline__ void attn_phase(KA a, int L, LAS unsigned char* lds, int bid, int G, int tid, int wave, int lane, bool do_store) {
    bf16_t* P = (bf16_t*)(a->ws + WS_P); const bf16_t* VT = (const bf16_t*)(a->ws + WS_V); const float* MISC = (const float*)(a->ws + WS_MISC);
    const int j2 = L >> 1; const float lam = MISC[j2], lam_init = MISC[2 + j2];
    const float* subln = a->in[I_ODSUBLN] + j2 * 128;
    const int nunits = 2048 + (L == 1 ? 128 : 0);
    const int m = wave & 1, qs = wave >> 1, r32 = lane & 31, hi = lane >> 5;
    const int krow = (r32 & 0x13) | ((r32 & 4) << 1) | ((r32 & 8) >> 1);
    for (int u = bid; u < nunits; u += G) {
        int bh, qb; const bool isctx = u >= 2048;
        if (!isctx) { bh = (u >> 8) * 8 + (u & 7); qb = (u >> 3) & 31; } else { const int u2 = u - 2048; bh = u2 >> 1; qb = u2 & 1; }
        const int b = bh >> 3, h = bh & 7;
        const int qrow = (isctx ? ML + b * CTXL : b * SEQ) + qb * 128 + qs * 32 + r32;
        const int ntiles = isctx ? 4 : 68;
        bf16x8 qf[4];
#pragma unroll
        for (int ks = 0; ks < 4; ++ks) qf[ks] = *(const bf16x8*)(P + (size_t)qrow * ODN + h * 128 + m * 64 + ks * 16 + hi * 8);
        const int kr0 = tid >> 4, kc = tid & 15;
        const int vd0 = tid >> 3, vc = tid & 7;
        const bf16_t* vsrc0 = VT + ((size_t)(bh * 128 + vd0)) * NKV + 8 * vc; const bf16_t* vsrc1 = vsrc0 + (size_t)64 * NKV;
        u32x4 rk0, rk1, rv0, rv1;
#define AT_LOAD(t) do { const int kv_ = 64 * (t) + kr0; const int g0_ = kv_ < CTXL ? ML + b * CTXL + kv_ : b * SEQ + kv_ - CTXL; const int kv1_ = kv_ + 32; const int g1_ = kv1_ < CTXL ? ML + b * CTXL + kv1_ : b * SEQ + kv1_ - CTXL; \
        rk0 = *(const u32x4*)(P + (size_t)g0_ * ODN + 1024 + h * 128 + kc * 8); rk1 = *(const u32x4*)(P + (size_t)g1_ * ODN + 1024 + h * 128 + kc * 8); \
        rv0 = *(const u32x4*)(vsrc0 + 64 * (t)); rv1 = *(const u32x4*)(vsrc1 + 64 * (t)); } while (0)
#define AT_STORE(boff) do { LAS unsigned char* kb_ = lds + (boff); LAS unsigned char* vb_ = kb_ + AT_KB; \
        *(LAS u32x4*)(kb_ + kr0 * 272 + kc * 16) = rk0; *(LAS u32x4*)(kb_ + (kr0 + 32) * 272 + kc * 16) = rk1; \
        *(LAS u32x4*)(vb_ + vd0 * 144 + vc * 16) = rv0; *(LAS u32x4*)(vb_ + (vd0 + 64) * 144 + vc * 16) = rv1; } while (0)
        { AT_LOAD(0); const u32x4 k0_ = rk0, k1_ = rk1, v0_ = rv0, v1_ = rv1;
          AT_LOAD(1);
          { LAS unsigned char* kb_ = lds; LAS unsigned char* vb_ = kb_ + AT_KB;
            *(LAS u32x4*)(kb_ + kr0 * 272 + kc * 16) = k0_; *(LAS u32x4*)(kb_ + (kr0 + 32) * 272 + kc * 16) = k1_;
            *(LAS u32x4*)(vb_ + vd0 * 144 + vc * 16) = v0_; *(LAS u32x4*)(vb_ + (vd0 + 64) * 144 + vc * 16) = v1_; }
          AT_STORE(AT_BUF); }
        __syncthreads();
        f32x16 o[4];
#pragma unroll
        for (int db = 0; db < 4; ++db)
#pragma unroll
            for (int r = 0; r < 16; ++r) o[db][r] = 0.f;
        f32x16 s0, s1;
        at_qk(lds, qf, s0, s1, m, krow, hi);
        float mrun; f32x16 lacc;
#pragma unroll
        for (int r = 0; r < 16; ++r) lacc[r] = 0.f;
        { float mx = fmaxf(s0[0], s1[0]);
#pragma unroll
          for (int r = 1; r < 16; ++r) mx = fmaxf(mx, fmaxf(s0[r], s1[r]));
          mrun = xhalf_max(mx); }
        f32x16 negm;
#pragma unroll
        for (int r = 0; r < 16; ++r) { s0[r] -= mrun; s1[r] -= mrun; negm[r] = -mrun; }
        int bc = 0, bn = AT_BUF, bs = 2 * AT_BUF;
        for (int t = 0; t + 1 < ntiles; ++t) {
            const bool stage = t + 2 < ntiles;
            if (stage) AT_LOAD(t + 2);
            at_step<true>(lds + bn, lds + bc + AT_KB, qf, o, s0, s1, negm, mrun, lacc, m, krow, r32, hi);
            if (stage) AT_STORE(bs);
            __syncthreads();
            const int tmp = bc; bc = bn; bn = bs; bs = tmp;
        }
        at_step<false>(lds, lds + bc + AT_KB, qf, o, s0, s1, negm, mrun, lacc, m, krow, r32, hi);
        __syncthreads();
#undef AT_LOAD
#undef AT_STORE
        const float inv = 1.0f / lacc[0];
        LAS float* ox = (LAS float*)(lds + AT_OX) + (qs * 32 + r32) * 132;
        if (m == 1) {
#pragma unroll
            for (int db = 0; db < 4; ++db)
#pragma unroll
                for (int r4 = 0; r4 < 4; ++r4) { f32x4 v = {o[db][4 * r4] * inv, o[db][4 * r4 + 1] * inv, o[db][4 * r4 + 2] * inv, o[db][4 * r4 + 3] * inv};
                    *(LAS f32x4*)(ox + 32 * db + 8 * r4 + 4 * hi) = v; }
        }
        __syncthreads();
        if (m == 0) {
            float ssq = 0.f;
#pragma unroll
            for (int db = 0; db < 4; ++db)
#pragma unroll
                for (int r4 = 0; r4 < 4; ++r4) { const f32x4 v1 = *(const LAS f32x4*)(ox + 32 * db + 8 * r4 + 4 * hi);
#pragma unroll
                    for (int e = 0; e < 4; ++e) { const float v = o[db][4 * r4 + e] * inv - lam * v1[e]; o[db][4 * r4 + e] = v; ssq += v * v; } }
            ssq = xhalf_sum(ssq);
            const float sc = (1.0f / sqrtf(ssq * (1.f / 128.f) + EPS)) * (1.0f - lam_init);
            bf16_t* op = P + (size_t)qrow * ODN + h * 128;
#pragma unroll
            for (int db = 0; db < 4; ++db)
#pragma unroll
                for (int r4 = 0; r4 < 4; ++r4) { const int dv = 32 * db + 8 * r4 + 4 * hi; const f32x4 g4 = *(const f32x4*)(subln + dv);
                    u32x2 w; w.x = pk2(o[db][4 * r4] * sc * g4[0], o[db][4 * r4 + 1] * sc * g4[1]); w.y = pk2(o[db][4 * r4 + 2] * sc * g4[2], o[db][4 * r4 + 3] * sc * g4[3]);
                    if (do_store) *(u32x2*)(op + dv) = w; }
        }
        __syncthreads();
    }
}

__device__ __forceinline__ void gdn_prep(KA a, int L, LAS unsigned char* lds, int gw, int NGW, int tid, int lane) {
    const int j2 = L >> 1;
    const bf16_t* P = (const bf16_t*)(a->ws + WS_P);
    bf16_t* QN = (bf16_t*)(a->ws + WS_U); bf16_t* KN = QN + (size_t)MT * 512; bf16_t* V = (bf16_t*)(a->ws + WS_V);
    float* Gb = (float*)(a->ws + WS_G); float* Bt = (float*)(a->ws + WS_BT);
    const float* cw = a->in[I_EVQKVCONV] + (size_t)j2 * 4 * 1536;
    LAS float* cwl = (LAS float*)lds;
    for (int i = tid; i < 4 * 1536 / 4; i += 512) *(LAS f32x4*)(cwl + 4 * i) = *(const f32x4*)(cw + 4 * i);
    __syncthreads();
    float alog = 0.f, dtb = 0.f;
    if (lane < 8) { alog = -expf(a->in[I_EVALOG][j2 * 8 + lane]); dtb = a->in[I_EVDTB][j2 * 8 + lane]; }
    for (int blk = gw; blk < MT / 17; blk += NGW) {
        const int r0 = 17 * blk;
        u32x4 R[20][3]; unsigned ab[17];
#define GP_LOAD(k_) do { const int row_ = r0 - 2 + (k_); const bool ok_ = row_ >= 0 && row_ < MT; \
        _Pragma("unroll") for (int p = 0; p < 3; ++p) R[k_][p] = ok_ ? *(const u32x4*)(P + (size_t)row_ * EVNP + p * 512 + 8 * lane) : (u32x4){0u, 0u, 0u, 0u}; } while (0)
#pragma unroll
        for (int k = 0; k < 6; ++k) GP_LOAD(k);
#pragma unroll
        for (int i = 0; i < 17; ++i) ab[i] = lane < 16 ? (unsigned)P[(size_t)(r0 + i) * EVNP + 2048 + lane] : 0u;
#pragma unroll
        for (int i = 0; i < 17; ++i) {
            if (i + 6 < 20) GP_LOAD(i + 6);
            const int row = r0 + i;
            const bool isctx = row >= ML; const int t = isctx ? ((row - ML) & (CTXL - 1)) : (row & (SEQ - 1)); const int len = isctx ? CTXL : SEQ;
            float val[3][8];
#pragma unroll
            for (int p = 0; p < 3; ++p) {
                float acc[8];
#pragma unroll
                for (int e = 0; e < 8; ++e) acc[e] = 0.f;
#pragma unroll
                for (int j = 0; j < 4; ++j) { const int tt = t + j - 2;
                    if (tt >= 0 && tt < len) { float x[8]; unpack8(R[i + j][p], x);
                        const f32x4 w0 = *(const LAS f32x4*)(cwl + j * 1536 + p * 512 + 8 * lane), w1 = *(const LAS f32x4*)(cwl + j * 1536 + p * 512 + 8 * lane + 4);
#pragma unroll
                        for (int e = 0; e < 8; ++e) acc[e] += (e < 4 ? w0[e & 3] : w1[e & 3]) * x[e]; } }
#pragma unroll
                for (int e = 0; e < 8; ++e) val[p][e] = fsilu(acc[e]);
            }
            float sq = 0.f, sk = 0.f;
#pragma unroll
            for (int e = 0; e < 8; ++e) { sq += val[0][e] * val[0][e]; sk += val[1][e] * val[1][e]; }
            sq = rowsum16(sq); sk = rowsum16(sk);
            const float rq = (1.0f / sqrtf(sq + EPS)) * 0.08838834764831845f, rk = 1.0f / sqrtf(sk + EPS);
#pragma unroll
            for (int e = 0; e < 8; ++e) { val[0][e] *= rq; val[1][e] *= rk; }
            *(u32x4*)(QN + (size_t)row * 512 + 8 * lane) = pack8(val[0]);
            *(u32x4*)(KN + (size_t)row * 512 + 8 * lane) = pack8(val[1]);
            *(u32x4*)(V + (size_t)row * 512 + 8 * lane) = pack8(val[2]);
            if (lane < 8) Gb[(size_t)row * 8 + lane] = alog * softplusf_(bf2f(ab[i]) + dtb);
            else if (lane < 16) Bt[(size_t)row * 8 + lane - 8] = sigmoidf_(bf2f(ab[i]));
        }
#undef GP_LOAD
    }
    __syncthreads();
}

constexpr int LR_XIN = 0, LR_XC = 17152, LR_XCB = LR_XC + 16384, LR_AU = LR_XCB + 9216, LR_WT = LR_AU + 65536, LR_END = LR_WT + 36864;
static_assert(LR_END <= LDS_BYTES, "lru lds");
template <int PASS>
__device__ __forceinline__ void lru_units(KA a, int L, LAS unsigned char* lds, int bid, int G, int tid) {
    const int j2 = L >> 1;
    const bf16_t* P = (const bf16_t*)(a->ws + WS_P); bf16_t* U = (bf16_t*)(a->ws + WS_U);
    float* TOTA = (float*)(a->ws + WS_TOTA); float* TOTH = (float*)(a->ws + WS_TOTH); const float* CARRY = (const float*)(a->ws + WS_CARRY);
    const float* cw = a->in[I_LRUCW] + (size_t)j2 * 4 * 512; const float* cb = a->in[I_LRUCB] + (size_t)j2 * 512;
    const float* gw_ = a->in[I_LRUGW] + (size_t)j2 * 2 * 2 * 8 * 64 * 64; const float* gb_ = a->in[I_LRUGB] + (size_t)j2 * 2 * 2 * 512; const float* lam_ = a->in[I_LRULAM] + (size_t)j2 * 2 * 512;
    LAS float* xin = (LAS float*)(lds + LR_XIN);
    LAS float* xc = (LAS float*)(lds + LR_XC);
    LAS bf16_t* xcb = (LAS bf16_t*)(lds + LR_XCB);
    LAS float* au = (LAS float*)(lds + LR_AU);
    LAS bf16_t* wt = (LAS bf16_t*)(lds + LR_WT);
    LAS float* sg = (LAS float*)(lds + LR_XIN);
    const int lane = tid & 63, w = tid >> 6, mt = w & 3, nh = w >> 2, fr = lane & 15, fq = lane >> 4;
    int cur_nblk = -1;
    const int cc = tid & 63;
    float cbv = 0.f, cwv[4] = {0.f, 0.f, 0.f, 0.f};
    float gbr[2][2], gbi[2][2], gsp[2][2];
#pragma unroll
    for (int q = 0; q < 2; ++q)
#pragma unroll
        for (int r = 0; r < 2; ++r) { gbr[q][r] = 0.f; gbi[q][r] = 0.f; gsp[q][r] = 0.f; }
    const int rrA = tid >> 3, c8 = (tid & 7) * 8, rrB = 64 + (tid >> 3);
    u32x4 xa = {0u, 0u, 0u, 0u}, xb = {0u, 0u, 0u, 0u}, gt4 = {0u, 0u, 0u, 0u};
#define LR_FETCH(XA, XB, GT, u_) do { const int nb_ = (u_) & 7, cs_ = (u_) >> 3, b_ = cs_ / 68, sl_ = cs_ % 68; const bool ic_ = sl_ < 4; const int t0_ = ic_ ? sl_ * 64 : (sl_ - 4) * 64; \
        const int len_ = ic_ ? CTXL : SEQ; const int rb_ = ic_ ? ML + b_ * CTXL : b_ * SEQ; const int ta_ = t0_ + rrA - 2, tb_ = t0_ + rrB - 2; \
        XA = (u32x4){0u, 0u, 0u, 0u}; XB = (u32x4){0u, 0u, 0u, 0u}; \
        if (ta_ >= 0 && ta_ < len_) XA = *(const u32x4*)(P + (size_t)(rb_ + ta_) * EVNP + 2064 + nb_ * 64 + c8); \
        if (tid < 24 && tb_ < len_) XB = *(const u32x4*)(P + (size_t)(rb_ + tb_) * EVNP + 2064 + nb_ * 64 + c8); \
        if (PASS == 2) GT = *(const u32x4*)(P + (size_t)(rb_ + t0_ + rrA) * EVNP + 2576 + nb_ * 64 + c8); } while (0)
    if (bid < NB * 68 * 8) LR_FETCH(xa, xb, gt4, bid);
    for (int u = bid; u < NB * 68 * 8; u += G) {
        const int nblk = u & 7, cs = u >> 3, b = cs / 68, slot = cs % 68; const bool isctx = slot < 4; const int t0 = isctx ? slot * 64 : (slot - 4) * 64;
        const int rowbase = isctx ? ML + b * CTXL : b * SEQ;
        u32x4 nxa, nxb, ngt = {0u, 0u, 0u, 0u};
        { const int un = u + G < NB * 68 * 8 ? u + G : u; LR_FETCH(nxa, nxb, ngt, un); }
        if (nblk != cur_nblk) {
            for (int i0 = tid; i0 < 4 * 4096; i0 += 512 * 8) { float wv[8];
#pragma unroll
                for (int k = 0; k < 8; ++k) { const int i = i0 + 512 * k; wv[k] = gw_[((size_t)((i >> 12) * 8 + nblk)) * 4096 + (i & 4095)]; }
#pragma unroll
                for (int k = 0; k < 8; ++k) { const int i = i0 + 512 * k; const int dg = i >> 12, c = (i >> 6) & 63, d = i & 63; wt[(dg * 64 + d) * 72 + c] = (bf16_t)f2bf(wv[k]); } }
            cbv = cb[nblk * 64 + cc];
#pragma unroll
            for (int dir = 0; dir < 2; ++dir)
#pragma unroll
                for (int nt = 0; nt < 2; ++nt) { const int ch = nblk * 64 + 32 * nh + 16 * nt + fr;
                    gbr[dir][nt] = gb_[(dir * 2 + 0) * 512 + ch]; gbi[dir][nt] = gb_[(dir * 2 + 1) * 512 + ch]; gsp[dir][nt] = softplusf_(-lam_[dir * 512 + ch]); }
#pragma unroll
            for (int j = 0; j < 4; ++j) cwv[j] = cw[j * 512 + nblk * 64 + cc];
            cur_nblk = nblk;
        }
        { float f[8]; unpack8(xa, f); *(LAS f32x4*)(xin + rrA * 64 + c8) = (f32x4){f[0], f[1], f[2], f[3]}; *(LAS f32x4*)(xin + rrA * 64 + c8 + 4) = (f32x4){f[4], f[5], f[6], f[7]};
          if (tid < 24) { unpack8(xb, f); *(LAS f32x4*)(xin + rrB * 64 + c8) = (f32x4){f[0], f[1], f[2], f[3]}; *(LAS f32x4*)(xin + rrB * 64 + c8 + 4) = (f32x4){f[4], f[5], f[6], f[7]}; } }
        __syncthreads();
#pragma unroll
        for (int k = 0; k < 8; ++k) { const int t = (tid >> 6) + 8 * k;
            float v = cbv;
#pragma unroll
            for (int j = 0; j < 4; ++j) v += cwv[j] * xin[(t + j) * 64 + cc];
            xc[t * 64 + cc] = v; xcb[t * 72 + cc] = (bf16_t)f2bf(v); }
        __syncthreads();
        {
            f32x4 acc[4][2];
#pragma unroll
            for (int dg = 0; dg < 4; ++dg)
#pragma unroll
                for (int nt = 0; nt < 2; ++nt) acc[dg][nt] = (f32x4){0.f, 0.f, 0.f, 0.f};
            bf16x8 af[2];
#pragma unroll
            for (int ks = 0; ks < 2; ++ks) af[ks] = *(const LAS bf16x8*)(xcb + (16 * mt + fr) * 72 + 32 * ks + 8 * fq);
#pragma unroll
            for (int dg = 0; dg < 4; ++dg)
#pragma unroll
                for (int nt = 0; nt < 2; ++nt)
#pragma unroll
                    for (int ks = 0; ks < 2; ++ks) { const bf16x8 bfm = *(const LAS bf16x8*)(wt + (dg * 64 + 32 * nh + 16 * nt + fr) * 72 + 32 * ks + 8 * fq);
                        acc[dg][nt] = __builtin_amdgcn_mfma_f32_16x16x32_bf16(af[ks], bfm, acc[dg][nt], 0, 0, 0); }
#pragma unroll
            for (int dir = 0; dir < 2; ++dir)
#pragma unroll
                for (int nt = 0; nt < 2; ++nt) { const int d = 32 * nh + 16 * nt + fr, ch = nblk * 64 + d;
                    const float br = gbr[dir][nt], bi = gbi[dir][nt], sp = gsp[dir][nt];
#pragma unroll
                    for (int r = 0; r < 4; ++r) { const int t = 16 * mt + 4 * fq + r;
                        const float rr = fsigmoid(acc[dir * 2 + 0][nt][r] + br), ii = fsigmoid(acc[dir * 2 + 1][nt][r] + bi);
                        const float la = -8.0f * 1.4426950408889634f * rr * sp; const float av = __builtin_amdgcn_exp2f(la);
                        const float uv = __builtin_amdgcn_sqrtf(fmaxf(1.0f - av * av, 0.f)) * (ii * xc[t * 64 + d]);
                        au[((dir * 2 + 0) * 64 + t) * 64 + d] = av; au[((dir * 2 + 1) * 64 + t) * 64 + d] = uv; } }
        }
        __syncthreads();
        {
            const int seg = tid >> 7, dir = (tid >> 6) & 1, c = tid & 63, ch = nblk * 64 + c;
            const LAS float* ap = au + ((dir * 2 + 0) * 64) * 64 + c; LAS float* up = au + ((dir * 2 + 1) * 64) * 64 + c;
            float A = 1.f, H = 0.f;
#pragma unroll 4
            for (int s = seg * 16; s < seg * 16 + 16; ++s) { const int t = dir ? 63 - s : s; const float av = ap[t * 64], uv = up[t * 64]; H = av * H + uv; A *= av; }
            sg[((0 * 4 + seg) * 2 + dir) * 64 + c] = A; sg[((1 * 4 + seg) * 2 + dir) * 64 + c] = H;
            __syncthreads();
            const size_t idx = ((size_t)((b * 2 + dir) * 68 + slot)) * 512 + ch;
            if (PASS == 1) {
                if (seg == 0) { float At = 1.f, Ht = 0.f;
#pragma unroll
                    for (int q = 0; q < 4; ++q) { const float Aq = sg[((0 * 4 + q) * 2 + dir) * 64 + c], Hq = sg[((1 * 4 + q) * 2 + dir) * 64 + c]; Ht = Aq * Ht + Hq; At *= Aq; }
                    TOTA[idx] = At; TOTH[idx] = Ht; }
            } else {
                float Hin = CARRY[idx];
                for (int q = 0; q < seg; ++q) { const float Aq = sg[((0 * 4 + q) * 2 + dir) * 64 + c], Hq = sg[((1 * 4 + q) * 2 + dir) * 64 + c]; Hin = Aq * Hin + Hq; }
#pragma unroll 4
                for (int s = seg * 16; s < seg * 16 + 16; ++s) { const int t = dir ? 63 - s : s; const float av = ap[t * 64], uv = up[t * 64]; Hin = av * Hin + uv; up[t * 64] = Hin; }
            }
        }
        __syncthreads();
        if (PASS == 2) {
            { const int t = rrA; float gt[8], y[8]; unpack8(gt4, gt);
              const LAS float* hf = au + ((0 * 2 + 1) * 64 + t) * 64 + c8; const LAS float* hb = au + ((1 * 2 + 1) * 64 + t) * 64 + c8;
              const f32x4 f0 = *(const LAS f32x4*)(hf), f1 = *(const LAS f32x4*)(hf + 4), b0 = *(const LAS f32x4*)(hb), b1 = *(const LAS f32x4*)(hb + 4);
#pragma unroll
              for (int e = 0; e < 8; ++e) { const float hs = (e < 4 ? f0[e & 3] + b0[e & 3] : f1[e & 3] + b1[e & 3]); const float g = gt[e];
                  y[e] = hs * g * fsigmoid(1.5957691216057308f * (g + 0.044715f * g * g * g)); }
              *(u32x4*)(U + (size_t)(rowbase + t0 + t) * D + 512 + nblk * 64 + c8) = pack8(y); }
            __syncthreads();
        }
        xa = nxa; xb = nxb; gt4 = ngt;
    }
#undef LR_FETCH
}

constexpr int GS_NS = 32, GS_K = 0, GS_Q = 16384, GS_V = 32768, GS_EG = 36864, GS_BTO = 36992, GS_BUF = 37120;
__device__ __forceinline__ void gdn_scan(KA a, LAS unsigned char* lds, int bid, int G, int tid, int wave, int lane) {
    const bf16_t* QN = (const bf16_t*)(a->ws + WS_U); const bf16_t* KN = QN + (size_t)MT * 512; const bf16_t* V = (const bf16_t*)(a->ws + WS_V);
    const float* Gb = (const float*)(a->ws + WS_G); const float* Bt = (const float*)(a->ws + WS_BT);
    for (int u = bid; u < 256; u += G) {
        const int chain = u >> 2, qd = u & 3, b = chain >> 3, h = (chain >> 1) & 3, dir = chain & 1;
        bf16_t* OD = (bf16_t*)(a->ws + (dir ? WS_OB : WS_OF));
        const int kg = lane & 7, cl = (wave & 3) * 8 + (lane >> 3), col = h * 128 + qd * 32 + cl;
        f32x2 S[8];
#pragma unroll
        for (int i = 0; i < 8; ++i) S[i] = (f32x2){0.f, 0.f};
#define GS_ROW(s) ((s) < CTXL ? (ML + b * CTXL + (dir ? CTXL - 1 - (s) : (s))) : (b * SEQ + (dir ? SEQ - 1 - ((s) - CTXL) : ((s) - CTXL))))
        const int lsl = tid >> 4, lc = tid & 15;
        u32x4 rk, rq, rv; float rg = 0.f;
#define GS_LOAD(blk) do { const int s_ = (blk) * GS_NS + lsl; const size_t row_ = (size_t)GS_ROW(s_); \
        rk = *(const u32x4*)(KN + row_ * 512 + h * 128 + lc * 8); rq = *(const u32x4*)(QN + row_ * 512 + h * 128 + lc * 8); \
        if (tid < 128) { const int s2_ = (blk) * GS_NS + (tid >> 2); const size_t r2_ = (size_t)GS_ROW(s2_); rv = *(const u32x4*)(V + r2_ * 512 + h * 128 + qd * 32 + (tid & 3) * 8); } \
        else if (tid < 160) { const int s2_ = (blk) * GS_NS + (tid - 128); rg = expf(Gb[(size_t)GS_ROW(s2_) * 8 + dir * 4 + h]); } \
        else if (tid < 192) { const int s2_ = (blk) * GS_NS + (tid - 160); rg = Bt[(size_t)GS_ROW(s2_) * 8 + dir * 4 + h]; } } while (0)
#define GS_ST8(dst, r) do { float f_[8]; unpack8(r, f_); *(LAS f32x4*)(dst) = (f32x4){f_[0], f_[1], f_[2], f_[3]}; *(LAS f32x4*)((dst) + 16) = (f32x4){f_[4], f_[5], f_[6], f_[7]}; } while (0)
#define GS_STORE(buf) do { LAS unsigned char* p_ = lds + (buf) * GS_BUF; \
        GS_ST8(p_ + GS_K + lsl * 512 + lc * 32, rk); GS_ST8(p_ + GS_Q + lsl * 512 + lc * 32, rq); \
        if (tid < 128) GS_ST8(p_ + GS_V + (tid >> 2) * 128 + (tid & 3) * 32, rv); \
        else if (tid < 160) *(LAS float*)(p_ + GS_EG + (tid - 128) * 4) = rg; \
        else if (tid < 192) *(LAS float*)(p_ + GS_BTO + (tid - 160) * 4) = rg; } while (0)
        GS_LOAD(0); GS_STORE(0);
        __syncthreads();
        constexpr int NBLK = NKV / GS_NS;
        for (int blk = 0; blk < NBLK; ++blk) {
            const bool more = blk + 1 < NBLK;
            if (more) GS_LOAD(blk + 1);
            const LAS unsigned char* p = lds + (blk & 1) * GS_BUF;
            if (wave < 4) {
              f32x4 k4[4], q4[4]; float vv, eg, bt;
#define GS_FETCH(K4, Q4, VV, EG, BT, sl_) do { _Pragma("unroll") for (int i = 0; i < 4; ++i) { K4[i] = *(const LAS f32x4*)(p + GS_K + (sl_) * 512 + kg * 64 + i * 16); Q4[i] = *(const LAS f32x4*)(p + GS_Q + (sl_) * 512 + kg * 64 + i * 16); } \
                VV = *(const LAS float*)(p + GS_V + (sl_) * 128 + cl * 4); EG = *(const LAS float*)(p + GS_EG + (sl_) * 4); BT = *(const LAS float*)(p + GS_BTO + (sl_) * 4); } while (0)
              GS_FETCH(k4, q4, vv, eg, bt, 0);
              bf16_t* odp = OD + (size_t)GS_ROW(blk * GS_NS) * 512 + col; const int ostep = dir ? -512 : 512;
#pragma unroll 2
              for (int sl = 0; sl < GS_NS; ++sl) {
                f32x4 nk4[4], nq4[4]; float nvv, neg, nbt;
                const int sn = sl + 1 < GS_NS ? sl + 1 : sl;
                GS_FETCH(nk4, nq4, nvv, neg, nbt, sn);
                f32x2 pa = {0.f, 0.f}, pb = {0.f, 0.f};
#pragma unroll
                for (int i = 0; i < 4; ++i) { pa += (f32x2){k4[i][0], k4[i][1]} * S[2 * i]; pb += (f32x2){k4[i][2], k4[i][3]} * S[2 * i + 1]; }
                const f32x2 pab = pa + pb; float pp = pab[0] + pab[1];
                pp += dppf(pp, 0); pp += dppf(pp, 1); pp += dppf(pp, 2);
                const float dl = bt * (vv - eg * pp);
                f32x2 oa = {0.f, 0.f}, ob = {0.f, 0.f};
#pragma unroll
                for (int i = 0; i < 4; ++i) {
                    S[2 * i] = S[2 * i] * eg + (f32x2){k4[i][0], k4[i][1]} * dl; S[2 * i + 1] = S[2 * i + 1] * eg + (f32x2){k4[i][2], k4[i][3]} * dl;
                    oa += (f32x2){q4[i][0], q4[i][1]} * S[2 * i]; ob += (f32x2){q4[i][2], q4[i][3]} * S[2 * i + 1]; }
                const f32x2 oab = oa + ob; float oo = oab[0] + oab[1];
                oo += dppf(oo, 0); oo += dppf(oo, 1); oo += dppf(oo, 2);
                if (kg == 0) odp[(ptrdiff_t)sl * ostep] = (bf16_t)f2bf(oo);
#pragma unroll
                for (int i = 0; i < 4; ++i) { k4[i] = nk4[i]; q4[i] = nq4[i]; }
                vv = nvv; eg = neg; bt = nbt;
              }
#undef GS_FETCH
            }
            if (more) GS_STORE((blk + 1) & 1);
            __syncthreads();
        }
#undef GS_ROW
#undef GS_LOAD
#undef GS_STORE
#undef GS_ST8
    }
    { const int gid = bid * 512 + tid;
      if (gid < NB * 2 * 512) { const int ch = gid & 511, dir = (gid >> 9) & 1, b = gid >> 10;
        const float* TOTA = (const float*)(a->ws + WS_TOTA); const float* TOTH = (const float*)(a->ws + WS_TOTH); float* CARRY = (float*)(a->ws + WS_CARRY);
        float carry = 0.f;
        for (int s = 0; s < 68; ++s) { const int slot = dir ? (s < 4 ? 3 - s : 67 - (s - 4)) : s; const size_t idx = ((size_t)((b * 2 + dir) * 68 + slot)) * 512 + ch;
            CARRY[idx] = carry; carry = TOTA[idx] * carry + TOTH[idx]; } } }
}


__device__ __forceinline__ int gs_row(int b, int dir, int s) { return s < CTXL ? (ML + b * CTXL + (dir ? CTXL - 1 - s : s)) : (b * SEQ + (dir ? SEQ - 1 - (s - CTXL) : (s - CTXL))); }
__device__ __forceinline__ float fexp(float x) { return __builtin_amdgcn_exp2f(1.4426950408889634f * x); }
constexpr int CP_WAVE = 64 * 68 * 4 + 512;
__device__ __forceinline__ void gdn_chunk_prep(KA a, LAS unsigned char* lds, int gw, int NGW, int wave, int lane) {
    const bf16_t* QN = (const bf16_t*)(a->ws + WS_U); const bf16_t* KN = QN + (size_t)MT * 512;
    const float* Gb = (const float*)(a->ws + WS_G); const float* Bt = (const float*)(a->ws + WS_BT);
    bf16_t* Tb = (bf16_t*)(a->ws + WS_TB); bf16_t* QKb = (bf16_t*)(a->ws + WS_QKB); float* GAM = (float*)(a->ws + WS_GAM);
    LAS float* Am = (LAS float*)(lds + wave * CP_WAVE); LAS float* gl = Am + 64 * 68; LAS float* bl = gl + 64;
    const int r32 = lane & 31, hi = lane >> 5;
    bf16x8 kf[2][8]; float gi_raw = 0.f, bt_raw = 0.f;
#define CP_FETCH(cu_) do { const int ch_ = (cu_) / 68, n_ = (cu_) % 68, b_ = ch_ >> 3, h_ = (ch_ >> 1) & 3, d_ = ch_ & 1; const int r0_ = gs_row(b_, d_, 64 * n_), rs_ = d_ ? -1 : 1; \
        _Pragma("unroll") for (int blk = 0; blk < 2; ++blk) _Pragma("unroll") for (int ks = 0; ks < 8; ++ks) \
            kf[blk][ks] = *(const bf16x8*)(KN + (size_t)(r0_ + rs_ * (32 * blk + r32)) * 512 + h_ * 128 + 16 * ks + 8 * hi); \
        const size_t rl_ = (size_t)(r0_ + rs_ * lane); gi_raw = Gb[rl_ * 8 + d_ * 4 + h_]; bt_raw = Bt[rl_ * 8 + d_ * 4 + h_]; } while (0)
    if (gw < 64 * 68) CP_FETCH(gw);
    for (int cu = gw; cu < 64 * 68; cu += NGW) {
        const int chain = cu / 68, n = cu % 68, b = chain >> 3, h = (chain >> 1) & 3, dir = chain & 1;
        const int row0 = gs_row(b, dir, 64 * n), rs = dir ? -1 : 1;
        { float gi = gi_raw;
#pragma unroll
          for (int o = 1; o < 64; o <<= 1) { const float t = __shfl_up(gi, o); if (lane >= o) gi += t; }
          gl[lane] = gi; bl[lane] = bt_raw; GAM[(size_t)cu * 64 + lane] = gi; }
        LDS_WAIT();
        const float gj0 = gl[r32], gj1 = gl[32 + r32];
#pragma unroll
        for (int tl = 0; tl < 3; ++tl) { const int mb = tl == 0 ? 0 : 1, nb = tl == 2 ? 1 : 0;
            f32x16 acc;
#pragma unroll
            for (int r = 0; r < 16; ++r) acc[r] = 0.f;
#pragma unroll
            for (int ks = 0; ks < 8; ++ks) acc = __builtin_amdgcn_mfma_f32_32x32x16_bf16(kf[mb][ks], kf[nb][ks], acc, 0, 0, 0);
            const int j = 32 * nb + r32; const float gj = nb ? gj1 : gj0;
#pragma unroll
            for (int q = 0; q < 4; ++q) { const int i0 = 32 * mb + 8 * q + 4 * hi; const f32x4 gmi = *(const LAS f32x4*)(gl + i0), bti = *(const LAS f32x4*)(bl + i0);
#pragma unroll
                for (int e = 0; e < 4; ++e) { const int i = i0 + e; Am[i * 68 + j] = (i > j) ? bti[e] * acc[4 * q + e] * fexp(gmi[e] - gj) : 0.f; } }
        }
        asm volatile("" ::: "memory");
        {
            bf16_t* qko = QKb + (size_t)cu * 4096;
#pragma unroll
            for (int mb = 0; mb < 2; ++mb) {
                bf16x8 qf[8];
#pragma unroll
                for (int ks = 0; ks < 8; ++ks) qf[ks] = *(const bf16x8*)(QN + (size_t)(row0 + rs * (32 * mb + r32)) * 512 + h * 128 + 16 * ks + 8 * hi);
#pragma unroll
                for (int nb = 0; nb <= mb; ++nb) {
                    f32x16 acc;
#pragma unroll
                    for (int r = 0; r < 16; ++r) acc[r] = 0.f;
#pragma unroll
                    for (int ks = 0; ks < 8; ++ks) acc = __builtin_amdgcn_mfma_f32_32x32x16_bf16(qf[ks], kf[nb][ks], acc, 0, 0, 0);
                    const int j = 32 * nb + r32; const float gj = nb ? gj1 : gj0;
#pragma unroll
                    for (int q = 0; q < 4; ++q) { const int i0 = 32 * mb + 8 * q + 4 * hi; const f32x4 gmi = *(const LAS f32x4*)(gl + i0);
#pragma unroll
                        for (int e = 0; e < 4; ++e) { const int i = i0 + e; qko[i * 64 + j] = (bf16_t)f2bf((i >= j) ? acc[4 * q + e] * fexp(gmi[e] - gj) : 0.f); } }
                }
                asm volatile("" ::: "memory");
            }
#pragma unroll
            for (int q = 0; q < 4; ++q)
#pragma unroll
                for (int e = 0; e < 4; ++e) qko[(8 * q + 4 * hi + e) * 64 + 32 + r32] = (bf16_t)0;
        }
        asm volatile("" ::: "memory");
        LDS_WAIT();
        { const int cn = cu + NGW < 64 * 68 ? cu + NGW : cu; CP_FETCH(cn); }
        {
            float Tc[64]; int ln = lane;
#pragma unroll
            for (int i = 0; i < 64; ++i) {
                if ((i & 3) == 0) asm volatile("" : "+v"(ln));
                float acc = (i == ln) ? 1.f : 0.f, acc1 = 0.f;
#pragma unroll
                for (int jj = 0; jj < (i + 3) / 4; ++jj) { const f32x4 a4 = *(const LAS f32x4*)(Am + i * 68 + 4 * jj);
#pragma unroll
                    for (int e = 0; e < 4; ++e) if (4 * jj + e < i) { if (e & 1) acc1 -= a4[e] * Tc[4 * jj + e]; else acc -= a4[e] * Tc[4 * jj + e]; } }
                Tc[i] = acc + acc1;
                if ((i & 1) == 1) asm volatile("" ::: "memory");
            }
            bf16_t* to = Tb + (size_t)cu * 4096 + lane;
#pragma unroll
            for (int i = 0; i < 64; ++i) to[i * 64] = (bf16_t)f2bf(Tc[i]);
        }
        LDS_WAIT();
    }
#undef CP_FETCH
}

constexpr int CS_KN = 0, CS_QN = 17408, CS_KT = 34816, CS_T = 53248, CS_QK = 62464, CS_VT = 71680, CS_GB = 76288, CS_ST = 77312, CS_RT = 86016, CS_VNT = 90624, CS_VDT = 95232, CS_END = 99840;
__device__ __forceinline__ void cs_compute(LAS unsigned char* lds, int wave, int r32, int hi, f32x16& acc, f32x16& Sreg, bf16_t* op, int row0, int rs) {
    const LAS float* gamL = (const LAS float*)(lds + CS_GB); const LAS float* betL = gamL + 64;
    const int mb = wave & 1;
    if (wave < 4) {
        const LAS unsigned char* X = lds + ((wave >> 1) ? CS_QN : CS_KN) + (32 * mb + r32) * 272 + 16 * hi; const LAS unsigned char* Sb = lds + CS_ST + r32 * 272 + 16 * hi;
#pragma unroll
        for (int r = 0; r < 16; ++r) acc[r] = 0.f;
#pragma unroll
        for (int ks = 0; ks < 8; ++ks) acc = __builtin_amdgcn_mfma_f32_32x32x16_bf16(*(const LAS bf16x8*)(X + 32 * ks), *(const LAS bf16x8*)(Sb + 32 * ks), acc, 0, 0, 0);
    }
    if (wave < 2) {
#pragma unroll
        for (int q = 0; q < 4; ++q) { const int t0 = 32 * mb + 8 * q + 4 * hi; const f32x4 gm = *(const LAS f32x4*)(gamL + t0), bt = *(const LAS f32x4*)(betL + t0);
            const u32x2 vv = *(const LAS u32x2*)(lds + CS_VT + r32 * 144 + t0 * 2);
            const float v0 = __uint_as_float(vv.x << 16), v1 = __uint_as_float(vv.x & 0xffff0000u), v2 = __uint_as_float(vv.y << 16), v3 = __uint_as_float(vv.y & 0xffff0000u);
            u32x2 w; w.x = pk2(bt[0] * (v0 - fexp(gm[0]) * acc[4 * q]), bt[1] * (v1 - fexp(gm[1]) * acc[4 * q + 1]));
            w.y = pk2(bt[2] * (v2 - fexp(gm[2]) * acc[4 * q + 2]), bt[3] * (v3 - fexp(gm[3]) * acc[4 * q + 3]));
            *(LAS u32x2*)(lds + CS_RT + r32 * 144 + t0 * 2) = w; }
    }
    __syncthreads();
    if (wave < 2) {
        f32x16 vn;
#pragma unroll
        for (int r = 0; r < 16; ++r) vn[r] = 0.f;
        const LAS unsigned char* Ta = lds + CS_T + (32 * mb + r32) * 144 + 16 * hi; const LAS unsigned char* Rb = lds + CS_RT + r32 * 144 + 16 * hi;
#pragma unroll
        for (int ks = 0; ks < 4; ++ks) vn = __builtin_amdgcn_mfma_f32_32x32x16_bf16(*(const LAS bf16x8*)(Ta + 32 * ks), *(const LAS bf16x8*)(Rb + 32 * ks), vn, 0, 0, 0);
        const float glast = gamL[63];
#pragma unroll
        for (int q = 0; q < 4; ++q) { const int t0 = 32 * mb + 8 * q + 4 * hi; const f32x4 gm = *(const LAS f32x4*)(gamL + t0);
            u32x2 w; w.x = pk2(vn[4 * q], vn[4 * q + 1]); w.y = pk2(vn[4 * q + 2], vn[4 * q + 3]);
            *(LAS u32x2*)(lds + CS_VNT + r32 * 144 + t0 * 2) = w;
            w.x = pk2(vn[4 * q] * fexp(glast - gm[0]), vn[4 * q + 1] * fexp(glast - gm[1])); w.y = pk2(vn[4 * q + 2] * fexp(glast - gm[2]), vn[4 * q + 3] * fexp(glast - gm[3]));
            *(LAS u32x2*)(lds + CS_VDT + r32 * 144 + t0 * 2) = w; }
    }
    __syncthreads();
    if (wave == 2 || wave == 3) {
#pragma unroll
        for (int q = 0; q < 4; ++q) { const int t0 = 32 * mb + 8 * q + 4 * hi; const f32x4 gm = *(const LAS f32x4*)(gamL + t0);
#pragma unroll
            for (int e = 0; e < 4; ++e) acc[4 * q + e] *= fexp(gm[e]); }
        const LAS unsigned char* Qa = lds + CS_QK + (32 * mb + r32) * 144 + 16 * hi; const LAS unsigned char* Vb = lds + CS_VNT + r32 * 144 + 16 * hi;
#pragma unroll
        for (int ks = 0; ks < 4; ++ks) acc = __builtin_amdgcn_mfma_f32_32x32x16_bf16(*(const LAS bf16x8*)(Qa + 32 * ks), *(const LAS bf16x8*)(Vb + 32 * ks), acc, 0, 0, 0);
#pragma unroll
        for (int r = 0; r < 16; ++r) { const int tok = 32 * mb + (r & 3) + 8 * (r >> 2) + 4 * hi; op[(ptrdiff_t)(row0 + rs * tok) * 512] = (bf16_t)f2bf(acc[r]); }
    } else if (wave >= 4) {
        const int mk = wave - 4; const float cd = fexp(gamL[63]);
#pragma unroll
        for (int r = 0; r < 16; ++r) Sreg[r] *= cd;
        const LAS unsigned char* Ka = lds + CS_KT + (32 * mk + r32) * 144 + 16 * hi; const LAS unsigned char* Db = lds + CS_VDT + r32 * 144 + 16 * hi;
#pragma unroll
        for (int ks = 0; ks < 4; ++ks) Sreg = __builtin_amdgcn_mfma_f32_32x32x16_bf16(*(const LAS bf16x8*)(Ka + 32 * ks), *(const LAS bf16x8*)(Db + 32 * ks), Sreg, 0, 0, 0);
#pragma unroll
        for (int q = 0; q < 4; ++q) { u32x2 w; w.x = pk2(Sreg[4 * q], Sreg[4 * q + 1]); w.y = pk2(Sreg[4 * q + 2], Sreg[4 * q + 3]);
            *(LAS u32x2*)(lds + CS_ST + r32 * 272 + (32 * mk + 8 * q + 4 * hi) * 2) = w; }
    }
    __syncthreads();
}
__device__ __forceinline__ void gdn_chunk_scan(KA a, LAS unsigned char* lds, int bid, int G, int tid, int wave, int lane) {
    const bf16_t* QN = (const bf16_t*)(a->ws + WS_U); const bf16_t* KN = QN + (size_t)MT * 512; const bf16_t* V = (const bf16_t*)(a->ws + WS_V);
    const float* Bt = (const float*)(a->ws + WS_BT);
    const bf16_t* Tb = (const bf16_t*)(a->ws + WS_TB); const bf16_t* QKb = (const bf16_t*)(a->ws + WS_QKB); const float* GAM = (const float*)(a->ws + WS_GAM);
    const int r32 = lane & 31, hi = lane >> 5;
    for (int u = bid; u < 256; u += G) {
        const int chain = (u & 7) * 8 + (u >> 5), qd = (u >> 3) & 3;
        const int b = chain >> 3, h = (chain >> 1) & 3, dir = chain & 1, rs = dir ? -1 : 1;
        bf16_t* op = (bf16_t*)(a->ws + (dir ? WS_OB : WS_OF)) + h * 128 + qd * 32 + r32;
        u32x4 rkA[2], rqA[2], rTA, rQKA, rVA; float rgbA = 0.f;
        u32x4 rkB[2], rqB[2], rTB, rQKB, rVB; float rgbB = 0.f;
#define CS_LOAD(S_, n_) do { const int row0_ = gs_row(b, dir, 64 * (n_)); const size_t cu_ = (size_t)(chain * 68 + (n_)); const size_t rowl_ = (size_t)(row0_ + rs * lane); \
        _Pragma("unroll") for (int i_ = 0; i_ < 2; ++i_) { const int c16_ = wave + 8 * i_; \
            rk##S_[i_] = *(const u32x4*)(KN + rowl_ * 512 + h * 128 + c16_ * 8); rq##S_[i_] = *(const u32x4*)(QN + rowl_ * 512 + h * 128 + c16_ * 8); } \
        rT##S_ = *(const u32x4*)(Tb + cu_ * 4096 + tid * 8); rQK##S_ = *(const u32x4*)(QKb + cu_ * 4096 + tid * 8); \
        if (wave < 4) rV##S_ = *(const u32x4*)(V + rowl_ * 512 + h * 128 + qd * 32 + wave * 8); \
        if (tid < 64) rgb##S_ = GAM[cu_ * 64 + tid]; else if (tid < 128) rgb##S_ = Bt[(size_t)(row0_ + rs * (tid - 64)) * 8 + dir * 4 + h]; } while (0)
#define CS_T16(base, v, col0, tok) do { const unsigned w_[4] = {(v).x, (v).y, (v).z, (v).w}; _Pragma("unroll") for (int e_ = 0; e_ < 8; ++e_) \
        *(LAS bf16_t*)(lds + (base) + ((col0) + e_) * 144 + (tok) * 2) = (bf16_t)((e_ & 1) ? (w_[e_ >> 1] >> 16) : (w_[e_ >> 1] & 0xffffu)); } while (0)
#define CS_STORE(S_) do { \
        _Pragma("unroll") for (int i_ = 0; i_ < 2; ++i_) { const int c16_ = wave + 8 * i_; \
            *(LAS u32x4*)(lds + CS_KN + lane * 272 + c16_ * 16) = rk##S_[i_]; *(LAS u32x4*)(lds + CS_QN + lane * 272 + c16_ * 16) = rq##S_[i_]; CS_T16(CS_KT, rk##S_[i_], c16_ * 8, lane); } \
        *(LAS u32x4*)(lds + CS_T + (tid >> 3) * 144 + (tid & 7) * 16) = rT##S_; *(LAS u32x4*)(lds + CS_QK + (tid >> 3) * 144 + (tid & 7) * 16) = rQK##S_; \
        if (wave < 4) CS_T16(CS_VT, rV##S_, wave * 8, lane); \
        if (tid < 128) *(LAS float*)(lds + CS_GB + tid * 4) = rgb##S_; } while (0)
        CS_LOAD(A, 0);
        for (int i = tid; i < 32 * 272 / 4; i += 512) *(LAS unsigned*)(lds + CS_ST + i * 4) = 0u;
        CS_STORE(A);
        __syncthreads();
        CS_LOAD(A, 1);
        f32x16 Sreg, acc;
#pragma unroll
        for (int r = 0; r < 16; ++r) { Sreg[r] = 0.f; acc[r] = 0.f; }
        for (int n = 0; n < 68; n += 2) {
            if (n + 2 < 68) CS_LOAD(B, n + 2);
            cs_compute(lds, wave, r32, hi, acc, Sreg, op, gs_row(b, dir, 64 * n), rs);
            CS_STORE(A);
            __syncthreads();
            if (n + 3 < 68) CS_LOAD(A, n + 3);
            cs_compute(lds, wave, r32, hi, acc, Sreg, op, gs_row(b, dir, 64 * (n + 1)), rs);
            if (n + 2 < 68) CS_STORE(B);
            __syncthreads();
        }
#undef CS_LOAD
#undef CS_T16
#undef CS_STORE
    }
    if (wave == 0 && lane < 32) {
      const float* TOTA = (const float*)(a->ws + WS_TOTA); const float* TOTH = (const float*)(a->ws + WS_TOTH); float* CARRY = (float*)(a->ws + WS_CARRY);
      for (int gid = bid * 32 + lane; gid < NB * 2 * 512; gid += G * 32) { const int ch = gid & 511, dir = (gid >> 9) & 1, b = gid >> 10;
        float carry = 0.f;
        for (int s0 = 0; s0 < 68; s0 += 17) {
            float ta[17], th[17];
#pragma unroll
            for (int k = 0; k < 17; ++k) { const int s = s0 + k; const int slot = dir ? (s < 4 ? 3 - s : 67 - (s - 4)) : s; const size_t idx = ((size_t)((b * 2 + dir) * 68 + slot)) * 512 + ch; ta[k] = TOTA[idx]; th[k] = TOTH[idx]; }
#pragma unroll
            for (int k = 0; k < 17; ++k) { const int s = s0 + k; const int slot = dir ? (s < 4 ? 3 - s : 67 - (s - 4)) : s; const size_t idx = ((size_t)((b * 2 + dir) * 68 + slot)) * 512 + ch; CARRY[idx] = carry; carry = ta[k] * carry + th[k]; }
        } } }
}

__device__ __forceinline__ void gdn_merge(KA a, int L, int gw, int NGW, int lane) {
    const int j2 = L >> 1;
    const bf16_t* P = (const bf16_t*)(a->ws + WS_P); bf16_t* U = (bf16_t*)(a->ws + WS_U);
    const bf16_t* OF = (const bf16_t*)(a->ws + WS_OF); const bf16_t* OB = (const bf16_t*)(a->ws + WS_OB);
    const float* gn = a->in[I_EVGDNNORM] + j2 * 128 + ((8 * lane) & 127);
    float g8[8];
#pragma unroll
    for (int e = 0; e < 8; ++e) g8[e] = gn[e];
    for (int row = gw; row < MT; row += NGW) {
        float of[8], ob[8], z[8], y[8];
        unpack8(*(const u32x4*)(OF + (size_t)row * 512 + 8 * lane), of); unpack8(*(const u32x4*)(OB + (size_t)row * 512 + 8 * lane), ob);
        unpack8(*(const u32x4*)(P + (size_t)row * EVNP + 1536 + 8 * lane), z);
        float ssq = 0.f;
#pragma unroll
        for (int e = 0; e < 8; ++e) { of[e] += ob[e]; ssq += of[e] * of[e]; }
        ssq = rowsum16(ssq);
        const float rms = 1.0f / sqrtf(ssq * (1.f / 128.f) + EPS);
#pragma unroll
        for (int e = 0; e < 8; ++e) y[e] = of[e] * rms * g8[e] * fsilu(z[e]);
        *(u32x4*)(U + (size_t)row * D + 8 * lane) = pack8(y);
    }
}


#define XB_TMO      128
#define XB_XCNT(j)  (256  + 64 * (j))
#define XB_XSUB(j)  (1280 + 64 * (j))
#define XB_XGEN(j)  (2304 + 64 * (j))
#define XB_TOP      3328
#define XB_TOPGEN   3392
#define XCD_BAR_WORDS 3456
#define XB_SPIN_CAP (1u << 20)
__device__ __forceinline__ unsigned xb_ld(unsigned* p)              { return __hip_atomic_load(p, __ATOMIC_RELAXED, __HIP_MEMORY_SCOPE_AGENT); }
__device__ __forceinline__ unsigned xb_add(unsigned* p, unsigned v) { return __hip_atomic_fetch_add(p, v, __ATOMIC_RELAXED, __HIP_MEMORY_SCOPE_AGENT); }
__device__ __forceinline__ unsigned xb_xcc_id() { return (unsigned)__builtin_amdgcn_s_getreg((3 << 11) | 20) & 0xFu; }
#define XB_SPIN(cond, bar) do { unsigned _sp = 0; while (cond) { __builtin_amdgcn_s_sleep(1); \
    if ((++_sp & 255u) == 0u) { if (xb_ld(&(bar)[XB_TMO])) break; if (_sp > XB_SPIN_CAP) { atomicAdd(&(bar)[XB_TMO], 1u); break; } } } } while (0)
struct XcdBarrier { unsigned* bar; unsigned x; volatile LAS unsigned* st; };
__device__ __forceinline__ XcdBarrier xcd_barrier_post(unsigned* bar, volatile LAS unsigned* st) {
    XcdBarrier b; b.bar = bar; b.x = xb_xcc_id(); b.st = st;
    if (threadIdx.x == 0) (void)xb_add(&bar[XB_XCNT(b.x)], 1u);
    return b;
}
__device__ __forceinline__ void xcd_barrier_complete(unsigned* bar, unsigned x, unsigned& nloc, unsigned& nx) {
    const unsigned G = gridDim.x * gridDim.y * gridDim.z;
    unsigned sum, cnt, mine, sp = 0u;
    for (;;) {
        sum = 0u; cnt = 0u; mine = 0u;
#pragma unroll
        for (unsigned j = 0; j < 16; ++j) { const unsigned c = xb_ld(&bar[XB_XCNT(j)]); sum += c; cnt += (c > 0u) ? 1u : 0u; mine = (j == x) ? c : mine; }
        if (sum == G) break;
        __builtin_amdgcn_s_sleep(1);
        if ((++sp & 255u) == 0u) { if (xb_ld(&bar[XB_TMO])) break; if (sp > XB_SPIN_CAP) { atomicAdd(&bar[XB_TMO], 1u); break; } }
    }
    nloc = mine > 0u ? mine : 1u; nx = cnt > 0u ? cnt : 1u;
}
__device__ __forceinline__ void xcd_barrier(const XcdBarrier& b) {
    asm volatile("s_waitcnt vmcnt(0)" ::: "memory");
    __syncthreads();
    if (threadIdx.x == 0) {
        unsigned* bar = b.bar;
        __builtin_amdgcn_s_waitcnt(0);
        unsigned nloc = b.st[0], nx = b.st[1];
        if (nloc == 0u) { xcd_barrier_complete(bar, b.x, nloc, nx); b.st[0] = nloc; b.st[1] = nx; }
        const unsigned old = xb_add(&bar[XB_XSUB(b.x)], 1u);
        const unsigned gen = old / nloc;
        if (old + 1u == (gen + 1u) * nloc) {
            __builtin_amdgcn_fence(__ATOMIC_RELEASE, "agent");
            asm volatile("s_waitcnt vmcnt(0)" ::: "memory");
            const unsigned og = xb_add(&bar[XB_TOP], 1u);
            const unsigned tg = og / nx;
            if (og + 1u == (tg + 1u) * nx) xb_add(&bar[XB_TOPGEN], 1u);
            else XB_SPIN(xb_ld(&bar[XB_TOPGEN]) == tg, bar);
            __builtin_amdgcn_fence(__ATOMIC_ACQUIRE, "agent");
            xb_add(&bar[XB_XGEN(b.x)], 1u);
            asm volatile("s_waitcnt vmcnt(0)" ::: "memory");
        } else {
            XB_SPIN(xb_ld(&bar[XB_XGEN(b.x)]) == gen, bar);
            __builtin_amdgcn_fence(__ATOMIC_ACQUIRE, "agent");
            asm volatile("s_waitcnt vmcnt(0)" ::: "memory");
        }
    }
    __syncthreads();
}

__device__ __forceinline__ void decode_phase(int ph, int& L, int& kind) {
    if (ph == 0) { L = 0; kind = K_PROA; return; }
    if (ph == 1) { L = 0; kind = K_PROB; return; }
    int p = ph - 2;
    if (p < 10) { L = 0; } else if (p < 18) { L = 1; p -= 10; } else if (p < 28) { L = 2; p -= 18; } else { L = 3; p -= 28; }
    if ((L & 1) == 0) { kind = p == 0 ? K_PROJ : p == 1 ? K_E2 : p == 2 ? K_E2B : p == 3 ? K_E3 : p == 4 ? K_E4 : p == 5 ? K_WOUT : p == 6 ? K_LN1 : p == 7 ? K_MLP1 : p == 8 ? K_MLP2 : K_LN2; }
    else { kind = p == 0 ? K_PROJ : p == 1 ? K_O2 : p == 2 ? K_O3 : p == 3 ? K_WOUT : p == 4 ? K_LN1 : p == 5 ? K_MLP1 : p == 6 ? K_MLP2 : K_LN2; }
}

#ifndef MK_DUP_GEMM
#define MK_DUP_GEMM 0
#endif
#ifndef MK_DUP_KIND
#define MK_DUP_KIND -1
#endif
#ifndef MK_SKIP1
#define MK_SKIP1 1
#endif
#ifndef MK_K2
#define MK_K2 1024
#endif
#ifndef MK_PHM
#define MK_PHM 0xffffu
#endif
#define EN(k) ((MK_PHM >> (k)) & 1u)
__global__ void __launch_bounds__(512, 2) fwd_kernel(Args args) {
    extern __shared__ __attribute__((aligned(16))) unsigned char lds_raw[];
    LAS unsigned char* lds = (LAS unsigned char*)lds_raw;
    cg::grid_group grid = cg::this_grid();
    const int G = gridDim.x;
    volatile LAS unsigned* bst = (volatile LAS unsigned*)(lds + LDS_BYTES - 16);
    if (threadIdx.x < 2) bst[threadIdx.x] = 0u;
    __syncthreads();
    const XcdBarrier xbar = xcd_barrier_post((unsigned*)(args.ws + WS_BAR), bst);
    const int ph_lo = args.ph_lo, ph_hi = args.ph_hi;
    bool second = false;
    for (int ph = ph_lo; ph < ph_hi; ) {
        KA a = (KA)__builtin_amdgcn_kernarg_segment_ptr(); asm volatile("" : "+s"(a));
        int tid = threadIdx.x; asm volatile("" : "+v"(tid));
        int bid = blockIdx.x; asm volatile("" : "+s"(bid));
        const int lane = tid & 63, wave = __builtin_amdgcn_readfirstlane(tid >> 6), gw = bid * 8 + wave, NGW = G * 8;
        bf16_t* U = (bf16_t*)(a->ws + WS_U); bf16_t* P = (bf16_t*)(a->ws + WS_P); float* HC = (float*)(a->ws + WS_HC);
        const float* MOD = (const float*)(a->ws + WS_MOD);
        int L, kind; decode_phase(ph, L, kind);
        const bool even = (L & 1) == 0; const bool last = L == 3;
        const int Mrows = last ? ML : MT;
        const bool isgemm = kind == K_PROJ || kind == K_MLP1 || kind == K_WOUT || kind == K_MLP2;
        const bool dup = (MK_DUP_GEMM && isgemm) || kind == MK_DUP_KIND;
        if (EN(K_PROA) && kind == K_PROA) prologue_a(a, lds, bid, G, tid, wave, lane);
        else if (EN(K_PROB) && kind == K_PROB) prologue_b(a, gw, NGW, lane);
        else if (EN(K_PROJ) && (kind == K_PROJ || kind == K_MLP1 || kind == K_WOUT || kind == K_MLP2)) {
            const float* modL = MOD + (size_t)L * 9 * 6144;
            const bool split = (kind == K_WOUT || kind == K_MLP2) && !last;
            const int ncall = split ? 2 : 1;
            for (int call = 0; call < ncall; ++call) {
                pg8::Gemm g; pg8::EpiBf16 E;
                if (kind == K_PROJ) { g = pg8::Gemm{U, (const bf16_t*)(a->ws + WS_WA), MT, even ? EVNP : ODN, D, D, D, 1}; E = pg8::EpiBf16{P, even ? EVNP : ODN, 0, nullptr, -1, 0}; }
                else if (kind == K_MLP1) { g = pg8::Gemm{U, (const bf16_t*)(a->ws + WS_W1), Mrows, FF, D, D, D, 1}; E = pg8::EpiBf16{P, FF, 2, nullptr, -1, 0}; }
                else if (kind == K_WOUT) { const bf16_t* A = even ? U : P; const int lda = even ? D : ODN;
                    if (call == 0) { g = pg8::Gemm{A, (const bf16_t*)(a->ws + WS_WO), ML, D, D, lda, D, 1}; E = pg8::EpiBf16{even ? P : U, D, 0, modL + 2 * D, -1, 0}; }
                    else { g = pg8::Gemm{A + (size_t)ML * lda, (const bf16_t*)(a->ws + WS_WO), MC, D, D / 4, lda, D, 4}; E = pg8::EpiBf16{(bf16_t*)(a->ws + WS_PART), D, 0, modL + 2 * D, 8, (size_t)MC * D}; } }
                else { if (call == 0) { g = pg8::Gemm{P, (const bf16_t*)(a->ws + WS_W2), ML, D, FF, FF, FF, 1}; E = pg8::EpiBf16{U, D, 0, modL + 5 * D, -1, 0}; }
                    else { g = pg8::Gemm{P + (size_t)ML * FF, (const bf16_t*)(a->ws + WS_W2), MC, D, FF / 8, FF, FF, 8}; E = pg8::EpiBf16{(bf16_t*)(a->ws + WS_PART), D, 0, modL + 5 * D, 8, (size_t)MC * D}; } }
                pg8::StaticOrder S; S.init(g.M, g.N, G, bid, g.nks);
                pg8::gemm_phase<pg8::EpiBf16>(lds, g, S, E, tid);
            }
        }
        else if (EN(K_LN1) && kind == K_LN1) ln_pass(a, L, 0, Mrows, true, L, 3, even ? P : U, last ? 0 : 4, gw, NGW, lane);
        else if (EN(K_LN2) && kind == K_LN2) {
            ln_pass(a, L, 1, Mrows, !last, L + 1, 0, U, last ? 0 : 8, gw, NGW, lane);
            if (!last) conv_weights(a, L + 1, lds, gw, NGW, wave, lane);
        }
        else if (EN(K_E2) && kind == K_E2) { gdn_prep(a, L, lds, gw, NGW, tid, lane); lru_units<1>(a, L, lds, bid, G, tid); }
        else if (EN(K_E2B) && kind == K_E2B) gdn_chunk_prep(a, lds, gw, NGW, wave, lane);
        else if (EN(K_E3) && kind == K_E3) gdn_chunk_scan(a, lds, bid, G, tid, wave, lane);
        else if (EN(K_E4) && kind == K_E4) { gdn_merge(a, L, gw, NGW, lane); lru_units<2>(a, L, lds, bid, G, tid); }
        else if (EN(K_O2) && kind == K_O2) attn_prep(a, lds, bid, G, tid);
        else if (EN(K_O3) && kind == K_O3) attn_phase(a, L, lds, bid, G, tid, wave, lane, !dup || second);
        if (dup && !second) { second = true; grid.sync(); continue; }
        second = false; ++ph;
        if (ph < ph_hi) { if (ph == ph_lo + 1) grid.sync(); else xcd_barrier(xbar); }
    }
}

#ifndef MK_PH_HI
#define MK_PH_HI N_PHASES
#endif
#ifndef MK_PER_PHASE
#define MK_PER_PHASE 0
#endif
extern "C" void kernel_launch(void* const* d_in, const int* in_sizes, int n_in, void* d_out, int out_size, void* d_ws, size_t ws_size, hipStream_t stream) {
    static int grid = 0;
    if (grid == 0) {
        if (n_in != 24 || ws_size < WS_END) { fprintf(stderr, "kernel_launch: unexpected n_in %d / ws_size %zu\n", n_in, ws_size); grid = -1; return; }
        int dev = 0, cus = 0, per_cu = 0;
        (void)hipGetDevice(&dev); (void)hipDeviceGetAttribute(&cus, hipDeviceAttributeMultiprocessorCount, dev);
        if (hipFuncSetAttribute((const void*)fwd_kernel, hipFuncAttributeMaxDynamicSharedMemorySize, LDS_BYTES) != hipSuccess) { fprintf(stderr, "kernel_launch: hipFuncSetAttribute failed\n"); grid = -1; return; }
        (void)hipOccupancyMaxActiveBlocksPerMultiprocessor(&per_cu, (const void*)fwd_kernel, 512, LDS_BYTES);
        (void)hipGetLastError();
        if (per_cu < 1) per_cu = 1;
        grid = cus;
        fprintf(stderr, "kernel_launch: cus %d per_cu %d grid %d\n", cus, per_cu, grid);
    }
    if (grid < 0) return;
    Args a{};
    for (int i = 0; i < 24; ++i) a.in[i] = (const float*)d_in[i];
    a.out = (float*)d_out; a.ws = (unsigned char*)d_ws;
#if MK_PER_PHASE
    for (int ph = 0; ph < N_PHASES; ++ph) { a.ph_lo = ph; a.ph_hi = ph + 1; hipLaunchKernelGGL(fwd_kernel, dim3(grid), dim3(512), LDS_BYTES, stream, a); }
#else
    a.ph_lo = 0; a.ph_hi = MK_PH_HI;
    (void)hipMemsetAsync((unsigned char*)d_ws + WS_BAR, 0, 16384, stream);
    void* args[] = {&a};
    hipError_t e = hipLaunchCooperativeKernel((const void*)fwd_kernel, dim3(grid), dim3(512), args, LDS_BYTES, stream);
    if (e != hipSuccess) fprintf(stderr, "kernel_launch: cooperative launch failed: %s (grid %d)\n", hipGetErrorString(e), grid);
#endif
}
```

```cpp
#include <hip/hip_runtime.h>
#include <hip/hip_cooperative_groups.h>
#include <cstdio>
#include <cstdint>
namespace cg = cooperative_groups;

#define LAS __attribute__((address_space(3)))
typedef unsigned short bf16_t;
typedef short bf16x8 __attribute__((ext_vector_type(8)));
typedef float f32x4 __attribute__((ext_vector_type(4)));
typedef float f32x2 __attribute__((ext_vector_type(2)));
typedef float f32x16 __attribute__((ext_vector_type(16)));
typedef unsigned u32x4 __attribute__((ext_vector_type(4)));
typedef unsigned u32x2 __attribute__((ext_vector_type(2)));
typedef __bf16 bf16x2_t __attribute__((ext_vector_type(2)));

constexpr int D = 1024, NB = 8, SEQ = 4096, CTXL = 256, FF = 4096;
constexpr int ML = NB * SEQ, MC = NB * CTXL, MT = ML + MC;
constexpr int EVN = 3088, EVNP = 3328, ODN = 3072;
constexpr float ALPHA = 1.6817928305074292f;
constexpr float EPS = 1e-6f;
constexpr int NKV = CTXL + SEQ;
constexpr float QSCALE = 0.125f * 1.4426950408889634f;

constexpr size_t MiB = 1u << 20;
constexpr size_t WS_MISC = 0;
constexpr size_t WS_BAR = 65536;
constexpr size_t WS_MOD = 1 * MiB;
constexpr size_t WS_WA = 2 * MiB;
constexpr size_t WS_WO = 9 * MiB;
constexpr size_t WS_W1 = 11 * MiB;
constexpr size_t WS_W2 = 19 * MiB;
constexpr size_t WS_HC = 27 * MiB;
constexpr size_t WS_U = 35 * MiB;
constexpr size_t WS_P = 103 * MiB;
constexpr size_t WS_X = 324 * MiB;
constexpr size_t WS_V = WS_X;
constexpr size_t WS_OF = WS_X + 34 * MiB;
constexpr size_t WS_OB = WS_X + 68 * MiB;
constexpr size_t WS_G = WS_X + 102 * MiB;
constexpr size_t WS_BT = WS_X + 104 * MiB;
constexpr size_t WS_TOTA = WS_X + 106 * MiB;
constexpr size_t WS_TOTH = WS_X + 109 * MiB;
constexpr size_t WS_CARRY = WS_X + 112 * MiB;
constexpr size_t WS_HLAST = 375 * MiB;
constexpr size_t WS_PART = 376 * MiB;
constexpr size_t WS_TB = WS_X + 116 * MiB;
constexpr size_t WS_QKB = WS_X + 150 * MiB;
constexpr size_t WS_GAM = WS_X + 184 * MiB;
constexpr size_t WS_END = WS_X + 186 * MiB;

constexpr int LDS_BYTES = 147456;

__device__ __forceinline__ float bf2f(unsigned v) { return __uint_as_float(v << 16); }
__device__ __forceinline__ unsigned pk2(float lo, float hi) { f32x2 v = {lo, hi}; bf16x2_t b = __builtin_convertvector(v, bf16x2_t); return __builtin_bit_cast(unsigned, b); }
__device__ __forceinline__ unsigned f2bf(float f) { return pk2(f, 0.f) & 0xffffu; }
__device__ __forceinline__ void unpack8(const u32x4 r, float* o) {
    o[0] = __uint_as_float(r.x << 16); o[1] = __uint_as_float(r.x & 0xffff0000u);
    o[2] = __uint_as_float(r.y << 16); o[3] = __uint_as_float(r.y & 0xffff0000u);
    o[4] = __uint_as_float(r.z << 16); o[5] = __uint_as_float(r.z & 0xffff0000u);
    o[6] = __uint_as_float(r.w << 16); o[7] = __uint_as_float(r.w & 0xffff0000u);
}
__device__ __forceinline__ u32x4 pack8(const float* v) { u32x4 o; o.x = pk2(v[0], v[1]); o.y = pk2(v[2], v[3]); o.z = pk2(v[4], v[5]); o.w = pk2(v[6], v[7]); return o; }
__device__ __forceinline__ float sigmoidf_(float x) { return 1.f / (1.f + expf(-x)); }
__device__ __forceinline__ float siluf_(float x) { return x / (1.f + expf(-x)); }
__device__ __forceinline__ float fsigmoid(float x) { return __builtin_amdgcn_rcpf(1.0f + __builtin_amdgcn_exp2f(-1.4426950408889634f * x)); }
__device__ __forceinline__ float fsilu(float x) { return x * fsigmoid(x); }
__device__ __forceinline__ float softplusf_(float x) { return fmaxf(x, 0.f) + log1pf(expf(-fabsf(x))); }
__device__ __forceinline__ float gelu_tanh(float x) { const float u = 0.7978845608028654f * (x + 0.044715f * x * x * x); return 0.5f * x * (1.f + tanhf(u)); }
__device__ __forceinline__ float dppf(float v, const int ctrl_sel) {
    int r;
    if (ctrl_sel == 0) r = __builtin_amdgcn_update_dpp(0, __float_as_int(v), 0xB1, 0xF, 0xF, true);
    else if (ctrl_sel == 1) r = __builtin_amdgcn_update_dpp(0, __float_as_int(v), 0x4E, 0xF, 0xF, true);
    else if (ctrl_sel == 2) r = __builtin_amdgcn_update_dpp(0, __float_as_int(v), 0x141, 0xF, 0xF, true);
    else r = __builtin_amdgcn_update_dpp(0, __float_as_int(v), 0x140, 0xF, 0xF, true);
    return __int_as_float(r);
}
__device__ __forceinline__ float rowsum16(float v) { v += dppf(v, 0); v += dppf(v, 1); v += dppf(v, 2); v += dppf(v, 3); return v; }
__device__ __forceinline__ float wave_sum(float v) {
#pragma unroll
    for (int o = 1; o < 64; o <<= 1) v += __shfl_xor(v, o);
    return v;
}
__device__ __forceinline__ float xhalf_max(float v) { auto rr = __builtin_amdgcn_permlane32_swap(__float_as_uint(v), __float_as_uint(v), false, false); return fmaxf(__uint_as_float(rr[0]), __uint_as_float(rr[1])); }
__device__ __forceinline__ float xhalf_sum(float v) { auto rr = __builtin_amdgcn_permlane32_swap(__float_as_uint(v), __float_as_uint(v), false, false); return __uint_as_float(rr[0]) + __uint_as_float(rr[1]); }
#define LDS_WAIT() asm volatile("s_waitcnt lgkmcnt(0)" ::: "memory")

namespace pg8 {
constexpr int BM = 256, BK = 64, HALF = 128, HTB = HALF * BK * 2, STAGE_BYTES = 8 * HTB, NXCD = 8, WGM = 8;
__host__ __device__ __forceinline__ int lds_byte(int r, int c) { const int st = (r >> 4) * 2 + (c >> 5), rr = r & 15, cc = c & 31, ob = rr * 64 + cc * 2; return st * 1024 + (ob ^ (((ob >> 9) & 1) << 5)); }
__host__ __device__ __forceinline__ void stage_rc(int b, int& R, int& C) { const int st = b / 1024, sb = b % 1024, swz = sb ^ (((sb >> 9) & 1) << 5); R = (st >> 1) * 16 + swz / 64; C = (st & 1) * 32 + (swz % 64) / 2; }
__host__ __device__ __forceinline__ int perm32(int rho) { const int n = rho >> 4, i = rho & 15; return 8 * (i >> 2) + 4 * n + (i & 3); }
struct Unit { int pm, pn, ks; };
struct Gemm { const bf16_t* A; const bf16_t* Bt; int M, N, K, lda, ldb, nks; };
struct StaticOrder {
    int nM, nN, nwg, G, c;
    int nks;
    __device__ void init(int M, int N, int G_, int c_, int nks_) { nM = M / BM; nN = N / BM; nwg = nM * nN; G = G_; c = c_; nks = nks_; }
    __device__ bool next(int i, Unit& u) const {
        const long L = (long)i * G + c; if (L >= (long)nwg * nks) return false;
        u.ks = (int)(L % nks); int wgid = (int)(L / nks); { const int q = nwg / NXCD, r = nwg % NXCD, xcd = wgid % NXCD, off = wgid / NXCD; wgid = (xcd < r ? xcd * (q + 1) : r * (q + 1) + (xcd - r) * q) + off; }
        const int nig = WGM * nN, gid = wgid / nig, fm = gid * WGM, gsz = (nM - fm) < WGM ? (nM - fm) : WGM;
        u.pm = fm + ((wgid % nig) % gsz); u.pn = (wgid % nig) / gsz; return true;
    }
};
struct EpiBf16 {
    static constexpr bool PERM = true;
    bf16_t* O; int ldc; int act; const float* gate; int bb_force; size_t ks_stride;
    __device__ __forceinline__ void operator()(const f32x4 (&acc)[2][2][4][2], const Unit& u, int wr, int wc, int fr, int fq) const {
        const int rt = u.pm * BM; const int bb = bb_force >= 0 ? bb_force : (rt >= ML ? 8 : (rt >> 12));
        const int row0 = rt + wr * 64 + fr; const int col0 = u.pn * BM + wc * 32 + 8 * fq;
        f32x4 gv[2][2];
#pragma unroll
        for (int bj = 0; bj < 2; ++bj)
#pragma unroll
            for (int n = 0; n < 2; ++n) gv[bj][n] = gate ? *(const f32x4*)(gate + bb * 6144 + col0 + bj * HALF + 4 * n) : (f32x4){1.f, 1.f, 1.f, 1.f};
#pragma unroll
        for (int ai = 0; ai < 2; ++ai)
#pragma unroll
            for (int m = 0; m < 4; ++m) { bf16_t* rowp = O + (size_t)u.ks * ks_stride + (size_t)(row0 + ai * HALF + m * 16) * ldc + col0;
#pragma unroll
                for (int bj = 0; bj < 2; ++bj) { f32x4 v0 = acc[ai][bj][m][0], v1 = acc[ai][bj][m][1];
                    if (act == 2) {
#pragma unroll
                        for (int e = 0; e < 4; ++e) { float a0 = fmaxf(v0[e], 0.f), a1 = fmaxf(v1[e], 0.f); v0[e] = a0 * a0; v1[e] = a1 * a1; } }
                    v0 = v0 * gv[bj][0]; v1 = v1 * gv[bj][1];
                    u32x4 w; w.x = pk2(v0[0], v0[1]); w.y = pk2(v0[2], v0[3]); w.z = pk2(v1[0], v1[1]); w.w = pk2(v1[2], v1[3]);
                    *(u32x4*)(rowp + bj * HALF) = w; } }
    }
};

template <class Epi>
__device__ __forceinline__ void gemm_phase(LAS unsigned char* lds, const Gemm g, const StaticOrder& S, const Epi& E, const int tid) {
    const int wid = __builtin_amdgcn_readfirstlane(tid >> 6), lane = tid & 63, wr = wid >> 2, wc = wid & 3, fr = lane & 15, fq = lane >> 4;
    const int K = g.K, nt = K / BK;
    unsigned voffA[2], voffB[2];
#pragma unroll
    for (int i = 0; i < 2; ++i) { int R, C; stage_rc(tid * 16 + i * 8192, R, C); const int Rb = Epi::PERM ? ((R & ~31) + perm32(R & 31)) : R;
        voffA[i] = (unsigned)(R * g.lda + C) * 2u; voffB[i] = (unsigned)(Rb * g.ldb + C) * 2u; }
    const size_t kstep = (size_t)(BK * 2);
    const size_t hA = (size_t)HALF * g.lda * 2, hB = (size_t)HALF * g.ldb * 2, kso = (size_t)K * 2;
    const size_t tA = 2 * hA, tB = 2 * hB;
    const unsigned ldsw = (unsigned)wid * 1024u;
    const int aoff = lds_byte(wr * 64 + fr, fq * 8), boff = lds_byte(wc * 32 + fr, fq * 8);
#define PG8_SA(b, h) (((b) * 2 + (h)) * HTB)
#define PG8_SB(b, h) ((4 + (b) * 2 + (h)) * HTB)
#define PG8_STAGE(bufoff, gbase, voff) do { _Pragma("unroll") for (int _i = 0; _i < 2; ++_i) \
        __builtin_amdgcn_global_load_lds((const unsigned*)((const char*)(gbase) + (voff)[_i]), (LAS unsigned*)(lds + (bufoff) + ldsw + _i * 8192), 16, 0, 0); } while (0)
#define PG8_LDA(dst, b, h) do { _Pragma("unroll") for (int m = 0; m < 4; ++m) _Pragma("unroll") for (int k = 0; k < 2; ++k) dst[m][k] = *(const LAS bf16x8*)(lds + PG8_SA(b, h) + aoff + m * 2048 + k * 1024); } while (0)
#define PG8_LDB(dst, b, h) do { _Pragma("unroll") for (int n = 0; n < 2; ++n) _Pragma("unroll") for (int k = 0; k < 2; ++k) dst[n][k] = *(const LAS bf16x8*)(lds + PG8_SB(b, h) + boff + n * 2048 + k * 1024); } while (0)
#define PG8_MMA(ai, bj, At, Bt) do { __builtin_amdgcn_s_setprio(1); _Pragma("unroll") for (int m = 0; m < 4; ++m) _Pragma("unroll") for (int n = 0; n < 2; ++n) _Pragma("unroll") for (int k = 0; k < 2; ++k) \
        acc[ai][bj][m][n] = __builtin_amdgcn_mfma_f32_16x16x32_bf16(Bt[n][k], At[m][k], acc[ai][bj][m][n], 0, 0, 0); __builtin_amdgcn_s_setprio(0); } while (0)
#define PG8_WAIT_V(n) asm volatile("s_waitcnt vmcnt(" #n ")" ::: "memory")
#define PG8_WAIT_L(n) asm volatile("s_waitcnt lgkmcnt(" #n ")" ::: "memory")
#define PG8_BAR __builtin_amdgcn_s_barrier()
#define PG8_SCHED __builtin_amdgcn_sched_barrier(0)
    Unit cur, nxt; int ui = 0;
    if (!S.next(0, cur)) return;
    f32x4 acc[2][2][4][2];
#pragma unroll
    for (int a = 0; a < 2; ++a)
#pragma unroll
        for (int b = 0; b < 2; ++b)
#pragma unroll
            for (int m = 0; m < 4; ++m)
#pragma unroll
                for (int n = 0; n < 2; ++n) acc[a][b][m][n] = (f32x4){0.f, 0.f, 0.f, 0.f};
    bf16x8 At[4][2], B0[2][2], B1[2][2];
    const char* cA = (const char*)g.A + (size_t)cur.pm * tA + cur.ks * kso; const char* cB = (const char*)g.Bt + (size_t)cur.pn * tB + cur.ks * kso;
    PG8_STAGE(PG8_SB(0, 0), cB, voffB); PG8_STAGE(PG8_SB(0, 1), cB + hB, voffB); PG8_STAGE(PG8_SA(0, 0), cA, voffA); PG8_STAGE(PG8_SA(0, 1), cA + hA, voffA);
    if (wr == 1) PG8_BAR;
    PG8_WAIT_V(2); PG8_BAR;
    PG8_STAGE(PG8_SB(1, 0), cB + kstep, voffB); PG8_STAGE(PG8_SA(1, 0), cA + kstep, voffA); PG8_STAGE(PG8_SB(1, 1), cB + hB + kstep, voffB);
    PG8_WAIT_V(6); PG8_BAR;
    for (;;) {
        const bool has_next = S.next(ui + 1, nxt);
        const char* nA = has_next ? (const char*)g.A + (size_t)nxt.pm * tA + nxt.ks * kso : cA; const char* nB = has_next ? (const char*)g.Bt + (size_t)nxt.pn * tB + nxt.ks * kso : cB;
        for (int t = 0; t < nt; t += 2) {
            const bool last = (t == nt - 2);
            const char* a1 = cA + (size_t)(t + 1) * kstep;
            const char* a2 = last ? nA : cA + (size_t)(t + 2) * kstep; const char* b2 = last ? nB : cB + (size_t)(t + 2) * kstep;
            const char* a3 = a2 + kstep; const char* b3 = b2 + kstep;
            PG8_LDB(B0, 0, 0); PG8_LDB(B1, 0, 1); PG8_SCHED; PG8_LDA(At, 0, 0); PG8_STAGE(PG8_SA(1, 1), a1 + hA, voffA);
            PG8_WAIT_V(8); PG8_WAIT_L(0); PG8_BAR; PG8_MMA(0, 0, At, B0); PG8_MMA(0, 1, At, B1); PG8_BAR; PG8_SCHED;
            PG8_LDA(At, 0, 1); PG8_STAGE(PG8_SB(0, 0), b2, voffB); PG8_STAGE(PG8_SB(0, 1), b2 + hB, voffB); PG8_STAGE(PG8_SA(0, 0), a2, voffA);
            PG8_WAIT_V(8); PG8_WAIT_L(0); PG8_BAR; PG8_MMA(1, 0, At, B0); PG8_MMA(1, 1, At, B1); PG8_BAR; PG8_SCHED;
            PG8_LDB(B0, 1, 0); PG8_LDB(B1, 1, 1); PG8_SCHED; PG8_LDA(At, 1, 0); PG8_STAGE(PG8_SA(0, 1), a2 + hA, voffA);
            PG8_WAIT_V(8); PG8_WAIT_L(0); PG8_BAR; PG8_MMA(0, 0, At, B0); PG8_MMA(0, 1, At, B1); PG8_BAR; PG8_SCHED;
            PG8_LDA(At, 1, 1); PG8_STAGE(PG8_SB(1, 0), b3, voffB); PG8_STAGE(PG8_SB(1, 1), b3 + hB, voffB); PG8_STAGE(PG8_SA(1, 0), a3, voffA);
            PG8_WAIT_V(8); PG8_WAIT_L(0); PG8_BAR; PG8_MMA(1, 0, At, B0); PG8_MMA(1, 1, At, B1); PG8_BAR; PG8_SCHED;
        }
        if (wr == 0) PG8_BAR;
        E(acc, cur, wr, wc, fr, fq);
        if (!has_next) break;
#pragma unroll
        for (int a = 0; a < 2; ++a)
#pragma unroll
            for (int b = 0; b < 2; ++b)
#pragma unroll
                for (int m = 0; m < 4; ++m)
#pragma unroll
                    for (int n = 0; n < 2; ++n) acc[a][b][m][n] = (f32x4){0.f, 0.f, 0.f, 0.f};
        cur = nxt; cA = nA; cB = nB; ++ui;
        if (wr == 1) PG8_BAR;
    }
    PG8_WAIT_V(0);
    PG8_BAR;
#undef PG8_SA
#undef PG8_SB
#undef PG8_STAGE
#undef PG8_LDA
#undef PG8_LDB
#undef PG8_MMA
#undef PG8_WAIT_V
#undef PG8_WAIT_L
#undef PG8_BAR
#undef PG8_SCHED
}
}

struct Args { const float* in[24]; float* out; unsigned char* ws; int ph_lo, ph_hi; };
typedef const __attribute__((address_space(4))) Args* KA;
enum { I_X = 0, I_C, I_CTX, I_CCTX, I_ADAW, I_ADAB, I_LNG, I_LNB, I_W1, I_W2, I_WOUT, I_EVWIN, I_EVQKVCONV, I_EVALOG, I_EVDTB, I_EVGDNNORM,
       I_LRUCW, I_LRUCB, I_LRUGW, I_LRUGB, I_LRULAM, I_ODWQKV, I_ODLAM, I_ODSUBLN };
enum { K_PROA = 0, K_PROB, K_PROJ, K_E2, K_E3, K_E4, K_O2, K_O3, K_WOUT, K_LN1, K_MLP1, K_MLP2, K_LN2, K_E2B };
constexpr int N_PHASES = 2 + 10 + 8 + 10 + 8;

__device__ __forceinline__ void transpose_item(const float* W, int K, int N, int Npad, bf16_t* WT, LAS float* scr, int item, int lane) {
    const int nblk = Npad / 32, kb = item / nblk, nb = item % nblk, k0 = 64 * kb, n0 = 32 * nb;
    const int n = n0 + (lane & 31);
    { float wv[32];
#pragma unroll
      for (int i = 0; i < 32; ++i) { const int kk = 2 * i + (lane >> 5); wv[i] = (n < N) ? W[(size_t)(k0 + kk) * N + n] : 0.f; }
#pragma unroll
      for (int i = 0; i < 32; ++i) { const int kk = 2 * i + (lane >> 5); scr[kk * 33 + (lane & 31)] = wv[i]; } }
    LDS_WAIT();
    const int c = lane & 7;
#pragma unroll
    for (int j = 0; j < 4; ++j) { const int nn = (lane >> 3) + 8 * j; const LAS float* s = scr + (8 * c) * 33 + nn;
        u32x4 o; o.x = pk2(s[0 * 33], s[1 * 33]); o.y = pk2(s[2 * 33], s[3 * 33]); o.z = pk2(s[4 * 33], s[5 * 33]); o.w = pk2(s[6 * 33], s[7 * 33]);
        *(u32x4*)(WT + (size_t)(n0 + nn) * K + k0 + 8 * c) = o; }
    LDS_WAIT();
}
__device__ __forceinline__ void conv_weights(KA a, int L, LAS unsigned char* lds, int gw, int NGW, int wave, int lane) {
    LAS float* scr = (LAS float*)(lds + wave * 16384);
    const bool even = (L & 1) == 0; const int j2 = L >> 1;
    const float* Wa = even ? a->in[I_EVWIN] + (size_t)j2 * D * EVN : a->in[I_ODWQKV] + (size_t)j2 * D * ODN;
    const int Na = even ? EVN : ODN, Nap = even ? EVNP : ODN;
    const int IA = (D / 64) * (Nap / 32), IO = (D / 64) * (D / 32), I1 = (D / 64) * (FF / 32), I2 = (FF / 64) * (D / 32);
    bf16_t* WA = (bf16_t*)(a->ws + WS_WA); bf16_t* WO = (bf16_t*)(a->ws + WS_WO); bf16_t* W1 = (bf16_t*)(a->ws + WS_W1); bf16_t* W2 = (bf16_t*)(a->ws + WS_W2);
    for (int it = gw; it < IA + IO + I1 + I2; it += NGW) {
        int r = it;
        if (r < IA) { transpose_item(Wa, D, Na, Nap, WA, scr, r, lane); continue; } r -= IA;
        if (r < IO) { transpose_item(a->in[I_WOUT] + (size_t)L * D * D, D, D, D, WO, scr, r, lane); continue; } r -= IO;
        if (r < I1) { transpose_item(a->in[I_W1] + (size_t)L * D * FF, D, FF, FF, W1, scr, r, lane); continue; } r -= I1;
        transpose_item(a->in[I_W2] + (size_t)L * FF * D, FF, D, D, W2, scr, r, lane);
    }
}

__device__ __forceinline__ void modulate_row_store(const f32x4 (&v)[4], const float* mod_bb, int sidx, bf16_t* urow, int lane) {
#pragma unroll
    for (int j = 0; j < 4; ++j) { const int c = 4 * (lane + 64 * j);
        const f32x4 sh = *(const f32x4*)(mod_bb + sidx * D + c), sc = *(const f32x4*)(mod_bb + (sidx + 1) * D + c);
        const f32x4 u = v[j] * (sc + 1.0f) + sh; u32x2 w; w.x = pk2(u[0], u[1]); w.y = pk2(u[2], u[3]); *(u32x2*)(urow + c) = w; }
}
__device__ __forceinline__ void prologue_b(KA a, int gw, int NGW, int lane) {
    const float* MOD = (const float*)(a->ws + WS_MOD); bf16_t* U = (bf16_t*)(a->ws + WS_U);
    for (int row = gw; row < MT; row += NGW) {
        const bool isctx = row >= ML; const int bb = isctx ? 8 : (row >> 12);
        const float* hp = isctx ? a->in[I_CTX] + (size_t)(row - ML) * D : a->in[I_X] + (size_t)row * D;
        f32x4 v[4];
#pragma unroll
        for (int j = 0; j < 4; ++j) v[j] = *(const f32x4*)(hp + 4 * (lane + 64 * j));
        modulate_row_store(v, MOD + (size_t)(0 * 9 + bb) * 6144, 0, U + (size_t)row * D, lane);
    }
}
__device__ __forceinline__ void ln_row_finish(f32x4 (&v)[4], float s, const float* lg, const float* lb, bf16_t* hp16, float* hp32, bool do_u, const float* mod_bb, int sidx, bf16_t* urow, int lane) {
    const float mean = wave_sum(s) * (1.f / D); float s2 = 0.f;
#pragma unroll
    for (int j = 0; j < 4; ++j) { v[j] = v[j] - mean; s2 += (v[j][0] * v[j][0] + v[j][1] * v[j][1]) + (v[j][2] * v[j][2] + v[j][3] * v[j][3]); }
    const float rstd = 1.0f / sqrtf(wave_sum(s2) * (1.f / D) + EPS);
#pragma unroll
    for (int j = 0; j < 4; ++j) { const int c = 4 * (lane + 64 * j); const f32x4 gg = *(const f32x4*)(lg + c), bbv = *(const f32x4*)(lb + c);
        v[j] = v[j] * rstd * gg + bbv;
        if (hp32) __builtin_nontemporal_store(v[j], (f32x4*)(hp32 + c));
        else { typedef _Float16 h4_t __attribute__((ext_vector_type(4))); const u32x2 w = __builtin_bit_cast(u32x2, __builtin_convertvector(v[j], h4_t)); __builtin_nontemporal_store(w, (u32x2*)(hp16 + c)); } }
    if (do_u) modulate_row_store(v, mod_bb, sidx, urow, lane);
}
typedef _Float16 h16x4 __attribute__((ext_vector_type(4)));
__device__ __forceinline__ f32x4 hf4(const u32x2 w) { return __builtin_convertvector(__builtin_bit_cast(h16x4, w), f32x4); }
__device__ __forceinline__ u32x2 f4h(const f32x4 v) { return __builtin_bit_cast(u32x2, __builtin_convertvector(v, h16x4)); }
__device__ __forceinline__ f32x4 bf4(const u32x2 w) { return (f32x4){__uint_as_float(w.x << 16), __uint_as_float(w.x & 0xffff0000u), __uint_as_float(w.y << 16), __uint_as_float(w.y & 0xffff0000u)}; }
__device__ __forceinline__ void ln_pass(KA a, int L, int which, int nrows, bool do_u, int Lm, int sidx, const bf16_t* T, int npart, int gw, int NGW, int lane) {
    const float* MOD = (const float*)(a->ws + WS_MOD); bf16_t* U = (bf16_t*)(a->ws + WS_U); bf16_t* HC = (bf16_t*)(a->ws + WS_HC);
    const float* lg = a->in[I_LNG] + (size_t)(L * 2 + which) * D; const float* lb = a->in[I_LNB] + (size_t)(L * 2 + which) * D;
    const bool first = (L == 0 && which == 0), fin = (L == 3 && which == 1);
    bf16_t* HL = (bf16_t*)((unsigned char*)a->out + (size_t)64 * MiB); bf16_t* HX = (bf16_t*)(a->ws + WS_HLAST);
    const bf16_t* hin16 = fin ? HX : HL;
    bf16_t* hout16 = (L == 3 && which == 0) ? HX : HL;
    const int nmain = npart > 0 ? ML : nrows;
    if (first) {
        f32x4 hv[4]; u32x2 tw[4];
#define LN_FETCH(HV, TW, row_) do { const int r_ = (row_); const float* hin_ = a->in[I_X] + (size_t)r_ * D; const bf16_t* tp_ = T + (size_t)r_ * D; \
        _Pragma("unroll") for (int j = 0; j < 4; ++j) { const int c = 4 * (lane + 64 * j); HV[j] = __builtin_nontemporal_load((const f32x4*)(hin_ + c)); TW[j] = __builtin_nontemporal_load((const u32x2*)(tp_ + c)); } } while (0)
        if (gw < nmain) LN_FETCH(hv, tw, gw);
#pragma unroll 2
        for (int row = gw; row < nmain; row += NGW) {
            f32x4 hn[4]; u32x2 tn[4]; const int nrow = row + NGW < nmain ? row + NGW : row;
            LN_FETCH(hn, tn, nrow);
            f32x4 v[4]; float s = 0.f;
#pragma unroll
            for (int j = 0; j < 4; ++j) { v[j] = hv[j] * ALPHA + bf4(tw[j]); s += (v[j][0] + v[j][1]) + (v[j][2] + v[j][3]); }
            ln_row_finish(v, s, lg, lb, hout16 + (size_t)row * D, nullptr, do_u, MOD + (size_t)(Lm * 9 + (row >> 12)) * 6144, sidx, U + (size_t)row * D, lane);
#pragma unroll
            for (int j = 0; j < 4; ++j) { hv[j] = hn[j]; tw[j] = tn[j]; }
        }
#undef LN_FETCH
    } else {
        u32x2 hv[4], tw[4];
#define LN_FETCH(HV, TW, row_) do { const int r_ = (row_); const bf16_t* hin_ = hin16 + (size_t)r_ * D; const bf16_t* tp_ = T + (size_t)r_ * D; \
        _Pragma("unroll") for (int j = 0; j < 4; ++j) { const int c = 4 * (lane + 64 * j); HV[j] = __builtin_nontemporal_load((const u32x2*)(hin_ + c)); TW[j] = __builtin_nontemporal_load((const u32x2*)(tp_ + c)); } } while (0)
        if (gw < nmain) LN_FETCH(hv, tw, gw);
#pragma unroll 2
        for (int row = gw; row < nmain; row += NGW) {
            u32x2 hn[4], tn[4]; const int nrow = row + NGW < nmain ? row + NGW : row;
            LN_FETCH(hn, tn, nrow);
            f32x4 v[4]; float s = 0.f;
#pragma unroll
            for (int j = 0; j < 4; ++j) { v[j] = hf4(hv[j]) * ALPHA + bf4(tw[j]); s += (v[j][0] + v[j][1]) + (v[j][2] + v[j][3]); }
            ln_row_finish(v, s, lg, lb, hout16 + (size_t)row * D, fin ? a->out + (size_t)row * D : nullptr, do_u, MOD + (size_t)(Lm * 9 + (row >> 12)) * 6144, sidx, U + (size_t)row * D, lane);
#pragma unroll
            for (int j = 0; j < 4; ++j) { hv[j] = hn[j]; tw[j] = tn[j]; }
        }
#undef LN_FETCH
    }
    if (npart > 0) {
        const bf16_t* PART = (const bf16_t*)(a->ws + WS_PART);
        for (int row = ML + gw; row < nrows; row += NGW) {
            const size_t rc = (size_t)(row - ML); bf16_t* hp = HC + rc * D;
            f32x4 v[4]; float s = 0.f;
#pragma unroll
            for (int j = 0; j < 4; ++j) { const int c = 4 * (lane + 64 * j); f32x4 tv = {0.f, 0.f, 0.f, 0.f};
                for (int ks = 0; ks < npart; ++ks) tv += bf4(*(const u32x2*)(PART + (size_t)ks * MC * D + rc * D + c));
                const f32x4 hh = first ? *(const f32x4*)(a->in[I_CTX] + rc * D + c) : hf4(*(const u32x2*)(hp + c));
                v[j] = hh * ALPHA + tv; s += (v[j][0] + v[j][1]) + (v[j][2] + v[j][3]); }
            ln_row_finish(v, s, lg, lb, hp, nullptr, do_u, MOD + (size_t)(Lm * 9 + 8) * 6144, sidx, U + (size_t)row * D, lane);
        }
    }
}

__device__ __forceinline__ void prologue_a(KA a, LAS unsigned char* lds, int bid, int G, int tid, int wave, int lane) {
    float* MOD = (float*)(a->ws + WS_MOD); float* MISC = (float*)(a->ws + WS_MISC);
    LAS float* sv = (LAS float*)lds;
    LAS float* red = (LAS float*)(lds + 9 * 1024 * 4);
    for (int i = tid; i < 9 * 1024; i += 512) { const int bb = i >> 10, k = i & 1023; const float v = bb < 8 ? a->in[I_C][bb * 1024 + k] : a->in[I_CCTX][k]; sv[i] = siluf_(v); }
    __syncthreads();
    for (int unit = bid; unit < 192; unit += G) {
        const int L = unit / 48, cb = unit % 48, col = tid & 127, kq = tid >> 7;
        const float* w = a->in[I_ADAW] + (size_t)L * D * 6144 + cb * 128 + col;
        float acc[9];
#pragma unroll
        for (int bb = 0; bb < 9; ++bb) acc[bb] = 0.f;
        for (int k0 = kq * 256; k0 < kq * 256 + 256; k0 += 16) { float wv[16];
#pragma unroll
            for (int i = 0; i < 16; ++i) wv[i] = w[(size_t)(k0 + i) * 6144];
#pragma unroll
            for (int i = 0; i < 16; ++i)
#pragma unroll
                for (int bb = 0; bb < 9; ++bb) acc[bb] += sv[bb * 1024 + k0 + i] * wv[i]; }
#pragma unroll
        for (int bb = 0; bb < 9; ++bb) red[(kq * 9 + bb) * 128 + col] = acc[bb];
        __syncthreads();
        for (int i = tid; i < 9 * 128; i += 512) { const int bb = i >> 7, cc = i & 127;
            float s = (red[(0 * 9 + bb) * 128 + cc] + red[(1 * 9 + bb) * 128 + cc]) + (red[(2 * 9 + bb) * 128 + cc] + red[(3 * 9 + bb) * 128 + cc]);
            s += a->in[I_ADAB][L * 6144 + cb * 128 + cc]; MOD[(size_t)(L * 9 + bb) * 6144 + cb * 128 + cc] = s; }
        __syncthreads();
    }
    if (bid == G - 1) {
        if (tid < 16) {
            double th = 1.0; for (int j = 0; j < tid; ++j) th *= 0.56234132519034908;
            const double t2 = th * th; double sn = th, term = th, cs = 1.0, tc = 1.0;
            for (int k = 1; k < 12; ++k) { tc *= -t2 / ((2.0 * k - 1.0) * (2.0 * k)); cs += tc; term *= -t2 / ((2.0 * k) * (2.0 * k + 1.0)); sn += term; }
            double c = 1.0, s = 0.0;
            for (int p = 0; p < 64; ++p) { MISC[64 + p * 16 + tid] = (float)c; MISC[1088 + p * 16 + tid] = (float)s; const double c2 = c * cs - s * sn, s2 = s * cs + c * sn; c = c2; s = s2; }
        }
        if (tid >= 64 && tid < 66) { const int j = tid - 64; const float* lv = a->in[I_ODLAM] + j * 256; float d0 = 0.f, d1 = 0.f;
            for (int i = 0; i < 64; ++i) { d0 += lv[i] * lv[64 + i]; d1 += lv[128 + i] * lv[192 + i]; }
            const float li = 0.8f - 0.6f * expf(-0.3f * (float)(2 * j + 1)); MISC[j] = expf(d0) - expf(d1) + li; MISC[2 + j] = li; }
    }
    __syncthreads();
    conv_weights(a, 0, lds, bid * 8 + wave, G * 8, wave, lane);
}

__device__ __forceinline__ void attn_prep(KA a, LAS unsigned char* lds, int bid, int G, int tid) {
    bf16_t* P = (bf16_t*)(a->ws + WS_P); bf16_t* VT = (bf16_t*)(a->ws + WS_V); const float* MISC = (const float*)(a->ws + WS_MISC);
    const float* tabc = MISC + 64; const float* tabs = MISC + 1088;
    constexpr int VP = 2064;
    for (int u = bid; u < 2 * NB * 68; u += G) {
        const bool vpart = u >= NB * 68; const int uu = vpart ? u - NB * 68 : u;
        const int b = uu / 68, tl = uu % 68; const bool isctx = tl < 4; const int t0 = isctx ? tl * 64 : (tl - 4) * 64;
        const int rowbase = isctx ? ML + b * CTXL + t0 : b * SEQ + t0; const int kv0 = isctx ? t0 : CTXL + t0;
        if (!vpart) {
#pragma unroll 1
            for (int half = 0; half < 2; ++half) {
                u32x4 r1[4], r2[4], r3[4], r4[4];
#pragma unroll
                for (int k = 0; k < 4; ++k) { const int it = tid + 512 * (4 * half + k); const int r = it >> 6, rem = it & 63, vec = rem >> 1, part = rem & 1;
                    const bf16_t* p = P + (size_t)(rowbase + r) * ODN + vec * 64 + part * 8;
                    r1[k] = *(const u32x4*)(p); r2[k] = *(const u32x4*)(p + 16); r3[k] = *(const u32x4*)(p + 32); r4[k] = *(const u32x4*)(p + 48); }
#pragma unroll
                for (int k = 0; k < 4; ++k) { const int it = tid + 512 * (4 * half + k); const int r = it >> 6, rem = it & 63, vec = rem >> 1, part = rem & 1; const bool isq = vec < 16;
                    if (isctx && !isq) continue;
                    bf16_t* p = P + (size_t)(rowbase + r) * ODN + vec * 64 + part * 8;
                    float t1[8], t2[8], t3[8], t4[8];
                    unpack8(r1[k], t1); unpack8(r2[k], t2); unpack8(r3[k], t3); unpack8(r4[k], t4);
                    const float sc = isq ? QSCALE : 1.0f;
                    if (!isctx) {
                        const int pos = t0 + r, rp = pos >> 6, cp = pos & 63;
#pragma unroll
                        for (int j = 0; j < 8; ++j) { const int jj = part * 8 + j;
                            const float cr = tabc[rp * 16 + jj], sr = tabs[rp * 16 + jj], cc = tabc[cp * 16 + jj], ss = tabs[cp * 16 + jj];
                            const float o1 = t1[j] * cr - t2[j] * sr, o2 = t2[j] * cr + t1[j] * sr, o3 = t3[j] * cc - t4[j] * ss, o4 = t4[j] * cc + t3[j] * ss;
                            t1[j] = o1 * sc; t2[j] = o2 * sc; t3[j] = o3 * sc; t4[j] = o4 * sc; }
                    } else {
#pragma unroll
                        for (int j = 0; j < 8; ++j) { t1[j] *= sc; t2[j] *= sc; t3[j] *= sc; t4[j] *= sc; }
                    }
                    *(u32x4*)(p) = pack8(t1); *(u32x4*)(p + 16) = pack8(t2); *(u32x4*)(p + 32) = pack8(t3); *(u32x4*)(p + 48) = pack8(t4);
                }
            }
        } else {
            { u32x4 rv[16];
#pragma unroll
              for (int k = 0; k < 16; ++k) { const int id = tid + 512 * k; rv[k] = *(const u32x4*)(P + (size_t)(rowbase + (id >> 7)) * ODN + 2048 + (id & 127) * 8); }
#pragma unroll
              for (int k = 0; k < 16; ++k) { const int id = tid + 512 * k; *(LAS u32x4*)(lds + (id >> 7) * VP + (id & 127) * 16) = rv[k]; } }
            __syncthreads();
#pragma unroll 4
            for (int k = 0; k < 16; ++k) { const int oc = tid + 512 * k; const int col = oc & 1023, c = oc >> 10;
                unsigned w[4];
#pragma unroll
                for (int j = 0; j < 4; ++j) { const unsigned lo = *(const LAS bf16_t*)(lds + (8 * c + 2 * j) * VP + col * 2), hi = *(const LAS bf16_t*)(lds + (8 * c + 2 * j + 1) * VP + col * 2); w[j] = lo | (hi << 16); }
                u32x4 o; o.x = w[0]; o.y = w[1]; o.z = w[2]; o.w = w[3];
                *(u32x4*)(VT + ((size_t)(b * 8 * 128 + col)) * NKV + kv0 + 8 * c) = o; }
            __syncthreads();
        }
    }
}

constexpr int AT_KB = 64 * 272, AT_VB = 128 * 144, AT_BUF = AT_KB + AT_VB, AT_OX = 0;
static_assert(3 * AT_BUF <= LDS_BYTES - 16 && 128 * 132 * 4 <= 3 * AT_BUF, "attention lds");
__device__ __forceinline__ void at_qk(const LAS unsigned char* Kb, const bf16x8 (&qf)[4], f32x16& s0, f32x16& s1, int m, int krow, int hi) {
#pragma unroll
    for (int r = 0; r < 16; ++r) { s0[r] = 0.f; s1[r] = 0.f; }
#pragma unroll
    for (int ks = 0; ks < 4; ++ks) {
        const bf16x8 a0 = *(const LAS bf16x8*)(Kb + krow * 272 + (m * 64 + ks * 16 + hi * 8) * 2);
        const bf16x8 a1 = *(const LAS bf16x8*)(Kb + (krow + 32) * 272 + (m * 64 + ks * 16 + hi * 8) * 2);
        s0 = __builtin_amdgcn_mfma_f32_32x32x16_bf16(a0, qf[ks], s0, 0, 0, 0);
        s1 = __builtin_amdgcn_mfma_f32_32x32x16_bf16(a1, qf[ks], s1, 0, 0, 0);
    }
}
template <bool HAS_NEXT>
__device__ __forceinline__ void at_step(const LAS unsigned char* Kn, const LAS unsigned char* Vc, const bf16x8 (&qf)[4], f32x16 (&o)[4], f32x16& s0, f32x16& s1, f32x16& negm, float& mrun, f32x16& lacc, int m, int krow, int r32, int hi) {
    f32x16 n0, n1;
#pragma unroll
    for (int ks = 0; ks < 4; ++ks) {
        if (HAS_NEXT) {
            const bf16x8 a0 = *(const LAS bf16x8*)(Kn + krow * 272 + (m * 64 + ks * 16 + hi * 8) * 2);
            const bf16x8 a1 = *(const LAS bf16x8*)(Kn + (krow + 32) * 272 + (m * 64 + ks * 16 + hi * 8) * 2);
            if (ks == 0) { n0 = __builtin_amdgcn_mfma_f32_32x32x16_bf16(a0, qf[0], negm, 0, 0, 0); n1 = __builtin_amdgcn_mfma_f32_32x32x16_bf16(a1, qf[0], negm, 0, 0, 0); }
            else { n0 = __builtin_amdgcn_mfma_f32_32x32x16_bf16(a0, qf[ks], n0, 0, 0, 0); n1 = __builtin_amdgcn_mfma_f32_32x32x16_bf16(a1, qf[ks], n1, 0, 0, 0); }
        }
#pragma unroll
        for (int r = 4 * ks; r < 4 * ks + 4; ++r) { s0[r] = __builtin_amdgcn_exp2f(s0[r]); s1[r] = __builtin_amdgcn_exp2f(s1[r]); }
    }
    bf16x8 pb[4];
    { u32x4 w;
      w.x = pk2(s0[0], s0[1]); w.y = pk2(s0[2], s0[3]); w.z = pk2(s0[4], s0[5]); w.w = pk2(s0[6], s0[7]); pb[0] = __builtin_bit_cast(bf16x8, w);
      w.x = pk2(s0[8], s0[9]); w.y = pk2(s0[10], s0[11]); w.z = pk2(s0[12], s0[13]); w.w = pk2(s0[14], s0[15]); pb[1] = __builtin_bit_cast(bf16x8, w);
      w.x = pk2(s1[0], s1[1]); w.y = pk2(s1[2], s1[3]); w.z = pk2(s1[4], s1[5]); w.w = pk2(s1[6], s1[7]); pb[2] = __builtin_bit_cast(bf16x8, w);
      w.x = pk2(s1[8], s1[9]); w.y = pk2(s1[10], s1[11]); w.z = pk2(s1[12], s1[13]); w.w = pk2(s1[14], s1[15]); pb[3] = __builtin_bit_cast(bf16x8, w); }
    const bf16x8 ones = {(short)0x3F80, (short)0x3F80, (short)0x3F80, (short)0x3F80, (short)0x3F80, (short)0x3F80, (short)0x3F80, (short)0x3F80};
    float mx = -3.0e38f;
#pragma unroll
    for (int db = 0; db < 4; ++db) {
#pragma unroll
        for (int i = 0; i < 4; ++i) {
            const bf16x8 av = *(const LAS bf16x8*)(Vc + (32 * db + r32) * 144 + (16 * i + 8 * hi) * 2);
            o[db] = __builtin_amdgcn_mfma_f32_32x32x16_bf16(av, pb[i], o[db], 0, 0, 0);
        }
        lacc = __builtin_amdgcn_mfma_f32_32x32x16_bf16(ones, pb[db], lacc, 0, 0, 0);
        if (HAS_NEXT) {
#pragma unroll
            for (int r = 4 * db; r < 4 * db + 4; ++r) mx = fmaxf(mx, fmaxf(n0[r], n1[r]));
        }
    }
    if (HAS_NEXT) {
        if (__any(mx > 8.0f)) {
            mx = xhalf_max(mx);
            const float delta = (mx > 8.0f) ? mx : 0.f; const float al = __builtin_amdgcn_exp2f(-delta);
#pragma unroll
            for (int db = 0; db < 4; ++db)
#pragma unroll
                for (int r = 0; r < 16; ++r) o[db][r] *= al;
            mrun += delta;
#pragma unroll
            for (int r = 0; r < 16; ++r) { n0[r] -= delta; n1[r] -= delta; negm[r] = -mrun; lacc[r] *= al; }
        }
        s0 = n0; s1 = n1;
    }
}
__device__ __forceinline__ void attn_phase(KA a, int L, LAS unsigned char* lds, int bid, int G, int tid, int wave, int lane, bool do_store) {
    bf16_t* P = (bf16_t*)(a->ws + WS_P); const bf16_t* VT = (const bf16_t*)(a->ws + WS_V); const float* MISC = (const float*)(a->ws + WS_MISC);
    const int j2 = L >> 1; const float lam = MISC[j2], lam_init = MISC[2 + j2];
    const float* subln = a->in[I_ODSUBLN] + j2 * 128;
    const int nunits = 2048 + (L == 1 ? 128 : 0);
    const int m = wave & 1, qs = wave >> 1, r32 = lane & 31, hi = lane >> 5;
    const int krow = (r32 & 0x13) | ((r32 & 4) << 1) | ((r32 & 8) >> 1);
    for (int u = bid; u < nunits; u += G) {
        int bh, qb; const bool isctx = u >= 2048;
        if (!isctx) { bh = (u >> 8) * 8 + (u & 7); qb = (u >> 3) & 31; } else { const int u2 = u - 2048; bh = u2 >> 1; qb = u2 & 1; }
        const int b = bh >> 3, h = bh & 7;
        const int qrow = (isctx ? ML + b * CTXL : b * SEQ) + qb * 128 + qs * 32 + r32;
        const int ntiles = isctx ? 4 : 68;
        bf16x8 qf[4];
#pragma unroll
        for (int ks = 0; ks < 4; ++ks) qf[ks] = *(const bf16x8*)(P + (size_t)qrow * ODN + h * 128 + m * 64 + ks * 16 + hi * 8);
        const int kr0 = tid >> 4, kc = tid & 15;
        const int vd0 = tid >> 3, vc = tid & 7;
        const bf16_t* vsrc0 = VT + ((size_t)(bh * 128 + vd0)) * NKV + 8 * vc; const bf16_t* vsrc1 = vsrc0 + (size_t)64 * NKV;
        u32x4 rk0, rk1, rv0, rv1;
#define AT_LOAD(t) do { const int kv_ = 64 * (t) + kr0; const int g0_ = kv_ < CTXL ? ML + b * CTXL + kv_ : b * SEQ + kv_ - CTXL; const int kv1_ = kv_ + 32; const int g1_ = kv1_ < CTXL ? ML + b * CTXL + kv1_ : b * SEQ + kv1_ - CTXL; \
        rk0 = *(const u32x4*)(P + (size_t)g0_ * ODN + 1024 + h * 128 + kc * 8); rk1 = *(const u32x4*)(P + (size_t)g1_ * ODN + 1024 + h * 128 + kc * 8); \
        rv0 = *(const u32x4*)(vsrc0 + 64 * (t)); rv1 = *(const u32x4*)(vsrc1 + 64 * (t)); } while (0)
#define AT_STORE(boff) do { LAS unsigned char* kb_ = lds + (boff); LAS unsigned char* vb_ = kb_ + AT_KB; \
        *(LAS u32x4*)(kb_ + kr0 * 272 + kc * 16) = rk0; *(LAS u32x4*)(kb_ + (kr0 + 32) * 272 + kc * 16) = rk1; \
        *(LAS u32x4*)(vb_ + vd0 * 144 + vc * 16) = rv0; *(LAS u32x4*)(vb_ + (vd0 + 64) * 144 + vc * 16) = rv1; } while (0)
        { AT_LOAD(0); const u32x4 k0_ = rk0, k1_ = rk1, v0_ = rv0, v1_ = rv1;
          AT_LOAD(1);
          { LAS unsigned char* kb_ = lds; LAS unsigned char* vb_ = kb_ + AT_KB;
            *(LAS u32x4*)(kb_ + kr0 * 272 + kc * 16) = k0_; *(LAS u32x4*)(kb_ + (kr0 + 32) * 272 + kc * 16) = k1_;
            *(LAS u32x4*)(vb_ + vd0 * 144 + vc * 16) = v0_; *(LAS u32x4*)(vb_ + (vd0 + 64) * 144 + vc * 16) = v1_; }
          AT_STORE(AT_BUF); }
        __syncthreads();
        f32x16 o[4];
#pragma unroll
        for (int db = 0; db < 4; ++db)
#pragma unroll
            for (int r = 0; r < 16; ++r) o[db][r] = 0.f;
        f32x16 s0, s1;
        at_qk(lds, qf, s0, s1, m, krow, hi);
        float mrun; f32x16 lacc;
#pragma unroll
        for (int r = 0; r < 16; ++r) lacc[r] = 0.f;
        { float mx = fmaxf(s0[0], s1[0]);
#pragma unroll
          for (int r = 1; r < 16; ++r) mx = fmaxf(mx, fmaxf(s0[r], s1[r]));
          mrun = xhalf_max(mx); }
        f32x16 negm;
#pragma unroll
        for (int r = 0; r < 16; ++r) { s0[r] -= mrun; s1[r] -= mrun; negm[r] = -mrun; }
        int bc = 0, bn = AT_BUF, bs = 2 * AT_BUF;
        for (int t = 0; t + 1 < ntiles; ++t) {
            const bool stage = t + 2 < ntiles;
            if (stage) AT_LOAD(t + 2);
            at_step<true>(lds + bn, lds + bc + AT_KB, qf, o, s0, s1, negm, mrun, lacc, m, krow, r32, hi);
            if (stage) AT_STORE(bs);
            __syncthreads();
            const int tmp = bc; bc = bn; bn = bs; bs = tmp;
        }
        at_step<false>(lds, lds + bc + AT_KB, qf, o, s0, s1, negm, mrun, lacc, m, krow, r32, hi);
        __syncthreads();
#undef AT_LOAD
#undef AT_STORE
        const float inv = 1.0f / lacc[0];
        LAS float* ox = (LAS float*)(lds + AT_OX) + (qs * 32 + r32) * 132;
        if (m == 1) {
#pragma unroll
            for (int db = 0; db < 4; ++db)
#pragma unroll
                for (int r4 = 0; r4 < 4; ++r4) { f32x4 v = {o[db][4 * r4] * inv, o[db][4 * r4 + 1] * inv, o[db][4 * r4 + 2] * inv, o[db][4 * r4 + 3] * inv};
                    *(LAS f32x4*)(ox + 32 * db + 8 * r4 + 4 * hi) = v; }
        }
        __syncthreads();
        if (m == 0) {
            float ssq = 0.f;
#pragma unroll
            for (int db = 0; db < 4; ++db)
#pragma unroll
                for (int r4 = 0; r4 < 4; ++r4) { const f32x4 v1 = *(const LAS f32x4*)(ox + 32 * db + 8 * r4 + 4 * hi);
#pragma unroll
                    for (int e = 0; e < 4; ++e) { const float v = o[db][4 * r4 + e] * inv - lam * v1[e]; o[db][4 * r4 + e] = v; ssq += v * v; } }
            ssq = xhalf_sum(ssq);
            const float sc = (1.0f / sqrtf(ssq * (1.f / 128.f) + EPS)) * (1.0f - lam_init);
            bf16_t* op = P + (size_t)qrow * ODN + h * 128;
#pragma unroll
            for (int db = 0; db < 4; ++db)
#pragma unroll
                for (int r4 = 0; r4 < 4; ++r4) { const int dv = 32 * db + 8 * r4 + 4 * hi; const f32x4 g4 = *(const f32x4*)(subln + dv);
                    u32x2 w; w.x = pk2(o[db][4 * r4] * sc * g4[0], o[db][4 * r4 + 1] * sc * g4[1]); w.y = pk2(o[db][4 * r4 + 2] * sc * g4[2], o[db][4 * r4 + 3] * sc * g4[3]);
                    if (do_store) *(u32x2*)(op + dv) = w; }
        }
        __syncthreads();
    }
}

__device__ __forceinline__ void gdn_prep(KA a, int L, LAS unsigned char* lds, int gw, int NGW, int tid, int lane) {
    const int j2 = L >> 1;
    const bf16_t* P = (const bf16_t*)(a->ws + WS_P);
    bf16_t* QN = (bf16_t*)(a->ws + WS_U); bf16_t* KN = QN + (size_t)MT * 512; bf16_t* V = (bf16_t*)(a->ws + WS_V);
    float* Gb = (float*)(a->ws + WS_G); float* Bt = (float*)(a->ws + WS_BT);
    const float* cw = a->in[I_EVQKVCONV] + (size_t)j2 * 4 * 1536;
    LAS float* cwl = (LAS float*)lds;
    for (int i = tid; i < 4 * 1536 / 4; i += 512) *(LAS f32x4*)(cwl + 4 * i) = *(const f32x4*)(cw + 4 * i);
    __syncthreads();
    float alog = 0.f, dtb = 0.f;
    if (lane < 8) { alog = -expf(a->in[I_EVALOG][j2 * 8 + lane]); dtb = a->in[I_EVDTB][j2 * 8 + lane]; }
    for (int blk = gw; blk < MT / 17; blk += NGW) {
        const int r0 = 17 * blk;
        u32x4 R[20][3]; unsigned ab[17];
#define GP_LOAD(k_) do { const int row_ = r0 - 2 + (k_); const bool ok_ = row_ >= 0 && row_ < MT; \
        _Pragma("unroll") for (int p = 0; p < 3; ++p) R[k_][p] = ok_ ? *(const u32x4*)(P + (size_t)row_ * EVNP + p * 512 + 8 * lane) : (u32x4){0u, 0u, 0u, 0u}; } while (0)
#pragma unroll
        for (int k = 0; k < 6; ++k) GP_LOAD(k);
#pragma unroll
        for (int i = 0; i < 17; ++i) ab[i] = lane < 16 ? (unsigned)P[(size_t)(r0 + i) * EVNP + 2048 + lane] : 0u;
#pragma unroll
        for (int i = 0; i < 17; ++i) {
            if (i + 6 < 20) GP_LOAD(i + 6);
            const int row = r0 + i;
            const bool isctx = row >= ML; const int t = isctx ? ((row - ML) & (CTXL - 1)) : (row & (SEQ - 1)); const int len = isctx ? CTXL : SEQ;
            float val[3][8];
#pragma unroll
            for (int p = 0; p < 3; ++p) {
                float acc[8];
#pragma unroll
                for (int e = 0; e < 8; ++e) acc[e] = 0.f;
#pragma unroll
                for (int j = 0; j < 4; ++j) { const int tt = t + j - 2;
                    if (tt >= 0 && tt < len) { float x[8]; unpack8(R[i + j][p], x);
                        const f32x4 w0 = *(const LAS f32x4*)(cwl + j * 1536 + p * 512 + 8 * lane), w1 = *(const LAS f32x4*)(cwl + j * 1536 + p * 512 + 8 * lane + 4);
#pragma unroll
                        for (int e = 0; e < 8; ++e) acc[e] += (e < 4 ? w0[e & 3] : w1[e & 3]) * x[e]; } }
#pragma unroll
                for (int e = 0; e < 8; ++e) val[p][e] = fsilu(acc[e]);
            }
            float sq = 0.f, sk = 0.f;
#pragma unroll
            for (int e = 0; e < 8; ++e) { sq += val[0][e] * val[0][e]; sk += val[1][e] * val[1][e]; }
            sq = rowsum16(sq); sk = rowsum16(sk);
            const float rq = (1.0f / sqrtf(sq + EPS)) * 0.08838834764831845f, rk = 1.0f / sqrtf(sk + EPS);
#pragma unroll
            for (int e = 0; e < 8; ++e) { val[0][e] *= rq; val[1][e] *= rk; }
            *(u32x4*)(QN + (size_t)row * 512 + 8 * lane) = pack8(val[0]);
            *(u32x4*)(KN + (size_t)row * 512 + 8 * lane) = pack8(val[1]);
            *(u32x4*)(V + (size_t)row * 512 + 8 * lane) = pack8(val[2]);
            if (lane < 8) Gb[(size_t)row * 8 + lane] = alog * softplusf_(bf2f(ab[i]) + dtb);
            else if (lane < 16) Bt[(size_t)row * 8 + lane - 8] = sigmoidf_(bf2f(ab[i]));
        }
#undef GP_LOAD
    }
    __syncthreads();
}

constexpr int LR_XIN = 0, LR_XC = 17152, LR_XCB = LR_XC + 16384, LR_AU = LR_XCB + 9216, LR_WT = LR_AU + 65536, LR_END = LR_WT + 36864;
static_assert(LR_END <= LDS_BYTES, "lru lds");
template <int PASS>
__device__ __forceinline__ void lru_units(KA a, int L, LAS unsigned char* lds, int bid, int G, int tid) {
    const int j2 = L >> 1;
    const bf16_t* P = (const bf16_t*)(a->ws + WS_P); bf16_t* U = (bf16_t*)(a->ws + WS_U);
    float* TOTA = (float*)(a->ws + WS_TOTA); float* TOTH = (float*)(a->ws + WS_TOTH); const float* CARRY = (const float*)(a->ws + WS_CARRY);
    const float* cw = a->in[I_LRUCW] + (size_t)j2 * 4 * 512; const float* cb = a->in[I_LRUCB] + (size_t)j2 * 512;
    const float* gw_ = a->in[I_LRUGW] + (size_t)j2 * 2 * 2 * 8 * 64 * 64; const float* gb_ = a->in[I_LRUGB] + (size_t)j2 * 2 * 2 * 512; const float* lam_ = a->in[I_LRULAM] + (size_t)j2 * 2 * 512;
    LAS float* xin = (LAS float*)(lds + LR_XIN);
    LAS float* xc = (LAS float*)(lds + LR_XC);
    LAS bf16_t* xcb = (LAS bf16_t*)(lds + LR_XCB);
    LAS float* au = (LAS float*)(lds + LR_AU);
    LAS bf16_t* wt = (LAS bf16_t*)(lds + LR_WT);
    LAS float* sg = (LAS float*)(lds + LR_XIN);
    const int lane = tid & 63, w = tid >> 6, mt = w & 3, nh = w >> 2, fr = lane & 15, fq = lane >> 4;
    int cur_nblk = -1;
    const int cc = tid & 63;
    float cbv = 0.f, cwv[4] = {0.f, 0.f, 0.f, 0.f};
    float gbr[2][2], gbi[2][2], gsp[2][2];
#pragma unroll
    for (int q = 0; q < 2; ++q)
#pragma unroll
        for (int r = 0; r < 2; ++r) { gbr[q][r] = 0.f; gbi[q][r] = 0.f; gsp[q][r] = 0.f; }
    const int rrA = tid >> 3, c8 = (tid & 7) * 8, rrB = 64 + (tid >> 3);
    u32x4 xa = {0u, 0u, 0u, 0u}, xb = {0u, 0u, 0u, 0u}, gt4 = {0u, 0u, 0u, 0u};
#define LR_FETCH(XA, XB, GT, u_) do { const int nb_ = (u_) & 7, cs_ = (u_) >> 3, b_ = cs_ / 68, sl_ = cs_ % 68; const bool ic_ = sl_ < 4; const int t0_ = ic_ ? sl_ * 64 : (sl_ - 4) * 64; \
        const int len_ = ic_ ? CTXL : SEQ; const int rb_ = ic_ ? ML + b_ * CTXL : b_ * SEQ; const int ta_ = t0_ + rrA - 2, tb_ = t0_ + rrB - 2; \
        XA = (u32x4){0u, 0u, 0u, 0u}; XB = (u32x4){0u, 0u, 0u, 0u}; \
        if (ta_ >= 0 && ta_ < len_) XA = *(const u32x4*)(P + (size_t)(rb_ + ta_) * EVNP + 2064 + nb_ * 64 + c8); \
        if (tid < 24 && tb_ < len_) XB = *(const u32x4*)(P + (size_t)(rb_ + tb_) * EVNP + 2064 + nb_ * 64 + c8); \
        if (PASS == 2) GT = *(const u32x4*)(P + (size_t)(rb_ + t0_ + rrA) * EVNP + 2576 + nb_ * 64 + c8); } while (0)
    if (bid < NB * 68 * 8) LR_FETCH(xa, xb, gt4, bid);
    for (int u = bid; u < NB * 68 * 8; u += G) {
        const int nblk = u & 7, cs = u >> 3, b = cs / 68, slot = cs % 68; const bool isctx = slot < 4; const int t0 = isctx ? slot * 64 : (slot - 4) * 64;
        const int rowbase = isctx ? ML + b * CTXL : b * SEQ;
        u32x4 nxa, nxb, ngt = {0u, 0u, 0u, 0u};
        { const int un = u + G < NB * 68 * 8 ? u + G : u; LR_FETCH(nxa, nxb, ngt, un); }
        if (nblk != cur_nblk) {
            for (int i0 = tid; i0 < 4 * 4096; i0 += 512 * 8) { float wv[8];
#pragma unroll
                for (int k = 0; k < 8; ++k) { const int i = i0 + 512 * k; wv[k] = gw_[((size_t)((i >> 12) * 8 + nblk)) * 4096 + (i & 4095)]; }
#pragma unroll
                for (int k = 0; k < 8; ++k) { const int i = i0 + 512 * k; const int dg = i >> 12, c = (i >> 6) & 63, d = i & 63; wt[(dg * 64 + d) * 72 + c] = (bf16_t)f2bf(wv[k]); } }
            cbv = cb[nblk * 64 + cc];
#pragma unroll
            for (int dir = 0; dir < 2; ++dir)
#pragma unroll
                for (int nt = 0; nt < 2; ++nt) { const int ch = nblk * 64 + 32 * nh + 16 * nt + fr;
                    gbr[dir][nt] = gb_[(dir * 2 + 0) * 512 + ch]; gbi[dir][nt] = gb_[(dir * 2 + 1) * 512 + ch]; gsp[dir][nt] = softplusf_(-lam_[dir * 512 + ch]); }
#pragma unroll
            for (int j = 0; j < 4; ++j) cwv[j] = cw[j * 512 + nblk * 64 + cc];
            cur_nblk = nblk;
        }
        { float f[8]; unpack8(xa, f); *(LAS f32x4*)(xin + rrA * 64 + c8) = (f32x4){f[0], f[1], f[2], f[3]}; *(LAS f32x4*)(xin + rrA * 64 + c8 + 4) = (f32x4){f[4], f[5], f[6], f[7]};
          if (tid < 24) { unpack8(xb, f); *(LAS f32x4*)(xin + rrB * 64 + c8) = (f32x4){f[0], f[1], f[2], f[3]}; *(LAS f32x4*)(xin + rrB * 64 + c8 + 4) = (f32x4){f[4], f[5], f[6], f[7]}; } }
        __syncthreads();
#pragma unroll
        for (int k = 0; k < 8; ++k) { const int t = (tid >> 6) + 8 * k;
            float v = cbv;
#pragma unroll
            for (int j = 0; j < 4; ++j) v += cwv[j] * xin[(t + j) * 64 + cc];
            xc[t * 64 + cc] = v; xcb[t * 72 + cc] = (bf16_t)f2bf(v); }
        __syncthreads();
        {
            f32x4 acc[4][2];
#pragma unroll
            for (int dg = 0; dg < 4; ++dg)
#pragma unroll
                for (int nt = 0; nt < 2; ++nt) acc[dg][nt] = (f32x4){0.f, 0.f, 0.f, 0.f};
            bf16x8 af[2];
#pragma unroll
            for (int ks = 0; ks < 2; ++ks) af[ks] = *(const LAS bf16x8*)(xcb + (16 * mt + fr) * 72 + 32 * ks + 8 * fq);
#pragma unroll
            for (int dg = 0; dg < 4; ++dg)
#pragma unroll
                for (int nt = 0; nt < 2; ++nt)
#pragma unroll
                    for (int ks = 0; ks < 2; ++ks) { const bf16x8 bfm = *(const LAS bf16x8*)(wt + (dg * 64 + 32 * nh + 16 * nt + fr) * 72 + 32 * ks + 8 * fq);
                        acc[dg][nt] = __builtin_amdgcn_mfma_f32_16x16x32_bf16(af[ks], bfm, acc[dg][nt], 0, 0, 0); }
#pragma unroll
            for (int dir = 0; dir < 2; ++dir)
#pragma unroll
                for (int nt = 0; nt < 2; ++nt) { const int d = 32 * nh + 16 * nt + fr, ch = nblk * 64 + d;
                    const float br = gbr[dir][nt], bi = gbi[dir][nt], sp = gsp[dir][nt];
#pragma unroll
                    for (int r = 0; r < 4; ++r) { const int t = 16 * mt + 4 * fq + r;
                        const float rr = fsigmoid(acc[dir * 2 + 0][nt][r] + br), ii = fsigmoid(acc[dir * 2 + 1][nt][r] + bi);
                        const float la = -8.0f * 1.4426950408889634f * rr * sp; const float av = __builtin_amdgcn_exp2f(la);
                        const float uv = __builtin_amdgcn_sqrtf(fmaxf(1.0f - av * av, 0.f)) * (ii * xc[t * 64 + d]);
                        au[((dir * 2 + 0) * 64 + t) * 64 + d] = av; au[((dir * 2 + 1) * 64 + t) * 64 + d] = uv; } }
        }
        __syncthreads();
        {
            const int seg = tid >> 7, dir = (tid >> 6) & 1, c = tid & 63, ch = nblk * 64 + c;
            const LAS float* ap = au + ((dir * 2 + 0) * 64) * 64 + c; LAS float* up = au + ((dir * 2 + 1) * 64) * 64 + c;
            float A = 1.f, H = 0.f;
#pragma unroll 4
            for (int s = seg * 16; s < seg * 16 + 16; ++s) { const int t = dir ? 63 - s : s; const float av = ap[t * 64], uv = up[t * 64]; H = av * H + uv; A *= av; }
            sg[((0 * 4 + seg) * 2 + dir) * 64 + c] = A; sg[((1 * 4 + seg) * 2 + dir) * 64 + c] = H;
            __syncthreads();
            const size_t idx = ((size_t)((b * 2 + dir) * 68 + slot)) * 512 + ch;
            if (PASS == 1) {
                if (seg == 0) { float At = 1.f, Ht = 0.f;
#pragma unroll
                    for (int q = 0; q < 4; ++q) { const float Aq = sg[((0 * 4 + q) * 2 + dir) * 64 + c], Hq = sg[((1 * 4 + q) * 2 + dir) * 64 + c]; Ht = Aq * Ht + Hq; At *= Aq; }
                    TOTA[idx] = At; TOTH[idx] = Ht; }
            } else {
                float Hin = CARRY[idx];
                for (int q = 0; q < seg; ++q) { const float Aq = sg[((0 * 4 + q) * 2 + dir) * 64 + c], Hq = sg[((1 * 4 + q) * 2 + dir) * 64 + c]; Hin = Aq * Hin + Hq; }
#pragma unroll 4
                for (int s = seg * 16; s < seg * 16 + 16; ++s) { const int t = dir ? 63 - s : s; const float av = ap[t * 64], uv = up[t * 64]; Hin = av * Hin + uv; up[t * 64] = Hin; }
            }
        }
        __syncthreads();
        if (PASS == 2) {
            { const int t = rrA; float gt[8], y[8]; unpack8(gt4, gt);
              const LAS float* hf = au + ((0 * 2 + 1) * 64 + t) * 64 + c8; const LAS float* hb = au + ((1 * 2 + 1) * 64 + t) * 64 + c8;
              const f32x4 f0 = *(const LAS f32x4*)(hf), f1 = *(const LAS f32x4*)(hf + 4), b0 = *(const LAS f32x4*)(hb), b1 = *(const LAS f32x4*)(hb + 4);
#pragma unroll
              for (int e = 0; e < 8; ++e) { const float hs = (e < 4 ? f0[e & 3] + b0[e & 3] : f1[e & 3] + b1[e & 3]); const float g = gt[e];
                  y[e] = hs * g * fsigmoid(1.5957691216057308f * (g + 0.044715f * g * g * g)); }
              *(u32x4*)(U + (size_t)(rowbase + t0 + t) * D + 512 + nblk * 64 + c8) = pack8(y); }
            __syncthreads();
        }
        xa = nxa; xb = nxb; gt4 = ngt;
    }
#undef LR_FETCH
}

constexpr int GS_NS = 32, GS_K = 0, GS_Q = 16384, GS_V = 32768, GS_EG = 36864, GS_BTO = 36992, GS_BUF = 37120;
__device__ __forceinline__ void gdn_scan(KA a, LAS unsigned char* lds, int bid, int G, int tid, int wave, int lane) {
    const bf16_t* QN = (const bf16_t*)(a->ws + WS_U); const bf16_t* KN = QN + (size_t)MT * 512; const bf16_t* V = (const bf16_t*)(a->ws + WS_V);
    const float* Gb = (const float*)(a->ws + WS_G); const float* Bt = (const float*)(a->ws + WS_BT);
    for (int u = bid; u < 256; u += G) {
        const int chain = u >> 2, qd = u & 3, b = chain >> 3, h = (chain >> 1) & 3, dir = chain & 1;
        bf16_t* OD = (bf16_t*)(a->ws + (dir ? WS_OB : WS_OF));
        const int kg = lane & 7, cl = (wave & 3) * 8 + (lane >> 3), col = h * 128 + qd * 32 + cl;
        f32x2 S[8];
#pragma unroll
        for (int i = 0; i < 8; ++i) S[i] = (f32x2){0.f, 0.f};
#define GS_ROW(s) ((s) < CTXL ? (ML + b * CTXL + (dir ? CTXL - 1 - (s) : (s))) : (b * SEQ + (dir ? SEQ - 1 - ((s) - CTXL) : ((s) - CTXL))))
        const int lsl = tid >> 4, lc = tid & 15;
        u32x4 rk, rq, rv; float rg = 0.f;
#define GS_LOAD(blk) do { const int s_ = (blk) * GS_NS + lsl; const size_t row_ = (size_t)GS_ROW(s_); \
        rk = *(const u32x4*)(KN + row_ * 512 + h * 128 + lc * 8); rq = *(const u32x4*)(QN + row_ * 512 + h * 128 + lc * 8); \
        if (tid < 128) { const int s2_ = (blk) * GS_NS + (tid >> 2); const size_t r2_ = (size_t)GS_ROW(s2_); rv = *(const u32x4*)(V + r2_ * 512 + h * 128 + qd * 32 + (tid & 3) * 8); } \
        else if (tid < 160) { const int s2_ = (blk) * GS_NS + (tid - 128); rg = expf(Gb[(size_t)GS_ROW(s2_) * 8 + dir * 4 + h]); } \
        else if (tid < 192) { const int s2_ = (blk) * GS_NS + (tid - 160); rg = Bt[(size_t)GS_ROW(s2_) * 8 + dir * 4 + h]; } } while (0)
#define GS_ST8(dst, r) do { float f_[8]; unpack8(r, f_); *(LAS f32x4*)(dst) = (f32x4){f_[0], f_[1], f_[2], f_[3]}; *(LAS f32x4*)((dst) + 16) = (f32x4){f_[4], f_[5], f_[6], f_[7]}; } while (0)
#define GS_STORE(buf) do { LAS unsigned char* p_ = lds + (buf) * GS_BUF; \
        GS_ST8(p_ + GS_K + lsl * 512 + lc * 32, rk); GS_ST8(p_ + GS_Q + lsl * 512 + lc * 32, rq); \
        if (tid < 128) GS_ST8(p_ + GS_V + (tid >> 2) * 128 + (tid & 3) * 32, rv); \
        else if (tid < 160) *(LAS float*)(p_ + GS_EG + (tid - 128) * 4) = rg; \
        else if (tid < 192) *(LAS float*)(p_ + GS_BTO + (tid - 160) * 4) = rg; } while (0)
        GS_LOAD(0); GS_STORE(0);
        __syncthreads();
        constexpr int NBLK = NKV / GS_NS;
        for (int blk = 0; blk < NBLK; ++blk) {
            const bool more = blk + 1 < NBLK;
            if (more) GS_LOAD(blk + 1);
            const LAS unsigned char* p = lds + (blk & 1) * GS_BUF;
            if (wave < 4) {
              f32x4 k4[4], q4[4]; float vv, eg, bt;
#define GS_FETCH(K4, Q4, VV, EG, BT, sl_) do { _Pragma("unroll") for (int i = 0; i < 4; ++i) { K4[i] = *(const LAS f32x4*)(p + GS_K + (sl_) * 512 + kg * 64 + i * 16); Q4[i] = *(const LAS f32x4*)(p + GS_Q + (sl_) * 512 + kg * 64 + i * 16); } \
                VV = *(const LAS float*)(p + GS_V + (sl_) * 128 + cl * 4); EG = *(const LAS float*)(p + GS_EG + (sl_) * 4); BT = *(const LAS float*)(p + GS_BTO + (sl_) * 4); } while (0)
              GS_FETCH(k4, q4, vv, eg, bt, 0);
              bf16_t* odp = OD + (size_t)GS_ROW(blk * GS_NS) * 512 + col; const int ostep = dir ? -512 : 512;
#pragma unroll 2
              for (int sl = 0; sl < GS_NS; ++sl) {
                f32x4 nk4[4], nq4[4]; float nvv, neg, nbt;
                const int sn = sl + 1 < GS_NS ? sl + 1 : sl;
                GS_FETCH(nk4, nq4, nvv, neg, nbt, sn);
                f32x2 pa = {0.f, 0.f}, pb = {0.f, 0.f};
#pragma unroll
                for (int i = 0; i < 4; ++i) { pa += (f32x2){k4[i][0], k4[i][1]} * S[2 * i]; pb += (f32x2){k4[i][2], k4[i][3]} * S[2 * i + 1]; }
                const f32x2 pab = pa + pb; float pp = pab[0] + pab[1];
                pp += dppf(pp, 0); pp += dppf(pp, 1); pp += dppf(pp, 2);
                const float dl = bt * (vv - eg * pp);
                f32x2 oa = {0.f, 0.f}, ob = {0.f, 0.f};
#pragma unroll
                for (int i = 0; i < 4; ++i) {
                    S[2 * i] = S[2 * i] * eg + (f32x2){k4[i][0], k4[i][1]} * dl; S[2 * i + 1] = S[2 * i + 1] * eg + (f32x2){k4[i][2], k4[i][3]} * dl;
                    oa += (f32x2){q4[i][0], q4[i][1]} * S[2 * i]; ob += (f32x2){q4[i][2], q4[i][3]} * S[2 * i + 1]; }
                const f32x2 oab = oa + ob; float oo = oab[0] + oab[1];
                oo += dppf(oo, 0); oo += dppf(oo, 1); oo += dppf(oo, 2);
                if (kg == 0) odp[(ptrdiff_t)sl * ostep] = (bf16_t)f2bf(oo);
#pragma unroll
                for (int i = 0; i < 4; ++i) { k4[i] = nk4[i]; q4[i] = nq4[i]; }
                vv = nvv; eg = neg; bt = nbt;
              }
#undef GS_FETCH
            }
            if (more) GS_STORE((blk + 1) & 1);
            __syncthreads();
        }
#undef GS_ROW
#undef GS_LOAD
#undef GS_STORE
#undef GS_ST8
    }
    { const int gid = bid * 512 + tid;
      if (gid < NB * 2 * 512) { const int ch = gid & 511, dir = (gid >> 9) & 1, b = gid >> 10;
        const float* TOTA = (const float*)(a->ws + WS_TOTA); const float* TOTH = (const float*)(a->ws + WS_TOTH); float* CARRY = (float*)(a->ws + WS_CARRY);
        float carry = 0.f;
        for (int s = 0; s < 68; ++s) { const int slot = dir ? (s < 4 ? 3 - s : 67 - (s - 4)) : s; const size_t idx = ((size_t)((b * 2 + dir) * 68 + slot)) * 512 + ch;
            CARRY[idx] = carry; carry = TOTA[idx] * carry + TOTH[idx]; } } }
}


__device__ __forceinline__ int gs_row(int b, int dir, int s) { return s < CTXL ? (ML + b * CTXL + (dir ? CTXL - 1 - s : s)) : (b * SEQ + (dir ? SEQ - 1 - (s - CTXL) : (s - CTXL))); }
__device__ __forceinline__ float fexp(float x) { return __builtin_amdgcn_exp2f(1.4426950408889634f * x); }
constexpr int CP_WAVE = 64 * 68 * 4 + 512;
__device__ __forceinline__ void gdn_chunk_prep(KA a, LAS unsigned char* lds, int gw, int NGW, int wave, int lane) {
    const bf16_t* QN = (const bf16_t*)(a->ws + WS_U); const bf16_t* KN = QN + (size_t)MT * 512;
    const float* Gb = (const float*)(a->ws + WS_G); const float* Bt = (const float*)(a->ws + WS_BT);
    bf16_t* Tb = (bf16_t*)(a->ws + WS_TB); bf16_t* QKb = (bf16_t*)(a->ws + WS_QKB); float* GAM = (float*)(a->ws + WS_GAM);
    LAS float* Am = (LAS float*)(lds + wave * CP_WAVE); LAS float* gl = Am + 64 * 68; LAS float* bl = gl + 64;
    const int r32 = lane & 31, hi = lane >> 5;
    bf16x8 kf[2][8]; float gi_raw = 0.f, bt_raw = 0.f;
#define CP_FETCH(cu_) do { const int ch_ = (cu_) / 68, n_ = (cu_) % 68, b_ = ch_ >> 3, h_ = (ch_ >> 1) & 3, d_ = ch_ & 1; const int r0_ = gs_row(b_, d_, 64 * n_), rs_ = d_ ? -1 : 1; \
        _Pragma("unroll") for (int blk = 0; blk < 2; ++blk) _Pragma("unroll") for (int ks = 0; ks < 8; ++ks) \
            kf[blk][ks] = *(const bf16x8*)(KN + (size_t)(r0_ + rs_ * (32 * blk + r32)) * 512 + h_ * 128 + 16 * ks + 8 * hi); \
        const size_t rl_ = (size_t)(r0_ + rs_ * lane); gi_raw = Gb[rl_ * 8 + d_ * 4 + h_]; bt_raw = Bt[rl_ * 8 + d_ * 4 + h_]; } while (0)
    if (gw < 64 * 68) CP_FETCH(gw);
    for (int cu = gw; cu < 64 * 68; cu += NGW) {
        const int chain = cu / 68, n = cu % 68, b = chain >> 3, h = (chain >> 1) & 3, dir = chain & 1;
        const int row0 = gs_row(b, dir, 64 * n), rs = dir ? -1 : 1;
        { float gi = gi_raw;
#pragma unroll
          for (int o = 1; o < 64; o <<= 1) { const float t = __shfl_up(gi, o); if (lane >= o) gi += t; }
          gl[lane] = gi; bl[lane] = bt_raw; GAM[(size_t)cu * 64 + lane] = gi; }
        LDS_WAIT();
        const float gj0 = gl[r32], gj1 = gl[32 + r32];
#pragma unroll
        for (int tl = 0; tl < 3; ++tl) { const int mb = tl == 0 ? 0 : 1, nb = tl == 2 ? 1 : 0;
            f32x16 acc;
#pragma unroll
            for (int r = 0; r < 16; ++r) acc[r] = 0.f;
#pragma unroll
            for (int ks = 0; ks < 8; ++ks) acc = __builtin_amdgcn_mfma_f32_32x32x16_bf16(kf[mb][ks], kf[nb][ks], acc, 0, 0, 0);
            const int j = 32 * nb + r32; const float gj = nb ? gj1 : gj0;
#pragma unroll
            for (int q = 0; q < 4; ++q) { const int i0 = 32 * mb + 8 * q + 4 * hi; const f32x4 gmi = *(const LAS f32x4*)(gl + i0), bti = *(const LAS f32x4*)(bl + i0);
#pragma unroll
                for (int e = 0; e < 4; ++e) { const int i = i0 + e; Am[i * 68 + j] = (i > j) ? bti[e] * acc[4 * q + e] * fexp(gmi[e] - gj) : 0.f; } }
        }
        asm volatile("" ::: "memory");
        {
            bf16_t* qko = QKb + (size_t)cu * 4096;
#pragma unroll
            for (int mb = 0; mb < 2; ++mb) {
                bf16x8 qf[8];
#pragma unroll
                for (int ks = 0; ks < 8; ++ks) qf[ks] = *(const bf16x8*)(QN + (size_t)(row0 + rs * (32 * mb + r32)) * 512 + h * 128 + 16 * ks + 8 * hi);
#pragma unroll
                for (int nb = 0; nb <= mb; ++nb) {
                    f32x16 acc;
#pragma unroll
                    for (int r = 0; r < 16; ++r) acc[r] = 0.f;
#pragma unroll
                    for (int ks = 0; ks < 8; ++ks) acc = __builtin_amdgcn_mfma_f32_32x32x16_bf16(qf[ks], kf[nb][ks], acc, 0, 0, 0);
                    const int j = 32 * nb + r32; const float gj = nb ? gj1 : gj0;
#pragma unroll
                    for (int q = 0; q < 4; ++q) { const int i0 = 32 * mb + 8 * q + 4 * hi; const f32x4 gmi = *(const LAS f32x4*)(gl + i0);
#pragma unroll
                        for (int e = 0; e < 4; ++e) { const int i = i0 + e; qko[i * 64 + j] = (bf16_t)f2bf((i >= j) ? acc[4 * q + e] * fexp(gmi[e] - gj) : 0.f); } }
                }
                asm volatile("" ::: "memory");
            }
#pragma unroll
            for (int q = 0; q < 4; ++q)
#pragma unroll
                for (int e = 0; e < 4; ++e) qko[(8 * q + 4 * hi + e) * 64 + 32 + r32] = (bf16_t)0;
        }
        asm volatile("" ::: "memory");
        LDS_WAIT();
        { const int cn = cu + NGW < 64 * 68 ? cu + NGW : cu; CP_FETCH(cn); }
        {
            float Tc[64]; int ln = lane;
#pragma unroll
            for (int i = 0; i < 64; ++i) {
                if ((i & 3) == 0) asm volatile("" : "+v"(ln));
                float acc = (i == ln) ? 1.f : 0.f, acc1 = 0.f;
#pragma unroll
                for (int jj = 0; jj < (i + 3) / 4; ++jj) { const f32x4 a4 = *(const LAS f32x4*)(Am + i * 68 + 4 * jj);
#pragma unroll
                    for (int e = 0; e < 4; ++e) if (4 * jj + e < i) { if (e & 1) acc1 -= a4[e] * Tc[4 * jj + e]; else acc -= a4[e] * Tc[4 * jj + e]; } }
                Tc[i] = acc + acc1;
                if ((i & 1) == 1) asm volatile("" ::: "memory");
            }
            bf16_t* to = Tb + (size_t)cu * 4096 + lane;
#pragma unroll
            for (int i = 0; i < 64; ++i) to[i * 64] = (bf16_t)f2bf(Tc[i]);
        }
        LDS_WAIT();
    }
#undef CP_FETCH
}

constexpr int CS_KN = 0, CS_QN = 17408, CS_KT = 34816, CS_T = 53248, CS_QK = 62464, CS_VT = 71680, CS_GB = 76288, CS_ST = 77312, CS_RT = 86016, CS_VNT = 90624, CS_VDT = 95232, CS_END = 99840;
__device__ __forceinline__ void cs_compute(LAS unsigned char* lds, int wave, int r32, int hi, f32x16& acc, f32x16& Sreg, bf16_t* op, int row0, int rs) {
    const LAS float* gamL = (const LAS float*)(lds + CS_GB); const LAS float* betL = gamL + 64;
    const int mb = wave & 1;
    if (wave < 4) {
        const LAS unsigned char* X = lds + ((wave >> 1) ? CS_QN : CS_KN) + (32 * mb + r32) * 272 + 16 * hi; const LAS unsigned char* Sb = lds + CS_ST + r32 * 272 + 16 * hi;
#pragma unroll
        for (int r = 0; r < 16; ++r) acc[r] = 0.f;
#pragma unroll
        for (int ks = 0; ks < 8; ++ks) acc = __builtin_amdgcn_mfma_f32_32x32x16_bf16(*(const LAS bf16x8*)(X + 32 * ks), *(const LAS bf16x8*)(Sb + 32 * ks), acc, 0, 0, 0);
    }
    if (wave < 2) {
#pragma unroll
        for (int q = 0; q < 4; ++q) { const int t0 = 32 * mb + 8 * q + 4 * hi; const f32x4 gm = *(const LAS f32x4*)(gamL + t0), bt = *(const LAS f32x4*)(betL + t0);
            const u32x2 vv = *(const LAS u32x2*)(lds + CS_VT + r32 * 144 + t0 * 2);
            const float v0 = __uint_as_float(vv.x << 16), v1 = __uint_as_float(vv.x & 0xffff0000u), v2 = __uint_as_float(vv.y << 16), v3 = __uint_as_float(vv.y & 0xffff0000u);
            u32x2 w; w.x = pk2(bt[0] * (v0 - fexp(gm[0]) * acc[4 * q]), bt[1] * (v1 - fexp(gm[1]) * acc[4 * q + 1]));
            w.y = pk2(bt[2] * (v2 - fexp(gm[2]) * acc[4 * q + 2]), bt[3] * (v3 - fexp(gm[3]) * acc[4 * q + 3]));
            *(LAS u32x2*)(lds + CS_RT + r32 * 144 + t0 * 2) = w; }
    }
    __syncthreads();
    if (wave < 2) {
        f32x16 vn;
#pragma unroll
        for (int r = 0; r < 16; ++r) vn[r] = 0.f;
        const LAS unsigned char* Ta = lds + CS_T + (32 * mb + r32) * 144 + 16 * hi; const LAS unsigned char* Rb = lds + CS_RT + r32 * 144 + 16 * hi;
#pragma unroll
        for (int ks = 0; ks < 4; ++ks) vn = __builtin_amdgcn_mfma_f32_32x32x16_bf16(*(const LAS bf16x8*)(Ta + 32 * ks), *(const LAS bf16x8*)(Rb + 32 * ks), vn, 0, 0, 0);
        const float glast = gamL[63];
#pragma unroll
        for (int q = 0; q < 4; ++q) { const int t0 = 32 * mb + 8 * q + 4 * hi; const f32x4 gm = *(const LAS f32x4*)(gamL + t0);
            u32x2 w; w.x = pk2(vn[4 * q], vn[4 * q + 1]); w.y = pk2(vn[4 * q + 2], vn[4 * q + 3]);
            *(LAS u32x2*)(lds + CS_VNT + r32 * 144 + t0 * 2) = w;
            w.x = pk2(vn[4 * q] * fexp(glast - gm[0]), vn[4 * q + 1] * fexp(glast - gm[1])); w.y = pk2(vn[4 * q + 2] * fexp(glast - gm[2]), vn[4 * q + 3] * fexp(glast - gm[3]));
            *(LAS u32x2*)(lds + CS_VDT + r32 * 144 + t0 * 2) = w; }
    }
    __syncthreads();
    if (wave == 2 || wave == 3) {
#pragma unroll
        for (int q = 0; q < 4; ++q) { const int t0 = 32 * mb + 8 * q + 4 * hi; const f32x4 gm = *(const LAS f32x4*)(gamL + t0);
#pragma unroll
            for (int e = 0; e < 4; ++e) acc[4 * q + e] *= fexp(gm[e]); }
        const LAS unsigned char* Qa = lds + CS_QK + (32 * mb + r32) * 144 + 16 * hi; const LAS unsigned char* Vb = lds + CS_VNT + r32 * 144 + 16 * hi;
#pragma unroll
        for (int ks = 0; ks < 4; ++ks) acc = __builtin_amdgcn_mfma_f32_32x32x16_bf16(*(const LAS bf16x8*)(Qa + 32 * ks), *(const LAS bf16x8*)(Vb + 32 * ks), acc, 0, 0, 0);
#pragma unroll
        for (int r = 0; r < 16; ++r) { const int tok = 32 * mb + (r & 3) + 8 * (r >> 2) + 4 * hi; op[(ptrdiff_t)(row0 + rs * tok) * 512] = (bf16_t)f2bf(acc[r]); }
    } else if (wave >= 4) {
        const int mk = wave - 4; const float cd = fexp(gamL[63]);
#pragma unroll
        for (int r = 0; r < 16; ++r) Sreg[r] *= cd;
        const LAS unsigned char* Ka = lds + CS_KT + (32 * mk + r32) * 144 + 16 * hi; const LAS unsigned char* Db = lds + CS_VDT + r32 * 144 + 16 * hi;
#pragma unroll
        for (int ks = 0; ks < 4; ++ks) Sreg = __builtin_amdgcn_mfma_f32_32x32x16_bf16(*(const LAS bf16x8*)(Ka + 32 * ks), *(const LAS bf16x8*)(Db + 32 * ks), Sreg, 0, 0, 0);
#pragma unroll
        for (int q = 0; q < 4; ++q) { u32x2 w; w.x = pk2(Sreg[4 * q], Sreg[4 * q + 1]); w.y = pk2(Sreg[4 * q + 2], Sreg[4 * q + 3]);
            *(LAS u32x2*)(lds + CS_ST + r32 * 272 + (32 * mk + 8 * q + 4 * hi) * 2) = w; }
    }
    __syncthreads();
}
__device__ __forceinline__ void gdn_chunk_scan(KA a, LAS unsigned char* lds, int bid, int G, int tid, int wave, int lane) {
    const bf16_t* QN = (const bf16_t*)(a->ws + WS_U); const bf16_t* KN = QN + (size_t)MT * 512; const bf16_t* V = (const bf16_t*)(a->ws + WS_V);
    const float* Bt = (const float*)(a->ws + WS_BT);
    const bf16_t* Tb = (const bf16_t*)(a->ws + WS_TB); const bf16_t* QKb = (const bf16_t*)(a->ws + WS_QKB); const float* GAM = (const float*)(a->ws + WS_GAM);
    const int r32 = lane & 31, hi = lane >> 5;
    for (int u = bid; u < 256; u += G) {
        const int chain = (u & 7) * 8 + (u >> 5), qd = (u >> 3) & 3;
        const int b = chain >> 3, h = (chain >> 1) & 3, dir = chain & 1, rs = dir ? -1 : 1;
        bf16_t* op = (bf16_t*)(a->ws + (dir ? WS_OB : WS_OF)) + h * 128 + qd * 32 + r32;
        u32x4 rkA[2], rqA[2], rTA, rQKA, rVA; float rgbA = 0.f;
        u32x4 rkB[2], rqB[2], rTB, rQKB, rVB; float rgbB = 0.f;
#define CS_LOAD(S_, n_) do { const int row0_ = gs_row(b, dir, 64 * (n_)); const size_t cu_ = (size_t)(chain * 68 + (n_)); const size_t rowl_ = (size_t)(row0_ + rs * lane); \
        _Pragma("unroll") for (int i_ = 0; i_ < 2; ++i_) { const int c16_ = wave + 8 * i_; \
            rk##S_[i_] = *(const u32x4*)(KN + rowl_ * 512 + h * 128 + c16_ * 8); rq##S_[i_] = *(const u32x4*)(QN + rowl_ * 512 + h * 128 + c16_ * 8); } \
        rT##S_ = *(const u32x4*)(Tb + cu_ * 4096 + tid * 8); rQK##S_ = *(const u32x4*)(QKb + cu_ * 4096 + tid * 8); \
        if (wave < 4) rV##S_ = *(const u32x4*)(V + rowl_ * 512 + h * 128 + qd * 32 + wave * 8); \
        if (tid < 64) rgb##S_ = GAM[cu_ * 64 + tid]; else if (tid < 128) rgb##S_ = Bt[(size_t)(row0_ + rs * (tid - 64)) * 8 + dir * 4 + h]; } while (0)
#define CS_T16(base, v, col0, tok) do { const unsigned w_[4] = {(v).x, (v).y, (v).z, (v).w}; _Pragma("unroll") for (int e_ = 0; e_ < 8; ++e_) \
        *(LAS bf16_t*)(lds + (base) + ((col0) + e_) * 144 + (tok) * 2) = (bf16_t)((e_ & 1) ? (w_[e_ >> 1] >> 16) : (w_[e_ >> 1] & 0xffffu)); } while (0)
#define CS_STORE(S_) do { \
        _Pragma("unroll") for (int i_ = 0; i_ < 2; ++i_) { const int c16_ = wave + 8 * i_; \
            *(LAS u32x4*)(lds + CS_KN + lane * 272 + c16_ * 16) = rk##S_[i_]; *(LAS u32x4*)(lds + CS_QN + lane * 272 + c16_ * 16) = rq##S_[i_]; CS_T16(CS_KT, rk##S_[i_], c16_ * 8, lane); } \
        *(LAS u32x4*)(lds + CS_T + (tid >> 3) * 144 + (tid & 7) * 16) = rT##S_; *(LAS u32x4*)(lds + CS_QK + (tid >> 3) * 144 + (tid & 7) * 16) = rQK##S_; \
        if (wave < 4) CS_T16(CS_VT, rV##S_, wave * 8, lane); \
        if (tid < 128) *(LAS float*)(lds + CS_GB + tid * 4) = rgb##S_; } while (0)
        CS_LOAD(A, 0);
        for (int i = tid; i < 32 * 272 / 4; i += 512) *(LAS unsigned*)(lds + CS_ST + i * 4) = 0u;
        CS_STORE(A);
        __syncthreads();
        CS_LOAD(A, 1);
        f32x16 Sreg, acc;
#pragma unroll
        for (int r = 0; r < 16; ++r) { Sreg[r] = 0.f; acc[r] = 0.f; }
        for (int n = 0; n < 68; n += 2) {
            if (n + 2 < 68) CS_LOAD(B, n + 2);
            cs_compute(lds, wave, r32, hi, acc, Sreg, op, gs_row(b, dir, 64 * n), rs);
            CS_STORE(A);
            __syncthreads();
            if (n + 3 < 68) CS_LOAD(A, n + 3);
            cs_compute(lds, wave, r32, hi, acc, Sreg, op, gs_row(b, dir, 64 * (n + 1)), rs);
            if (n + 2 < 68) CS_STORE(B);
            __syncthreads();
        }
#undef CS_LOAD
#undef CS_T16
#undef CS_STORE
    }
    if (wave == 0 && lane < 32) {
      const float* TOTA = (const float*)(a->ws + WS_TOTA); const float* TOTH = (const float*)(a->ws + WS_TOTH); float* CARRY = (float*)(a->ws + WS_CARRY);
      for (int gid = bid * 32 + lane; gid < NB * 2 * 512; gid += G * 32) { const int ch = gid & 511, dir = (gid >> 9) & 1, b = gid >> 10;
        float carry = 0.f;
        for (int s0 = 0; s0 < 68; s0 += 17) {
            float ta[17], th[17];
#pragma unroll
            for (int k = 0; k < 17; ++k) { const int s = s0 + k; const int slot = dir ? (s < 4 ? 3 - s : 67 - (s - 4)) : s; const size_t idx = ((size_t)((b * 2 + dir) * 68 + slot)) * 512 + ch; ta[k] = TOTA[idx]; th[k] = TOTH[idx]; }
#pragma unroll
            for (int k = 0; k < 17; ++k) { const int s = s0 + k; const int slot = dir ? (s < 4 ? 3 - s : 67 - (s - 4)) : s; const size_t idx = ((size_t)((b * 2 + dir) * 68 + slot)) * 512 + ch; CARRY[idx] = carry; carry = ta[k] * carry + th[k]; }
        } } }
}

__device__ __forceinline__ void gdn_merge(KA a, int L, int gw, int NGW, int lane) {
    const int j2 = L >> 1;
    const bf16_t* P = (const bf16_t*)(a->ws + WS_P); bf16_t* U = (bf16_t*)(a->ws + WS_U);
    const bf16_t* OF = (const bf16_t*)(a->ws + WS_OF); const bf16_t* OB = (const bf16_t*)(a->ws + WS_OB);
    const float* gn = a->in[I_EVGDNNORM] + j2 * 128 + ((8 * lane) & 127);
    float g8[8];
#pragma unroll
    for (int e = 0; e < 8; ++e) g8[e] = gn[e];
    for (int row = gw; row < MT; row += NGW) {
        float of[8], ob[8], z[8], y[8];
        unpack8(*(const u32x4*)(OF + (size_t)row * 512 + 8 * lane), of); unpack8(*(const u32x4*)(OB + (size_t)row * 512 + 8 * lane), ob);
        unpack8(*(const u32x4*)(P + (size_t)row * EVNP + 1536 + 8 * lane), z);
        float ssq = 0.f;
#pragma unroll
        for (int e = 0; e < 8; ++e) { of[e] += ob[e]; ssq += of[e] * of[e]; }
        ssq = rowsum16(ssq);
        const float rms = 1.0f / sqrtf(ssq * (1.f / 128.f) + EPS);
#pragma unroll
        for (int e = 0; e < 8; ++e) y[e] = of[e] * rms * g8[e] * fsilu(z[e]);
        *(u32x4*)(U + (size_t)row * D + 8 * lane) = pack8(y);
    }
}


#define XB_TMO      128
#define XB_XCNT(j)  (256  + 64 * (j))
#define XB_XSUB(j)  (1280 + 64 * (j))
#define XB_XGEN(j)  (2304 + 64 * (j))
#define XB_TOP      3328
#define XB_TOPGEN   3392
#define XCD_BAR_WORDS 3456
#define XB_SPIN_CAP (1u << 20)
__device__ __forceinline__ unsigned xb_ld(unsigned* p)              { return __hip_atomic_load(p, __ATOMIC_RELAXED, __HIP_MEMORY_SCOPE_AGENT); }
__device__ __forceinline__ unsigned xb_add(unsigned* p, unsigned v) { return __hip_atomic_fetch_add(p, v, __ATOMIC_RELAXED, __HIP_MEMORY_SCOPE_AGENT); }
__device__ __forceinline__ unsigned xb_xcc_id() { return (unsigned)__builtin_amdgcn_s_getreg((3 << 11) | 20) & 0xFu; }
#define XB_SPIN(cond, bar) do { unsigned _sp = 0; while (cond) { __builtin_amdgcn_s_sleep(1); \
    if ((++_sp & 255u) == 0u) { if (xb_ld(&(bar)[XB_TMO])) break; if (_sp > XB_SPIN_CAP) { atomicAdd(&(bar)[XB_TMO], 1u); break; } } } } while (0)
struct XcdBarrier { unsigned* bar; unsigned x; volatile LAS unsigned* st; };
__device__ __forceinline__ XcdBarrier xcd_barrier_post(unsigned* bar, volatile LAS unsigned* st) {
    XcdBarrier b; b.bar = bar; b.x = xb_xcc_id(); b.st = st;
    if (threadIdx.x == 0) (void)xb_add(&bar[XB_XCNT(b.x)], 1u);
    return b;
}
__device__ __forceinline__ void xcd_barrier_complete(unsigned* bar, unsigned x, unsigned& nloc, unsigned& nx) {
    const unsigned G = gridDim.x * gridDim.y * gridDim.z;
    unsigned sum, cnt, mine, sp = 0u;
    for (;;) {
        sum = 0u; cnt = 0u; mine = 0u;
#pragma unroll
        for (unsigned j = 0; j < 16; ++j) { const unsigned c = xb_ld(&bar[XB_XCNT(j)]); sum += c; cnt += (c > 0u) ? 1u : 0u; mine = (j == x) ? c : mine; }
        if (sum == G) break;
        __builtin_amdgcn_s_sleep(1);
        if ((++sp & 255u) == 0u) { if (xb_ld(&bar[XB_TMO])) break; if (sp > XB_SPIN_CAP) { atomicAdd(&bar[XB_TMO], 1u); break; } }
    }
    nloc = mine > 0u ? mine : 1u; nx = cnt > 0u ? cnt : 1u;
}
__device__ __forceinline__ void xcd_barrier(const XcdBarrier& b) {
    asm volatile("s_waitcnt vmcnt(0)" ::: "memory");
    __syncthreads();
    if (threadIdx.x == 0) {
        unsigned* bar = b.bar;
        __builtin_amdgcn_s_waitcnt(0);
        unsigned nloc = b.st[0], nx = b.st[1];
        if (nloc == 0u) { xcd_barrier_complete(bar, b.x, nloc, nx); b.st[0] = nloc; b.st[1] = nx; }
        const unsigned old = xb_add(&bar[XB_XSUB(b.x)], 1u);
        const unsigned gen = old / nloc;
        if (old + 1u == (gen + 1u) * nloc) {
            __builtin_amdgcn_fence(__ATOMIC_RELEASE, "agent");
            asm volatile("s_waitcnt vmcnt(0)" ::: "memory");
            const unsigned og = xb_add(&bar[XB_TOP], 1u);
            const unsigned tg = og / nx;
            if (og + 1u == (tg + 1u) * nx) xb_add(&bar[XB_TOPGEN], 1u);
            else XB_SPIN(xb_ld(&bar[XB_TOPGEN]) == tg, bar);
            __builtin_amdgcn_fence(__ATOMIC_ACQUIRE, "agent");
            xb_add(&bar[XB_XGEN(b.x)], 1u);
            asm volatile("s_waitcnt vmcnt(0)" ::: "memory");
        } else {
            XB_SPIN(xb_ld(&bar[XB_XGEN(b.x)]) == gen, bar);
            __builtin_amdgcn_fence(__ATOMIC_ACQUIRE, "agent");
            asm volatile("s_waitcnt vmcnt(0)" ::: "memory");
        }
    }
    __syncthreads();
}

__device__ __forceinline__ void decode_phase(int ph, int& L, int& kind) {
    if (ph == 0) { L = 0; kind = K_PROA; return; }
    if (ph == 1) { L = 0; kind = K_PROB; return; }
    int p = ph - 2;
    if (p < 10) { L = 0; } else if (p < 18) { L = 1; p -= 10; } else if (p < 28) { L = 2; p -= 18; } else { L = 3; p -= 28; }
    if ((L & 1) == 0) { kind = p == 0 ? K_PROJ : p == 1 ? K_E2 : p == 2 ? K_E2B : p == 3 ? K_E3 : p == 4 ? K_E4 : p == 5 ? K_WOUT : p == 6 ? K_LN1 : p == 7 ? K_MLP1 : p == 8 ? K_MLP2 : K_LN2; }
    else { kind = p == 0 ? K_PROJ : p == 1 ? K_O2 : p == 2 ? K_O3 : p == 3 ? K_WOUT : p == 4 ? K_LN1 : p == 5 ? K_MLP1 : p == 6 ? K_MLP2 : K_LN2; }
}

#ifndef MK_DUP_GEMM
#define MK_DUP_GEMM 0
#endif
#ifndef MK_DUP_KIND
#define MK_DUP_KIND -1
#endif
#ifndef MK_SKIP1
#define MK_SKIP1 1
#endif
#ifndef MK_K2
#define MK_K2 1024
#endif
#ifndef MK_PHM
#define MK_PHM 0xffffu
#endif
#define EN(k) ((MK_PHM >> (k)) & 1u)
__global__ void __launch_bounds__(512, 2) fwd_kernel(Args args) {
    extern __shared__ __attribute__((aligned(16))) unsigned char lds_raw[];
    LAS unsigned char* lds = (LAS unsigned char*)lds_raw;
    cg::grid_group grid = cg::this_grid();
    const int G = gridDim.x;
    volatile LAS unsigned* bst = (volatile LAS unsigned*)(lds + LDS_BYTES - 16);
    if (threadIdx.x < 2) bst[threadIdx.x] = 0u;
    __syncthreads();
    const XcdBarrier xbar = xcd_barrier_post((unsigned*)(args.ws + WS_BAR), bst);
    const int ph_lo = args.ph_lo, ph_hi = args.ph_hi;
    bool second = false;
    for (int ph = ph_lo; ph < ph_hi; ) {
        KA a = (KA)__builtin_amdgcn_kernarg_segment_ptr(); asm volatile("" : "+s"(a));
        int tid = threadIdx.x; asm volatile("" : "+v"(tid));
        int bid = blockIdx.x; asm volatile("" : "+s"(bid));
        const int lane = tid & 63, wave = __builtin_amdgcn_readfirstlane(tid >> 6), gw = bid * 8 + wave, NGW = G * 8;
        bf16_t* U = (bf16_t*)(a->ws + WS_U); bf16_t* P = (bf16_t*)(a->ws + WS_P); float* HC = (float*)(a->ws + WS_HC);
        const float* MOD = (const float*)(a->ws + WS_MOD);
        int L, kind; decode_phase(ph, L, kind);
        const bool even = (L & 1) == 0; const bool last = L == 3;
        const int Mrows = last ? ML : MT;
        const bool isgemm = kind == K_PROJ || kind == K_MLP1 || kind == K_WOUT || kind == K_MLP2;
        const bool dup = (MK_DUP_GEMM && isgemm) || kind == MK_DUP_KIND;
        if (EN(K_PROA) && kind == K_PROA) prologue_a(a, lds, bid, G, tid, wave, lane);
        else if (EN(K_PROB) && kind == K_PROB) prologue_b(a, gw, NGW, lane);
        else if (EN(K_PROJ) && (kind == K_PROJ || kind == K_MLP1 || kind == K_WOUT || kind == K_MLP2)) {
            const float* modL = MOD + (size_t)L * 9 * 6144;
            const bool split = (kind == K_WOUT || kind == K_MLP2) && !last;
            const int ncall = split ? 2 : 1;
            for (int call = 0; call < ncall; ++call) {
                pg8::Gemm g; pg8::EpiBf16 E;
                if (kind == K_PROJ) { g = pg8::Gemm{U, (const bf16_t*)(a->ws + WS_WA), MT, even ? EVNP : ODN, D, D, D, 1}; E = pg8::EpiBf16{P, even ? EVNP : ODN, 0, nullptr, -1, 0}; }
                else if (kind == K_MLP1) { g = pg8::Gemm{U, (const bf16_t*)(a->ws + WS_W1), Mrows, FF, D, D, D, 1}; E = pg8::EpiBf16{P, FF, 2, nullptr, -1, 0}; }
                else if (kind == K_WOUT) { const bf16_t* A = even ? U : P; const int lda = even ? D : ODN;
                    if (call == 0) { g = pg8::Gemm{A, (const bf16_t*)(a->ws + WS_WO), ML, D, D, lda, D, 1}; E = pg8::EpiBf16{even ? P : U, D, 0, modL + 2 * D, -1, 0}; }
                    else { g = pg8::Gemm{A + (size_t)ML * lda, (const bf16_t*)(a->ws + WS_WO), MC, D, D / 4, lda, D, 4}; E = pg8::EpiBf16{(bf16_t*)(a->ws + WS_PART), D, 0, modL + 2 * D, 8, (size_t)MC * D}; } }
                else { if (call == 0) { g = pg8::Gemm{P, (const bf16_t*)(a->ws + WS_W2), ML, D, FF, FF, FF, 1}; E = pg8::EpiBf16{U, D, 0, modL + 5 * D, -1, 0}; }
                    else { g = pg8::Gemm{P + (size_t)ML * FF, (const bf16_t*)(a->ws + WS_W2), MC, D, FF / 8, FF, FF, 8}; E = pg8::EpiBf16{(bf16_t*)(a->ws + WS_PART), D, 0, modL + 5 * D, 8, (size_t)MC * D}; } }
                pg8::StaticOrder S; S.init(g.M, g.N, G, bid, g.nks);
                pg8::gemm_phase<pg8::EpiBf16>(lds, g, S, E, tid);
            }
        }
        else if (EN(K_LN1) && kind == K_LN1) ln_pass(a, L, 0, Mrows, true, L, 3, even ? P : U, last ? 0 : 4, gw, NGW, lane);
        else if (EN(K_LN2) && kind == K_LN2) {
            ln_pass(a, L, 1, Mrows, !last, L + 1, 0, U, last ? 0 : 8, gw, NGW, lane);
            if (!last) conv_weights(a, L + 1, lds, gw, NGW, wave, lane);
        }
        else if (EN(K_E2) && kind == K_E2) { gdn_prep(a, L, lds, gw, NGW, tid, lane); lru_units<1>(a, L, lds, bid, G, tid); }
        else if (EN(K_E2B) && kind == K_E2B) gdn_chunk_prep(a, lds, gw, NGW, wave, lane);
        else if (EN(K_E3) && kind == K_E3) gdn_chunk_scan(a, lds, bid, G, tid, wave, lane);
        else if (EN(K_E4) && kind == K_E4) { gdn_merge(a, L, gw, NGW, lane); lru_units<2>(a, L, lds, bid, G, tid); }
        else if (EN(K_O2) && kind == K_O2) attn_prep(a, lds, bid, G, tid);
        else if (EN(K_O3) && kind == K_O3) attn_phase(a, L, lds, bid, G, tid, wave, lane, !dup || second);
        if (dup && !second) { second = true; grid.sync(); continue; }
        second = false; ++ph;
        if (ph < ph_hi) { if (ph == ph_lo + 1) grid.sync(); else xcd_barrier(xbar); }
    }
}

#ifndef MK_PH_HI
#define MK_PH_HI N_PHASES
#endif
#ifndef MK_PER_PHASE
#define MK_PER_PHASE 0
#endif
extern "C" void kernel_launch(void* const* d_in, const int* in_sizes, int n_in, void* d_out, int out_size, void* d_ws, size_t ws_size, hipStream_t stream) {
    static int grid = 0;
    if (grid == 0) {
        if (n_in != 24 || ws_size < WS_END) { fprintf(stderr, "kernel_launch: unexpected n_in %d / ws_size %zu\n", n_in, ws_size); grid = -1; return; }
        int dev = 0, cus = 0, per_cu = 0;
        (void)hipGetDevice(&dev); (void)hipDeviceGetAttribute(&cus, hipDeviceAttributeMultiprocessorCount, dev);
        if (hipFuncSetAttribute((const void*)fwd_kernel, hipFuncAttributeMaxDynamicSharedMemorySize, LDS_BYTES) != hipSuccess) { fprintf(stderr, "kernel_launch: hipFuncSetAttribute failed\n"); grid = -1; return; }
        (void)hipOccupancyMaxActiveBlocksPerMultiprocessor(&per_cu, (const void*)fwd_kernel, 512, LDS_BYTES);
        (void)hipGetLastError();
        if (per_cu < 1) per_cu = 1;
        grid = cus;
        fprintf(stderr, "kernel_launch: cus %d per_cu %d grid %d\n", cus, per_cu, grid);
    }
    if (grid < 0) return;
    Args a{};
    for (int i = 0; i < 24; ++i) a.in[i] = (const float*)d_in[i];
    a.out = (float*)d_out; a.ws = (unsigned char*)d_ws;
#if MK_PER_PHASE
    for (int ph = 0; ph < N_PHASES; ++ph) { a.ph_lo = ph; a.ph_hi = ph + 1; hipLaunchKernelGGL(fwd_kernel, dim3(grid), dim3(512), LDS_BYTES, stream, a); }
#else
    a.ph_lo = 0; a.ph_hi = MK_PH_HI;
    (void)hipMemsetAsync((unsigned char*)d_ws + WS_BAR, 0, 16384, stream);
    void* args[] = {&a};
    hipError_t e = hipLaunchCooperativeKernel((const void*)fwd_kernel, dim3(grid), dim3(512), args, LDS_BYTES, stream);
    if (e != hipSuccess) fprintf(stderr, "kernel_launch: cooperative launch failed: %s (grid %d)\n", hipGetErrorString(e), grid);
#endif
}
```

```cpp
#include <hip/hip_runtime.h>
#include <hip/hip_cooperative_groups.h>
#include <cstdio>
#include <cstdint>
namespace cg = cooperative_groups;

#define LAS __attribute__((address_space(3)))
typedef unsigned short bf16_t;
typedef short bf16x8 __attribute__((ext_vector_type(8)));
typedef float f32x4 __attribute__((ext_vector_type(4)));
typedef float f32x2 __attribute__((ext_vector_type(2)));
typedef float f32x16 __attribute__((ext_vector_type(16)));
typedef unsigned u32x4 __attribute__((ext_vector_type(4)));
typedef unsigned u32x2 __attribute__((ext_vector_type(2)));
typedef __bf16 bf16x2_t __attribute__((ext_vector_type(2)));

constexpr int D = 1024, NB = 8, SEQ = 4096, CTXL = 256, FF = 4096;
constexpr int ML = NB * SEQ, MC = NB * CTXL, MT = ML + MC;
constexpr int EVN = 3088, EVNP = 3328, ODN = 3072;
constexpr float ALPHA = 1.6817928305074292f;
constexpr float EPS = 1e-6f;
constexpr int NKV = CTXL + SEQ;
constexpr float QSCALE = 0.125f * 1.4426950408889634f;

constexpr size_t MiB = 1u << 20;
constexpr size_t WS_MISC = 0;
constexpr size_t WS_BAR = 65536;
constexpr size_t WS_MOD = 1 * MiB;
constexpr size_t WS_WA = 2 * MiB;
constexpr size_t WS_WO = 9 * MiB;
constexpr size_t WS_W1 = 11 * MiB;
constexpr size_t WS_W2 = 19 * MiB;
constexpr size_t WS_HC = 27 * MiB;
constexpr size_t WS_U = 35 * MiB;
constexpr size_t WS_P = 103 * MiB;
constexpr size_t WS_X = 324 * MiB;
constexpr size_t WS_V = WS_X;
constexpr size_t WS_OF = WS_X + 34 * MiB;
constexpr size_t WS_OB = WS_X + 68 * MiB;
constexpr size_t WS_G = WS_X + 102 * MiB;
constexpr size_t WS_BT = WS_X + 104 * MiB;
constexpr size_t WS_TOTA = WS_X + 106 * MiB;
constexpr size_t WS_TOTH = WS_X + 109 * MiB;
constexpr size_t WS_CARRY = WS_X + 112 * MiB;
constexpr size_t WS_HLAST = 375 * MiB;
constexpr size_t WS_PART = 376 * MiB;
constexpr size_t WS_TB = WS_X + 116 * MiB;
constexpr size_t WS_QKB = WS_X + 150 * MiB;
constexpr size_t WS_GAM = WS_X + 184 * MiB;
constexpr size_t WS_END = WS_X + 186 * MiB;

constexpr int LDS_BYTES = 147456;

__device__ __forceinline__ float bf2f(unsigned v) { return __uint_as_float(v << 16); }
__device__ __forceinline__ unsigned pk2(float lo, float hi) { f32x2 v = {lo, hi}; bf16x2_t b = __builtin_convertvector(v, bf16x2_t); return __builtin_bit_cast(unsigned, b); }
__device__ __forceinline__ unsigned f2bf(float f) { return pk2(f, 0.f) & 0xffffu; }
__device__ __forceinline__ void unpack8(const u32x4 r, float* o) {
    o[0] = __uint_as_float(r.x << 16); o[1] = __uint_as_float(r.x & 0xffff0000u);
    o[2] = __uint_as_float(r.y << 16); o[3] = __uint_as_float(r.y & 0xffff0000u);
    o[4] = __uint_as_float(r.z << 16); o[5] = __uint_as_float(r.z & 0xffff0000u);
    o[6] = __uint_as_float(r.w << 16); o[7] = __uint_as_float(r.w & 0xffff0000u);
}
__device__ __forceinline__ u32x4 pack8(const float* v) { u32x4 o; o.x = pk2(v[0], v[1]); o.y = pk2(v[2], v[3]); o.z = pk2(v[4], v[5]); o.w = pk2(v[6], v[7]); return o; }
__device__ __forceinline__ float sigmoidf_(float x) { return 1.f / (1.f + expf(-x)); }
__device__ __forceinline__ float siluf_(float x) { return x / (1.f + expf(-x)); }
__device__ __forceinline__ float fsigmoid(float x) { return __builtin_amdgcn_rcpf(1.0f + __builtin_amdgcn_exp2f(-1.4426950408889634f * x)); }
__device__ __forceinline__ float fsilu(float x) { return x * fsigmoid(x); }
__device__ __forceinline__ float softplusf_(float x) { return fmaxf(x, 0.f) + log1pf(expf(-fabsf(x))); }
__device__ __forceinline__ float gelu_tanh(float x) { const float u = 0.7978845608028654f * (x + 0.044715f * x * x * x); return 0.5f * x * (1.f + tanhf(u)); }
__device__ __forceinline__ float dppf(float v, const int ctrl_sel) {
    int r;
    if (ctrl_sel == 0) r = __builtin_amdgcn_update_dpp(0, __float_as_int(v), 0xB1, 0xF, 0xF, true);
    else if (ctrl_sel == 1) r = __builtin_amdgcn_update_dpp(0, __float_as_int(v), 0x4E, 0xF, 0xF, true);
    else if (ctrl_sel == 2) r = __builtin_amdgcn_update_dpp(0, __float_as_int(v), 0x141, 0xF, 0xF, true);
    else r = __builtin_amdgcn_update_dpp(0, __float_as_int(v), 0x140, 0xF, 0xF, true);
    return __int_as_float(r);
}
__device__ __forceinline__ float rowsum16(float v) { v += dppf(v, 0); v += dppf(v, 1); v += dppf(v, 2); v += dppf(v, 3); return v; }
__device__ __forceinline__ float wave_sum(float v) {
#pragma unroll
    for (int o = 1; o < 64; o <<= 1) v += __shfl_xor(v, o);
    return v;
}
__device__ __forceinline__ float xhalf_max(float v) { auto rr = __builtin_amdgcn_permlane32_swap(__float_as_uint(v), __float_as_uint(v), false, false); return fmaxf(__uint_as_float(rr[0]), __uint_as_float(rr[1])); }
__device__ __forceinline__ float xhalf_sum(float v) { auto rr = __builtin_amdgcn_permlane32_swap(__float_as_uint(v), __float_as_uint(v), false, false); return __uint_as_float(rr[0]) + __uint_as_float(rr[1]); }
#define LDS_WAIT() asm volatile("s_waitcnt lgkmcnt(0)" ::: "memory")

namespace pg8 {
constexpr int BM = 256, BK = 64, HALF = 128, HTB = HALF * BK * 2, STAGE_BYTES = 8 * HTB, NXCD = 8, WGM = 8;
__host__ __device__ __forceinline__ int lds_byte(int r, int c) { const int st = (r >> 4) * 2 + (c >> 5), rr = r & 15, cc = c & 31, ob = rr * 64 + cc * 2; return st * 1024 + (ob ^ (((ob >> 9) & 1) << 5)); }
__host__ __device__ __forceinline__ void stage_rc(int b, int& R, int& C) { const int st = b / 1024, sb = b % 1024, swz = sb ^ (((sb >> 9) & 1) << 5); R = (st >> 1) * 16 + swz / 64; C = (st & 1) * 32 + (swz % 64) / 2; }
__host__ __device__ __forceinline__ int perm32(int rho) { const int n = rho >> 4, i = rho & 15; return 8 * (i >> 2) + 4 * n + (i & 3); }
struct Unit { int pm, pn, ks; };
struct Gemm { const bf16_t* A; const bf16_t* Bt; int M, N, K, lda, ldb, nks; };
struct StaticOrder {
    int nM, nN, nwg, G, c;
    int nks;
    __device__ void init(int M, int N, int G_, int c_, int nks_) { nM = M / BM; nN = N / BM; nwg = nM * nN; G = G_; c = c_; nks = nks_; }
    __device__ bool next(int i, Unit& u) const {
        const long L = (long)i * G + c; if (L >= (long)nwg * nks) return false;
        u.ks = (int)(L % nks); int wgid = (int)(L / nks); { const int q = nwg / NXCD, r = nwg % NXCD, xcd = wgid % NXCD, off = wgid / NXCD; wgid = (xcd < r ? xcd * (q + 1) : r * (q + 1) + (xcd - r) * q) + off; }
        const int nig = WGM * nN, gid = wgid / nig, fm = gid * WGM, gsz = (nM - fm) < WGM ? (nM - fm) : WGM;
        u.pm = fm + ((wgid % nig) % gsz); u.pn = (wgid % nig) / gsz; return true;
    }
};
struct EpiBf16 {
    static constexpr bool PERM = true;
    bf16_t* O; int ldc; int act; const float* gate; int bb_force; size_t ks_stride;
    __device__ __forceinline__ void operator()(const f32x4 (&acc)[2][2][4][2], const Unit& u, int wr, int wc, int fr, int fq) const {
        const int rt = u.pm * BM; const int bb = bb_force >= 0 ? bb_force : (rt >= ML ? 8 : (rt >> 12));
        const int row0 = rt + wr * 64 + fr; const int col0 = u.pn * BM + wc * 32 + 8 * fq;
        f32x4 gv[2][2];
#pragma unroll
        for (int bj = 0; bj < 2; ++bj)
#pragma unroll
            for (int n = 0; n < 2; ++n) gv[bj][n] = gate ? *(const f32x4*)(gate + bb * 6144 + col0 + bj * HALF + 4 * n) : (f32x4){1.f, 1.f, 1.f, 1.f};
#pragma unroll
        for (int ai = 0; ai < 2; ++ai)
#pragma unroll
            for (int m = 0; m < 4; ++m) { bf16_t* rowp = O + (size_t)u.ks * ks_stride + (size_t)(row0 + ai * HALF + m * 16) * ldc + col0;
#pragma unroll
                for (int bj = 0; bj < 2; ++bj) { f32x4 v0 = acc[ai][bj][m][0], v1 = acc[ai][bj][m][1];
                    if (act == 2) {
#pragma unroll
                        for (int e = 0; e < 4; ++e) { float a0 = fmaxf(v0[e], 0.f), a1 = fmaxf(v1[e], 0.f); v0[e] = a0 * a0; v1[e] = a1 * a1; } }
                    v0 = v0 * gv[bj][0]; v1 = v1 * gv[bj][1];
                    u32x4 w; w.x = pk2(v0[0], v0[1]); w.y = pk2(v0[2], v0[3]); w.z = pk2(v1[0], v1[1]); w.w = pk2(v1[2], v1[3]);
                    *(u32x4*)(rowp + bj * HALF) = w; } }
    }
};

template <class Epi>
__device__ __forceinline__ void gemm_phase(LAS unsigned char* lds, const Gemm g, const StaticOrder& S, const Epi& E, const int tid) {
    const int wid = __builtin_amdgcn_readfirstlane(tid >> 6), lane = tid & 63, wr = wid >> 2, wc = wid & 3, fr = lane & 15, fq = lane >> 4;
    const int K = g.K, nt = K / BK;
    unsigned voffA[2], voffB[2];
#pragma unroll
    for (int i = 0; i < 2; ++i) { int R, C; stage_rc(tid * 16 + i * 8192, R, C); const int Rb = Epi::PERM ? ((R & ~31) + perm32(R & 31)) : R;
        voffA[i] = (unsigned)(R * g.lda + C) * 2u; voffB[i] = (unsigned)(Rb * g.ldb + C) * 2u; }
    const size_t kstep = (size_t)(BK * 2);
    const size_t hA = (size_t)HALF * g.lda * 2, hB = (size_t)HALF * g.ldb * 2, kso = (size_t)K * 2;
    const size_t tA = 2 * hA, tB = 2 * hB;
    const unsigned ldsw = (unsigned)wid * 1024u;
    const int aoff = lds_byte(wr * 64 + fr, fq * 8), boff = lds_byte(wc * 32 + fr, fq * 8);
#define PG8_SA(b, h) (((b) * 2 + (h)) * HTB)
#define PG8_SB(b, h) ((4 + (b) * 2 + (h)) * HTB)
#define PG8_STAGE(bufoff, gbase, voff) do { _Pragma("unroll") for (int _i = 0; _i < 2; ++_i) \
        __builtin_amdgcn_global_load_lds((const unsigned*)((const char*)(gbase) + (voff)[_i]), (LAS unsigned*)(lds + (bufoff) + ldsw + _i * 8192), 16, 0, 0); } while (0)
#define PG8_LDA(dst, b, h) do { _Pragma("unroll") for (int m = 0; m < 4; ++m) _Pragma("unroll") for (int k = 0; k < 2; ++k) dst[m][k] = *(const LAS bf16x8*)(lds + PG8_SA(b, h) + aoff + m * 2048 + k * 1024); } while (0)
#define PG8_LDB(dst, b, h) do { _Pragma("unroll") for (int n = 0; n < 2; ++n) _Pragma("unroll") for (int k = 0; k < 2; ++k) dst[n][k] = *(const LAS bf16x8*)(lds + PG8_SB(b, h) + boff + n * 2048 + k * 1024); } while (0)
#define PG8_MMA(ai, bj, At, Bt) do { __builtin_amdgcn_s_setprio(1); _Pragma("unroll") for (int m = 0; m < 4; ++m) _Pragma("unroll") for (int n = 0; n < 2; ++n) _Pragma("unroll") for (int k = 0; k < 2; ++k) \
        acc[ai][bj][m][n] = __builtin_amdgcn_mfma_f32_16x16x32_bf16(Bt[n][k], At[m][k], acc[ai][bj][m][n], 0, 0, 0); __builtin_amdgcn_s_setprio(0); } while (0)
#define PG8_WAIT_V(n) asm volatile("s_waitcnt vmcnt(" #n ")" ::: "memory")
#define PG8_WAIT_L(n) asm volatile("s_waitcnt lgkmcnt(" #n ")" ::: "memory")
#define PG8_BAR __builtin_amdgcn_s_barrier()
#define PG8_SCHED __builtin_amdgcn_sched_barrier(0)
    Unit cur, nxt; int ui = 0;
    if (!S.next(0, cur)) return;
    f32x4 acc[2][2][4][2];
#pragma unroll
    for (int a = 0; a < 2; ++a)
#pragma unroll
        for (int b = 0; b < 2; ++b)
#pragma unroll
            for (int m = 0; m < 4; ++m)
#pragma unroll
                for (int n = 0; n < 2; ++n) acc[a][b][m][n] = (f32x4){0.f, 0.f, 0.f, 0.f};
    bf16x8 At[4][2], B0[2][2], B1[2][2];
    const char* cA = (const char*)g.A + (size_t)cur.pm * tA + cur.ks * kso; const char* cB = (const char*)g.Bt + (size_t)cur.pn * tB + cur.ks * kso;
    PG8_STAGE(PG8_SB(0, 0), cB, voffB); PG8_STAGE(PG8_SB(0, 1), cB + hB, voffB); PG8_STAGE(PG8_SA(0, 0), cA, voffA); PG8_STAGE(PG8_SA(0, 1), cA + hA, voffA);
    if (wr == 1) PG8_BAR;
    PG8_WAIT_V(2); PG8_BAR;
    PG8_STAGE(PG8_SB(1, 0), cB + kstep, voffB); PG8_STAGE(PG8_SA(1, 0), cA + kstep, voffA); PG8_STAGE(PG8_SB(1, 1), cB + hB + kstep, voffB);
    PG8_WAIT_V(6); PG8_BAR;
    for (;;) {
        const bool has_next = S.next(ui + 1, nxt);
        const char* nA = has_next ? (const char*)g.A + (size_t)nxt.pm * tA + nxt.ks * kso : cA; const char* nB = has_next ? (const char*)g.Bt + (size_t)nxt.pn * tB + nxt.ks * kso : cB;
        for (int t = 0; t < nt; t += 2) {
            const bool last = (t == nt - 2);
            const char* a1 = cA + (size_t)(t + 1) * kstep;
            const char* a2 = last ? nA : cA + (size_t)(t + 2) * kstep; const char* b2 = last ? nB : cB + (size_t)(t + 2) * kstep;
            const char* a3 = a2 + kstep; const char* b3 = b2 + kstep;
            PG8_LDB(B0, 0, 0); PG8_LDB(B1, 0, 1); PG8_SCHED; PG8_LDA(At, 0, 0); PG8_STAGE(PG8_SA(1, 1), a1 + hA, voffA);
            PG8_WAIT_V(8); PG8_WAIT_L(0); PG8_BAR; PG8_MMA(0, 0, At, B0); PG8_MMA(0, 1, At, B1); PG8_BAR; PG8_SCHED;
            PG8_LDA(At, 0, 1); PG8_STAGE(PG8_SB(0, 0), b2, voffB); PG8_STAGE(PG8_SB(0, 1), b2 + hB, voffB); PG8_STAGE(PG8_SA(0, 0), a2, voffA);
            PG8_WAIT_V(8); PG8_WAIT_L(0); PG8_BAR; PG8_MMA(1, 0, At, B0); PG8_MMA(1, 1, At, B1); PG8_BAR; PG8_SCHED;
            PG8_LDB(B0, 1, 0); PG8_LDB(B1, 1, 1); PG8_SCHED; PG8_LDA(At, 1, 0); PG8_STAGE(PG8_SA(0, 1), a2 + hA, voffA);
            PG8_WAIT_V(8); PG8_WAIT_L(0); PG8_BAR; PG8_MMA(0, 0, At, B0); PG8_MMA(0, 1, At, B1); PG8_BAR; PG8_SCHED;
            PG8_LDA(At, 1, 1); PG8_STAGE(PG8_SB(1, 0), b3, voffB); PG8_STAGE(PG8_SB(1, 1), b3 + hB, voffB); PG8_STAGE(PG8_SA(1, 0), a3, voffA);
            PG8_WAIT_V(8); PG8_WAIT_L(0); PG8_BAR; PG8_MMA(1, 0, At, B0); PG8_MMA(1, 1, At, B1); PG8_BAR; PG8_SCHED;
        }
        if (wr == 0) PG8_BAR;
        E(acc, cur, wr, wc, fr, fq);
        if (!has_next) break;
#pragma unroll
        for (int a = 0; a < 2; ++a)
#pragma unroll
            for (int b = 0; b < 2; ++b)
#pragma unroll
                for (int m = 0; m < 4; ++m)
#pragma unroll
                    for (int n = 0; n < 2; ++n) acc[a][b][m][n] = (f32x4){0.f, 0.f, 0.f, 0.f};
        cur = nxt; cA = nA; cB = nB; ++ui;
        if (wr == 1) PG8_BAR;
    }
    PG8_WAIT_V(0);
    PG8_BAR;
#undef PG8_SA
#undef PG8_SB
#undef PG8_STAGE
#undef PG8_LDA
#undef PG8_LDB
#undef PG8_MMA
#undef PG8_WAIT_V
#undef PG8_WAIT_L
#undef PG8_BAR
#undef PG8_SCHED
}
}

struct Args { const float* in[24]; float* out; unsigned char* ws; int ph_lo, ph_hi; };
typedef const __attribute__((address_space(4))) Args* KA;
enum { I_X = 0, I_C, I_CTX, I_CCTX, I_ADAW, I_ADAB, I_LNG, I_LNB, I_W1, I_W2, I_WOUT, I_EVWIN, I_EVQKVCONV, I_EVALOG, I_EVDTB, I_EVGDNNORM,
       I_LRUCW, I_LRUCB, I_LRUGW, I_LRUGB, I_LRULAM, I_ODWQKV, I_ODLAM, I_ODSUBLN };
enum { K_PROA = 0, K_PROB, K_PROJ, K_E2, K_E3, K_E4, K_O2, K_O3, K_WOUT, K_LN1, K_MLP1, K_MLP2, K_LN2, K_E2B };
constexpr int N_PHASES = 2 + 10 + 8 + 10 + 8;

__device__ __forceinline__ void transpose_item(const float* W, int K, int N, int Npad, bf16_t* WT, LAS float* scr, int item, int lane) {
    const int nblk = Npad / 32, kb = item / nblk, nb = item % nblk, k0 = 64 * kb, n0 = 32 * nb;
    const int n = n0 + (lane & 31);
    { float wv[32];
#pragma unroll
      for (int i = 0; i < 32; ++i) { const int kk = 2 * i + (lane >> 5); wv[i] = (n < N) ? W[(size_t)(k0 + kk) * N + n] : 0.f; }
#pragma unroll
      for (int i = 0; i < 32; ++i) { const int kk = 2 * i + (lane >> 5); scr[kk * 33 + (lane & 31)] = wv[i]; } }
    LDS_WAIT();
    const int c = lane & 7;
#pragma unroll
    for (int j = 0; j < 4; ++j) { const int nn = (lane >> 3) + 8 * j; const LAS float* s = scr + (8 * c) * 33 + nn;
        u32x4 o; o.x = pk2(s[0 * 33], s[1 * 33]); o.y = pk2(s[2 * 33], s[3 * 33]); o.z = pk2(s[4 * 33], s[5 * 33]); o.w = pk2(s[6 * 33], s[7 * 33]);
        *(u32x4*)(WT + (size_t)(n0 + nn) * K + k0 + 8 * c) = o; }
    LDS_WAIT();
}
__device__ __forceinline__ void conv_weights(KA a, int L, LAS unsigned char* lds, int gw, int NGW, int wave, int lane) {
    LAS float* scr = (LAS float*)(lds + wave * 16384);
    const bool even = (L & 1) == 0; const int j2 = L >> 1;
    const float* Wa = even ? a->in[I_EVWIN] + (size_t)j2 * D * EVN : a->in[I_ODWQKV] + (size_t)j2 * D * ODN;
    const int Na = even ? EVN : ODN, Nap = even ? EVNP : ODN;
    const int IA = (D / 64) * (Nap / 32), IO = (D / 64) * (D / 32), I1 = (D / 64) * (FF / 32), I2 = (FF / 64) * (D / 32);
    bf16_t* WA = (bf16_t*)(a->ws + WS_WA); bf16_t* WO = (bf16_t*)(a->ws + WS_WO); bf16_t* W1 = (bf16_t*)(a->ws + WS_W1); bf16_t* W2 = (bf16_t*)(a->ws + WS_W2);
    for (int it = gw; it < IA + IO + I1 + I2; it += NGW) {
        int r = it;
        if (r < IA) { transpose_item(Wa, D, Na, Nap, WA, scr, r, lane); continue; } r -= IA;
        if (r < IO) { transpose_item(a->in[I_WOUT] + (size_t)L * D * D, D, D, D, WO, scr, r, lane); continue; } r -= IO;
        if (r < I1) { transpose_item(a->in[I_W1] + (size_t)L * D * FF, D, FF, FF, W1, scr, r, lane); continue; } r -= I1;
        transpose_item(a->in[I_W2] + (size_t)L * FF * D, FF, D, D, W2, scr, r, lane);
    }
}

__device__ __forceinline__ void modulate_row_store(const f32x4 (&v)[4], const float* mod_bb, int sidx, bf16_t* urow, int lane) {
#pragma unroll
    for (int j = 0; j < 4; ++j) { const int c = 4 * (lane + 64 * j);
        const f32x4 sh = *(const f32x4*)(mod_bb + sidx * D + c), sc = *(const f32x4*)(mod_bb + (sidx + 1) * D + c);
        const f32x4 u = v[j] * (sc + 1.0f) + sh; u32x2 w; w.x = pk2(u[0], u[1]); w.y = pk2(u[2], u[3]); *(u32x2*)(urow + c) = w; }
}
__device__ __forceinline__ void prologue_b(KA a, int gw, int NGW, int lane) {
    const float* MOD = (const float*)(a->ws + WS_MOD); bf16_t* U = (bf16_t*)(a->ws + WS_U);
    for (int row = gw; row < MT; row += NGW) {
        const bool isctx = row >= ML; const int bb = isctx ? 8 : (row >> 12);
        const float* hp = isctx ? a->in[I_CTX] + (size_t)(row - ML) * D : a->in[I_X] + (size_t)row * D;
        f32x4 v[4];
#pragma unroll
        for (int j = 0; j < 4; ++j) v[j] = *(const f32x4*)(hp + 4 * (lane + 64 * j));
        modulate_row_store(v, MOD + (size_t)(0 * 9 + bb) * 6144, 0, U + (size_t)row * D, lane);
    }
}
__device__ __forceinline__ void ln_row_finish(f32x4 (&v)[4], float s, const float* lg, const float* lb, bf16_t* hp16, float* hp32, bool do_u, const float* mod_bb, int sidx, bf16_t* urow, int lane) {
    const float mean = wave_sum(s) * (1.f / D); float s2 = 0.f;
#pragma unroll
    for (int j = 0; j < 4; ++j) { v[j] = v[j] - mean; s2 += (v[j][0] * v[j][0] + v[j][1] * v[j][1]) + (v[j][2] * v[j][2] + v[j][3] * v[j][3]); }
    const float rstd = 1.0f / sqrtf(wave_sum(s2) * (1.f / D) + EPS);
#pragma unroll
    for (int j = 0; j < 4; ++j) { const int c = 4 * (lane + 64 * j); const f32x4 gg = *(const f32x4*)(lg + c), bbv = *(const f32x4*)(lb + c);
        v[j] = v[j] * rstd * gg + bbv;
        if (hp32) __builtin_nontemporal_store(v[j], (f32x4*)(hp32 + c));
        else { typedef _Float16 h4_t __attribute__((ext_vector_type(4))); const u32x2 w = __builtin_bit_cast(u32x2, __builtin_convertvector(v[j], h4_t)); __builtin_nontemporal_store(w, (u32x2*)(hp16 + c)); } }
    if (do_u) modulate_row_store(v, mod_bb, sidx, urow, lane);
}
typedef _Float16 h16x4 __attribute__((ext_vector_type(4)));
__device__ __forceinline__ f32x4 hf4(const u32x2 w) { return __builtin_convertvector(__builtin_bit_cast(h16x4, w), f32x4); }
__device__ __forceinline__ u32x2 f4h(const f32x4 v) { return __builtin_bit_cast(u32x2, __builtin_convertvector(v, h16x4)); }
__device__ __forceinline__ f32x4 bf4(const u32x2 w) { return (f32x4){__uint_as_float(w.x << 16), __uint_as_float(w.x & 0xffff0000u), __uint_as_float(w.y << 16), __uint_as_float(w.y & 0xffff0000u)}; }
__device__ __forceinline__ void ln_pass(KA a, int L, int which, int nrows, bool do_u, int Lm, int sidx, const bf16_t* T, int npart, int gw, int NGW, int lane) {
    const float* MOD = (const float*)(a->ws + WS_MOD); bf16_t* U = (bf16_t*)(a->ws + WS_U); bf16_t* HC = (bf16_t*)(a->ws + WS_HC);
    const float* lg = a->in[I_LNG] + (size_t)(L * 2 + which) * D; const float* lb = a->in[I_LNB] + (size_t)(L * 2 + which) * D;
    const bool first = (L == 0 && which == 0), fin = (L == 3 && which == 1);
    bf16_t* HL = (bf16_t*)((unsigned char*)a->out + (size_t)64 * MiB); bf16_t* HX = (bf16_t*)(a->ws + WS_HLAST);
    const bf16_t* hin16 = fin ? HX : HL;
    bf16_t* hout16 = (L == 3 && which == 0) ? HX : HL;
    const int nmain = npart > 0 ? ML : nrows;
    if (first) {
        f32x4 hv[4]; u32x2 tw[4];
#define LN_FETCH(HV, TW, row_) do { const int r_ = (row_); const float* hin_ = a->in[I_X] + (size_t)r_ * D; const bf16_t* tp_ = T + (size_t)r_ * D; \
        _Pragma("unroll") for (int j = 0; j < 4; ++j) { const int c = 4 * (lane + 64 * j); HV[j] = __builtin_nontemporal_load((const f32x4*)(hin_ + c)); TW[j] = __builtin_nontemporal_load((const u32x2*)(tp_ + c)); } } while (0)
        if (gw < nmain) LN_FETCH(hv, tw, gw);
#pragma unroll 2
        for (int row = gw; row < nmain; row += NGW) {
            f32x4 hn[4]; u32x2 tn[4]; const int nrow = row + NGW < nmain ? row + NGW : row;
            LN_FETCH(hn, tn, nrow);
            f32x4 v[4]; float s = 0.f;
#pragma unroll
            for (int j = 0; j < 4; ++j) { v[j] = hv[j] * ALPHA + bf4(tw[j]); s += (v[j][0] + v[j][1]) + (v[j][2] + v[j][3]); }
            ln_row_finish(v, s, lg, lb, hout16 + (size_t)row * D, nullptr, do_u, MOD + (size_t)(Lm * 9 + (row >> 12)) * 6144, sidx, U + (size_t)row * D, lane);
#pragma unroll
            for (int j = 0; j < 4; ++j) { hv[j] = hn[j]; tw[j] = tn[j]; }
        }
#undef LN_FETCH
    } else {
        u32x2 hv[4], tw[4];
#define LN_FETCH(HV, TW, row_) do { const int r_ = (row_); const bf16_t* hin_ = hin16 + (size_t)r_ * D; const bf16_t* tp_ = T + (size_t)r_ * D; \
        _Pragma("unroll") for (int j = 0; j < 4; ++j) { const int c = 4 * (lane + 64 * j); HV[j] = __builtin_nontemporal_load((const u32x2*)(hin_ + c)); TW[j] = __builtin_nontemporal_load((const u32x2*)(tp_ + c)); } } while (0)
        if (gw < nmain) LN_FETCH(hv, tw, gw);
#pragma unroll 2
        for (int row = gw; row < nmain; row += NGW) {
            u32x2 hn[4], tn[4]; const int nrow = row + NGW < nmain ? row + NGW : row;
            LN_FETCH(hn, tn, nrow);
            f32x4 v[4]; float s = 0.f;
#pragma unroll
            for (int j = 0; j < 4; ++j) { v[j] = hf4(hv[j]) * ALPHA + bf4(tw[j]); s += (v[j][0] + v[j][1]) + (v[j][2] + v[j][3]); }
            ln_row_finish(v, s, lg, lb, hout16 + (size_t)row * D, fin ? a->out + (size_t)row * D : nullptr, do_u, MOD + (size_t)(Lm * 9 + (row >> 12)) * 6144, sidx, U + (size_t)row * D, lane);
#pragma unroll
            for (int j = 0; j < 4; ++j) { hv[j] = hn[j]; tw[j] = tn[j]; }
        }
#undef LN_FETCH
    }
    if (npart > 0) {
        const bf16_t* PART = (const bf16_t*)(a->ws + WS_PART);
        for (int row = ML + gw; row < nrows; row += NGW) {
            const size_t rc = (size_t)(row - ML); bf16_t* hp = HC + rc * D;
            f32x4 v[4]; float s = 0.f;
#pragma unroll
            for (int j = 0; j < 4; ++j) { const int c = 4 * (lane + 64 * j); f32x4 tv = {0.f, 0.f, 0.f, 0.f};
                for (int ks = 0; ks < npart; ++ks) tv += bf4(*(const u32x2*)(PART + (size_t)ks * MC * D + rc * D + c));
                const f32x4 hh = first ? *(const f32x4*)(a->in[I_CTX] + rc * D + c) : hf4(*(const u32x2*)(hp + c));
                v[j] = hh * ALPHA + tv; s += (v[j][0] + v[j][1]) + (v[j][2] + v[j][3]); }
            ln_row_finish(v, s, lg, lb, hp, nullptr, do_u, MOD + (size_t)(Lm * 9 + 8) * 6144, sidx, U + (size_t)row * D, lane);
        }
    }
}

__device__ __forceinline__ void prologue_a(KA a, LAS unsigned char* lds, int bid, int G, int tid, int wave, int lane) {
    float* MOD = (float*)(a->ws + WS_MOD); float* MISC = (float*)(a->ws + WS_MISC);
    LAS float* sv = (LAS float*)lds;
    LAS float* red = (LAS float*)(lds + 9 * 1024 * 4);
    for (int i = tid; i < 9 * 1024; i += 512) { const int bb = i >> 10, k = i & 1023; const float v = bb < 8 ? a->in[I_C][bb * 1024 + k] : a->in[I_CCTX][k]; sv[i] = siluf_(v); }
    __syncthreads();
    for (int unit = bid; unit < 192; unit += G) {
        const int L = unit / 48, cb = unit % 48, col = tid & 127, kq = tid >> 7;
        const float* w = a->in[I_ADAW] + (size_t)L * D * 6144 + cb * 128 + col;
        float acc[9];
#pragma unroll
        for (int bb = 0; bb < 9; ++bb) acc[bb] = 0.f;
        for (int k0 = kq * 256; k0 < kq * 256 + 256; k0 += 16) { float wv[16];
#pragma unroll
            for (int i = 0; i < 16; ++i) wv[i] = w[(size_t)(k0 + i) * 6144];
#pragma unroll
            for (int i = 0; i < 16; ++i)
#pragma unroll
                for (int bb = 0; bb < 9; ++bb) acc[bb] += sv[bb * 1024 + k0 + i] * wv[i]; }
#pragma unroll
        for (int bb = 0; bb < 9; ++bb) red[(kq * 9 + bb) * 128 + col] = acc[bb];
        __syncthreads();
        for (int i = tid; i < 9 * 128; i += 512) { const int bb = i >> 7, cc = i & 127;
            float s = (red[(0 * 9 + bb) * 128 + cc] + red[(1 * 9 + bb) * 128 + cc]) + (red[(2 * 9 + bb) * 128 + cc] + red[(3 * 9 + bb) * 128 + cc]);
            s += a->in[I_ADAB][L * 6144 + cb * 128 + cc]; MOD[(size_t)(L * 9 + bb) * 6144 + cb * 128 + cc] = s; }
        __syncthreads();
    }
    if (bid == G - 1) {
        if (tid < 16) {
            double th = 1.0; for (int j = 0; j < tid; ++j) th *= 0.56234132519034908;
            const double t2 = th * th; double sn = th, term = th, cs = 1.0, tc = 1.0;
            for (int k = 1; k < 12; ++k) { tc *= -t2 / ((2.0 * k - 1.0) * (2.0 * k)); cs += tc; term *= -t2 / ((2.0 * k) * (2.0 * k + 1.0)); sn += term; }
            double c = 1.0, s = 0.0;
            for (int p = 0; p < 64; ++p) { MISC[64 + p * 16 + tid] = (float)c; MISC[1088 + p * 16 + tid] = (float)s; const double c2 = c * cs - s * sn, s2 = s * cs + c * sn; c = c2; s = s2; }
        }
        if (tid >= 64 && tid < 66) { const int j = tid - 64; const float* lv = a->in[I_ODLAM] + j * 256; float d0 = 0.f, d1 = 0.f;
            for (int i = 0; i < 64; ++i) { d0 += lv[i] * lv[64 + i]; d1 += lv[128 + i] * lv[192 + i]; }
            const float li = 0.8f - 0.6f * expf(-0.3f * (float)(2 * j + 1)); MISC[j] = expf(d0) - expf(d1) + li; MISC[2 + j] = li; }
    }
    __syncthreads();
    conv_weights(a, 0, lds, bid * 8 + wave, G * 8, wave, lane);
}

__device__ __forceinline__ void attn_prep(KA a, LAS unsigned char* lds, int bid, int G, int tid) {
    bf16_t* P = (bf16_t*)(a->ws + WS_P); bf16_t* VT = (bf16_t*)(a->ws + WS_V); const float* MISC = (const float*)(a->ws + WS_MISC);
    const float* tabc = MISC + 64; const float* tabs = MISC + 1088;
    constexpr int VP = 2064;
    for (int u = bid; u < 2 * NB * 68; u += G) {
        const bool vpart = u >= NB * 68; const int uu = vpart ? u - NB * 68 : u;
        const int b = uu / 68, tl = uu % 68; const bool isctx = tl < 4; const int t0 = isctx ? tl * 64 : (tl - 4) * 64;
        const int rowbase = isctx ? ML + b * CTXL + t0 : b * SEQ + t0; const int kv0 = isctx ? t0 : CTXL + t0;
        if (!vpart) {
#pragma unroll 1
            for (int half = 0; half < 2; ++half) {
                u32x4 r1[4], r2[4], r3[4], r4[4];
#pragma unroll
                for (int k = 0; k < 4; ++k) { const int it = tid + 512 * (4 * half + k); const int r = it >> 6, rem = it & 63, vec = rem >> 1, part = rem & 1;
                    const bf16_t* p = P + (size_t)(rowbase + r) * ODN + vec * 64 + part * 8;
                    r1[k] = *(const u32x4*)(p); r2[k] = *(const u32x4*)(p + 16); r3[k] = *(const u32x4*)(p + 32); r4[k] = *(const u32x4*)(p + 48); }
#pragma unroll
                for (int k = 0; k < 4; ++k) { const int it = tid + 512 * (4 * half + k); const int r = it >> 6, rem = it & 63, vec = rem >> 1, part = rem & 1; const bool isq = vec < 16;
                    if (isctx && !isq) continue;
                    bf16_t* p = P + (size_t)(rowbase + r) * ODN + vec * 64 + part * 8;
                    float t1[8], t2[8], t3[8], t4[8];
                    unpack8(r1[k], t1); unpack8(r2[k], t2); unpack8(r3[k], t3); unpack8(r4[k], t4);
                    const float sc = isq ? QSCALE : 1.0f;
                    if (!isctx) {
                        const int pos = t0 + r, rp = pos >> 6, cp = pos & 63;
#pragma unroll
                        for (int j = 0; j < 8; ++j) { const int jj = part * 8 + j;
                            const float cr = tabc[rp * 16 + jj], sr = tabs[rp * 16 + jj], cc = tabc[cp * 16 + jj], ss = tabs[cp * 16 + jj];
                            const float o1 = t1[j] * cr - t2[j] * sr, o2 = t2[j] * cr + t1[j] * sr, o3 = t3[j] * cc - t4[j] * ss, o4 = t4[j] * cc + t3[j] * ss;
                            t1[j] = o1 * sc; t2[j] = o2 * sc; t3[j] = o3 * sc; t4[j] = o4 * sc; }
                    } else {
#pragma unroll
                        for (int j = 0; j < 8; ++j) { t1[j] *= sc; t2[j] *= sc; t3[j] *= sc; t4[j] *= sc; }
                    }
                    *(u32x4*)(p) = pack8(t1); *(u32x4*)(p + 16) = pack8(t2); *(u32x4*)(p + 32) = pack8(t3); *(u32x4*)(p + 48) = pack8(t4);
                }
            }
        } else {
            { u32x4 rv[16];
#pragma unroll
              for (int k = 0; k < 16; ++k) { const int id = tid + 512 * k; rv[k] = *(const u32x4*)(P + (size_t)(rowbase + (id >> 7)) * ODN + 2048 + (id & 127) * 8); }
#pragma unroll
              for (int k = 0; k < 16; ++k) { const int id = tid + 512 * k; *(LAS u32x4*)(lds + (id >> 7) * VP + (id & 127) * 16) = rv[k]; } }
            __syncthreads();
#pragma unroll 4
            for (int k = 0; k < 16; ++k) { const int oc = tid + 512 * k; const int col = oc & 1023, c = oc >> 10;
                unsigned w[4];
#pragma unroll
                for (int j = 0; j < 4; ++j) { const unsigned lo = *(const LAS bf16_t*)(lds + (8 * c + 2 * j) * VP + col * 2), hi = *(const LAS bf16_t*)(lds + (8 * c + 2 * j + 1) * VP + col * 2); w[j] = lo | (hi << 16); }
                u32x4 o; o.x = w[0]; o.y = w[1]; o.z = w[2]; o.w = w[3];
                *(u32x4*)(VT + ((size_t)(b * 8 * 128 + col)) * NKV + kv0 + 8 * c) = o; }
            __syncthreads();
        }
    }
}

constexpr int AT_KB = 64 * 272, AT_VB = 128 * 144, AT_BUF = AT_KB + AT_VB, AT_OX = 0;
static_assert(3 * AT_BUF <= LDS_BYTES - 16 && 128 * 132 * 4 <= 3 * AT_BUF, "attention lds");
__device__ __forceinline__ void at_qk(const LAS unsigned char* Kb, const bf16x8 (&qf)[4], f32x16& s0, f32x16& s1, int m, int krow, int hi) {
#pragma unroll
    for (int r = 0; r < 16; ++r) { s0[r] = 0.f; s1[r] = 0.f; }
#pragma unroll
    for (int ks = 0; ks < 4; ++ks) {
        const bf16x8 a0 = *(const LAS bf16x8*)(Kb + krow * 272 + (m * 64 + ks * 16 + hi * 8) * 2);
        const bf16x8 a1 = *(const LAS bf16x8*)(Kb + (krow + 32) * 272 + (m * 64 + ks * 16 + hi * 8) * 2);
        s0 = __builtin_amdgcn_mfma_f32_32x32x16_bf16(a0, qf[ks], s0, 0, 0, 0);
        s1 = __builtin_amdgcn_mfma_f32_32x32x16_bf16(a1, qf[ks], s1, 0, 0, 0);
    }
}
template <bool HAS_NEXT>
__device__ __forceinline__ void at_step(const LAS unsigned char* Kn, const LAS unsigned char* Vc, const bf16x8 (&qf)[4], f32x16 (&o)[4], f32x16& s0, f32x16& s1, f32x16& negm, float& mrun, f32x16& lacc, int m, int krow, int r32, int hi) {
    f32x16 n0, n1;
#pragma unroll
    for (int ks = 0; ks < 4; ++ks) {
        if (HAS_NEXT) {
            const bf16x8 a0 = *(const LAS bf16x8*)(Kn + krow * 272 + (m * 64 + ks * 16 + hi * 8) * 2);
            const bf16x8 a1 = *(const LAS bf16x8*)(Kn + (krow + 32) * 272 + (m * 64 + ks * 16 + hi * 8) * 2);
            if (ks == 0) { n0 = __builtin_amdgcn_mfma_f32_32x32x16_bf16(a0, qf[0], negm, 0, 0, 0); n1 = __builtin_amdgcn_mfma_f32_32x32x16_bf16(a1, qf[0], negm, 0, 0, 0); }
            else { n0 = __builtin_amdgcn_mfma_f32_32x32x16_bf16(a0, qf[ks], n0, 0, 0, 0); n1 = __builtin_amdgcn_mfma_f32_32x32x16_bf16(a1, qf[ks], n1, 0, 0, 0); }
        }
#pragma unroll
        for (int r = 4 * ks; r < 4 * ks + 4; ++r) { s0[r] = __builtin_amdgcn_exp2f(s0[r]); s1[r] = __builtin_amdgcn_exp2f(s1[r]); }
    }
    bf16x8 pb[4];
    { u32x4 w;
      w.x = pk2(s0[0], s0[1]); w.y = pk2(s0[2], s0[3]); w.z = pk2(s0[4], s0[5]); w.w = pk2(s0[6], s0[7]); pb[0] = __builtin_bit_cast(bf16x8, w);
      w.x = pk2(s0[8], s0[9]); w.y = pk2(s0[10], s0[11]); w.z = pk2(s0[12], s0[13]); w.w = pk2(s0[14], s0[15]); pb[1] = __builtin_bit_cast(bf16x8, w);
      w.x = pk2(s1[0], s1[1]); w.y = pk2(s1[2], s1[3]); w.z = pk2(s1[4], s1[5]); w.w = pk2(s1[6], s1[7]); pb[2] = __builtin_bit_cast(bf16x8, w);
      w.x = pk2(s1[8], s1[9]); w.y = pk2(s1[10], s1[11]); w.z = pk2(s1[12], s1[13]); w.w = pk2(s1[14], s1[15]); pb[3] = __builtin_bit_cast(bf16x8, w); }
    const bf16x8 ones = {(short)0x3F80, (short)0x3F80, (short)0x3F80, (short)0x3F80, (short)0x3F80, (short)0x3F80, (short)0x3F80, (short)0x3F80};
    float mx = -3.0e38f;
#pragma unroll
    for (int db = 0; db < 4; ++db) {
#pragma unroll
        for (int i = 0; i < 4; ++i) {
            const bf16x8 av = *(const LAS bf16x8*)(Vc + (32 * db + r32) * 144 + (16 * i + 8 * hi) * 2);
            o[db] = __builtin_amdgcn_mfma_f32_32x32x16_bf16(av, pb[i], o[db], 0, 0, 0);
        }
        lacc = __builtin_amdgcn_mfma_f32_32x32x16_bf16(ones, pb[db], lacc, 0, 0, 0);
        if (HAS_NEXT) {
#pragma unroll
            for (int r = 4 * db; r < 4 * db + 4; ++r) mx = fmaxf(mx, fmaxf(n0[r], n1[r]));
        }
    }
    if (HAS_NEXT) {
        if (__any(mx > 8.0f)) {
            mx = xhalf_max(mx);
            const float delta = (mx > 8.0f) ? mx : 0.f; const float al = __builtin_amdgcn_exp2f(-delta);
#pragma unroll
            for (int db = 0; db < 4; ++db)
#pragma unroll
                for (int r = 0; r < 16; ++r) o[db][r] *= al;
            mrun += delta;
#pragma unroll
            for (int r = 0; r < 16; ++r) { n0[r] -= delta; n1[r] -= delta; negm[r] = -mrun; lacc[r] *= al; }
        }
        s0 = n0; s1 = n1;
    }
}
__device__ __forceinline__ void attn_phase(KA a, int L, LAS unsigned char* lds, int bid, int G, int tid, int wave, int lane, bool do_store) {
    bf16_t* P = (bf16_t*)(a->ws + WS_P); const bf16_t* VT = (const bf16_t*)(a->ws + WS_V); const float* MISC = (const float*)(a->ws + WS_MISC);
    const int j2 = L >> 1; const float lam = MISC[j2], lam_init = MISC[2 + j2];
    const float* subln = a->in[I_ODSUBLN] + j2 * 128;
    const int nunits = 2048 + (L == 1 ? 128 : 0);
    const int m = wave & 1, qs = wave >> 1, r32 = lane & 31, hi = lane >> 5;
    const int krow = (r32 & 0x13) | ((r32 & 4) << 1) | ((r32 & 8) >> 1);
    for (int u = bid; u < nunits; u += G) {
        int bh, qb; const bool isctx = u >= 2048;
        if (!isctx) { bh = (u >> 8) * 8 + (u & 7); qb = (u >> 3) & 31; } else { const int u2 = u - 2048; bh = u2 >> 1; qb = u2 & 1; }
        const int b = bh >> 3, h = bh & 7;
        const int qrow = (isctx ? ML + b * CTXL : b * SEQ) + qb * 128 + qs * 32 + r32;
        const int ntiles = isctx ? 4 : 68;
        bf16x8 qf[4];
#pragma unroll
        for (int ks = 0; ks < 4; ++ks) qf[ks] = *(const bf16x8*)(P + (size_t)qrow * ODN + h * 128 + m * 64 + ks * 16 + hi * 8);
        const int kr0 = tid >> 4, kc = tid & 15;
        const int vd0 = tid >> 3, vc = tid & 7;
        const bf16_t* vsrc0 = VT + ((size_t)(bh * 128 + vd0)) * NKV + 8 * vc; const bf16_t* vsrc1 = vsrc0 + (size_t)64 * NKV;
        u32x4 rk0, rk1, rv0, rv1;
#define AT_LOAD(t) do { const int kv_ = 64 * (t) + kr0; const int g0_ = kv_ < CTXL ? ML + b * CTXL + kv_ : b * SEQ + kv_ - CTXL; const int kv1_ = kv_ + 32; const int g1_ = kv1_ < CTXL ? ML + b * CTXL + kv1_ : b * SEQ + kv1_ - CTXL; \
        rk0 = *(const u32x4*)(P + (size_t)g0_ * ODN + 1024 + h * 128 + kc * 8); rk1 = *(const u32x4*)(P + (size_t)g1_ * ODN + 1024 + h * 128 + kc * 8); \
        rv0 = *(const u32x4*)(vsrc0 + 64 * (t)); rv1 = *(const u32x4*)(vsrc1 + 64 * (t)); } while (0)
#define AT_STORE(boff) do { LAS unsigned char* kb_ = lds + (boff); LAS unsigned char* vb_ = kb_ + AT_KB; \
        *(LAS u32x4*)(kb_ + kr0 * 272 + kc * 16) = rk0; *(LAS u32x4*)(kb_ + (kr0 + 32) * 272 + kc * 16) = rk1; \
        *(LAS u32x4*)(vb_ + vd0 * 144 + vc * 16) = rv0; *(LAS u32x4*)(vb_ + (vd0 + 64) * 144 + vc * 16) = rv1; } while (0)
        { AT_LOAD(0); const u32x4 k0_ = rk0, k1_ = rk1, v0_ = rv0, v1_ = rv1;
          AT_LOAD(1);
          { LAS unsigned char* kb_ = lds; LAS unsigned char* vb_ = kb_ + AT_KB;
            *(LAS u32x4*)(kb_ + kr0 * 272 + kc * 16) = k0_; *(LAS u32x4*)(kb_ + (kr0 + 32) * 272 + kc * 16) = k1_;
            *(LAS u32x4*)(vb_ + vd0 * 144 + vc * 16) = v0_; *(LAS u32x4*)(vb_ + (vd0 + 64) * 144 + vc * 16) = v1_; }
          AT_STORE(AT_BUF); }
        __syncthreads();
        f32x16 o[4];
#pragma unroll
        for (int db = 0; db < 4; ++db)
#pragma unroll
            for (int r = 0; r < 16; ++r) o[db][r] = 0.f;
        f32x16 s0, s1;
        at_qk(lds, qf, s0, s1, m, krow, hi);
        float mrun; f32x16 lacc;
#pragma unroll
        for (int r = 0; r < 16; ++r) lacc[r] = 0.f;
        { float mx = fmaxf(s0[0], s1[0]);
#pragma unroll
          for (int r = 1; r < 16; ++r) mx = fmaxf(mx, fmaxf(s0[r], s1[r]));
          mrun = xhalf_max(mx); }
        f32x16 negm;
#pragma unroll
        for (int r = 0; r < 16; ++r) { s0[r] -= mrun; s1[r] -= mrun; negm[r] = -mrun; }
        int bc = 0, bn = AT_BUF, bs = 2 * AT_BUF;
        for (int t = 0; t + 1 < ntiles; ++t) {
            const bool stage = t + 2 < ntiles;
            if (stage) AT_LOAD(t + 2);
            at_step<true>(lds + bn, lds + bc + AT_KB, qf, o, s0, s1, negm, mrun, lacc, m, krow, r32, hi);
            if (stage) AT_STORE(bs);
            __syncthreads();
            const int tmp = bc; bc = bn; bn = bs; bs = tmp;
        }
        at_step<false>(lds, lds + bc + AT_KB, qf, o, s0, s1, negm, mrun, lacc, m, krow, r32, hi);
        __syncthreads();
#undef AT_LOAD
#undef AT_STORE
        const float inv = 1.0f / lacc[0];
        LAS float* ox = (LAS float*)(lds + AT_OX) + (qs * 32 + r32) * 132;
        if (m == 1) {
#pragma unroll
            for (int db = 0; db < 4; ++db)
#pragma unroll
                for (int r4 = 0; r4 < 4; ++r4) { f32x4 v = {o[db][4 * r4] * inv, o[db][4 * r4 + 1] * inv, o[db][4 * r4 + 2] * inv, o[db][4 * r4 + 3] * inv};
                    *(LAS f32x4*)(ox + 32 * db + 8 * r4 + 4 * hi) = v; }
        }
        __syncthreads();
        if (m == 0) {
            float ssq = 0.f;
#pragma unroll
            for (int db = 0; db < 4; ++db)
#pragma unroll
                for (int r4 = 0; r4 < 4; ++r4) { const f32x4 v1 = *(const LAS f32x4*)(ox + 32 * db + 8 * r4 + 4 * hi);
#pragma unroll
                    for (int e = 0; e < 4; ++e) { const float v = o[db][4 * r4 + e] * inv - lam * v1[e]; o[db][4 * r4 + e] = v; ssq += v * v; } }
            ssq = xhalf_sum(ssq);
            const float sc = (1.0f / sqrtf(ssq * (1.f / 128.f) + EPS)) * (1.0f - lam_init);
            bf16_t* op = P + (size_t)qrow * ODN + h * 128;
#pragma unroll
            for (int db = 0; db < 4; ++db)
#pragma unroll
                for (int r4 = 0; r4 < 4; ++r4) { const int dv = 32 * db + 8 * r4 + 4 * hi; const f32x4 g4 = *(const f32x4*)(subln + dv);
                    u32x2 w; w.x = pk2(o[db][4 * r4] * sc * g4[0], o[db][4 * r4 + 1] * sc * g4[1]); w.y = pk2(o[db][4 * r4 + 2] * sc * g4[2], o[db][4 * r4 + 3] * sc * g4[3]);
                    if (do_store) *(u32x2*)(op + dv) = w; }
        }
        __syncthreads();
    }
}

__device__ __forceinline__ void gdn_prep(KA a, int L, LAS unsigned char* lds, int gw, int NGW, int tid, int lane) {
    const int j2 = L >> 1;
    const bf16_t* P = (const bf16_t*)(a->ws + WS_P);
    bf16_t* QN = (bf16_t*)(a->ws + WS_U); bf16_t* KN = QN + (size_t)MT * 512; bf16_t* V = (bf16_t*)(a->ws + WS_V);
    float* Gb = (float*)(a->ws + WS_G); float* Bt = (float*)(a->ws + WS_BT);
    const float* cw = a->in[I_EVQKVCONV] + (size_t)j2 * 4 * 1536;
    LAS float* cwl = (LAS float*)lds;
    for (int i = tid; i < 4 * 1536 / 4; i += 512) *(LAS f32x4*)(cwl + 4 * i) = *(const f32x4*)(cw + 4 * i);
    __syncthreads();
    float alog = 0.f, dtb = 0.f;
    if (lane < 8) { alog = -expf(a->in[I_EVALOG][j2 * 8 + lane]); dtb = a->in[I_EVDTB][j2 * 8 + lane]; }
    for (int blk = gw; blk < MT / 17; blk += NGW) {
        const int r0 = 17 * blk;
        u32x4 R[20][3]; unsigned ab[17];
#define GP_LOAD(k_) do { const int row_ = r0 - 2 + (k_); const bool ok_ = row_ >= 0 && row_ < MT; \
        _Pragma("unroll") for (int p = 0; p < 3; ++p) R[k_][p] = ok_ ? *(const u32x4*)(P + (size_t)row_ * EVNP + p * 512 + 8 * lane) : (u32x4){0u, 0u, 0u, 0u}; } while (0)
#pragma unroll
        for (int k = 0; k < 6; ++k) GP_LOAD(k);
#pragma unroll
        for (int i = 0; i < 17; ++i) ab[i] = lane < 16 ? (unsigned)P[(size_t)(r0 + i) * EVNP + 2048 + lane] : 0u;
#pragma unroll
        for (int i = 0; i < 17; ++i) {
            if (i + 6 < 20) GP_LOAD(i + 6);
            const int row = r0 + i;
            const bool isctx = row >= ML; const int t = isctx ? ((row - ML) & (CTXL - 1)) : (row & (SEQ - 1)); const int len = isctx ? CTXL : SEQ;
            float val[3][8];
#pragma unroll
            for (int p = 0; p < 3; ++p) {
                float acc[8];
#pragma unroll
                for (int e = 0; e < 8; ++e) acc[e] = 0.f;
#pragma unroll
                for (int j = 0; j < 4; ++j) { const int tt = t + j - 2;
                    if (tt >= 0 && tt < len) { float x[8]; unpack8(R[i + j][p], x);
                        const f32x4 w0 = *(const LAS f32x4*)(cwl + j * 1536 + p * 512 + 8 * lane), w1 = *(const LAS f32x4*)(cwl + j * 1536 + p * 512 + 8 * lane + 4);
#pragma unroll
                        for (int e = 0; e < 8; ++e) acc[e] += (e < 4 ? w0[e & 3] : w1[e & 3]) * x[e]; } }
#pragma unroll
                for (int e = 0; e < 8; ++e) val[p][e] = fsilu(acc[e]);
            }
            float sq = 0.f, sk = 0.f;
#pragma unroll
            for (int e = 0; e < 8; ++e) { sq += val[0][e] * val[0][e]; sk += val[1][e] * val[1][e]; }
            sq = rowsum16(sq); sk = rowsum16(sk);
            const float rq = (1.0f / sqrtf(sq + EPS)) * 0.08838834764831845f, rk = 1.0f / sqrtf(sk + EPS);
#pragma unroll
            for (int e = 0; e < 8; ++e) { val[0][e] *= rq; val[1][e] *= rk; }
            *(u32x4*)(QN + (size_t)row * 512 + 8 * lane) = pack8(val[0]);
            *(u32x4*)(KN + (size_t)row * 512 + 8 * lane) = pack8(val[1]);
            *(u32x4*)(V + (size_t)row * 512 + 8 * lane) = pack8(val[2]);
            if (lane < 8) Gb[(size_t)row * 8 + lane] = alog * softplusf_(bf2f(ab[i]) + dtb);
            else if (lane < 16) Bt[(size_t)row * 8 + lane - 8] = sigmoidf_(bf2f(ab[i]));
        }
#undef GP_LOAD
    }
    __syncthreads();
}

constexpr int LR_XIN = 0, LR_XC = 17152, LR_XCB = LR_XC + 16384, LR_AU = LR_XCB + 9216, LR_WT = LR_AU + 65536, LR_END = LR_WT + 36864;
static_assert(LR_END <= LDS_BYTES, "lru lds");
template <int PASS>
__device__ __forceinline__ void lru_units(KA a, int L, LAS unsigned char* lds, int bid, int G, int tid) {
    const int j2 = L >> 1;
    const bf16_t* P = (const bf16_t*)(a->ws + WS_P); bf16_t* U = (bf16_t*)(a->ws + WS_U);
    float* TOTA = (float*)(a->ws + WS_TOTA); float* TOTH = (float*)(a->ws + WS_TOTH); const float* CARRY = (const float*)(a->ws + WS_CARRY);
    const float* cw = a->in[I_LRUCW] + (size_t)j2 * 4 * 512; const float* cb = a->in[I_LRUCB] + (size_t)j2 * 512;
    const float* gw_ = a->in[I_LRUGW] + (size_t)j2 * 2 * 2 * 8 * 64 * 64; const float* gb_ = a->in[I_LRUGB] + (size_t)j2 * 2 * 2 * 512; const float* lam_ = a->in[I_LRULAM] + (size_t)j2 * 2 * 512;
    LAS float* xin = (LAS float*)(lds + LR_XIN);
    LAS float* xc = (LAS float*)(lds + LR_XC);
    LAS bf16_t* xcb = (LAS bf16_t*)(lds + LR_XCB);
    LAS float* au = (LAS float*)(lds + LR_AU);
    LAS bf16_t* wt = (LAS bf16_t*)(lds + LR_WT);
    LAS float* sg = (LAS float*)(lds + LR_XIN);
    const int lane = tid & 63, w = tid >> 6, mt = w & 3, nh = w >> 2, fr = lane & 15, fq = lane >> 4;
    int cur_nblk = -1;
    const int cc = tid & 63;
    float cbv = 0.f, cwv[4] = {0.f, 0.f, 0.f, 0.f};
    float gbr[2][2], gbi[2][2], gsp[2][2];
#pragma unroll
    for (int q = 0; q < 2; ++q)
#pragma unroll
        for (int r = 0; r < 2; ++r) { gbr[q][r] = 0.f; gbi[q][r] = 0.f; gsp[q][r] = 0.f; }
    const int rrA = tid >> 3, c8 = (tid & 7) * 8, rrB = 64 + (tid >> 3);
    u32x4 xa = {0u, 0u, 0u, 0u}, xb = {0u, 0u, 0u, 0u}, gt4 = {0u, 0u, 0u, 0u};
#define LR_FETCH(XA, XB, GT, u_) do { const int nb_ = (u_) & 7, cs_ = (u_) >> 3, b_ = cs_ / 68, sl_ = cs_ % 68; const bool ic_ = sl_ < 4; const int t0_ = ic_ ? sl_ * 64 : (sl_ - 4) * 64; \
        const int len_ = ic_ ? CTXL : SEQ; const int rb_ = ic_ ? ML + b_ * CTXL : b_ * SEQ; const int ta_ = t0_ + rrA - 2, tb_ = t0_ + rrB - 2; \
        XA = (u32x4){0u, 0u, 0u, 0u}; XB = (u32x4){0u, 0u, 0u, 0u}; \
        if (ta_ >= 0 && ta_ < len_) XA = *(const u32x4*)(P + (size_t)(rb_ + ta_) * EVNP + 2064 + nb_ * 64 + c8); \
        if (tid < 24 && tb_ < len_) XB = *(const u32x4*)(P + (size_t)(rb_ + tb_) * EVNP + 2064 + nb_ * 64 + c8); \
        if (PASS == 2) GT = *(const u32x4*)(P + (size_t)(rb_ + t0_ + rrA) * EVNP + 2576 + nb_ * 64 + c8); } while (0)
    if (bid < NB * 68 * 8) LR_FETCH(xa, xb, gt4, bid);
    for (int u = bid; u < NB * 68 * 8; u += G) {
        const int nblk = u & 7, cs = u >> 3, b = cs / 68, slot = cs % 68; const bool isctx = slot < 4; const int t0 = isctx ? slot * 64 : (slot - 4) * 64;
        const int rowbase = isctx ? ML + b * CTXL : b * SEQ;
        u32x4 nxa, nxb, ngt = {0u, 0u, 0u, 0u};
        { const int un = u + G < NB * 68 * 8 ? u + G : u; LR_FETCH(nxa, nxb, ngt, un); }
        if (nblk != cur_nblk) {
            for (int i0 = tid; i0 < 4 * 4096; i0 += 512 * 8) { float wv[8];
#pragma unroll
                for (int k = 0; k < 8; ++k) { const int i = i0 + 512 * k; wv[k] = gw_[((size_t)((i >> 12) * 8 + nblk)) * 4096 + (i & 4095)]; }
#pragma unroll
                for (int k = 0; k < 8; ++k) { const int i = i0 + 512 * k; const int dg = i >> 12, c = (i >> 6) & 63, d = i & 63; wt[(dg * 64 + d) * 72 + c] = (bf16_t)f2bf(wv[k]); } }
            cbv = cb[nblk * 64 + cc];
#pragma unroll
            for (int dir = 0; dir < 2; ++dir)
#pragma unroll
                for (int nt = 0; nt < 2; ++nt) { const int ch = nblk * 64 + 32 * nh + 16 * nt + fr;
                    gbr[dir][nt] = gb_[(dir * 2 + 0) * 512 + ch]; gbi[dir][nt] = gb_[(dir * 2 + 1) * 512 + ch]; gsp[dir][nt] = softplusf_(-lam_[dir * 512 + ch]); }
#pragma unroll
            for (int j = 0; j < 4; ++j) cwv[j] = cw[j * 512 + nblk * 64 + cc];
            cur_nblk = nblk;
        }
        { float f[8]; unpack8(xa, f); *(LAS f32x4*)(xin + rrA * 64 + c8) = (f32x4){f[0], f[1], f[2], f[3]}; *(LAS f32x4*)(xin + rrA * 64 + c8 + 4) = (f32x4){f[4], f[5], f[6], f[7]};
          if (tid < 24) { unpack8(xb, f); *(LAS f32x4*)(xin + rrB * 64 + c8) = (f32x4){f[0], f[1], f[2], f[3]}; *(LAS f32x4*)(xin + rrB * 64 + c8 + 4) = (f32x4){f[4], f[5], f[6], f[7]}; } }
        __syncthreads();
#pragma unroll
        for (int k = 0; k < 8; ++k) { const int t = (tid >> 6) + 8 * k;
            float v = cbv;
#pragma unroll
            for (int j = 0; j < 4; ++j) v += cwv[j] * xin[(t + j) * 64 + cc];
            xc[t * 64 + cc] = v; xcb[t * 72 + cc] = (bf16_t)f2bf(v); }
        __syncthreads();
        {
            f32x4 acc[4][2];
#pragma unroll
            for (int dg = 0; dg < 4; ++dg)
#pragma unroll
                for (int nt = 0; nt < 2; ++nt) acc[dg][nt] = (f32x4){0.f, 0.f, 0.f, 0.f};
            bf16x8 af[2];
#pragma unroll
            for (int ks = 0; ks < 2; ++ks) af[ks] = *(const LAS bf16x8*)(xcb + (16 * mt + fr) * 72 + 32 * ks + 8 * fq);
#pragma unroll
            for (int dg = 0; dg < 4; ++dg)
#pragma unroll
                for (int nt = 0; nt < 2; ++nt)
#pragma unroll
                    for (int ks = 0; ks < 2; ++ks) { const bf16x8 bfm = *(const LAS bf16x8*)(wt + (dg * 64 + 32 * nh + 16 * nt + fr) * 72 + 32 * ks + 8 * fq);
                        acc[dg][nt] = __builtin_amdgcn_mfma_f32_16x16x32_bf16(af[ks], bfm, acc[dg][nt], 0, 0, 0); }
#pragma unroll
            for (int dir = 0; dir < 2; ++dir)
#pragma unroll
                for (int nt = 0; nt < 2; ++nt) { const int d = 32 * nh + 16 * nt + fr, ch = nblk * 64 + d;
                    const float br = gbr[dir][nt], bi = gbi[dir][nt], sp = gsp[dir][nt];
#pragma unroll
                    for (int r = 0; r < 4; ++r) { const int t = 16 * mt + 4 * fq + r;
                        const float rr = fsigmoid(acc[dir * 2 + 0][nt][r] + br), ii = fsigmoid(acc[dir * 2 + 1][nt][r] + bi);
                        const float la = -8.0f * 1.4426950408889634f * rr * sp; const float av = __builtin_amdgcn_exp2f(la);
                        const float uv = __builtin_amdgcn_sqrtf(fmaxf(1.0f - av * av, 0.f)) * (ii * xc[t * 64 + d]);
                        au[((dir * 2 + 0) * 64 + t) * 64 + d] = av; au[((dir * 2 + 1) * 64 + t) * 64 + d] = uv; } }
        }
        __syncthreads();
        {
            const int seg = tid >> 7, dir = (tid >> 6) & 1, c = tid & 63, ch = nblk * 64 + c;
            const LAS float* ap = au + ((dir * 2 + 0) * 64) * 64 + c; LAS float* up = au + ((dir * 2 + 1) * 64) * 64 + c;
            float A = 1.f, H = 0.f;
#pragma unroll 4
            for (int s = seg * 16; s < seg * 16 + 16; ++s) { const int t = dir ? 63 - s : s; const float av = ap[t * 64], uv = up[t * 64]; H = av * H + uv; A *= av; }
            sg[((0 * 4 + seg) * 2 + dir) * 64 + c] = A; sg[((1 * 4 + seg) * 2 + dir) * 64 + c] = H;
            __syncthreads();
            const size_t idx = ((size_t)((b * 2 + dir) * 68 + slot)) * 512 + ch;
            if (PASS == 1) {
                if (seg == 0) { float At = 1.f, Ht = 0.f;
#pragma unroll
                    for (int q = 0; q < 4; ++q) { const float Aq = sg[((0 * 4 + q) * 2 + dir) * 64 + c], Hq = sg[((1 * 4 + q) * 2 + dir) * 64 + c]; Ht = Aq * Ht + Hq; At *= Aq; }
                    TOTA[idx] = At; TOTH[idx] = Ht; }
            } else {
                float Hin = CARRY[idx];
                for (int q = 0; q < seg; ++q) { const float Aq = sg[((0 * 4 + q) * 2 + dir) * 64 + c], Hq = sg[((1 * 4 + q) * 2 + dir) * 64 + c]; Hin = Aq * Hin + Hq; }
#pragma unroll 4
                for (int s = seg * 16; s < seg * 16 + 16; ++s) { const int t = dir ? 63 - s : s; const float av = ap[t * 64], uv = up[t * 64]; Hin = av * Hin + uv; up[t * 64] = Hin; }
            }
        }
        __syncthreads();
        if (PASS == 2) {
            { const int t = rrA; float gt[8], y[8]; unpack8(gt4, gt);
              const LAS float* hf = au + ((0 * 2 + 1) * 64 + t) * 64 + c8; const LAS float* hb = au + ((1 * 2 + 1) * 64 + t) * 64 + c8;
              const f32x4 f0 = *(const LAS f32x4*)(hf), f1 = *(const LAS f32x4*)(hf + 4), b0 = *(const LAS f32x4*)(hb), b1 = *(const LAS f32x4*)(hb + 4);
#pragma unroll
              for (int e = 0; e < 8; ++e) { const float hs = (e < 4 ? f0[e & 3] + b0[e & 3] : f1[e & 3] + b1[e & 3]); const float g = gt[e];
                  y[e] = hs * g * fsigmoid(1.5957691216057308f * (g + 0.044715f * g * g * g)); }
              *(u32x4*)(U + (size_t)(rowbase + t0 + t) * D + 512 + nblk * 64 + c8) = pack8(y); }
            __syncthreads();
        }
        xa = nxa; xb = nxb; gt4 = ngt;
    }
#undef LR_FETCH
}

constexpr int GS_NS = 32, GS_K = 0, GS_Q = 16384, GS_V = 32768, GS_EG = 36864, GS_BTO = 36992, GS_BUF = 37120;
__device__ __forceinline__ void gdn_scan(KA a, LAS unsigned char* lds, int bid, int G, int tid, int wave, int lane) {
    const bf16_t* QN = (const bf16_t*)(a->ws + WS_U); const bf16_t* KN = QN + (size_t)MT * 512; const bf16_t* V = (const bf16_t*)(a->ws + WS_V);
    const float* Gb = (const float*)(a->ws + WS_G); const float* Bt = (const float*)(a->ws + WS_BT);
    for (int u = bid; u < 256; u += G) {
        const int chain = u >> 2, qd = u & 3, b = chain >> 3, h = (chain >> 1) & 3, dir = chain & 1;
        bf16_t* OD = (bf16_t*)(a->ws + (dir ? WS_OB : WS_OF));
        const int kg = lane & 7, cl = (wave & 3) * 8 + (lane >> 3), col = h * 128 + qd * 32 + cl;
        f32x2 S[8];
#pragma unroll
        for (int i = 0; i < 8; ++i) S[i] = (f32x2){0.f, 0.f};
#define GS_ROW(s) ((s) < CTXL ? (ML + b * CTXL + (dir ? CTXL - 1 - (s) : (s))) : (b * SEQ + (dir ? SEQ - 1 - ((s) - CTXL) : ((s) - CTXL))))
        const int lsl = tid >> 4, lc = tid & 15;
        u32x4 rk, rq, rv; float rg = 0.f;
#define GS_LOAD(blk) do { const int s_ = (blk) * GS_NS + lsl; const size_t row_ = (size_t)GS_ROW(s_); \
        rk = *(const u32x4*)(KN + row_ * 512 + h * 128 + lc * 8); rq = *(const u32x4*)(QN + row_ * 512 + h * 128 + lc * 8); \
        if (tid < 128) { const int s2_ = (blk) * GS_NS + (tid >> 2); const size_t r2_ = (size_t)GS_ROW(s2_); rv = *(const u32x4*)(V + r2_ * 512 + h * 128 + qd * 32 + (tid & 3) * 8); } \
        else if (tid < 160) { const int s2_ = (blk) * GS_NS + (tid - 128); rg = expf(Gb[(size_t)GS_ROW(s2_) * 8 + dir * 4 + h]); } \
        else if (tid < 192) { const int s2_ = (blk) * GS_NS + (tid - 160); rg = Bt[(size_t)GS_ROW(s2_) * 8 + dir * 4 + h]; } } while (0)
#define GS_ST8(dst, r) do { float f_[8]; unpack8(r, f_); *(LAS f32x4*)(dst) = (f32x4){f_[0], f_[1], f_[2], f_[3]}; *(LAS f32x4*)((dst) + 16) = (f32x4){f_[4], f_[5], f_[6], f_[7]}; } while (0)
#define GS_STORE(buf) do { LAS unsigned char* p_ = lds + (buf) * GS_BUF; \
        GS_ST8(p_ + GS_K + lsl * 512 + lc * 32, rk); GS_ST8(p_ + GS_Q + lsl * 512 + lc * 32, rq); \
        if (tid < 128) GS_ST8(p_ + GS_V + (tid >> 2) * 128 + (tid & 3) * 32, rv); \
        else if (tid < 160) *(LAS float*)(p_ + GS_EG + (tid - 128) * 4) = rg; \
        else if (tid < 192) *(LAS float*)(p_ + GS_BTO + (tid - 160) * 4) = rg; } while (0)
        GS_LOAD(0); GS_STORE(0);
        __syncthreads();
        constexpr int NBLK = NKV / GS_NS;
        for (int blk = 0; blk < NBLK; ++blk) {
            const bool more = blk + 1 < NBLK;
            if (more) GS_LOAD(blk + 1);
            const LAS unsigned char* p = lds + (blk & 1) * GS_BUF;
            if (wave < 4) {
              f32x4 k4[4], q4[4]; float vv, eg, bt;
#define GS_FETCH(K4, Q4, VV, EG, BT, sl_) do { _Pragma("unroll") for (int i = 0; i < 4; ++i) { K4[i] = *(const LAS f32x4*)(p + GS_K + (sl_) * 512 + kg * 64 + i * 16); Q4[i] = *(const LAS f32x4*)(p + GS_Q + (sl_) * 512 + kg * 64 + i * 16); } \
                VV = *(const LAS float*)(p + GS_V + (sl_) * 128 + cl * 4); EG = *(const LAS float*)(p + GS_EG + (sl_) * 4); BT = *(const LAS float*)(p + GS_BTO + (sl_) * 4); } while (0)
              GS_FETCH(k4, q4, vv, eg, bt, 0);
              bf16_t* odp = OD + (size_t)GS_ROW(blk * GS_NS) * 512 + col; const int ostep = dir ? -512 : 512;
#pragma unroll 2
              for (int sl = 0; sl < GS_NS; ++sl) {
                f32x4 nk4[4], nq4[4]; float nvv, neg, nbt;
                const int sn = sl + 1 < GS_NS ? sl + 1 : sl;
                GS_FETCH(nk4, nq4, nvv, neg, nbt, sn);
                f32x2 pa = {0.f, 0.f}, pb = {0.f, 0.f};
#pragma unroll
                for (int i = 0; i < 4; ++i) { pa += (f32x2){k4[i][0], k4[i][1]} * S[2 * i]; pb += (f32x2){k4[i][2], k4[i][3]} * S[2 * i + 1]; }
                const f32x2 pab = pa + pb; float pp = pab[0] + pab[1];
                pp += dppf(pp, 0); pp += dppf(pp, 1); pp += dppf(pp, 2);
                const float dl = bt * (vv - eg * pp);
                f32x2 oa = {0.f, 0.f}, ob = {0.f, 0.f};
#pragma unroll
                for (int i = 0; i < 4; ++i) {
                    S[2 * i] = S[2 * i] * eg + (f32x2){k4[i][0], k4[i][1]} * dl; S[2 * i + 1] = S[2 * i + 1] * eg + (f32x2){k4[i][2], k4[i][3]} * dl;
                    oa += (f32x2){q4[i][0], q4[i][1]} * S[2 * i]; ob += (f32x2){q4[i][2], q4[i][3]} * S[2 * i + 1]; }
                const f32x2 oab = oa + ob; float oo = oab[0] + oab[1];
                oo += dppf(oo, 0); oo += dppf(oo, 1); oo += dppf(oo, 2);
                if (kg == 0) odp[(ptrdiff_t)sl * ostep] = (bf16_t)f2bf(oo);
#pragma unroll
                for (int i = 0; i < 4; ++i) { k4[i] = nk4[i]; q4[i] = nq4[i]; }
                vv = nvv; eg = neg; bt = nbt;
              }
#undef GS_FETCH
            }
            if (more) GS_STORE((blk + 1) & 1);
            __syncthreads();
        }
#undef GS_ROW
#undef GS_LOAD
#undef GS_STORE
#undef GS_ST8
    }
    { const int gid = bid * 512 + tid;
      if (gid < NB * 2 * 512) { const int ch = gid & 511, dir = (gid >> 9) & 1, b = gid >> 10;
        const float* TOTA = (const float*)(a->ws + WS_TOTA); const float* TOTH = (const float*)(a->ws + WS_TOTH); float* CARRY = (float*)(a->ws + WS_CARRY);
        float carry = 0.f;
        for (int s = 0; s < 68; ++s) { const int slot = dir ? (s < 4 ? 3 - s : 67 - (s - 4)) : s; const size_t idx = ((size_t)((b * 2 + dir) * 68 + slot)) * 512 + ch;
            CARRY[idx] = carry; carry = TOTA[idx] * carry + TOTH[idx]; } } }
}


__device__ __forceinline__ int gs_row(int b, int dir, int s) { return s < CTXL ? (ML + b * CTXL + (dir ? CTXL - 1 - s : s)) : (b * SEQ + (dir ? SEQ - 1 - (s - CTXL) : (s - CTXL))); }
__device__ __forceinline__ float fexp(float x) { return __builtin_amdgcn_exp2f(1.4426950408889634f * x); }
constexpr int CP_WAVE = 64 * 68 * 4 + 512;
__device__ __forceinline__ void gdn_chunk_prep(KA a, LAS unsigned char* lds, int gw, int NGW, int wave, int lane) {
    const bf16_t* QN = (const bf16_t*)(a->ws + WS_U); const bf16_t* KN = QN + (size_t)MT * 512;
    const float* Gb = (const float*)(a->ws + WS_G); const float* Bt = (const float*)(a->ws + WS_BT);
    bf16_t* Tb = (bf16_t*)(a->ws + WS_TB); bf16_t* QKb = (bf16_t*)(a->ws + WS_QKB); float* GAM = (float*)(a->ws + WS_GAM);
    LAS float* Am = (LAS float*)(lds + wave * CP_WAVE); LAS float* gl = Am + 64 * 68; LAS float* bl = gl + 64;
    const int r32 = lane & 31, hi = lane >> 5;
    bf16x8 kf[2][8]; float gi_raw = 0.f, bt_raw = 0.f;
#define CP_FETCH(cu_) do { const int ch_ = (cu_) / 68, n_ = (cu_) % 68, b_ = ch_ >> 3, h_ = (ch_ >> 1) & 3, d_ = ch_ & 1; const int r0_ = gs_row(b_, d_, 64 * n_), rs_ = d_ ? -1 : 1; \
        _Pragma("unroll") for (int blk = 0; blk < 2; ++blk) _Pragma("unroll") for (int ks = 0; ks < 8; ++ks) \
            kf[blk][ks] = *(const bf16x8*)(KN + (size_t)(r0_ + rs_ * (32 * blk + r32)) * 512 + h_ * 128 + 16 * ks + 8 * hi); \
        const size_t rl_ = (size_t)(r0_ + rs_ * lane); gi_raw = Gb[rl_ * 8 + d_ * 4 + h_]; bt_raw = Bt[rl_ * 8 + d_ * 4 + h_]; } while (0)
    if (gw < 64 * 68) CP_FETCH(gw);
    for (int cu = gw; cu < 64 * 68; cu += NGW) {
        const int chain = cu / 68, n = cu % 68, b = chain >> 3, h = (chain >> 1) & 3, dir = chain & 1;
        const int row0 = gs_row(b, dir, 64 * n), rs = dir ? -1 : 1;
        { float gi = gi_raw;
#pragma unroll
          for (int o = 1; o < 64; o <<= 1) { const float t = __shfl_up(gi, o); if (lane >= o) gi += t; }
          gl[lane] = gi; bl[lane] = bt_raw; GAM[(size_t)cu * 64 + lane] = gi; }
        LDS_WAIT();
        const float gj0 = gl[r32], gj1 = gl[32 + r32];
#pragma unroll
        for (int tl = 0; tl < 3; ++tl) { const int mb = tl == 0 ? 0 : 1, nb = tl == 2 ? 1 : 0;
            f32x16 acc;
#pragma unroll
            for (int r = 0; r < 16; ++r) acc[r] = 0.f;
#pragma unroll
            for (int ks = 0; ks < 8; ++ks) acc = __builtin_amdgcn_mfma_f32_32x32x16_bf16(kf[mb][ks], kf[nb][ks], acc, 0, 0, 0);
            const int j = 32 * nb + r32; const float gj = nb ? gj1 : gj0;
#pragma unroll
            for (int q = 0; q < 4; ++q) { const int i0 = 32 * mb + 8 * q + 4 * hi; const f32x4 gmi = *(const LAS f32x4*)(gl + i0), bti = *(const LAS f32x4*)(bl + i0);
#pragma unroll
                for (int e = 0; e < 4; ++e) { const int i = i0 + e; Am[i * 68 + j] = (i > j) ? bti[e] * acc[4 * q + e] * fexp(gmi[e] - gj) : 0.f; } }
        }
        asm volatile("" ::: "memory");
        {
            bf16_t* qko = QKb + (size_t)cu * 4096;
#pragma unroll
            for (int mb = 0; mb < 2; ++mb) {
                bf16x8 qf[8];
#pragma unroll
                for (int ks = 0; ks < 8; ++ks) qf[ks] = *(const bf16x8*)(QN + (size_t)(row0 + rs * (32 * mb + r32)) * 512 + h * 128 + 16 * ks + 8 * hi);
#pragma unroll
                for (int nb = 0; nb <= mb; ++nb) {
                    f32x16 acc;
#pragma unroll
                    for (int r = 0; r < 16; ++r) acc[r] = 0.f;
#pragma unroll
                    for (int ks = 0; ks < 8; ++ks) acc = __builtin_amdgcn_mfma_f32_32x32x16_bf16(qf[ks], kf[nb][ks], acc, 0, 0, 0);
                    const int j = 32 * nb + r32; const float gj = nb ? gj1 : gj0;
#pragma unroll
                    for (int q = 0; q < 4; ++q) { const int i0 = 32 * mb + 8 * q + 4 * hi; const f32x4 gmi = *(const LAS f32x4*)(gl + i0);
#pragma unroll
                        for (int e = 0; e < 4; ++e) { const int i = i0 + e; qko[i * 64 + j] = (bf16_t)f2bf((i >= j) ? acc[4 * q + e] * fexp(gmi[e] - gj) : 0.f); } }
                }
                asm volatile("" ::: "memory");
            }
#pragma unroll
            for (int q = 0; q < 4; ++q)
#pragma unroll
                for (int e = 0; e < 4; ++e) qko[(8 * q + 4 * hi + e) * 64 + 32 + r32] = (bf16_t)0;
        }
        asm volatile("" ::: "memory");
        LDS_WAIT();
        { const int cn = cu + NGW < 64 * 68 ? cu + NGW : cu; CP_FETCH(cn); }
        {
            float Tc[64]; int ln = lane;
#pragma unroll
            for (int i = 0; i < 64; ++i) {
                if ((i & 3) == 0) asm volatile("" : "+v"(ln));
                float acc = (i == ln) ? 1.f : 0.f, acc1 = 0.f;
#pragma unroll
                for (int jj = 0; jj < (i + 3) / 4; ++jj) { const f32x4 a4 = *(const LAS f32x4*)(Am + i * 68 + 4 * jj);
#pragma unroll
                    for (int e = 0; e < 4; ++e) if (4 * jj + e < i) { if (e & 1) acc1 -= a4[e] * Tc[4 * jj + e]; else acc -= a4[e] * Tc[4 * jj + e]; } }
                Tc[i] = acc + acc1;
                if ((i & 1) == 1) asm volatile("" ::: "memory");
            }
            bf16_t* to = Tb + (size_t)cu * 4096 + lane;
#pragma unroll
            for (int i = 0; i < 64; ++i) to[i * 64] = (bf16_t)f2bf(Tc[i]);
        }
        LDS_WAIT();
    }
#undef CP_FETCH
}

constexpr int CS_KN = 0, CS_QN = 17408, CS_KT = 34816, CS_T = 53248, CS_QK = 62464, CS_VT = 71680, CS_GB = 76288, CS_ST = 77312, CS_RT = 86016, CS_VNT = 90624, CS_VDT = 95232, CS_END = 99840;
__device__ __forceinline__ void cs_compute(LAS unsigned char* lds, int wave, int r32, int hi, f32x16& acc, f32x16& Sreg, bf16_t* op, int row0, int rs) {
    const LAS float* gamL = (const LAS float*)(lds + CS_GB); const LAS float* betL = gamL + 64;
    const int mb = wave & 1;
    if (wave < 4) {
        const LAS unsigned char* X = lds + ((wave >> 1) ? CS_QN : CS_KN) + (32 * mb + r32) * 272 + 16 * hi; const LAS unsigned char* Sb = lds + CS_ST + r32 * 272 + 16 * hi;
#pragma unroll
        for (int r = 0; r < 16; ++r) acc[r] = 0.f;
#pragma unroll
        for (int ks = 0; ks < 8; ++ks) acc = __builtin_amdgcn_mfma_f32_32x32x16_bf16(*(const LAS bf16x8*)(X + 32 * ks), *(const LAS bf16x8*)(Sb + 32 * ks), acc, 0, 0, 0);
    }
    if (wave < 2) {
#pragma unroll
        for (int q = 0; q < 4; ++q) { const int t0 = 32 * mb + 8 * q + 4 * hi; const f32x4 gm = *(const LAS f32x4*)(gamL + t0), bt = *(const LAS f32x4*)(betL + t0);
            const u32x2 vv = *(const LAS u32x2*)(lds + CS_VT + r32 * 144 + t0 * 2);
            const float v0 = __uint_as_float(vv.x << 16), v1 = __uint_as_float(vv.x & 0xffff0000u), v2 = __uint_as_float(vv.y << 16), v3 = __uint_as_float(vv.y & 0xffff0000u);
            u32x2 w; w.x = pk2(bt[0] * (v0 - fexp(gm[0]) * acc[4 * q]), bt[1] * (v1 - fexp(gm[1]) * acc[4 * q + 1]));
            w.y = pk2(bt[2] * (v2 - fexp(gm[2]) * acc[4 * q + 2]), bt[3] * (v3 - fexp(gm[3]) * acc[4 * q + 3]));
            *(LAS u32x2*)(lds + CS_RT + r32 * 144 + t0 * 2) = w; }
    }
    __syncthreads();
    if (wave < 2) {
        f32x16 vn;
#pragma unroll
        for (int r = 0; r < 16; ++r) vn[r] = 0.f;
        const LAS unsigned char* Ta = lds + CS_T + (32 * mb + r32) * 144 + 16 * hi; const LAS unsigned char* Rb = lds + CS_RT + r32 * 144 + 16 * hi;
#pragma unroll
        for (int ks = 0; ks < 4; ++ks) vn = __builtin_amdgcn_mfma_f32_32x32x16_bf16(*(const LAS bf16x8*)(Ta + 32 * ks), *(const LAS bf16x8*)(Rb + 32 * ks), vn, 0, 0, 0);
        const float glast = gamL[63];
#pragma unroll
        for (int q = 0; q < 4; ++q) { const int t0 = 32 * mb + 8 * q + 4 * hi; const f32x4 gm = *(const LAS f32x4*)(gamL + t0);
            u32x2 w; w.x = pk2(vn[4 * q], vn[4 * q + 1]); w.y = pk2(vn[4 * q + 2], vn[4 * q + 3]);
            *(LAS u32x2*)(lds + CS_VNT + r32 * 144 + t0 * 2) = w;
            w.x = pk2(vn[4 * q] * fexp(glast - gm[0]), vn[4 * q + 1] * fexp(glast - gm[1])); w.y = pk2(vn[4 * q + 2] * fexp(glast - gm[2]), vn[4 * q + 3] * fexp(glast - gm[3]));
            *(LAS u32x2*)(lds + CS_VDT + r32 * 144 + t0 * 2) = w; }
    }
    __syncthreads();
    if (wave == 2 || wave == 3) {
#pragma unroll
        for (int q = 0; q < 4; ++q) { const int t0 = 32 * mb + 8 * q + 4 * hi; const f32x4 gm = *(const LAS f32x4*)(gamL + t0);
#pragma unroll
            for (int e = 0; e < 4; ++e) acc[4 * q + e] *= fexp(gm[e]); }
        const LAS unsigned char* Qa = lds + CS_QK + (32 * mb + r32) * 144 + 16 * hi; const LAS unsigned char* Vb = lds + CS_VNT + r32 * 144 + 16 * hi;
#pragma unroll
        for (int ks = 0; ks < 4; ++ks) acc = __builtin_amdgcn_mfma_f32_32x32x16_bf16(*(const LAS bf16x8*)(Qa + 32 * ks), *(const LAS bf16x8*)(Vb + 32 * ks), acc, 0, 0, 0);
#pragma unroll
        for (int r = 0; r < 16; ++r) { const int tok = 32 * mb + (r & 3) + 8 * (r >> 2) + 4 * hi; op[(ptrdiff_t)(row0 + rs * tok) * 512] = (bf16_t)f2bf(acc[r]); }
    } else if (wave >= 4) {
        const int mk = wave - 4; const float cd = fexp(gamL[63]);
#pragma unroll
        for (int r = 0; r < 16; ++r) Sreg[r] *= cd;
        const LAS unsigned char* Ka = lds + CS_KT + (32 * mk + r32) * 144 + 16 * hi; const LAS unsigned char* Db = lds + CS_VDT + r32 * 144 + 16 * hi;
#pragma unroll
        for (int ks = 0; ks < 4; ++ks) Sreg = __builtin_amdgcn_mfma_f32_32x32x16_bf16(*(const LAS bf16x8*)(Ka + 32 * ks), *(const LAS bf16x8*)(Db + 32 * ks), Sreg, 0, 0, 0);
#pragma unroll
        for (int q = 0; q < 4; ++q) { u32x2 w; w.x = pk2(Sreg[4 * q], Sreg[4 * q + 1]); w.y = pk2(Sreg[4 * q + 2], Sreg[4 * q + 3]);
            *(LAS u32x2*)(lds + CS_ST + r32 * 272 + (32 * mk + 8 * q + 4 * hi) * 2) = w; }
    }
    __syncthreads();
}
__device__ __forceinline__ void gdn_chunk_scan(KA a, LAS unsigned char* lds, int bid, int G, int tid, int wave, int lane) {
    const bf16_t* QN = (const bf16_t*)(a->ws + WS_U); const bf16_t* KN = QN + (size_t)MT * 512; const bf16_t* V = (const bf16_t*)(a->ws + WS_V);
    const float* Bt = (const float*)(a->ws + WS_BT);
    const bf16_t* Tb = (const bf16_t*)(a->ws + WS_TB); const bf16_t* QKb = (const bf16_t*)(a->ws + WS_QKB); const float* GAM = (const float*)(a->ws + WS_GAM);
    const int r32 = lane & 31, hi = lane >> 5;
    for (int u = bid; u < 256; u += G) {
        const int chain = (u & 7) * 8 + (u >> 5), qd = (u >> 3) & 3;
        const int b = chain >> 3, h = (chain >> 1) & 3, dir = chain & 1, rs = dir ? -1 : 1;
        bf16_t* op = (bf16_t*)(a->ws + (dir ? WS_OB : WS_OF)) + h * 128 + qd * 32 + r32;
        u32x4 rkA[2], rqA[2], rTA, rQKA, rVA; float rgbA = 0.f;
        u32x4 rkB[2], rqB[2], rTB, rQKB, rVB; float rgbB = 0.f;
#define CS_LOAD(S_, n_) do { const int row0_ = gs_row(b, dir, 64 * (n_)); const size_t cu_ = (size_t)(chain * 68 + (n_)); const size_t rowl_ = (size_t)(row0_ + rs * lane); \
        _Pragma("unroll") for (int i_ = 0; i_ < 2; ++i_) { const int c16_ = wave + 8 * i_; \
            rk##S_[i_] = *(const u32x4*)(KN + rowl_ * 512 + h * 128 + c16_ * 8); rq##S_[i_] = *(const u32x4*)(QN + rowl_ * 512 + h * 128 + c16_ * 8); } \
        rT##S_ = *(const u32x4*)(Tb + cu_ * 4096 + tid * 8); rQK##S_ = *(const u32x4*)(QKb + cu_ * 4096 + tid * 8); \
        if (wave < 4) rV##S_ = *(const u32x4*)(V + rowl_ * 512 + h * 128 + qd * 32 + wave * 8); \
        if (tid < 64) rgb##S_ = GAM[cu_ * 64 + tid]; else if (tid < 128) rgb##S_ = Bt[(size_t)(row0_ + rs * (tid - 64)) * 8 + dir * 4 + h]; } while (0)
#define CS_T16(base, v, col0, tok) do { const unsigned w_[4] = {(v).x, (v).y, (v).z, (v).w}; _Pragma("unroll") for (int e_ = 0; e_ < 8; ++e_) \
        *(LAS bf16_t*)(lds + (base) + ((col0) + e_) * 144 + (tok) * 2) = (bf16_t)((e_ & 1) ? (w_[e_ >> 1] >> 16) : (w_[e_ >> 1] & 0xffffu)); } while (0)
#define CS_STORE(S_) do { \
        _Pragma("unroll") for (int i_ = 0; i_ < 2; ++i_) { const int c16_ = wave + 8 * i_; \
            *(LAS u32x4*)(lds + CS_KN + lane * 272 + c16_ * 16) = rk##S_[i_]; *(LAS u32x4*)(lds + CS_QN + lane * 272 + c16_ * 16) = rq##S_[i_]; CS_T16(CS_KT, rk##S_[i_], c16_ * 8, lane); } \
        *(LAS u32x4*)(lds + CS_T + (tid >> 3) * 144 + (tid & 7) * 16) = rT##S_; *(LAS u32x4*)(lds + CS_QK + (tid >> 3) * 144 + (tid & 7) * 16) = rQK##S_; \
        if (wave < 4) CS_T16(CS_VT, rV##S_, wave * 8, lane); \
        if (tid < 128) *(LAS float*)(lds + CS_GB + tid * 4) = rgb##S_; } while (0)
        CS_LOAD(A, 0);
        for (int i = tid; i < 32 * 272 / 4; i += 512) *(LAS unsigned*)(lds + CS_ST + i * 4) = 0u;
        CS_STORE(A);
        __syncthreads();
        CS_LOAD(A, 1);
        f32x16 Sreg, acc;
#pragma unroll
        for (int r = 0; r < 16; ++r) { Sreg[r] = 0.f; acc[r] = 0.f; }
        for (int n = 0; n < 68; n += 2) {
            if (n + 2 < 68) CS_LOAD(B, n + 2);
            cs_compute(lds, wave, r32, hi, acc, Sreg, op, gs_row(b, dir, 64 * n), rs);
            CS_STORE(A);
            __syncthreads();
            if (n + 3 < 68) CS_LOAD(A, n + 3);
            cs_compute(lds, wave, r32, hi, acc, Sreg, op, gs_row(b, dir, 64 * (n + 1)), rs);
            if (n + 2 < 68) CS_STORE(B);
            __syncthreads();
        }
#undef CS_LOAD
#undef CS_T16
#undef CS_STORE
    }
    if (wave == 0 && lane < 32) {
      const float* TOTA = (const float*)(a->ws + WS_TOTA); const float* TOTH = (const float*)(a->ws + WS_TOTH); float* CARRY = (float*)(a->ws + WS_CARRY);
      for (int gid = bid * 32 + lane; gid < NB * 2 * 512; gid += G * 32) { const int ch = gid & 511, dir = (gid >> 9) & 1, b = gid >> 10;
        float carry = 0.f;
        for (int s0 = 0; s0 < 68; s0 += 17) {
            float ta[17], th[17];
#pragma unroll
            for (int k = 0; k < 17; ++k) { const int s = s0 + k; const int slot = dir ? (s < 4 ? 3 - s : 67 - (s - 4)) : s; const size_t idx = ((size_t)((b * 2 + dir) * 68 + slot)) * 512 + ch; ta[k] = TOTA[idx]; th[k] = TOTH[idx]; }
#pragma unroll
            for (int k = 0; k < 17; ++k) { const int s = s0 + k; const int slot = dir ? (s < 4 ? 3 - s : 67 - (s - 4)) : s; const size_t idx = ((size_t)((b * 2 + dir) * 68 + slot)) * 512 + ch; CARRY[idx] = carry; carry = ta[k] * carry + th[k]; }
        } } }
}

__device__ __forceinline__ void gdn_merge(KA a, int L, int gw, int NGW, int lane) {
    const int j2 = L >> 1;
    const bf16_t* P = (const bf16_t*)(a->ws + WS_P); bf16_t* U = (bf16_t*)(a->ws + WS_U);
    const bf16_t* OF = (const bf16_t*)(a->ws + WS_OF); const bf16_t* OB = (const bf16_t*)(a->ws + WS_OB);
    const float* gn = a->in[I_EVGDNNORM] + j2 * 128 + ((8 * lane) & 127);
    float g8[8];
#pragma unroll
    for (int e = 0; e < 8; ++e) g8[e] = gn[e];
    for (int row = gw; row < MT; row += NGW) {
        float of[8], ob[8], z[8], y[8];
        unpack8(*(const u32x4*)(OF + (size_t)row * 512 + 8 * lane), of); unpack8(*(const u32x4*)(OB + (size_t)row * 512 + 8 * lane), ob);
        unpack8(*(const u32x4*)(P + (size_t)row * EVNP + 1536 + 8 * lane), z);
        float ssq = 0.f;
#pragma unroll
        for (int e = 0; e < 8; ++e) { of[e] += ob[e]; ssq += of[e] * of[e]; }
        ssq = rowsum16(ssq);
        const float rms = 1.0f / sqrtf(ssq * (1.f / 128.f) + EPS);
#pragma unroll
        for (int e = 0; e < 8; ++e) y[e] = of[e] * rms * g8[e] * fsilu(z[e]);
        *(u32x4*)(U + (size_t)row * D + 8 * lane) = pack8(y);
    }
}


#define XB_TMO      128
#define XB_XCNT(j)  (256  + 64 * (j))
#define XB_XSUB(j)  (1280 + 64 * (j))
#define XB_XGEN(j)  (2304 + 64 * (j))
#define XB_TOP      3328
#define XB_TOPGEN   3392
#define XCD_BAR_WORDS 3456
#define XB_SPIN_CAP (1u << 20)
__device__ __forceinline__ unsigned xb_ld(unsigned* p)              { return __hip_atomic_load(p, __ATOMIC_RELAXED, __HIP_MEMORY_SCOPE_AGENT); }
__device__ __forceinline__ unsigned xb_add(unsigned* p, unsigned v) { return __hip_atomic_fetch_add(p, v, __ATOMIC_RELAXED, __HIP_MEMORY_SCOPE_AGENT); }
__device__ __forceinline__ unsigned xb_xcc_id() { return (unsigned)__builtin_amdgcn_s_getreg((3 << 11) | 20) & 0xFu; }
#define XB_SPIN(cond, bar) do { unsigned _sp = 0; while (cond) { __builtin_amdgcn_s_sleep(1); \
    if ((++_sp & 255u) == 0u) { if (xb_ld(&(bar)[XB_TMO])) break; if (_sp > XB_SPIN_CAP) { atomicAdd(&(bar)[XB_TMO], 1u); break; } } } } while (0)
struct XcdBarrier { unsigned* bar; unsigned x; volatile LAS unsigned* st; };
__device__ __forceinline__ XcdBarrier xcd_barrier_post(unsigned* bar, volatile LAS unsigned* st) {
    XcdBarrier b; b.bar = bar; b.x = xb_xcc_id(); b.st = st;
    if (threadIdx.x == 0) (void)xb_add(&bar[XB_XCNT(b.x)], 1u);
    return b;
}
__device__ __forceinline__ void xcd_barrier_complete(unsigned* bar, unsigned x, unsigned& nloc, unsigned& nx) {
    const unsigned G = gridDim.x * gridDim.y * gridDim.z;
    unsigned sum, cnt, mine, sp = 0u;
    for (;;) {
        sum = 0u; cnt = 0u; mine = 0u;
#pragma unroll
        for (unsigned j = 0; j < 16; ++j) { const unsigned c = xb_ld(&bar[XB_XCNT(j)]); sum += c; cnt += (c > 0u) ? 1u : 0u; mine = (j == x) ? c : mine; }
        if (sum == G) break;
        __builtin_amdgcn_s_sleep(1);
        if ((++sp & 255u) == 0u) { if (xb_ld(&bar[XB_TMO])) break; if (sp > XB_SPIN_CAP) { atomicAdd(&bar[XB_TMO], 1u); break; } }
    }
    nloc = mine > 0u ? mine : 1u; nx = cnt > 0u ? cnt : 1u;
}
__device__ __forceinline__ void xcd_barrier(const XcdBarrier& b) {
    asm volatile("s_waitcnt vmcnt(0)" ::: "memory");
    __syncthreads();
    if (threadIdx.x == 0) {
        unsigned* bar = b.bar;
        __builtin_amdgcn_s_waitcnt(0);
        unsigned nloc = b.st[0], nx = b.st[1];
        if (nloc == 0u) { xcd_barrier_complete(bar, b.x, nloc, nx); b.st[0] = nloc; b.st[1] = nx; }
        const unsigned old = xb_add(&bar[XB_XSUB(b.x)], 1u);
        const unsigned gen = old / nloc;
        if (old + 1u == (gen + 1u) * nloc) {
            __builtin_amdgcn_fence(__ATOMIC_RELEASE, "agent");
            asm volatile("s_waitcnt vmcnt(0)" ::: "memory");
            const unsigned og = xb_add(&bar[XB_TOP], 1u);
            const unsigned tg = og / nx;
            if (og + 1u == (tg + 1u) * nx) xb_add(&bar[XB_TOPGEN], 1u);
            else XB_SPIN(xb_ld(&bar[XB_TOPGEN]) == tg, bar);
            __builtin_amdgcn_fence(__ATOMIC_ACQUIRE, "agent");
            xb_add(&bar[XB_XGEN(b.x)], 1u);
            asm volatile("s_waitcnt vmcnt(0)" ::: "memory");
        } else {
            XB_SPIN(xb_ld(&bar[XB_XGEN(b.x)]) == gen, bar);
            __builtin_amdgcn_fence(__ATOMIC_ACQUIRE, "agent");
            asm volatile("s_waitcnt vmcnt(0)" ::: "memory");
        }
    }
    __syncthreads();
}

__device__ __forceinline__ void decode_phase(int ph, int& L, int& kind) {
    if (ph == 0) { L = 0; kind = K_PROA; return; }
    if (ph == 1) { L = 0; kind = K_PROB; return; }
    int p = ph - 2;
    if (p < 10) { L = 0; } else if (p < 18) { L = 1; p -= 10; } else if (p < 28) { L = 2; p -= 18; } else { L = 3; p -= 28; }
    if ((L & 1) == 0) { kind = p == 0 ? K_PROJ : p == 1 ? K_E2 : p == 2 ? K_E2B : p == 3 ? K_E3 : p == 4 ? K_E4 : p == 5 ? K_WOUT : p == 6 ? K_LN1 : p == 7 ? K_MLP1 : p == 8 ? K_MLP2 : K_LN2; }
    else { kind = p == 0 ? K_PROJ : p == 1 ? K_O2 : p == 2 ? K_O3 : p == 3 ? K_WOUT : p == 4 ? K_LN1 : p == 5 ? K_MLP1 : p == 6 ? K_MLP2 : K_LN2; }
}

#ifndef MK_DUP_GEMM
#define MK_DUP_GEMM 0
#endif
#ifndef MK_DUP_KIND
#define MK_DUP_KIND -1
#endif
#ifndef MK_SKIP1
#define MK_SKIP1 1
#endif
#ifndef MK_K2
#define MK_K2 1024
#endif
#ifndef MK_PHM
#define MK_PHM 0xffffu
#endif
#define EN(k) ((MK_PHM >> (k)) & 1u)
__global__ void __launch_bounds__(512, 2) fwd_kernel(Args args) {
    extern __shared__ __attribute__((aligned(16))) unsigned char lds_raw[];
    LAS unsigned char* lds = (LAS unsigned char*)lds_raw;
    cg::grid_group grid = cg::this_grid();
    const int G = gridDim.x;
    volatile LAS unsigned* bst = (volatile LAS unsigned*)(lds + LDS_BYTES - 16);
    if (threadIdx.x < 2) bst[threadIdx.x] = 0u;
    __syncthreads();
    const XcdBarrier xbar = xcd_barrier_post((unsigned*)(args.ws + WS_BAR), bst);
    const int ph_lo = args.ph_lo, ph_hi = args.ph_hi;
    bool second = false;
    for (int ph = ph_lo; ph < ph_hi; ) {
        KA a = (KA)__builtin_amdgcn_kernarg_segment_ptr(); asm volatile("" : "+s"(a));
        int tid = threadIdx.x; asm volatile("" : "+v"(tid));
        int bid = blockIdx.x; asm volatile("" : "+s"(bid));
        const int lane = tid & 63, wave = __builtin_amdgcn_readfirstlane(tid >> 6), gw = bid * 8 + wave, NGW = G * 8;
        bf16_t* U = (bf16_t*)(a->ws + WS_U); bf16_t* P = (bf16_t*)(a->ws + WS_P); float* HC = (float*)(a->ws + WS_HC);
        const float* MOD = (const float*)(a->ws + WS_MOD);
        int L, kind; decode_phase(ph, L, kind);
        const bool even = (L & 1) == 0; const bool last = L == 3;
        const int Mrows = last ? ML : MT;
        const bool isgemm = kind == K_PROJ || kind == K_MLP1 || kind == K_WOUT || kind == K_MLP2;
        const bool dup = (MK_DUP_GEMM && isgemm) || kind == MK_DUP_KIND;
        if (EN(K_PROA) && kind == K_PROA) prologue_a(a, lds, bid, G, tid, wave, lane);
        else if (EN(K_PROB) && kind == K_PROB) prologue_b(a, gw, NGW, lane);
        else if (EN(K_PROJ) && (kind == K_PROJ || kind == K_MLP1 || kind == K_WOUT || kind == K_MLP2)) {
            const float* modL = MOD + (size_t)L * 9 * 6144;
            const bool split = (kind == K_WOUT || kind == K_MLP2) && !last;
            const int ncall = split ? 2 : 1;
            for (int call = 0; call < ncall; ++call) {
                pg8::Gemm g; pg8::EpiBf16 E;
                if (kind == K_PROJ) { g = pg8::Gemm{U, (const bf16_t*)(a->ws + WS_WA), MT, even ? EVNP : ODN, D, D, D, 1}; E = pg8::EpiBf16{P, even ? EVNP : ODN, 0, nullptr, -1, 0}; }
                else if (kind == K_MLP1) { g = pg8::Gemm{U, (const bf16_t*)(a->ws + WS_W1), Mrows, FF, D, D, D, 1}; E = pg8::EpiBf16{P, FF, 2, nullptr, -1, 0}; }
                else if (kind == K_WOUT) { const bf16_t* A = even ? U : P; const int lda = even ? D : ODN;
                    if (call == 0) { g = pg8::Gemm{A, (const bf16_t*)(a->ws + WS_WO), ML, D, D, lda, D, 1}; E = pg8::EpiBf16{even ? P : U, D, 0, modL + 2 * D, -1, 0}; }
                    else { g = pg8::Gemm{A + (size_t)ML * lda, (const bf16_t*)(a->ws + WS_WO), MC, D, D / 4, lda, D, 4}; E = pg8::EpiBf16{(bf16_t*)(a->ws + WS_PART), D, 0, modL + 2 * D, 8, (size_t)MC * D}; } }
                else { if (call == 0) { g = pg8::Gemm{P, (const bf16_t*)(a->ws + WS_W2), ML, D, FF, FF, FF, 1}; E = pg8::EpiBf16{U, D, 0, modL + 5 * D, -1, 0}; }
                    else { g = pg8::Gemm{P + (size_t)ML * FF, (const bf16_t*)(a->ws + WS_W2), MC, D, FF / 8, FF, FF, 8}; E = pg8::EpiBf16{(bf16_t*)(a->ws + WS_PART), D, 0, modL + 5 * D, 8, (size_t)MC * D}; } }
                pg8::StaticOrder S; S.init(g.M, g.N, G, bid, g.nks);
                pg8::gemm_phase<pg8::EpiBf16>(lds, g, S, E, tid);
            }
        }
        else if (EN(K_LN1) && kind == K_LN1) ln_pass(a, L, 0, Mrows, true, L, 3, even ? P : U, last ? 0 : 4, gw, NGW, lane);
        else if (EN(K_LN2) && kind == K_LN2) {
            ln_pass(a, L, 1, Mrows, !last, L + 1, 0, U, last ? 0 : 8, gw, NGW, lane);
            if (!last) conv_weights(a, L + 1, lds, gw, NGW, wave, lane);
        }
        else if (EN(K_E2) && kind == K_E2) { gdn_prep(a, L, lds, gw, NGW, tid, lane); lru_units<1>(a, L, lds, bid, G, tid); }
        else if (EN(K_E2B) && kind == K_E2B) gdn_chunk_prep(a, lds, gw, NGW, wave, lane);
        else if (EN(K_E3) && kind == K_E3) gdn_chunk_scan(a, lds, bid, G, tid, wave, lane);
        else if (EN(K_E4) && kind == K_E4) { gdn_merge(a, L, gw, NGW, lane); lru_units<2>(a, L, lds, bid, G, tid); }
        else if (EN(K_O2) && kind == K_O2) attn_prep(a, lds, bid, G, tid);
        else if (EN(K_O3) && kind == K_O3) attn_phase(a, L, lds, bid, G, tid, wave, lane, !dup || second);
        if (dup && !second) { second = true; grid.sync(); continue; }
        second = false; ++ph;
        if (ph < ph_hi) { if (ph_hi > 1000) grid.sync(); else xcd_barrier(xbar); }
    }
}

#ifndef MK_PH_HI
#define MK_PH_HI N_PHASES
#endif
#ifndef MK_PER_PHASE
#define MK_PER_PHASE 0
#endif
extern "C" void kernel_launch(void* const* d_in, const int* in_sizes, int n_in, void* d_out, int out_size, void* d_ws, size_t ws_size, hipStream_t stream) {
    static int grid = 0;
    if (grid == 0) {
        if (n_in != 24 || ws_size < WS_END) { fprintf(stderr, "kernel_launch: unexpected n_in %d / ws_size %zu\n", n_in, ws_size); grid = -1; return; }
        int dev = 0, cus = 0, per_cu = 0;
        (void)hipGetDevice(&dev); (void)hipDeviceGetAttribute(&cus, hipDeviceAttributeMultiprocessorCount, dev);
        if (hipFuncSetAttribute((const void*)fwd_kernel, hipFuncAttributeMaxDynamicSharedMemorySize, LDS_BYTES) != hipSuccess) { fprintf(stderr, "kernel_launch: hipFuncSetAttribute failed\n"); grid = -1; return; }
        (void)hipOccupancyMaxActiveBlocksPerMultiprocessor(&per_cu, (const void*)fwd_kernel, 512, LDS_BYTES);
        (void)hipGetLastError();
        if (per_cu < 1) per_cu = 1;
        grid = cus;
        fprintf(stderr, "kernel_launch: cus %d per_cu %d grid %d\n", cus, per_cu, grid);
    }
    if (grid < 0) return;
    Args a{};
    for (int i = 0; i < 24; ++i) a.in[i] = (const float*)d_in[i];
    a.out = (float*)d_out; a.ws = (unsigned char*)d_ws;
#if MK_PER_PHASE
    for (int ph = 0; ph < N_PHASES; ++ph) { a.ph_lo = ph; a.ph_hi = ph + 1; hipLaunchKernelGGL(fwd_kernel, dim3(grid), dim3(512), LDS_BYTES, stream, a); }
#else
    a.ph_lo = 0; a.ph_hi = MK_PH_HI;
    (void)hipMemsetAsync((unsigned char*)d_ws + WS_BAR, 0, 16384, stream);
    void* args[] = {&a};
    hipError_t e = hipLaunchCooperativeKernel((const void*)fwd_kernel, dim3(grid), dim3(512), args, LDS_BYTES, stream);
    if (e != hipSuccess) fprintf(stderr, "kernel_launch: cooperative launch failed: %s (grid %d)\n", hipGetErrorString(e), grid);
#endif
}
```
